# Optimizing an MI355X kernel written in HIP

```python
import math
import jax, jax.numpy as jnp
from jax import lax
import numpy as np

D_MODEL = 1024
BATCH = 4
SEQ = 8192
DEPTH = 2

RET_HEADS = 4
RET_DK = 64
RET_DV = 128
RET_THETA = 10000.0
ATT_HEADS = 4
ATT_DIM = 64
ROPE_THETA = 500000.0
ROPE_DIMS = ATT_DIM // 4
DILATED_BRANCHES = ((128, 1), (512, 4), (2048, 16))
ATT_BLOCK = 128
MLSTM_HEADS = 4
MLSTM_DIM = 64
CONV_WIDTH = 4
CHUNK = 128
MIX_WIDTH = RET_HEADS * RET_DV + ATT_HEADS * ATT_DIM + MLSTM_HEADS * MLSTM_DIM
IN_SPLITS = (RET_HEADS * RET_DK, RET_HEADS * RET_DK, RET_HEADS * RET_DV, RET_HEADS * RET_DV,
             ATT_HEADS * ATT_DIM, ATT_HEADS * ATT_DIM, ATT_HEADS * ATT_DIM,
             MLSTM_HEADS * MLSTM_DIM, MLSTM_HEADS * MLSTM_DIM, MLSTM_HEADS * MLSTM_DIM,
             MLSTM_HEADS * MLSTM_DIM, MLSTM_HEADS, MLSTM_HEADS)
W_IN_COLS = sum(IN_SPLITS)
PEER_HEADS = 8
PEER_NKEYS = 128
PEER_EXPERTS = PEER_NKEYS * PEER_NKEYS
PEER_QDIM = 256
PEER_TOPK = 16
PEER_TOKEN_BLOCK = 128
PLE_DIM = 256
DN_ALPHA = (2 * DEPTH) ** 0.25
DN_BETA = (8 * DEPTH) ** -0.25
LN_EPS = 1e-5

kernel_name = "hybrid_ret_dilattn_mlstm_peer_deepnorm"


def layer_norm(x, g, b):
    xf = x.astype(jnp.float32)
    mu = jnp.mean(xf, -1, keepdims=True)
    var = jnp.mean(jnp.square(xf - mu), -1, keepdims=True)
    return ((xf - mu) * lax.rsqrt(var + LN_EPS) * g + b).astype(x.dtype)


def head_norm(x, g):
    mu = jnp.mean(x, -1, keepdims=True)
    var = jnp.mean(jnp.square(x - mu), -1, keepdims=True)
    return (x - mu) * lax.rsqrt(var + LN_EPS) * g.astype(jnp.float32).reshape(x.shape[-2:])


def rotate(x, pos, n_rot, theta):
    half = n_rot // 2
    inv = theta ** (-jnp.arange(half, dtype=jnp.float32) / half)
    ang = pos.astype(jnp.float32)[:, None] * inv[None, :]
    cos, sin = jnp.cos(ang)[:, None, :], jnp.sin(ang)[:, None, :]
    x1, x2 = x[..., :half], x[..., half:n_rot]
    rot = jnp.concatenate([x1 * cos - x2 * sin, x2 * cos + x1 * sin], -1)
    return jnp.concatenate([rot, x[..., n_rot:]], -1)


def causal_depthwise_conv(x, w):
    C = x.shape[-1]
    return lax.conv_general_dilated(x, w[:, None, :].astype(x.dtype), window_strides=(1,),
                                    padding=[(CONV_WIDTH - 1, 0)],
                                    dimension_numbers=("NWC", "WIO", "NWC"),
                                    feature_group_count=C)


def retention(q, k, v):
    B, S, H, dk = q.shape
    nC, L = S // CHUNK, CHUNK
    lg = jnp.log(1.0 - 2.0 ** (-5.0 - jnp.arange(H, dtype=jnp.float32)))

    def chunks(t):
        return t.reshape(B, nC, L, H, -1).transpose(0, 3, 1, 2, 4)

    qc, kc, vc = chunks(q), chunks(k) * dk ** -0.5, chunks(v)
    t = jnp.arange(L, dtype=jnp.float32)
    diff = t[:, None] - t[None, :]
    decay = jnp.where(diff >= 0, jnp.exp(lg[:, None, None] * jnp.maximum(diff, 0.0)), 0.0)
    scores = jnp.einsum('bhctk,bhcsk->bhcts', qc, kc) * decay[None, :, None]
    intra = jnp.einsum('bhcts,bhcsv->bhctv', scores, vc)
    zeta = jnp.exp(lg[:, None] * (L - 1 - t)[None, :])
    xi = jnp.exp(lg[:, None] * (t + 1)[None, :])
    s_chunk = jnp.einsum('bhcsk,bhcsv->cbhkv', kc * zeta[None, :, None, :, None], vc)
    g_chunk = jnp.exp(lg * L)[None, :, None, None]

    def step(R, s):
        return g_chunk * R + s, R

    _, r_prev = lax.scan(step, jnp.zeros((B, H, dk, vc.shape[-1]), jnp.float32), s_chunk)
    cross = jnp.einsum('bhctk,cbhkv->bhctv', qc * xi[None, :, None, :, None], r_prev)
    return (intra + cross).transpose(0, 2, 3, 1, 4).reshape(B, S, H, -1)


def dilated_branch(q, k, v, window, dilation):
    B, S, H, d = q.shape
    Ld = S // dilation
    span = window // dilation
    nb = -(-Ld // ATT_BLOCK)
    Lp = nb * ATT_BLOCK

    def sub(t):
        t = t.reshape(B, Ld, dilation, H, d).transpose(0, 2, 3, 1, 4)
        return jnp.pad(t, ((0, 0), (0, 0), (0, 0), (0, Lp - Ld), (0, 0)))

    def band(t):
        tb = t.reshape(B, dilation, H, nb, ATT_BLOCK, d)
        prev = jnp.concatenate([jnp.zeros_like(tb[:, :, :, :1]), tb[:, :, :, :-1]], axis=3)
        return jnp.concatenate([prev, tb], axis=4)

    qb = sub(q).reshape(B, dilation, H, nb, ATT_BLOCK, d)
    kb, vb = band(sub(k)), band(sub(v))
    s = jnp.einsum('bxhnqd,bxhnkd->bxhnqk', qb, kb) * d ** -0.5
    iq = jnp.arange(ATT_BLOCK)
    ik = jnp.arange(2 * ATT_BLOCK)
    dist = iq[:, None] + ATT_BLOCK - ik[None, :]
    kpos = jnp.arange(nb)[:, None] * ATT_BLOCK - ATT_BLOCK + ik[None, :]
    valid = ((dist >= 0) & (dist <= span))[None] & (kpos >= 0)[:, None, :]
    s = jnp.where(valid, s, -jnp.inf)
    m = jnp.max(s, -1, keepdims=True)
    pexp = jnp.exp(s - m)
    den = jnp.sum(pexp, -1, keepdims=True)
    o = jnp.einsum('bxhnqk,bxhnkd->bxhnqd', pexp, vb) / den
    lse = (m + jnp.log(den))[..., 0]
    o = o.reshape(B, dilation, H, Lp, d)[:, :, :, :Ld].transpose(0, 3, 1, 2, 4).reshape(B, S, H, d)
    lse = lse.reshape(B, dilation, H, Lp)[:, :, :, :Ld].transpose(0, 3, 1, 2).reshape(B, S, H)
    return o, lse


def dilated_attention(q, k, v):
    outs, lses = [], []
    for window, dilation in DILATED_BRANCHES:
        o, l = dilated_branch(q, k, v, window, dilation)
        outs.append(o)
        lses.append(l)
    w = jax.nn.softmax(jnp.stack(lses, 0), axis=0)
    return jnp.einsum('rbsh,rbshd->bshd', w, jnp.stack(outs, 0))


def mlstm(q, k, v, ig, fg):
    B, S, H, d = q.shape
    nC, L = S // CHUNK, CHUNK
    k = k * d ** -0.5
    lf = jax.nn.log_sigmoid(fg)

    def to_c(t):
        return t.reshape(B, nC, L, H, -1).transpose(1, 0, 3, 2, 4)

    def gate_c(t):
        return t.reshape(B, nC, L, H).transpose(1, 0, 3, 2)

    tri = jnp.tril(jnp.ones((L, L), bool))

    def step(carry, xs):
        C, n, m = carry
        qc, kc, vc, ic, fc = xs
        b = jnp.cumsum(fc, -1)
        dm = jnp.where(tri, b[..., :, None] - b[..., None, :] + ic[..., None, :], -jnp.inf)
        inter = b + m[..., None]
        mt = jnp.maximum(inter, jnp.max(dm, -1))
        w_intra = jnp.exp(dm - mt[..., None])
        w_inter = jnp.exp(inter - mt)
        sm = jnp.einsum('bhtd,bhsd->bhts', qc, kc) * w_intra
        num = jnp.einsum('bhts,bhsd->bhtd', sm, vc) + w_inter[..., None] * jnp.einsum('bhtk,bhkv->bhtv', qc, C)
        den = jnp.sum(sm, -1) + w_inter * jnp.einsum('bhtk,bhk->bht', qc, n)
        h = num / jnp.maximum(jnp.abs(den), jnp.exp(-mt))[..., None]
        m_new = mt[..., -1]
        wk = jnp.exp(b[..., -1:] - b + ic - m_new[..., None])
        dec = jnp.exp(b[..., -1] + m - m_new)
        C_new = dec[..., None, None] * C + jnp.einsum('bhs,bhsk,bhsv->bhkv', wk, kc, vc)
        n_new = dec[..., None] * n + jnp.einsum('bhs,bhsk->bhk', wk, kc)
        return (C_new, n_new, m_new), h

    init = (jnp.zeros((B, H, d, d), jnp.float32), jnp.zeros((B, H, d), jnp.float32),
            jnp.zeros((B, H), jnp.float32))
    _, h = lax.scan(step, init, (to_c(q), to_c(k), to_c(v), gate_c(ig), gate_c(lf)))
    return h.transpose(1, 0, 3, 2, 4).reshape(B, S, H, d)


def hybrid_mixer(x, w_in, conv_w, b_if, ret_norm_g, mlstm_norm_g, w_out):
    B, S, _ = x.shape
    z = (x @ w_in).astype(jnp.float32)
    offsets = np.cumsum(IN_SPLITS)[:-1].tolist()
    rq, rk, rv, rg, aq, ak, av, mq, mk, mv, mo, mi, mf = jnp.split(z, offsets, axis=-1)
    pos = jnp.arange(S)
    rq = rotate(rq.reshape(B, S, RET_HEADS, RET_DK), pos, RET_DK, RET_THETA)
    rk = rotate(rk.reshape(B, S, RET_HEADS, RET_DK), pos, RET_DK, RET_THETA)
    ret = retention(rq, rk, rv.reshape(B, S, RET_HEADS, RET_DV))
    ret = head_norm(ret, ret_norm_g).reshape(B, S, -1) * jax.nn.silu(rg)
    aq = rotate(aq.reshape(B, S, ATT_HEADS, ATT_DIM), pos, ROPE_DIMS, ROPE_THETA)
    ak = rotate(ak.reshape(B, S, ATT_HEADS, ATT_DIM), pos, ROPE_DIMS, ROPE_THETA)
    att = dilated_attention(aq, ak, av.reshape(B, S, ATT_HEADS, ATT_DIM)).reshape(B, S, -1)
    qk = jax.nn.silu(causal_depthwise_conv(jnp.concatenate([mq, mk], -1), conv_w.astype(jnp.float32)))
    mq, mk = jnp.split(qk, 2, axis=-1)
    b_if = b_if.astype(jnp.float32)
    h = mlstm(mq.reshape(B, S, MLSTM_HEADS, MLSTM_DIM), mk.reshape(B, S, MLSTM_HEADS, MLSTM_DIM),
              mv.reshape(B, S, MLSTM_HEADS, MLSTM_DIM), mi + b_if[:MLSTM_HEADS], mf + b_if[MLSTM_HEADS:])
    mls = head_norm(h, mlstm_norm_g).reshape(B, S, -1) * jax.nn.sigmoid(mo)
    mix = jnp.concatenate([ret, att, mls], -1).astype(x.dtype)
    return mix @ w_out


def peer(x, wq, sub_keys, expert_u, expert_v):
    B, S, D = x.shape
    T = B * S
    xf = x.reshape(T, D)
    qry = (xf @ wq).reshape(T, PEER_HEADS, 2, PEER_QDIM // 2).astype(jnp.float32)
    sc = jnp.einsum('thpc,hpnc->thpn', qry, sub_keys.astype(jnp.float32))
    s1, i1 = lax.top_k(sc[:, :, 0], PEER_TOPK)
    s2, i2 = lax.top_k(sc[:, :, 1], PEER_TOPK)
    cand = (s1[..., :, None] + s2[..., None, :]).reshape(T, PEER_HEADS, PEER_TOPK * PEER_TOPK)
    cidx = (i1[..., :, None] * PEER_NKEYS + i2[..., None, :]).reshape(T, PEER_HEADS, PEER_TOPK * PEER_TOPK)
    top_s, sel = lax.top_k(cand, PEER_TOPK)
    eidx = jnp.take_along_axis(cidx, sel, axis=-1)
    g = jax.nn.softmax(top_s, axis=-1)
    nb = T // PEER_TOKEN_BLOCK
    kk = PEER_HEADS * PEER_TOPK
    xs = (xf.reshape(nb, PEER_TOKEN_BLOCK, D), eidx.reshape(nb, PEER_TOKEN_BLOCK, kk),
          g.reshape(nb, PEER_TOKEN_BLOCK, kk).astype(x.dtype))

    def block(args):
        xb, ib, gb = args
        a = jax.nn.gelu(jnp.einsum('td,tkd->tk', xb, expert_u[ib]), approximate=False)
        return jnp.einsum('tk,tkd->td', a * gb, expert_v[ib])

    return lax.map(block, xs).reshape(B, S, D)


def setup_inputs(seed: int = 0) -> dict:
    key = jax.random.key(seed)
    ks = jax.random.split(key, 24)
    nrm = lambda k, shape, s: jax.random.normal(k, shape, jnp.float32) * s
    mls_q = MLSTM_HEADS * MLSTM_DIM
    b_if = jnp.concatenate([
        nrm(ks[4], (DEPTH, MLSTM_HEADS), 0.1),
        jnp.broadcast_to(jnp.linspace(3.0, 6.0, MLSTM_HEADS), (DEPTH, MLSTM_HEADS)) + nrm(ks[5], (DEPTH, MLSTM_HEADS), 0.1),
    ], axis=-1)
    return {
        "x": nrm(ks[0], (BATCH, SEQ, D_MODEL), 1.0),
        "p": nrm(ks[1], (DEPTH, BATCH, SEQ, PLE_DIM), 1.0),
        "w_in": nrm(ks[2], (DEPTH, D_MODEL, W_IN_COLS), D_MODEL ** -0.5),
        "conv_w": nrm(ks[3], (DEPTH, CONV_WIDTH, 2 * mls_q), CONV_WIDTH ** -0.5),
        "b_if": b_if,
        "ret_norm_g": 1.0 + nrm(ks[6], (DEPTH, RET_HEADS * RET_DV), 0.02),
        "mlstm_norm_g": 1.0 + nrm(ks[7], (DEPTH, mls_q), 0.02),
        "w_out": nrm(ks[8], (DEPTH, MIX_WIDTH, D_MODEL), MIX_WIDTH ** -0.5 * DN_BETA),
        "ln1_g": 1.0 + nrm(ks[9], (DEPTH, D_MODEL), 0.02),
        "ln1_b": nrm(ks[10], (DEPTH, D_MODEL), 0.02),
        "peer_wq": nrm(ks[11], (DEPTH, D_MODEL, PEER_HEADS * PEER_QDIM), D_MODEL ** -0.5),
        "peer_keys": nrm(ks[12], (DEPTH, PEER_HEADS, 2, PEER_NKEYS, PEER_QDIM // 2), (PEER_QDIM // 2) ** -0.5),
        "peer_u": nrm(ks[13], (DEPTH, PEER_EXPERTS, D_MODEL), D_MODEL ** -0.5),
        "peer_v": nrm(ks[14], (DEPTH, PEER_EXPERTS, D_MODEL), DN_BETA),
        "ple_wg": nrm(ks[15], (DEPTH, D_MODEL, D_MODEL), D_MODEL ** -0.5),
        "ple_bg": nrm(ks[16], (DEPTH, D_MODEL), 0.02),
        "ple_wp": nrm(ks[17], (DEPTH, PLE_DIM, D_MODEL), PLE_DIM ** -0.5 * DN_BETA),
        "ln2_g": 1.0 + nrm(ks[18], (DEPTH, D_MODEL), 0.02),
        "ln2_b": nrm(ks[19], (DEPTH, D_MODEL), 0.02),
    }


def reference(x, p, w_in, conv_w, b_if, ret_norm_g, mlstm_norm_g, w_out, ln1_g, ln1_b,
              peer_wq, peer_keys, peer_u, peer_v, ple_wg, ple_bg, ple_wp, ln2_g, ln2_b):
    for i in range(DEPTH):
        mix = hybrid_mixer(x, w_in[i], conv_w[i], b_if[i], ret_norm_g[i], mlstm_norm_g[i], w_out[i])
        x1 = layer_norm(DN_ALPHA * x + mix, ln1_g[i], ln1_b[i])
        y = peer(x1, peer_wq[i], peer_keys[i], peer_u[i], peer_v[i])
        e = jax.nn.sigmoid(x1 @ ple_wg[i] + ple_bg[i]) * (p[i] @ ple_wp[i])
        x = layer_norm(DN_ALPHA * x1 + y + e, ln2_g[i], ln2_b[i])
    return x
```

```cpp
#include <hip/hip_runtime.h>
#include <cstdio>
#include <cstdint>
#include <cmath>

#ifndef MK_SPLIT
#define MK_SPLIT 1
#endif

#ifndef ONLY
#define ONLY -1
#endif
#ifndef PMASK
#define PMASK 0x1ff
#endif
#define PHON(k) ((ONLY < 0 || ONLY == (k)) && ((PMASK >> (k)) & 1))
#define LAS __attribute__((address_space(3)))
typedef unsigned short bf16;

#define XB_TMO      128
#define XB_XCNT(j)  (256  + 64 * (j))
#define XB_XSUB(j)  (1280 + 64 * (j))
#define XB_XGEN(j)  (2304 + 64 * (j))
#define XB_TOP      3328
#define XB_TOPGEN   3392
#define XCD_BAR_WORDS 3456
#define XB_SPIN_CAP (1u << 22)

__device__ __forceinline__ unsigned xb_ld(unsigned* p)              { return __hip_atomic_load(p, __ATOMIC_RELAXED, __HIP_MEMORY_SCOPE_AGENT); }
__device__ __forceinline__ unsigned xb_add(unsigned* p, unsigned v) { return __hip_atomic_fetch_add(p, v, __ATOMIC_RELAXED, __HIP_MEMORY_SCOPE_AGENT); }
__device__ __forceinline__ unsigned xb_xcc_id() { return (unsigned)__builtin_amdgcn_s_getreg((3 << 11) | 20) & 0xFu; }
#define XB_SPIN(cond, bar) do { unsigned _sp = 0; while (cond) { __builtin_amdgcn_s_sleep(1); \
    if ((++_sp & 255u) == 0u) { if (xb_ld(&(bar)[XB_TMO])) break; if (_sp > XB_SPIN_CAP) { atomicAdd(&(bar)[XB_TMO], 1u); break; } } } } while (0)

struct XcdBarrier { unsigned* bar; unsigned x; volatile LAS unsigned* st; };

__device__ __forceinline__ XcdBarrier xcd_barrier_post(unsigned* bar, volatile LAS unsigned* st) {
    XcdBarrier b; b.bar = bar; b.x = xb_xcc_id(); b.st = st;
    if (threadIdx.x == 0) (void)xb_add(&bar[XB_XCNT(b.x)], 1u);
    return b;
}
__device__ __forceinline__ void xcd_barrier_complete(unsigned* bar, unsigned x, unsigned& nloc, unsigned& nx) {
    const unsigned G = gridDim.x * gridDim.y * gridDim.z;
    unsigned sum, cnt, mine, sp = 0u;
    for (;;) {
        sum = 0u; cnt = 0u; mine = 0u;
#pragma unroll
        for (unsigned j = 0; j < 16; ++j) { const unsigned c = xb_ld(&bar[XB_XCNT(j)]); sum += c; cnt += (c > 0u) ? 1u : 0u; mine = (j == x) ? c : mine; }
        if (sum == G) break;
        __builtin_amdgcn_s_sleep(1);
        if ((++sp & 255u) == 0u) { if (xb_ld(&bar[XB_TMO])) break; if (sp > XB_SPIN_CAP) { atomicAdd(&bar[XB_TMO], 1u); break; } }
    }
    nloc = mine > 0u ? mine : 1u; nx = cnt > 0u ? cnt : 1u;
}
__device__ __forceinline__ void xcd_barrier(const XcdBarrier& b) {
    asm volatile("s_waitcnt vmcnt(0)" ::: "memory");
    __syncthreads();
    if (threadIdx.x == 0) {
        unsigned* bar = b.bar;
        __builtin_amdgcn_s_waitcnt(0);
        unsigned nloc = b.st[0], nx = b.st[1];
        if (nloc == 0u) { xcd_barrier_complete(bar, b.x, nloc, nx); b.st[0] = nloc; b.st[1] = nx; }
        const unsigned old = xb_add(&bar[XB_XSUB(b.x)], 1u);
        const unsigned gen = old / nloc;
        if (old + 1u == (gen + 1u) * nloc) {
            __builtin_amdgcn_fence(__ATOMIC_RELEASE, "agent");
            asm volatile("s_waitcnt vmcnt(0)" ::: "memory");
            const unsigned og = xb_add(&bar[XB_TOP], 1u);
            const unsigned tg = og / nx;
            if (og + 1u == (tg + 1u) * nx) xb_add(&bar[XB_TOPGEN], 1u);
            else XB_SPIN(xb_ld(&bar[XB_TOPGEN]) == tg, bar);
            __builtin_amdgcn_fence(__ATOMIC_ACQUIRE, "agent");
            xb_add(&bar[XB_XGEN(b.x)], 1u);
            asm volatile("s_waitcnt vmcnt(0)" ::: "memory");
        } else {
            XB_SPIN(xb_ld(&bar[XB_XGEN(b.x)]) == gen, bar);
            __builtin_amdgcn_fence(__ATOMIC_ACQUIRE, "agent");
            asm volatile("s_waitcnt vmcnt(0)" ::: "memory");
        }
    }
    __syncthreads();
}

constexpr int NB = 4, SEQ = 8192, NT = NB * SEQ, DM = 1024;
constexpr int ZW = 3328, NZ = 3336;
constexpr int C_RQ = 0, C_RK = 256, C_RV = 512, C_RG = 1024, C_AQ = 1536, C_AK = 1792, C_AV = 2048, C_MQ = 2304, C_MK = 2560, C_MV = 2816, C_MO = 3072;
constexpr float DN_ALPHA = 1.41421356237f;
constexpr float LN_EPS = 1e-5f;
constexpr int NTHR = 512, NWAVE = 8;
constexpr int LDS_BYTES = 160 * 1024;
constexpr int LDS_CTL_OFF = 159 * 1024;

constexpr size_t MiB = 1u << 20;
constexpr size_t WS_CTL = 0, CTL_ZERO_BYTES = 64 * 1024;
constexpr size_t WS_RCOS = 1 * MiB, WS_RSIN = 2 * MiB, WS_ACOS = 3 * MiB, WS_ASIN = 3 * MiB + 512 * 1024;
constexpr size_t WS_RST = 4 * MiB;
constexpr size_t WS_MC = 36 * MiB;
constexpr size_t WS_MN = 52 * MiB;
constexpr size_t WS_MA = 52 * MiB + 512 * 1024, WS_MML = WS_MA + 4096, WS_MMP = WS_MML + 4096;
constexpr size_t WS_GATES = 54 * MiB;
constexpr size_t WS_Z = 56 * MiB;
constexpr size_t WS_MIX = 264 * MiB;
constexpr size_t WS_QRY = 56 * MiB;
constexpr size_t WS_E = 312 * MiB;
constexpr size_t WS_RI = 440 * MiB, WS_RG = 456 * MiB;
constexpr size_t WS_END = 472 * MiB;

struct Params {
    const float *x, *p, *w_in, *conv_w, *b_if, *ret_g, *mls_g, *w_out, *ln1_g, *ln1_b, *wq, *keys, *pu, *pv, *wg, *bg, *wp, *ln2_g, *ln2_b;
    float* out; unsigned char* ws; int ph_lo, ph_hi;
};

__device__ __forceinline__ float bf2f(bf16 h) { return __uint_as_float(((unsigned)h) << 16); }
__device__ __forceinline__ unsigned f2bf(float f) { unsigned u = __float_as_uint(f); return (u + 0x7fffu + ((u >> 16) & 1u)) >> 16; }
__device__ __forceinline__ unsigned pk2(float lo, float hi) { return f2bf(lo) | (f2bf(hi) << 16); }
__device__ __forceinline__ float wave_sum(float v) {
#pragma unroll
    for (int o = 1; o < 64; o <<= 1) v += __shfl_xor(v, o);
    return v;
}
__device__ __forceinline__ float wave_max(float v) {
#pragma unroll
    for (int o = 1; o < 64; o <<= 1) v = fmaxf(v, __shfl_xor(v, o));
    return v;
}
__device__ __forceinline__ float sigmoidf_(float x) { return 1.f / (1.f + expf(-x)); }
__device__ __forceinline__ float siluf_(float x) { return x / (1.f + expf(-x)); }
__device__ __forceinline__ void unpack8(const uint4 v, float* o) {
    o[0] = __uint_as_float(v.x << 16); o[1] = __uint_as_float(v.x & 0xffff0000u);
    o[2] = __uint_as_float(v.y << 16); o[3] = __uint_as_float(v.y & 0xffff0000u);
    o[4] = __uint_as_float(v.z << 16); o[5] = __uint_as_float(v.z & 0xffff0000u);
    o[6] = __uint_as_float(v.w << 16); o[7] = __uint_as_float(v.w & 0xffff0000u);
}

template <class Epi>
__device__ __forceinline__ void gemm_tile_f32(const float* __restrict__ A, int lda, const float* __restrict__ W, int N, int K, int m0, int n0, float* lds, const Epi& epi) {
    float* As = lds; float* Bs = lds + 16 * 132;
    const int tid = threadIdx.x, ty = tid >> 4, tx = tid & 15;
    float acc[4][8];
#pragma unroll
    for (int i = 0; i < 4; ++i)
#pragma unroll
        for (int j = 0; j < 8; ++j) acc[i][j] = 0.f;
    const int arow = tid >> 2, akq = (tid & 3) * 4;
    const int bk = tid >> 5, bn = (tid & 31) * 4;
    const bool bvalid = (n0 + bn) < N;
    const float* ap = A + (size_t)(m0 + arow) * lda + akq;
    const float* bp = W + (size_t)bk * N + n0 + bn;
    for (int k0 = 0; k0 < K; k0 += 16) {
        const float4 av = *(const float4*)(ap + k0);
        float4 bv = make_float4(0.f, 0.f, 0.f, 0.f);
        if (bvalid) bv = *(const float4*)(bp + (size_t)k0 * N);
        __syncthreads();
        As[(akq + 0) * 132 + arow] = av.x; As[(akq + 1) * 132 + arow] = av.y; As[(akq + 2) * 132 + arow] = av.z; As[(akq + 3) * 132 + arow] = av.w;
        *(float4*)(Bs + bk * 128 + bn) = bv;
        __syncthreads();
#pragma unroll
        for (int k = 0; k < 16; ++k) {
            const float4 a = *(const float4*)(As + k * 132 + ty * 4);
            const float4 b0 = *(const float4*)(Bs + k * 128 + tx * 8);
            const float4 b1 = *(const float4*)(Bs + k * 128 + tx * 8 + 4);
            const float aa[4] = {a.x, a.y, a.z, a.w};
            const float bb[8] = {b0.x, b0.y, b0.z, b0.w, b1.x, b1.y, b1.z, b1.w};
#pragma unroll
            for (int i = 0; i < 4; ++i)
#pragma unroll
                for (int j = 0; j < 8; ++j) acc[i][j] = fmaf(aa[i], bb[j], acc[i][j]);
        }
    }
#pragma unroll
    for (int i = 0; i < 4; ++i) epi(m0 + ty * 4 + i, n0 + tx * 8, acc[i]);
    __syncthreads();
}

struct EpiZ {
    bf16* Z; float* gates;
    __device__ __forceinline__ void operator()(int row, int col0, const float (&v)[8]) const {
        if (col0 < ZW) { uint4 w; w.x = pk2(v[0], v[1]); w.y = pk2(v[2], v[3]); w.z = pk2(v[4], v[5]); w.w = pk2(v[6], v[7]); *(uint4*)(Z + (size_t)row * ZW + col0) = w; }
        else if (col0 == ZW) { float* g = gates + (size_t)row * 8; *(float4*)g = make_float4(v[0], v[1], v[2], v[3]); *(float4*)(g + 4) = make_float4(v[4], v[5], v[6], v[7]); }
    }
};
struct EpiRes {
    const float* xin; float* out;
    __device__ __forceinline__ void operator()(int row, int col0, const float (&v)[8]) const {
        const size_t o = (size_t)row * DM + col0;
        const float4 a = *(const float4*)(xin + o), b = *(const float4*)(xin + o + 4);
        *(float4*)(out + o) = make_float4(DN_ALPHA * a.x + v[0], DN_ALPHA * a.y + v[1], DN_ALPHA * a.z + v[2], DN_ALPHA * a.w + v[3]);
        *(float4*)(out + o + 4) = make_float4(DN_ALPHA * b.x + v[4], DN_ALPHA * b.y + v[5], DN_ALPHA * b.z + v[6], DN_ALPHA * b.w + v[7]);
    }
};
struct EpiStore {
    float* out; int ld;
    __device__ __forceinline__ void operator()(int row, int col0, const float (&v)[8]) const {
        const size_t o = (size_t)row * ld + col0;
        *(float4*)(out + o) = make_float4(v[0], v[1], v[2], v[3]); *(float4*)(out + o + 4) = make_float4(v[4], v[5], v[6], v[7]);
    }
};
struct EpiGate {
    float* E; const float* bg;
    __device__ __forceinline__ void operator()(int row, int col0, const float (&v)[8]) const {
        const size_t o = (size_t)row * DM + col0;
        float4 a = *(const float4*)(E + o), b = *(const float4*)(E + o + 4);
        a.x *= sigmoidf_(v[0] + bg[col0 + 0]); a.y *= sigmoidf_(v[1] + bg[col0 + 1]); a.z *= sigmoidf_(v[2] + bg[col0 + 2]); a.w *= sigmoidf_(v[3] + bg[col0 + 3]);
        b.x *= sigmoidf_(v[4] + bg[col0 + 4]); b.y *= sigmoidf_(v[5] + bg[col0 + 5]); b.z *= sigmoidf_(v[6] + bg[col0 + 6]); b.w *= sigmoidf_(v[7] + bg[col0 + 7]);
        *(float4*)(E + o) = a; *(float4*)(E + o + 4) = b;
    }
};

template <class Epi>
__device__ __forceinline__ void gemm_phase_f32(const float* A, int lda, const float* W, int N, int K, float* lds, const Epi& epi) {
    const int ntn = (N + 127) / 128, ntm = NT / 128, nit = ntn * ntm;
    for (int it = blockIdx.x; it < nit; it += gridDim.x) { const int mt = it / ntn, nt = it - mt * ntn; gemm_tile_f32(A, lda, W, N, K, mt * 128, nt * 128, lds, epi); }
}

__device__ __forceinline__ void p0_tables(const Params& p) {
    float* rcos = (float*)(p.ws + WS_RCOS); float* rsin = (float*)(p.ws + WS_RSIN); float* acos_ = (float*)(p.ws + WS_ACOS); float* asin_ = (float*)(p.ws + WS_ASIN);
    const int gt = blockIdx.x * NTHR + threadIdx.x, GT = gridDim.x * NTHR;
    for (int i = gt; i < SEQ * 32; i += GT) { const int pos = i >> 5, k = i & 31; const float inv = powf(10000.0f, -(float)k / 32.0f); const float ang = (float)pos * inv; rcos[i] = cosf(ang); rsin[i] = sinf(ang); }
    for (int i = gt; i < SEQ * 8; i += GT) { const int pos = i >> 3, k = i & 7; const float inv = powf(500000.0f, -(float)k / 8.0f); const float ang = (float)pos * inv; acos_[i] = cosf(ang); asin_[i] = sinf(ang); }
}

__device__ __forceinline__ float ret_lg(int h) { return logf(1.0f - exp2f(-5.0f - (float)h)); }

__device__ __forceinline__ void ret_state_item(const Params& p, int item, float* lds) {
    const int tid = threadIdx.x;
    const int c = item & 63, bh = item >> 6, h = bh & 3, b = bh >> 2;
    const int t0 = b * SEQ + c * 128, s0 = c * 128;
    const bf16* Z = (const bf16*)(p.ws + WS_Z);
    const float* rcos = (const float*)(p.ws + WS_RCOS); const float* rsin = (const float*)(p.ws + WS_RSIN);
    float* RST = (float*)(p.ws + WS_RST);
    float* Kz = lds; float* V = lds + 128 * 64;
    const float lg = ret_lg(h);
    for (int idx = tid; idx < 128 * 32; idx += NTHR) {
        const int row = idx >> 5, i = idx & 31;
        const bf16* zr = Z + (size_t)(t0 + row) * ZW + C_RK + h * 64;
        const float x1 = bf2f(zr[i]), x2 = bf2f(zr[i + 32]);
        const float cs = rcos[(s0 + row) * 32 + i], sn = rsin[(s0 + row) * 32 + i];
        const float sc = 0.125f * expf(lg * (float)(127 - row));
        Kz[row * 64 + i] = (x1 * cs - x2 * sn) * sc; Kz[row * 64 + i + 32] = (x2 * cs + x1 * sn) * sc;
    }
    for (int idx = tid; idx < 128 * 128; idx += NTHR) { const int row = idx >> 7, d = idx & 127; V[idx] = bf2f(Z[(size_t)(t0 + row) * ZW + C_RV + h * 128 + d]); }
    __syncthreads();
    const int k = tid >> 3, v0 = (tid & 7) * 16;
    float acc[16];
#pragma unroll
    for (int j = 0; j < 16; ++j) acc[j] = 0.f;
#pragma unroll 4
    for (int s = 0; s < 128; ++s) {
        const float kk = Kz[s * 64 + k];
#pragma unroll
        for (int j = 0; j < 16; ++j) acc[j] = fmaf(kk, V[s * 128 + v0 + j], acc[j]);
    }
    float* dst = RST + (size_t)item * 8192 + k * 128 + v0;
#pragma unroll
    for (int j = 0; j < 16; ++j) dst[j] = acc[j];
    __syncthreads();
}

__device__ __forceinline__ float logsigmoidf_(float f) { return fminf(f, 0.f) - log1pf(expf(-fabsf(f))); }

__device__ __forceinline__ void mls_state_item(const Params& p, int li, int item, float* lds) {
    const int tid = threadIdx.x;
    const int c = item & 63, bh = item >> 6, h = bh & 3, b = bh >> 2;
    const int t0 = b * SEQ + c * 128;
    const bf16* Z = (const bf16*)(p.ws + WS_Z);
    const float* gates = (const float*)(p.ws + WS_GATES);
    float* MC = (float*)(p.ws + WS_MC); float* MN = (float*)(p.ws + WS_MN); float* MA = (float*)(p.ws + WS_MA); float* MML = (float*)(p.ws + WS_MML);
    const float* cw = p.conv_w + (size_t)li * 4 * 512;
    float* Kc = lds; float* Vv = lds + 8192; float* ib = lds + 16384; float* bb = ib + 128; float* wk = bb + 128; float* scal = wk + 128;
    for (int idx = tid; idx < 128 * 64; idx += NTHR) {
        const int row = idx >> 6, d = idx & 63, ch = 256 + h * 64 + d;
        float a = 0.f;
#pragma unroll
        for (int j = 0; j < 4; ++j) { const int sp = c * 128 + row - 3 + j; if (sp >= 0) a = fmaf(cw[j * 512 + ch], bf2f(Z[(size_t)(t0 + row - 3 + j) * ZW + C_MK + h * 64 + d]), a); }
        Kc[idx] = siluf_(a) * 0.125f;
        Vv[idx] = bf2f(Z[(size_t)(t0 + row) * ZW + C_MV + h * 64 + d]);
    }
    if (tid < 128) {
        const int t = t0 + tid;
        const float ig = gates[(size_t)t * 8 + h] + p.b_if[li * 8 + h];
        const float fg = gates[(size_t)t * 8 + 4 + h] + p.b_if[li * 8 + 4 + h];
        ib[tid] = ig; bb[tid] = logsigmoidf_(fg);
    }
    __syncthreads();
    if (tid == 0) {
        float run = 0.f;
#pragma unroll 4
        for (int s = 0; s < 128; ++s) { run += bb[s]; bb[s] = run; }
        float ml = -INFINITY;
        for (int s = 0; s < 128; ++s) ml = fmaxf(ml, run - bb[s] + ib[s]);
        scal[0] = run; scal[1] = ml;
    }
    __syncthreads();
    const float a = scal[0], ml = scal[1];
    if (tid < 128) wk[tid] = expf(a - bb[tid] + ib[tid] - ml);
    __syncthreads();
    const int k = tid >> 3, v0 = (tid & 7) * 8;
    float acc[8], nacc = 0.f;
#pragma unroll
    for (int j = 0; j < 8; ++j) acc[j] = 0.f;
#pragma unroll 4
    for (int s = 0; s < 128; ++s) {
        const float kw = Kc[s * 64 + k] * wk[s];
        nacc += kw;
#pragma unroll
        for (int j = 0; j < 8; ++j) acc[j] = fmaf(kw, Vv[s * 64 + v0 + j], acc[j]);
    }
    float* dst = MC + (size_t)item * 4096 + k * 64 + v0;
#pragma unroll
    for (int j = 0; j < 8; ++j) dst[j] = acc[j];
    if ((tid & 7) == 0) MN[(size_t)item * 64 + k] = nacc;
    if (tid == 0) { MA[item] = a; MML[item] = ml; }
    __syncthreads();
}

__device__ __forceinline__ void attn_pair(const Params& p, int pair, int lane) {
    const bf16* Z = (const bf16*)(p.ws + WS_Z);
    const float* acos_ = (const float*)(p.ws + WS_ACOS); const float* asin_ = (const float*)(p.ws + WS_ASIN);
    float* MIX = (float*)(p.ws + WS_MIX);
    const int t = pair >> 2, h = pair & 3, b = t >> 13, s = t & 8191;
    float q[64];
    {
        const uint4* zq = (const uint4*)(Z + (size_t)t * ZW + C_AQ + h * 64);
#pragma unroll
        for (int i = 0; i < 8; ++i) unpack8(zq[i], q + 8 * i);
#pragma unroll
        for (int i = 0; i < 8; ++i) { const float cs = acos_[s * 8 + i], sn = asin_[s * 8 + i]; const float a = q[i], bq = q[i + 8]; q[i] = a * cs - bq * sn; q[i + 8] = bq * cs + a * sn; }
#pragma unroll
        for (int i = 0; i < 64; ++i) q[i] *= 0.125f;
    }
    float lse[3], o[3];
#pragma unroll
    for (int r = 0; r < 3; ++r) {
        const int dl = 1 << (2 * r);
        const int sd = s / dl;
        const int nk = (sd < 128 ? sd : 128) + 1;
        float sc[3];
#pragma unroll
        for (int j = 0; j < 3; ++j) {
            const int i = lane + 64 * j;
            float dot = -INFINITY;
            if (i < nk) {
                const int pos = s - i * dl;
                const uint4* kr = (const uint4*)(Z + (size_t)(b * SEQ + pos) * ZW + C_AK + h * 64);
                float kv[64];
#pragma unroll
                for (int u = 0; u < 8; ++u) unpack8(kr[u], kv + 8 * u);
#pragma unroll
                for (int u = 0; u < 8; ++u) { const float cs = acos_[pos * 8 + u], sn = asin_[pos * 8 + u]; const float a = kv[u], bk = kv[u + 8]; kv[u] = a * cs - bk * sn; kv[u + 8] = bk * cs + a * sn; }
                dot = 0.f;
#pragma unroll
                for (int u = 0; u < 64; ++u) dot = fmaf(q[u], kv[u], dot);
            }
            sc[j] = dot;
        }
        const float m = wave_max(fmaxf(fmaxf(sc[0], sc[1]), sc[2]));
        const float p0 = expf(sc[0] - m), p1 = expf(sc[1] - m), p2 = expf(sc[2] - m);
        const float den = wave_sum(p0 + p1 + p2);
        float acc = 0.f;
#pragma unroll 2
        for (int i = 0; i < nk; ++i) {
            const int j = i >> 6;
            const float pj = (j == 0) ? p0 : ((j == 1) ? p1 : p2);
            const float pij = __shfl(pj, i & 63);
            const float vv = bf2f(Z[(size_t)(b * SEQ + s - i * dl) * ZW + C_AV + h * 64 + lane]);
            acc = fmaf(pij, vv, acc);
        }
        o[r] = acc / den; lse[r] = m + logf(den);
    }
    const float M = fmaxf(fmaxf(lse[0], lse[1]), lse[2]);
    const float w0 = expf(lse[0] - M), w1 = expf(lse[1] - M), w2 = expf(lse[2] - M);
    MIX[(size_t)t * DM + 512 + h * 64 + lane] = (w0 * o[0] + w1 * o[1] + w2 * o[2]) / (w0 + w1 + w2);
}

__device__ __forceinline__ void p3_scans(const Params& p) {
    float* RST = (float*)(p.ws + WS_RST);
    float* MC = (float*)(p.ws + WS_MC); float* MN = (float*)(p.ws + WS_MN); const float* MA = (const float*)(p.ws + WS_MA); const float* MML = (const float*)(p.ws + WS_MML); float* MMP = (float*)(p.ws + WS_MMP);
    const int gt = blockIdx.x * NTHR + threadIdx.x, GT = gridDim.x * NTHR;
    for (int e = gt; e < 16 * 8192; e += GT) {
        const int bh = e >> 13, el = e & 8191, h = bh & 3;
        const float gL = expf(ret_lg(h) * 128.0f);
        float R = 0.f;
        float* ptr = RST + (size_t)bh * 64 * 8192 + el;
        for (int c = 0; c < 64; ++c) { const float sv = ptr[(size_t)c * 8192]; ptr[(size_t)c * 8192] = R; R = fmaf(gL, R, sv); }
    }
    for (int e = gt; e < 16 * 4160; e += GT) {
        const int bh = e / 4160, el = e - bh * 4160;
        float* ptr; size_t stride;
        if (el < 4096) { ptr = MC + (size_t)bh * 64 * 4096 + el; stride = 4096; } else { ptr = MN + (size_t)bh * 64 * 64 + (el - 4096); stride = 64; }
        float m = 0.f, C = 0.f;
        for (int c = 0; c < 64; ++c) {
            const float a = MA[bh * 64 + c], ml = MML[bh * 64 + c];
            const float mn = fmaxf(a + m, ml);
            const float f1 = expf(a + m - mn), f2 = expf(ml - mn);
            const float sv = ptr[(size_t)c * stride]; ptr[(size_t)c * stride] = C; C = f1 * C + f2 * sv;
            if (el == 0) MMP[bh * 64 + c] = m;
            m = mn;
        }
    }
}

__device__ __forceinline__ void ret_out_item(const Params& p, int li, int item, float* lds) {
    const int tid = threadIdx.x;
    const int c = item & 63, bh = item >> 6, h = bh & 3, b = bh >> 2;
    const int t0 = b * SEQ + c * 128, s0 = c * 128;
    const bf16* Z = (const bf16*)(p.ws + WS_Z);
    const float* rcos = (const float*)(p.ws + WS_RCOS); const float* rsin = (const float*)(p.ws + WS_RSIN);
    const float* RST = (const float*)(p.ws + WS_RST);
    float* MIX = (float*)(p.ws + WS_MIX);
    float* Q = lds; float* K = Q + 8320; float* SC = K + 8320; float* V = SC + 8256; float* R = V + 8192;
    const float lg = ret_lg(h);
    for (int idx = tid; idx < 128 * 32; idx += NTHR) {
        const int row = idx >> 5, i = idx & 31;
        const bf16* zq = Z + (size_t)(t0 + row) * ZW + C_RQ + h * 64; const bf16* zk = Z + (size_t)(t0 + row) * ZW + C_RK + h * 64;
        const float cs = rcos[(s0 + row) * 32 + i], sn = rsin[(s0 + row) * 32 + i];
        const float q1 = bf2f(zq[i]), q2 = bf2f(zq[i + 32]), k1 = bf2f(zk[i]), k2 = bf2f(zk[i + 32]);
        Q[row * 65 + i] = q1 * cs - q2 * sn; Q[row * 65 + i + 32] = q2 * cs + q1 * sn;
        K[row * 65 + i] = (k1 * cs - k2 * sn) * 0.125f; K[row * 65 + i + 32] = (k2 * cs + k1 * sn) * 0.125f;
    }
    __syncthreads();
    const int r = tid >> 3, d0 = (tid & 7) * 8;
#pragma unroll 1
    for (int rh = 0; rh < 2; ++rh) {
        const int t = rh * 64 + r;
#pragma unroll 1
        for (int j = 0; j < 16; ++j) {
            const int s = (tid & 7) + 8 * j;
            float dot = 0.f;
#pragma unroll 16
            for (int d = 0; d < 64; ++d) dot = fmaf(Q[t * 65 + d], K[s * 65 + d], dot);
            SC[r * 129 + s] = (s <= t) ? dot * expf(lg * (float)(t - s)) : 0.f;
        }
        __syncthreads();
        float o[2][8];
#pragma unroll
        for (int dh = 0; dh < 2; ++dh) {
            for (int idx = tid; idx < 128 * 64; idx += NTHR) { const int row = idx >> 6, d = idx & 63; V[idx] = bf2f(Z[(size_t)(t0 + row) * ZW + C_RV + h * 128 + dh * 64 + d]); }
            for (int idx = tid; idx < 64 * 64; idx += NTHR) { const int k = idx >> 6, d = idx & 63; R[idx] = RST[(size_t)item * 8192 + k * 128 + dh * 64 + d]; }
            __syncthreads();
            float acc[8], cr[8];
#pragma unroll
            for (int j = 0; j < 8; ++j) { acc[j] = 0.f; cr[j] = 0.f; }
#pragma unroll 4
            for (int s = 0; s < 128; ++s) {
                const float w = SC[r * 129 + s];
#pragma unroll
                for (int j = 0; j < 8; ++j) acc[j] = fmaf(w, V[s * 64 + d0 + j], acc[j]);
            }
#pragma unroll 4
            for (int k = 0; k < 64; ++k) {
                const float qv = Q[t * 65 + k];
#pragma unroll
                for (int j = 0; j < 8; ++j) cr[j] = fmaf(qv, R[k * 64 + d0 + j], cr[j]);
            }
            const float xi = expf(lg * (float)(t + 1));
#pragma unroll
            for (int j = 0; j < 8; ++j) o[dh][j] = acc[j] + xi * cr[j];
            __syncthreads();
        }
        float sum = 0.f;
#pragma unroll
        for (int dh = 0; dh < 2; ++dh)
#pragma unroll
            for (int j = 0; j < 8; ++j) sum += o[dh][j];
        sum += __shfl_xor(sum, 1); sum += __shfl_xor(sum, 2); sum += __shfl_xor(sum, 4);
        const float mean = sum * (1.0f / 128.0f);
        float sq = 0.f;
#pragma unroll
        for (int dh = 0; dh < 2; ++dh)
#pragma unroll
            for (int j = 0; j < 8; ++j) { const float dd = o[dh][j] - mean; sq += dd * dd; }
        sq += __shfl_xor(sq, 1); sq += __shfl_xor(sq, 2); sq += __shfl_xor(sq, 4);
        const float rstd = 1.0f / sqrtf(sq * (1.0f / 128.0f) + LN_EPS);
#pragma unroll
        for (int dh = 0; dh < 2; ++dh)
#pragma unroll
            for (int j = 0; j < 8; ++j) {
                const int d = dh * 64 + d0 + j;
                const float g = p.ret_g[li * 512 + h * 128 + d];
                const float rg = bf2f(Z[(size_t)(t0 + t) * ZW + C_RG + h * 128 + d]);
                MIX[(size_t)(t0 + t) * DM + h * 128 + d] = (o[dh][j] - mean) * rstd * g * siluf_(rg);
            }
    }
    __syncthreads();
}

__device__ __forceinline__ void mls_out_item(const Params& p, int li, int item, float* lds) {
    const int tid = threadIdx.x;
    const int c = item & 63, bh = item >> 6, h = bh & 3, b = bh >> 2;
    const int t0 = b * SEQ + c * 128;
    const bf16* Z = (const bf16*)(p.ws + WS_Z);
    const float* gates = (const float*)(p.ws + WS_GATES);
    const float* MC = (const float*)(p.ws + WS_MC); const float* MN = (const float*)(p.ws + WS_MN); const float* MMP = (const float*)(p.ws + WS_MMP);
    float* MIX = (float*)(p.ws + WS_MIX);
    const float* cw = p.conv_w + (size_t)li * 4 * 512;
    float* Q = lds; float* K = Q + 8320; float* SM = K + 8320; float* V = SM + 8256; float* C = V + 8192; float* nv = C + 4096; float* ib = nv + 64; float* bb = ib + 128; float* pm = bb + 128;
    for (int idx = tid; idx < 128 * 64; idx += NTHR) {
        const int row = idx >> 6, d = idx & 63, chq = h * 64 + d, chk = 256 + h * 64 + d;
        float aq = 0.f, ak = 0.f;
#pragma unroll
        for (int j = 0; j < 4; ++j) {
            const int sp = c * 128 + row - 3 + j;
            if (sp >= 0) {
                const bf16* zr = Z + (size_t)(t0 + row - 3 + j) * ZW;
                aq = fmaf(cw[j * 512 + chq], bf2f(zr[C_MQ + h * 64 + d]), aq);
                ak = fmaf(cw[j * 512 + chk], bf2f(zr[C_MK + h * 64 + d]), ak);
            }
        }
        Q[row * 65 + d] = siluf_(aq); K[row * 65 + d] = siluf_(ak) * 0.125f;
        V[idx] = bf2f(Z[(size_t)(t0 + row) * ZW + C_MV + h * 64 + d]);
    }
    for (int idx = tid; idx < 4096; idx += NTHR) C[idx] = MC[(size_t)item * 4096 + idx];
    if (tid < 64) nv[tid] = MN[(size_t)item * 64 + tid];
    if (tid < 128) {
        const int t = t0 + tid;
        ib[tid] = gates[(size_t)t * 8 + h] + p.b_if[li * 8 + h];
        bb[tid] = logsigmoidf_(gates[(size_t)t * 8 + 4 + h] + p.b_if[li * 8 + 4 + h]);
    }
    const float mprev = MMP[item];
    __syncthreads();
    if (tid == 0) {
        float run = 0.f, pmx = -INFINITY;
#pragma unroll 4
        for (int s = 0; s < 128; ++s) { run += bb[s]; bb[s] = run; pmx = fmaxf(pmx, ib[s] - run); pm[s] = pmx; }
    }
    __syncthreads();
    const int r = tid >> 3, d0 = (tid & 7) * 8;
#pragma unroll 1
    for (int rh = 0; rh < 2; ++rh) {
        const int t = rh * 64 + r;
        const float mt = bb[t] + fmaxf(mprev, pm[t]);
#pragma unroll 1
        for (int j = 0; j < 16; ++j) {
            const int s = (tid & 7) + 8 * j;
            float dot = 0.f;
#pragma unroll 16
            for (int d = 0; d < 64; ++d) dot = fmaf(Q[t * 65 + d], K[s * 65 + d], dot);
            SM[r * 129 + s] = (s <= t) ? dot * expf(bb[t] - bb[s] + ib[s] - mt) : 0.f;
        }
        __syncthreads();
        float acc[8], qc[8], den = 0.f, qn = 0.f;
#pragma unroll
        for (int j = 0; j < 8; ++j) { acc[j] = 0.f; qc[j] = 0.f; }
#pragma unroll 4
        for (int s = 0; s < 128; ++s) {
            const float w = SM[r * 129 + s]; den += w;
#pragma unroll
            for (int j = 0; j < 8; ++j) acc[j] = fmaf(w, V[s * 64 + d0 + j], acc[j]);
        }
#pragma unroll 4
        for (int k = 0; k < 64; ++k) {
            const float qv = Q[t * 65 + k]; qn = fmaf(qv, nv[k], qn);
#pragma unroll
            for (int j = 0; j < 8; ++j) qc[j] = fmaf(qv, C[k * 64 + d0 + j], qc[j]);
        }
        const float winter = expf(bb[t] + mprev - mt);
        den += winter * qn;
        const float denom = fmaxf(fabsf(den), expf(-mt));
        float hv[8], sum = 0.f;
#pragma unroll
        for (int j = 0; j < 8; ++j) { hv[j] = (acc[j] + winter * qc[j]) / denom; sum += hv[j]; }
        sum += __shfl_xor(sum, 1); sum += __shfl_xor(sum, 2); sum += __shfl_xor(sum, 4);
        const float mean = sum * (1.0f / 64.0f);
        float sq = 0.f;
#pragma unroll
        for (int j = 0; j < 8; ++j) { const float dd = hv[j] - mean; sq += dd * dd; }
        sq += __shfl_xor(sq, 1); sq += __shfl_xor(sq, 2); sq += __shfl_xor(sq, 4);
        const float rstd = 1.0f / sqrtf(sq * (1.0f / 64.0f) + LN_EPS);
#pragma unroll
        for (int j = 0; j < 8; ++j) {
            const int d = d0 + j;
            const float g = p.mls_g[li * 256 + h * 64 + d];
            const float mo = bf2f(Z[(size_t)(t0 + t) * ZW + C_MO + h * 64 + d]);
            MIX[(size_t)(t0 + t) * DM + 768 + h * 64 + d] = (hv[j] - mean) * rstd * g * sigmoidf_(mo);
        }
        __syncthreads();
    }
}

__device__ __forceinline__ void ln_row_inplace(float* row, const float* g, const float* bta, int lane) {
    float4 v[4]; float s = 0.f;
#pragma unroll
    for (int j = 0; j < 4; ++j) { v[j] = *(const float4*)(row + 256 * j + 4 * lane); s += (v[j].x + v[j].y) + (v[j].z + v[j].w); }
    const float mean = wave_sum(s) * (1.0f / DM);
    float s2 = 0.f;
#pragma unroll
    for (int j = 0; j < 4; ++j) { v[j].x -= mean; v[j].y -= mean; v[j].z -= mean; v[j].w -= mean; s2 += (v[j].x * v[j].x + v[j].y * v[j].y) + (v[j].z * v[j].z + v[j].w * v[j].w); }
    const float rstd = 1.0f / sqrtf(wave_sum(s2) * (1.0f / DM) + LN_EPS);
#pragma unroll
    for (int j = 0; j < 4; ++j) {
        const float4 gg = *(const float4*)(g + 256 * j + 4 * lane), bv = *(const float4*)(bta + 256 * j + 4 * lane);
        *(float4*)(row + 256 * j + 4 * lane) = make_float4(v[j].x * rstd * gg.x + bv.x, v[j].y * rstd * gg.y + bv.y, v[j].z * rstd * gg.z + bv.z, v[j].w * rstd * gg.w + bv.w);
    }
}

__device__ __forceinline__ void topk_item(const Params& p, int li, int item, float* lds) {
    const int tid = threadIdx.x, lane = tid & 63, wave = tid >> 6;
    const int tile = item >> 3, h = item & 7, tok0 = tile * 64;
    const float* QRY = (const float*)(p.ws + WS_QRY);
    int* RI = (int*)(p.ws + WS_RI); float* RG = (float*)(p.ws + WS_RG);
    float* Kk = lds; float* Qt = Kk + 128 * 129; float* SC = Qt + 64 * 129; float* TKV = SC + 64 * 128; int* TKI = (int*)(TKV + 2048);
#pragma unroll 1
    for (int pp = 0; pp < 2; ++pp) {
        const float* kb = p.keys + ((size_t)((li * 8 + h) * 2 + pp)) * 128 * 128;
        for (int idx = tid; idx < 128 * 128; idx += NTHR) { const int n = idx >> 7, c = idx & 127; Kk[n * 129 + c] = kb[idx]; }
        for (int idx = tid; idx < 64 * 128; idx += NTHR) { const int tok = idx >> 7, c = idx & 127; Qt[tok * 129 + c] = QRY[(size_t)(tok0 + tok) * 2048 + h * 256 + pp * 128 + c]; }
        __syncthreads();
        {
            const int tok = tid >> 3;
#pragma unroll 1
            for (int j = 0; j < 16; ++j) {
                const int n = (tid & 7) + 8 * j;
                float dot = 0.f;
#pragma unroll 16
                for (int c = 0; c < 128; ++c) dot = fmaf(Qt[tok * 129 + c], Kk[n * 129 + c], dot);
                SC[tok * 128 + n] = dot;
            }
        }
        __syncthreads();
#pragma unroll 1
        for (int q = 0; q < 8; ++q) {
            const int tok = wave * 8 + q;
            float v0 = SC[tok * 128 + lane], v1 = SC[tok * 128 + 64 + lane];
#pragma unroll 1
            for (int k = 0; k < 16; ++k) {
                const float wm = wave_max(fmaxf(v0, v1));
                const unsigned long long b0 = __ballot(v0 == wm);
                int idx;
                if (b0) { const int sl = __ffsll((long long)b0) - 1; idx = sl; if (lane == sl) v0 = -INFINITY; }
                else { const unsigned long long b1 = __ballot(v1 == wm); const int sl = __ffsll((long long)b1) - 1; idx = 64 + sl; if (lane == sl) v1 = -INFINITY; }
                if (lane == 0) { TKV[(tok * 2 + pp) * 16 + k] = wm; TKI[(tok * 2 + pp) * 16 + k] = idx; }
            }
        }
        __syncthreads();
    }
#pragma unroll 1
    for (int q = 0; q < 8; ++q) {
        const int tok = wave * 8 + q;
        const float s1 = TKV[(tok * 2) * 16 + (lane >> 2)];
        float cnd[4];
#pragma unroll
        for (int j = 0; j < 4; ++j) cnd[j] = s1 + TKV[(tok * 2 + 1) * 16 + (lane & 3) * 4 + j];
        float myval = 0.f; int myflat = 0;
#pragma unroll 1
        for (int k = 0; k < 16; ++k) {
            const float wm = wave_max(fmaxf(fmaxf(cnd[0], cnd[1]), fmaxf(cnd[2], cnd[3])));
            const bool has = (cnd[0] == wm) | (cnd[1] == wm) | (cnd[2] == wm) | (cnd[3] == wm);
            const unsigned long long bl = __ballot(has);
            const int sl = __ffsll((long long)bl) - 1;
            int fl = 0;
            if (lane == sl) {
                int j = (cnd[0] == wm) ? 0 : ((cnd[1] == wm) ? 1 : ((cnd[2] == wm) ? 2 : 3));
                fl = lane * 4 + j;
                if (j == 0) cnd[0] = -INFINITY; else if (j == 1) cnd[1] = -INFINITY; else if (j == 2) cnd[2] = -INFINITY; else cnd[3] = -INFINITY;
            }
            fl = __shfl(fl, sl);
            if (lane == k) { myval = wm; myflat = fl; }
        }
        const float m0 = __shfl(myval, 0);
        const float e = (lane < 16) ? expf(myval - m0) : 0.f;
        const float ssum = wave_sum(e);
        if (lane < 16) {
            const int a = myflat >> 4, bq = myflat & 15;
            const int eidx = TKI[(tok * 2) * 16 + a] * 128 + TKI[(tok * 2 + 1) * 16 + bq];
            RI[(size_t)(tok0 + tok) * 128 + h * 16 + lane] = eidx;
            RG[(size_t)(tok0 + tok) * 128 + h * 16 + lane] = e / ssum;
        }
    }
    __syncthreads();
}

__device__ __forceinline__ void peer_token(const Params& p, int li, int t, int lane) {
    float* stream = p.out;
    const float* E = (const float*)(p.ws + WS_E);
    const int* RI = (const int*)(p.ws + WS_RI); const float* RG = (const float*)(p.ws + WS_RG);
    const float* U = p.pu + (size_t)li * 16384 * 1024; const float* Vt = p.pv + (size_t)li * 16384 * 1024;
    float* row = stream + (size_t)t * DM;
    float4 x[4], acc[4];
#pragma unroll
    for (int j = 0; j < 4; ++j) { x[j] = *(const float4*)(row + 256 * j + 4 * lane); acc[j] = make_float4(0.f, 0.f, 0.f, 0.f); }
    const int e0 = RI[(size_t)t * 128 + lane], e1 = RI[(size_t)t * 128 + 64 + lane];
    const float g0 = RG[(size_t)t * 128 + lane], g1 = RG[(size_t)t * 128 + 64 + lane];
#pragma unroll 2
    for (int k = 0; k < 128; ++k) {
        const int e = __shfl((k < 64) ? e0 : e1, k & 63);
        const float g = __shfl((k < 64) ? g0 : g1, k & 63);
        const float* ur = U + (size_t)e * 1024; const float* vr = Vt + (size_t)e * 1024;
        float dot = 0.f;
        float4 vv[4];
#pragma unroll
        for (int j = 0; j < 4; ++j) { const float4 uv = *(const float4*)(ur + 256 * j + 4 * lane); vv[j] = *(const float4*)(vr + 256 * j + 4 * lane); dot += (x[j].x * uv.x + x[j].y * uv.y) + (x[j].z * uv.z + x[j].w * uv.w); }
        dot = wave_sum(dot);
        const float cf = 0.5f * dot * (1.0f + erff(dot * 0.70710678118f)) * g;
#pragma unroll
        for (int j = 0; j < 4; ++j) { acc[j].x = fmaf(cf, vv[j].x, acc[j].x); acc[j].y = fmaf(cf, vv[j].y, acc[j].y); acc[j].z = fmaf(cf, vv[j].z, acc[j].z); acc[j].w = fmaf(cf, vv[j].w, acc[j].w); }
    }
    float s = 0.f;
#pragma unroll
    for (int j = 0; j < 4; ++j) {
        const float4 ev = *(const float4*)(E + (size_t)t * DM + 256 * j + 4 * lane);
        acc[j].x += DN_ALPHA * x[j].x + ev.x; acc[j].y += DN_ALPHA * x[j].y + ev.y; acc[j].z += DN_ALPHA * x[j].z + ev.z; acc[j].w += DN_ALPHA * x[j].w + ev.w;
        s += (acc[j].x + acc[j].y) + (acc[j].z + acc[j].w);
    }
    const float mean = wave_sum(s) * (1.0f / DM);
    float s2 = 0.f;
#pragma unroll
    for (int j = 0; j < 4; ++j) { acc[j].x -= mean; acc[j].y -= mean; acc[j].z -= mean; acc[j].w -= mean; s2 += (acc[j].x * acc[j].x + acc[j].y * acc[j].y) + (acc[j].z * acc[j].z + acc[j].w * acc[j].w); }
    const float rstd = 1.0f / sqrtf(wave_sum(s2) * (1.0f / DM) + LN_EPS);
    const float* g2 = p.ln2_g + li * DM; const float* b2 = p.ln2_b + li * DM;
#pragma unroll
    for (int j = 0; j < 4; ++j) {
        const float4 gg = *(const float4*)(g2 + 256 * j + 4 * lane), bv = *(const float4*)(b2 + 256 * j + 4 * lane);
        *(float4*)(row + 256 * j + 4 * lane) = make_float4(acc[j].x * rstd * gg.x + bv.x, acc[j].y * rstd * gg.y + bv.y, acc[j].z * rstd * gg.z + bv.z, acc[j].w * rstd * gg.w + bv.w);
    }
}

constexpr int PH_PER_LAYER = 9, NPHASE = 1 + 2 * PH_PER_LAYER;

#define PH_BEGIN(k) if (lo <= (k) && (k) < hi && ((k) == 0 || PHON(((k) - 1) % 9))) {
#define PH_END(k) if ((k) + 1 < hi) xcd_barrier(bar); }

template <int LI>
__device__ __forceinline__ void run_layer(const Params& p, float* lds, const XcdBarrier& bar, int lo, int hi) {
    constexpr int li = LI, base = 1 + LI * PH_PER_LAYER;
    const int tid = threadIdx.x, lane = tid & 63, wave = __builtin_amdgcn_readfirstlane(tid >> 6);
    const int G = gridDim.x;
    float* stream = p.out;
    PH_BEGIN(base + 0)
        const float* xin = (li == 0) ? p.x : stream;
        EpiZ e{(bf16*)(p.ws + WS_Z), (float*)(p.ws + WS_GATES)};
        gemm_phase_f32(xin, DM, p.w_in + (size_t)li * DM * NZ, NZ, DM, lds, e);
    PH_END(base + 0)
    PH_BEGIN(base + 1)
        const int nitems = 2048 + (NT * 4) / NWAVE;
        for (int it = blockIdx.x; it < nitems; it += G) {
            if (it < 1024) ret_state_item(p, it, lds);
            else if (it < 2048) mls_state_item(p, li, it - 1024, lds);
            else attn_pair(p, (it - 2048) * NWAVE + wave, lane);
        }
    PH_END(base + 1)
    PH_BEGIN(base + 2)
        p3_scans(p);
    PH_END(base + 2)
    PH_BEGIN(base + 3)
        for (int it = blockIdx.x; it < 2048; it += G) { if (it < 1024) ret_out_item(p, li, it, lds); else mls_out_item(p, li, it - 1024, lds); }
    PH_END(base + 3)
    PH_BEGIN(base + 4)
        const float* xin = (li == 0) ? p.x : stream;
        EpiRes e{xin, stream};
        gemm_phase_f32((const float*)(p.ws + WS_MIX), DM, p.w_out + (size_t)li * DM * DM, DM, DM, lds, e);
    PH_END(base + 4)
    PH_BEGIN(base + 5)
        for (int r = blockIdx.x * NWAVE + wave; r < NT; r += G * NWAVE) ln_row_inplace(stream + (size_t)r * DM, p.ln1_g + li * DM, p.ln1_b + li * DM, lane);
        EpiStore e{(float*)(p.ws + WS_E), DM};
        gemm_phase_f32(p.p + (size_t)li * NT * 256, 256, p.wp + (size_t)li * 256 * DM, DM, 256, lds, e);
    PH_END(base + 5)
    PH_BEGIN(base + 6)
        EpiStore eq{(float*)(p.ws + WS_QRY), 2048};
        gemm_phase_f32(stream, DM, p.wq + (size_t)li * DM * 2048, 2048, DM, lds, eq);
        EpiGate eg{(float*)(p.ws + WS_E), p.bg + li * DM};
        gemm_phase_f32(stream, DM, p.wg + (size_t)li * DM * DM, DM, DM, lds, eg);
    PH_END(base + 6)
    PH_BEGIN(base + 7)
        for (int it = blockIdx.x; it < (NT / 64) * 8; it += G) topk_item(p, li, it, lds);
    PH_END(base + 7)
    PH_BEGIN(base + 8)
        for (int t = blockIdx.x * NWAVE + wave; t < NT; t += G * NWAVE) peer_token(p, li, t, lane);
    PH_END(base + 8)
}

__global__ void __launch_bounds__(NTHR, 2) mk_fwd(Params p) {
    extern __shared__ __attribute__((aligned(16))) unsigned char lds_raw[];
    float* lds = (float*)lds_raw;
    const int tid = threadIdx.x;
    volatile LAS unsigned* MISC = (volatile LAS unsigned*)((LAS unsigned char*)lds_raw + LDS_CTL_OFF);
    if (tid < 64) MISC[tid] = 0u;
    __syncthreads();
    const int lo = p.ph_lo, hi = p.ph_hi;
    XcdBarrier bar; bar.bar = (unsigned*)(p.ws + WS_CTL) + 1024; bar.x = 0; bar.st = nullptr;
    if (hi - lo > 1) bar = xcd_barrier_post((unsigned*)(p.ws + WS_CTL) + 1024, MISC + 8);
    PH_BEGIN(0)
        p0_tables(p);
    PH_END(0)
    run_layer<0>(p, lds, bar, lo, hi);
    run_layer<1>(p, lds, bar, lo, hi);
}

extern "C" void kernel_launch(void* const* d_in, const int* in_sizes, int n_in, void* d_out, int out_size, void* d_ws, size_t ws_size, hipStream_t stream) {
    static int grid = 0;
    if (grid == 0) {
        if (n_in != 19 || in_sizes[0] != NT * DM || out_size != NT * DM || ws_size < WS_END) { fprintf(stderr, "kernel_launch: unexpected shapes (n_in %d in0 %d out %d ws %zu)\n", n_in, n_in > 0 ? in_sizes[0] : -1, out_size, ws_size); grid = -1; return; }
        int dev = 0, cus = 0;
        if (hipGetDevice(&dev) != hipSuccess || hipDeviceGetAttribute(&cus, hipDeviceAttributeMultiprocessorCount, dev) != hipSuccess) { grid = -1; return; }
        if (hipFuncSetAttribute((const void*)mk_fwd, hipFuncAttributeMaxDynamicSharedMemorySize, LDS_BYTES) != hipSuccess) { fprintf(stderr, "kernel_launch: hipFuncSetAttribute failed\n"); grid = -1; return; }
        int per_cu = 0;
        if (hipOccupancyMaxActiveBlocksPerMultiprocessor(&per_cu, (const void*)mk_fwd, NTHR, LDS_BYTES) != hipSuccess || per_cu < 1) fprintf(stderr, "kernel_launch: occupancy query says %d\n", per_cu);
        (void)hipGetLastError();
        grid = cus;
    }
    if (grid < 0) return;
    if (hipMemsetAsync((char*)d_ws + WS_CTL, 0, CTL_ZERO_BYTES, stream) != hipSuccess) return;
    Params a{};
    a.x = (const float*)d_in[0]; a.p = (const float*)d_in[1]; a.w_in = (const float*)d_in[2]; a.conv_w = (const float*)d_in[3]; a.b_if = (const float*)d_in[4];
    a.ret_g = (const float*)d_in[5]; a.mls_g = (const float*)d_in[6]; a.w_out = (const float*)d_in[7]; a.ln1_g = (const float*)d_in[8]; a.ln1_b = (const float*)d_in[9];
    a.wq = (const float*)d_in[10]; a.keys = (const float*)d_in[11]; a.pu = (const float*)d_in[12]; a.pv = (const float*)d_in[13]; a.wg = (const float*)d_in[14];
    a.bg = (const float*)d_in[15]; a.wp = (const float*)d_in[16]; a.ln2_g = (const float*)d_in[17]; a.ln2_b = (const float*)d_in[18];
    a.out = (float*)d_out; a.ws = (unsigned char*)d_ws;
#if MK_SPLIT
    for (int ph = 0; ph < NPHASE; ++ph) { a.ph_lo = ph; a.ph_hi = ph + 1; hipLaunchKernelGGL(mk_fwd, dim3(grid), dim3(NTHR), LDS_BYTES, stream, a); }
#else
    a.ph_lo = 0; a.ph_hi = NPHASE;
    hipLaunchKernelGGL(mk_fwd, dim3(grid), dim3(NTHR), LDS_BYTES, stream, a);
#endif
}
```

```cpp
#include <hip/hip_runtime.h>
#include <cstdio>
#include <cstdint>
#include <cmath>

#ifndef MK_SPLIT
#define MK_SPLIT 0
#endif

#ifndef ONLY
#define ONLY -1
#endif
#ifndef PMASK
#define PMASK 0x1ff
#endif
#define PHON(k) ((ONLY < 0 || ONLY == (k)) && ((PMASK >> (k)) & 1))
#define LAS __attribute__((address_space(3)))
typedef unsigned short bf16;

#define XB_TMO      128
#define XB_XCNT(j)  (256  + 64 * (j))
#define XB_XSUB(j)  (1280 + 64 * (j))
#define XB_XGEN(j)  (2304 + 64 * (j))
#define XB_TOP      3328
#define XB_TOPGEN   3392
#define XCD_BAR_WORDS 3456
#define XB_SPIN_CAP (1u << 22)

__device__ __forceinline__ unsigned xb_ld(unsigned* p)              { return __hip_atomic_load(p, __ATOMIC_RELAXED, __HIP_MEMORY_SCOPE_AGENT); }
__device__ __forceinline__ unsigned xb_add(unsigned* p, unsigned v) { return __hip_atomic_fetch_add(p, v, __ATOMIC_RELAXED, __HIP_MEMORY_SCOPE_AGENT); }
__device__ __forceinline__ unsigned xb_xcc_id() { return (unsigned)__builtin_amdgcn_s_getreg((3 << 11) | 20) & 0xFu; }
#define XB_SPIN(cond, bar) do { unsigned _sp = 0; while (cond) { __builtin_amdgcn_s_sleep(1); \
    if ((++_sp & 255u) == 0u) { if (xb_ld(&(bar)[XB_TMO])) break; if (_sp > XB_SPIN_CAP) { atomicAdd(&(bar)[XB_TMO], 1u); break; } } } } while (0)

struct XcdBarrier { unsigned* bar; unsigned x; volatile LAS unsigned* st; };

__device__ __forceinline__ XcdBarrier xcd_barrier_post(unsigned* bar, volatile LAS unsigned* st) {
    XcdBarrier b; b.bar = bar; b.x = xb_xcc_id(); b.st = st;
    if (threadIdx.x == 0) (void)xb_add(&bar[XB_XCNT(b.x)], 1u);
    return b;
}
__device__ __forceinline__ void xcd_barrier_complete(unsigned* bar, unsigned x, unsigned& nloc, unsigned& nx) {
    const unsigned G = gridDim.x * gridDim.y * gridDim.z;
    unsigned sum, cnt, mine, sp = 0u;
    for (;;) {
        sum = 0u; cnt = 0u; mine = 0u;
#pragma unroll
        for (unsigned j = 0; j < 16; ++j) { const unsigned c = xb_ld(&bar[XB_XCNT(j)]); sum += c; cnt += (c > 0u) ? 1u : 0u; mine = (j == x) ? c : mine; }
        if (sum == G) break;
        __builtin_amdgcn_s_sleep(1);
        if ((++sp & 255u) == 0u) { if (xb_ld(&bar[XB_TMO])) break; if (sp > XB_SPIN_CAP) { atomicAdd(&bar[XB_TMO], 1u); break; } }
    }
    nloc = mine > 0u ? mine : 1u; nx = cnt > 0u ? cnt : 1u;
}
__device__ __forceinline__ void xcd_barrier(const XcdBarrier& b) {
    asm volatile("s_waitcnt vmcnt(0)" ::: "memory");
    __syncthreads();
    if (threadIdx.x == 0) {
        unsigned* bar = b.bar;
        __builtin_amdgcn_s_waitcnt(0);
        unsigned nloc = b.st[0], nx = b.st[1];
        if (nloc == 0u) { xcd_barrier_complete(bar, b.x, nloc, nx); b.st[0] = nloc; b.st[1] = nx; }
        const unsigned old = xb_add(&bar[XB_XSUB(b.x)], 1u);
        const unsigned gen = old / nloc;
        if (old + 1u == (gen + 1u) * nloc) {
            __builtin_amdgcn_fence(__ATOMIC_RELEASE, "agent");
            asm volatile("s_waitcnt vmcnt(0)" ::: "memory");
            const unsigned og = xb_add(&bar[XB_TOP], 1u);
            const unsigned tg = og / nx;
            if (og + 1u == (tg + 1u) * nx) xb_add(&bar[XB_TOPGEN], 1u);
            else XB_SPIN(xb_ld(&bar[XB_TOPGEN]) == tg, bar);
            __builtin_amdgcn_fence(__ATOMIC_ACQUIRE, "agent");
            xb_add(&bar[XB_XGEN(b.x)], 1u);
            asm volatile("s_waitcnt vmcnt(0)" ::: "memory");
        } else {
            XB_SPIN(xb_ld(&bar[XB_XGEN(b.x)]) == gen, bar);
            __builtin_amdgcn_fence(__ATOMIC_ACQUIRE, "agent");
            asm volatile("s_waitcnt vmcnt(0)" ::: "memory");
        }
    }
    __syncthreads();
}

namespace pg8 {
#define PG8_LAS __attribute__((address_space(3)))
typedef unsigned short bf16_t;
typedef short bf16x8 __attribute__((ext_vector_type(8)));
typedef float f32x4 __attribute__((ext_vector_type(4)));
typedef unsigned u32x4 __attribute__((ext_vector_type(4)));
constexpr int BM = 256, BK = 64, HALF = 128, HTB = HALF * BK * 2  , STAGE_BYTES = 8 * HTB, NXCD = 8, WGM = 8;

__host__ __device__ __forceinline__ int lds_byte(int r, int c) { const int st = (r >> 4) * 2 + (c >> 5), rr = r & 15, cc = c & 31, ob = rr * 64 + cc * 2; return st * 1024 + (ob ^ (((ob >> 9) & 1) << 5)); }
__host__ __device__ __forceinline__ void stage_rc(int b, int& R, int& C) { const int st = b / 1024, sb = b % 1024, swz = sb ^ (((sb >> 9) & 1) << 5); R = (st >> 1) * 16 + swz / 64; C = (st & 1) * 32 + (swz % 64) / 2; }
__host__ __device__ __forceinline__ int perm32(int rho) { const int n = rho >> 4, i = rho & 15; return 8 * (i >> 2) + 4 * n + (i & 3); }

struct Unit { int pm, pn; };
struct Gemm { const bf16_t* A; const bf16_t* Bt; int M, N, K; };

struct StaticOrder {
    int nM, nN, nwg, G, c;
    __host__ __device__ void init(int M, int N, int G_, int c_) { nM = M / BM; nN = N / BM; nwg = nM * nN; G = G_; c = c_; }
    __host__ __device__ bool next(int i, Unit& u) const {
        const long L = (long)i * G + c; if (L >= nwg) return false;
        int wgid = (int)L; { const int q = nwg / NXCD, r = nwg % NXCD, xcd = wgid % NXCD, off = wgid / NXCD; wgid = (xcd < r ? xcd * (q + 1) : r * (q + 1) + (xcd - r) * q) + off; }
        const int nig = WGM * nN, gid = wgid / nig, fm = gid * WGM, gsz = (nM - fm) < WGM ? (nM - fm) : WGM;
        u.pm = fm + ((wgid % nig) % gsz); u.pn = (wgid % nig) / gsz; return true;
    }
    __device__ __forceinline__ void a_ready(const Unit&) const {}
    __device__ __forceinline__ void done(const Unit&) const {}
};

__device__ __forceinline__ unsigned cvt_pk_bf16(float lo, float hi) { unsigned r; asm volatile("v_cvt_pk_bf16_f32 %0, %1, %2" : "=v"(r) : "v"(lo), "v"(hi)); return r; }
template <class Epi, class Sched, bool ALIGN_EPI = false, bool SP2 = false>
__device__ __forceinline__ void gemm_phase(PG8_LAS unsigned char* lds, const Gemm g, const Sched& S, const Epi& E) {
    const int tid = threadIdx.x, wid = __builtin_amdgcn_readfirstlane(tid >> 6), lane = tid & 63, wr = wid >> 2, wc = wid & 3, fr = lane & 15, fq = lane >> 4;
    const int K = g.K, nt = K / BK;
    unsigned voffA[2], voffB[2];
#pragma unroll
    for (int i = 0; i < 2; ++i) { int R, C; stage_rc(tid * 16 + i * 8192, R, C); const int Rb = Epi::PERM ? ((R & ~31) + perm32(R & 31)) : R;
        voffA[i] = (unsigned)(R * K + C) * 2u; voffB[i] = (unsigned)(Rb * K + C) * 2u; }
    const size_t kstep = (size_t)(BK * 2);
    const size_t hstep = (size_t)HALF * K * 2;
    const size_t tstep = 2 * hstep;
    const unsigned ldsw = (unsigned)wid * 1024u;
    const int aoff = lds_byte(wr * 64 + fr, fq * 8), boff = lds_byte(wc * 32 + fr, fq * 8);
#define PG8_SA(b, h) (((b) * 2 + (h)) * HTB)
#define PG8_SB(b, h) ((4 + (b) * 2 + (h)) * HTB)
#define PG8_STAGE(bufoff, gbase, voff) do { _Pragma("unroll") for (int _i = 0; _i < 2; ++_i) \
        __builtin_amdgcn_global_load_lds((const unsigned*)((const char*)(gbase) + (voff)[_i]), (PG8_LAS unsigned*)(lds + (bufoff) + ldsw + _i * 8192), 16, 0, 0); } while (0)
#define PG8_LDA(dst, b, h) do { _Pragma("unroll") for (int m = 0; m < 4; ++m) _Pragma("unroll") for (int k = 0; k < 2; ++k) dst[m][k] = *(const PG8_LAS bf16x8*)(lds + PG8_SA(b, h) + aoff + m * 2048 + k * 1024); } while (0)
#define PG8_LDB(dst, b, h) do { _Pragma("unroll") for (int n = 0; n < 2; ++n) _Pragma("unroll") for (int k = 0; k < 2; ++k) dst[n][k] = *(const PG8_LAS bf16x8*)(lds + PG8_SB(b, h) + boff + n * 2048 + k * 1024); } while (0)
#define PG8_MMA(ai, bj, At, Bt) do { __builtin_amdgcn_s_setprio(1); _Pragma("unroll") for (int m = 0; m < 4; ++m) _Pragma("unroll") for (int n = 0; n < 2; ++n) _Pragma("unroll") for (int k = 0; k < 2; ++k) \
        acc[ai][bj][m][n] = __builtin_amdgcn_mfma_f32_16x16x32_bf16(Bt[n][k], At[m][k], acc[ai][bj][m][n], 0, 0, 0); __builtin_amdgcn_s_setprio(0); } while (0)
#define PG8_WAIT_V(n) asm volatile("s_waitcnt vmcnt(" #n ")" ::: "memory")
#define PG8_WAIT_L(n) asm volatile("s_waitcnt lgkmcnt(" #n ")" ::: "memory")
#define PG8_BAR __builtin_amdgcn_s_barrier()
#define PG8_SCHED __builtin_amdgcn_sched_barrier(0)
    Unit cur, nxt; int ui = 0;
    if (!S.next(0, cur)) return;
    f32x4 acc[2][2][4][2];
#pragma unroll
    for (int a = 0; a < 2; ++a)
#pragma unroll
        for (int b = 0; b < 2; ++b)
#pragma unroll
            for (int m = 0; m < 4; ++m)
#pragma unroll
                for (int n = 0; n < 2; ++n) acc[a][b][m][n] = (f32x4){0.f, 0.f, 0.f, 0.f};
    bf16x8 At[4][2], B0[2][2], B1[2][2];
    const char* cA = (const char*)g.A + (size_t)cur.pm * tstep; const char* cB = (const char*)g.Bt + (size_t)cur.pn * tstep;
    S.a_ready(cur);
    if constexpr (SP2) {
        PG8_STAGE(PG8_SB(0, 0), cB, voffB); PG8_STAGE(PG8_SB(0, 1), cB + hstep, voffB); PG8_STAGE(PG8_SA(0, 0), cA, voffA); PG8_STAGE(PG8_SA(0, 1), cA + hstep, voffA);
        if (wr == 1) PG8_BAR;
        PG8_WAIT_V(2); PG8_BAR;
        PG8_STAGE(PG8_SB(1, 0), cB + kstep, voffB); PG8_STAGE(PG8_SA(1, 0), cA + kstep, voffA); PG8_STAGE(PG8_SB(1, 1), cB + hstep + kstep, voffB);
        PG8_WAIT_V(6); PG8_BAR;
    } else {
        PG8_STAGE(PG8_SB(0, 0), cB, voffB); PG8_STAGE(PG8_SA(0, 0), cA, voffA); PG8_STAGE(PG8_SB(0, 1), cB + hstep, voffB); PG8_STAGE(PG8_SA(0, 1), cA + hstep, voffA);
        if (wr == 1) PG8_BAR;
        PG8_WAIT_V(4); PG8_BAR;
        PG8_STAGE(PG8_SB(1, 0), cB + kstep, voffB); PG8_STAGE(PG8_SA(1, 0), cA + kstep, voffA); PG8_STAGE(PG8_SB(1, 1), cB + hstep + kstep, voffB);
        PG8_WAIT_V(6); PG8_BAR;
    }
    for (;;) {
        const bool has_next = S.next(ui + 1, nxt);
        const char* nA = has_next ? (const char*)g.A + (size_t)nxt.pm * tstep : cA; const char* nB = has_next ? (const char*)g.Bt + (size_t)nxt.pn * tstep : cB;
        for (int t = 0; t < nt; t += 2) {
            const bool last = (t == nt - 2);
            const char* a1 = cA + (size_t)(t + 1) * kstep;
            const char* a2 = last ? nA : cA + (size_t)(t + 2) * kstep; const char* b2 = last ? nB : cB + (size_t)(t + 2) * kstep;
            const char* a3 = a2 + kstep; const char* b3 = b2 + kstep;
            if (last && has_next) S.a_ready(nxt);
            if constexpr (SP2) {
            PG8_LDB(B0, 0, 0); PG8_LDB(B1, 0, 1); PG8_SCHED; PG8_LDA(At, 0, 0); PG8_STAGE(PG8_SA(1, 1), a1 + hstep, voffA);
            PG8_WAIT_V(8); PG8_WAIT_L(0); PG8_BAR; PG8_MMA(0, 0, At, B0); PG8_MMA(0, 1, At, B1); PG8_BAR; PG8_SCHED;
            PG8_LDA(At, 0, 1); PG8_STAGE(PG8_SB(0, 0), b2, voffB); PG8_STAGE(PG8_SB(0, 1), b2 + hstep, voffB); PG8_STAGE(PG8_SA(0, 0), a2, voffA);
            PG8_WAIT_V(8); PG8_WAIT_L(0); PG8_BAR; PG8_MMA(1, 0, At, B0); PG8_MMA(1, 1, At, B1); PG8_BAR; PG8_SCHED;
            PG8_LDB(B0, 1, 0); PG8_LDB(B1, 1, 1); PG8_SCHED; PG8_LDA(At, 1, 0); PG8_STAGE(PG8_SA(0, 1), a2 + hstep, voffA);
            PG8_WAIT_V(8); PG8_WAIT_L(0); PG8_BAR; PG8_MMA(0, 0, At, B0); PG8_MMA(0, 1, At, B1); PG8_BAR; PG8_SCHED;
            PG8_LDA(At, 1, 1); PG8_STAGE(PG8_SB(1, 0), b3, voffB); PG8_STAGE(PG8_SB(1, 1), b3 + hstep, voffB); PG8_STAGE(PG8_SA(1, 0), a3, voffA);
            PG8_WAIT_V(8); PG8_WAIT_L(0); PG8_BAR; PG8_MMA(1, 0, At, B0); PG8_MMA(1, 1, At, B1); PG8_BAR; PG8_SCHED;
            } else {
            PG8_LDB(B0, 0, 0); PG8_SCHED; PG8_LDA(At, 0, 0); PG8_STAGE(PG8_SA(1, 1), a1 + hstep, voffA);
            PG8_WAIT_L(8); PG8_BAR; PG8_WAIT_L(0); PG8_MMA(0, 0, At, B0); PG8_BAR; PG8_SCHED;
            PG8_LDB(B1, 0, 1); PG8_STAGE(PG8_SB(0, 0), b2, voffB);
            PG8_BAR; PG8_WAIT_L(0); PG8_MMA(0, 1, At, B1); PG8_BAR;
            PG8_LDA(At, 0, 1); PG8_STAGE(PG8_SA(0, 0), a2, voffA);
            PG8_BAR; PG8_WAIT_L(0); PG8_MMA(1, 0, At, B0); PG8_BAR; PG8_SCHED;
            PG8_STAGE(PG8_SB(0, 1), b2 + hstep, voffB);
            PG8_WAIT_V(6); PG8_BAR; PG8_MMA(1, 1, At, B1); PG8_BAR;
            PG8_LDB(B0, 1, 0); PG8_SCHED; PG8_LDA(At, 1, 0); PG8_STAGE(PG8_SA(0, 1), a2 + hstep, voffA);
            PG8_WAIT_L(8); PG8_BAR; PG8_WAIT_L(0); PG8_MMA(0, 0, At, B0); PG8_BAR; PG8_SCHED;
            PG8_LDB(B1, 1, 1); PG8_STAGE(PG8_SB(1, 0), b3, voffB);
            PG8_BAR; PG8_WAIT_L(0); PG8_MMA(0, 1, At, B1); PG8_BAR;
            PG8_LDA(At, 1, 1); PG8_STAGE(PG8_SA(1, 0), a3, voffA);
            PG8_BAR; PG8_WAIT_L(0); PG8_MMA(1, 0, At, B0); PG8_BAR; PG8_SCHED;
            PG8_STAGE(PG8_SB(1, 1), b3 + hstep, voffB);
            PG8_WAIT_V(6); PG8_BAR; PG8_MMA(1, 1, At, B1); PG8_BAR;
            }
        }
        if constexpr (ALIGN_EPI) { if (wr == 0) PG8_BAR; }
        if constexpr (!Epi::AFTER_DRAIN) { E(acc, cur, wr, wc, fr, fq); S.done(cur); }
        if (!has_next) break;
#pragma unroll
        for (int a = 0; a < 2; ++a)
#pragma unroll
            for (int b = 0; b < 2; ++b)
#pragma unroll
                for (int m = 0; m < 4; ++m)
#pragma unroll
                    for (int n = 0; n < 2; ++n) acc[a][b][m][n] = (f32x4){0.f, 0.f, 0.f, 0.f};
        cur = nxt; cA = nA; cB = nB; ++ui;
        if constexpr (ALIGN_EPI) { if (wr == 1) PG8_BAR; }
    }
    PG8_WAIT_V(0);
    if constexpr (!ALIGN_EPI) { if (wr == 0) PG8_BAR; }
    PG8_BAR;
    if constexpr (Epi::AFTER_DRAIN) { E.fused(acc, cur, wr, wc, fr, fq, lds, wid, lane); S.done(cur); }
#undef PG8_SA
#undef PG8_SB
#undef PG8_STAGE
#undef PG8_LDA
#undef PG8_LDB
#undef PG8_MMA
#undef PG8_WAIT_V
#undef PG8_WAIT_L
#undef PG8_BAR
#undef PG8_SCHED
}
}

constexpr int NB = 4, SEQ = 8192, NT = NB * SEQ, DM = 1024;
constexpr int ZW = 3328, NZ = 3336;
constexpr int C_RQ = 0, C_RK = 256, C_RV = 512, C_RG = 1024, C_AQ = 1536, C_AK = 1792, C_AV = 2048, C_MQ = 2304, C_MK = 2560, C_MV = 2816, C_MO = 3072;
constexpr float DN_ALPHA = 1.41421356237f;
constexpr float LN_EPS = 1e-5f;
constexpr int NTHR = 512, NWAVE = 8;
constexpr int LDS_BYTES = 160 * 1024;
constexpr int LDS_CTL_OFF = 159 * 1024;

constexpr size_t MiB = 1u << 20;
constexpr size_t WS_CTL = 0, CTL_ZERO_BYTES = 64 * 1024;
constexpr size_t WS_RCOS = 1 * MiB, WS_RSIN = 2 * MiB, WS_ACOS = 3 * MiB, WS_ASIN = 3 * MiB + 512 * 1024;
constexpr size_t WS_RST = 4 * MiB;
constexpr size_t WS_MC = 36 * MiB;
constexpr size_t WS_MN = 52 * MiB;
constexpr size_t WS_MA = 52 * MiB + 512 * 1024, WS_MML = WS_MA + 4096, WS_MMP = WS_MML + 4096;
constexpr size_t WS_GATES = 54 * MiB;
constexpr int NZP = 3584;
constexpr size_t WS_WIN = 56 * MiB;
constexpr size_t WS_WOUT = 70 * MiB;
constexpr size_t WS_WQ = 74 * MiB;
constexpr size_t WS_WG = 82 * MiB;
constexpr size_t WS_WP = 86 * MiB;
constexpr size_t WS_KEYS = 87 * MiB;
constexpr size_t WS_PB = 88 * MiB;
constexpr size_t WS_XB = 120 * MiB;
constexpr size_t WS_AO = 120 * MiB;
constexpr size_t WS_ALSE = 168 * MiB;
constexpr size_t WS_Z = 184 * MiB;
constexpr size_t WS_MIX = 392 * MiB;
constexpr size_t WS_QRY = 184 * MiB;
constexpr size_t WS_E = 312 * MiB;
constexpr size_t WS_UQ = 376 * MiB, WS_VQ = 392 * MiB;
constexpr size_t WS_US = 408 * MiB, WS_VS = 408 * MiB + 65536;
constexpr size_t WS_RI = 456 * MiB, WS_RG = 472 * MiB;
constexpr size_t WS_END = 488 * MiB;

struct Params {
    const float *x, *p, *w_in, *conv_w, *b_if, *ret_g, *mls_g, *w_out, *ln1_g, *ln1_b, *wq, *keys, *pu, *pv, *wg, *bg, *wp, *ln2_g, *ln2_b;
    float* out; unsigned char* ws; int ph_lo, ph_hi;
};

__device__ __forceinline__ float bf2f(bf16 h) { return __uint_as_float(((unsigned)h) << 16); }
__device__ __forceinline__ unsigned f2bf(float f) { unsigned u = __float_as_uint(f); return (u + 0x7fffu + ((u >> 16) & 1u)) >> 16; }
__device__ __forceinline__ unsigned pk2(float lo, float hi) { return f2bf(lo) | (f2bf(hi) << 16); }
__device__ __forceinline__ float wave_sum(float v) {
#pragma unroll
    for (int o = 1; o < 64; o <<= 1) v += __shfl_xor(v, o);
    return v;
}
__device__ __forceinline__ float wave_max(float v) {
#pragma unroll
    for (int o = 1; o < 64; o <<= 1) v = fmaxf(v, __shfl_xor(v, o));
    return v;
}
__device__ __forceinline__ float sigmoidf_(float x) { return 1.f / (1.f + expf(-x)); }
__device__ __forceinline__ float siluf_(float x) { return x / (1.f + expf(-x)); }
__device__ __forceinline__ void unpack8(const uint4 v, float* o) {
    o[0] = __uint_as_float(v.x << 16); o[1] = __uint_as_float(v.x & 0xffff0000u);
    o[2] = __uint_as_float(v.y << 16); o[3] = __uint_as_float(v.y & 0xffff0000u);
    o[4] = __uint_as_float(v.z << 16); o[5] = __uint_as_float(v.z & 0xffff0000u);
    o[6] = __uint_as_float(v.w << 16); o[7] = __uint_as_float(v.w & 0xffff0000u);
}

template <class Epi>
__device__ __forceinline__ void gemm_tile_f32(const float* __restrict__ A, int lda, const float* __restrict__ W, int N, int K, int m0, int n0, float* lds, const Epi& epi) {
    float* As = lds; float* Bs = lds + 16 * 132;
    const int tid = threadIdx.x, ty = tid >> 4, tx = tid & 15;
    float acc[4][8];
#pragma unroll
    for (int i = 0; i < 4; ++i)
#pragma unroll
        for (int j = 0; j < 8; ++j) acc[i][j] = 0.f;
    const int arow = tid >> 2, akq = (tid & 3) * 4;
    const int bk = tid >> 5, bn = (tid & 31) * 4;
    const bool bvalid = (n0 + bn) < N;
    const float* ap = A + (size_t)(m0 + arow) * lda + akq;
    const float* bp = W + (size_t)bk * N + n0 + bn;
    for (int k0 = 0; k0 < K; k0 += 16) {
        const float4 av = *(const float4*)(ap + k0);
        float4 bv = make_float4(0.f, 0.f, 0.f, 0.f);
        if (bvalid) bv = *(const float4*)(bp + (size_t)k0 * N);
        __syncthreads();
        As[(akq + 0) * 132 + arow] = av.x; As[(akq + 1) * 132 + arow] = av.y; As[(akq + 2) * 132 + arow] = av.z; As[(akq + 3) * 132 + arow] = av.w;
        *(float4*)(Bs + bk * 128 + bn) = bv;
        __syncthreads();
#pragma unroll
        for (int k = 0; k < 16; ++k) {
            const float4 a = *(const float4*)(As + k * 132 + ty * 4);
            const float4 b0 = *(const float4*)(Bs + k * 128 + tx * 8);
            const float4 b1 = *(const float4*)(Bs + k * 128 + tx * 8 + 4);
            const float aa[4] = {a.x, a.y, a.z, a.w};
            const float bb[8] = {b0.x, b0.y, b0.z, b0.w, b1.x, b1.y, b1.z, b1.w};
#pragma unroll
            for (int i = 0; i < 4; ++i)
#pragma unroll
                for (int j = 0; j < 8; ++j) acc[i][j] = fmaf(aa[i], bb[j], acc[i][j]);
        }
    }
#pragma unroll
    for (int i = 0; i < 4; ++i) epi(m0 + ty * 4 + i, n0 + tx * 8, acc[i]);
    __syncthreads();
}

struct EpiZ {
    bf16* Z; float* gates;
    __device__ __forceinline__ void operator()(int row, int col0, const float (&v)[8]) const {
        if (col0 < ZW) { uint4 w; w.x = pk2(v[0], v[1]); w.y = pk2(v[2], v[3]); w.z = pk2(v[4], v[5]); w.w = pk2(v[6], v[7]); *(uint4*)(Z + (size_t)row * ZW + col0) = w; }
        else if (col0 == ZW) { float* g = gates + (size_t)row * 8; *(float4*)g = make_float4(v[0], v[1], v[2], v[3]); *(float4*)(g + 4) = make_float4(v[4], v[5], v[6], v[7]); }
    }
};
struct EpiRes {
    const float* xin; float* out;
    __device__ __forceinline__ void operator()(int row, int col0, const float (&v)[8]) const {
        const size_t o = (size_t)row * DM + col0;
        const float4 a = *(const float4*)(xin + o), b = *(const float4*)(xin + o + 4);
        *(float4*)(out + o) = make_float4(DN_ALPHA * a.x + v[0], DN_ALPHA * a.y + v[1], DN_ALPHA * a.z + v[2], DN_ALPHA * a.w + v[3]);
        *(float4*)(out + o + 4) = make_float4(DN_ALPHA * b.x + v[4], DN_ALPHA * b.y + v[5], DN_ALPHA * b.z + v[6], DN_ALPHA * b.w + v[7]);
    }
};
struct EpiStore {
    float* out; int ld;
    __device__ __forceinline__ void operator()(int row, int col0, const float (&v)[8]) const {
        const size_t o = (size_t)row * ld + col0;
        *(float4*)(out + o) = make_float4(v[0], v[1], v[2], v[3]); *(float4*)(out + o + 4) = make_float4(v[4], v[5], v[6], v[7]);
    }
};
struct EpiGate {
    float* E; const float* bg;
    __device__ __forceinline__ void operator()(int row, int col0, const float (&v)[8]) const {
        const size_t o = (size_t)row * DM + col0;
        float4 a = *(const float4*)(E + o), b = *(const float4*)(E + o + 4);
        a.x *= sigmoidf_(v[0] + bg[col0 + 0]); a.y *= sigmoidf_(v[1] + bg[col0 + 1]); a.z *= sigmoidf_(v[2] + bg[col0 + 2]); a.w *= sigmoidf_(v[3] + bg[col0 + 3]);
        b.x *= sigmoidf_(v[4] + bg[col0 + 4]); b.y *= sigmoidf_(v[5] + bg[col0 + 5]); b.z *= sigmoidf_(v[6] + bg[col0 + 6]); b.w *= sigmoidf_(v[7] + bg[col0 + 7]);
        *(float4*)(E + o) = a; *(float4*)(E + o + 4) = b;
    }
};

template <class Epi>
__device__ __forceinline__ void gemm_phase_f32(const float* A, int lda, const float* W, int N, int K, float* lds, const Epi& epi) {
    const int ntn = (N + 127) / 128, ntm = NT / 128, nit = ntn * ntm;
    for (int it = blockIdx.x; it < nit; it += gridDim.x) { const int mt = it / ntn, nt = it - mt * ntn; gemm_tile_f32(A, lda, W, N, K, mt * 128, nt * 128, lds, epi); }
}

typedef float f32x4 __attribute__((ext_vector_type(4)));
typedef unsigned u32x4 __attribute__((ext_vector_type(4)));
struct EpiZ16 {
    static constexpr bool PERM = true, AFTER_DRAIN = false;
    bf16* Z; float* gates; const float* acos_; const float* asin_;
    __device__ __forceinline__ void operator()(const f32x4 (&acc)[2][2][4][2], const pg8::Unit& u, int wr, int wc, int fr, int fq) const {
        const int row0 = u.pm * 256 + wr * 64 + fr;
        if (u.pn < 13) {
            const int col0 = u.pn * 256 + wc * 32 + 8 * fq;
            const bool rot = (u.pn == 6 || u.pn == 7) && ((wc & 1) == 0);
            const float qs = (u.pn == 6) ? 0.125f : 1.0f;
#pragma unroll
            for (int ai = 0; ai < 2; ++ai)
#pragma unroll
                for (int m = 0; m < 4; ++m) { const int row = row0 + ai * 128 + m * 16; bf16* rowp = Z + (size_t)row * ZW + col0;
#pragma unroll
                    for (int bj = 0; bj < 2; ++bj) { f32x4 v0 = acc[ai][bj][m][0], v1 = acc[ai][bj][m][1];
                        if (rot) {
                            f32x4 p0, p1;
#pragma unroll
                            for (int j = 0; j < 4; ++j) { p0[j] = __shfl_xor(v0[j], 16); p1[j] = __shfl_xor(v1[j], 16); }
                            if (fq < 2) {
                                const int pos = row & (SEQ - 1);
                                const f32x4 c0 = *(const f32x4*)(acos_ + pos * 8), c1 = *(const f32x4*)(acos_ + pos * 8 + 4), s0 = *(const f32x4*)(asin_ + pos * 8), s1 = *(const f32x4*)(asin_ + pos * 8 + 4);
                                const float sg = (fq == 0) ? -1.0f : 1.0f;
                                v0 = v0 * c0 + p0 * s0 * sg; v1 = v1 * c1 + p1 * s1 * sg;
                            }
                        }
                        v0 = v0 * qs; v1 = v1 * qs;
                        u32x4 w; w.x = pk2(v0[0], v0[1]); w.y = pk2(v0[2], v0[3]); w.z = pk2(v1[0], v1[1]); w.w = pk2(v1[2], v1[3]);
                        *(u32x4*)(rowp + bj * 128) = w; } }
        } else if (wc == 0 && fq == 0) {
#pragma unroll
            for (int ai = 0; ai < 2; ++ai)
#pragma unroll
                for (int m = 0; m < 4; ++m) { float* g = gates + (size_t)(row0 + ai * 128 + m * 16) * 8; *(f32x4*)g = acc[ai][0][m][0]; *(f32x4*)(g + 4) = acc[ai][0][m][1]; }
        }
    }
};
struct EpiBf16Store {
    static constexpr bool PERM = true, AFTER_DRAIN = false;
    bf16* O; int ldc;
    __device__ __forceinline__ void operator()(const f32x4 (&acc)[2][2][4][2], const pg8::Unit& u, int wr, int wc, int fr, int fq) const {
        const int row0 = u.pm * 256 + wr * 64 + fr, col0 = u.pn * 256 + wc * 32 + 8 * fq;
#pragma unroll
        for (int ai = 0; ai < 2; ++ai)
#pragma unroll
            for (int m = 0; m < 4; ++m) { bf16* rowp = O + (size_t)(row0 + ai * 128 + m * 16) * ldc + col0;
#pragma unroll
                for (int bj = 0; bj < 2; ++bj) { const f32x4 v0 = acc[ai][bj][m][0], v1 = acc[ai][bj][m][1];
                    u32x4 w; w.x = pk2(v0[0], v0[1]); w.y = pk2(v0[2], v0[3]); w.z = pk2(v1[0], v1[1]); w.w = pk2(v1[2], v1[3]);
                    *(u32x4*)(rowp + bj * 128) = w; } }
    }
};
struct EpiGate16 {
    static constexpr bool PERM = true, AFTER_DRAIN = false;
    bf16* E; const float* bg;
    __device__ __forceinline__ void operator()(const f32x4 (&acc)[2][2][4][2], const pg8::Unit& u, int wr, int wc, int fr, int fq) const {
        const int row0 = u.pm * 256 + wr * 64 + fr, col0 = u.pn * 256 + wc * 32 + 8 * fq;
#pragma unroll
        for (int bj = 0; bj < 2; ++bj) {
            const f32x4 b0 = *(const f32x4*)(bg + col0 + bj * 128), b1 = *(const f32x4*)(bg + col0 + bj * 128 + 4);
#pragma unroll
            for (int ai = 0; ai < 2; ++ai)
#pragma unroll
                for (int m = 0; m < 4; ++m) { bf16* ep = E + (size_t)(row0 + ai * 128 + m * 16) * DM + col0 + bj * 128;
                    const uint4 pv = *(const uint4*)ep; float pp[8]; unpack8(pv, pp);
                    const f32x4 v0 = acc[ai][bj][m][0] + b0, v1 = acc[ai][bj][m][1] + b1;
                    u32x4 w; w.x = pk2(pp[0] * sigmoidf_(v0[0]), pp[1] * sigmoidf_(v0[1])); w.y = pk2(pp[2] * sigmoidf_(v0[2]), pp[3] * sigmoidf_(v0[3]));
                    w.z = pk2(pp[4] * sigmoidf_(v1[0]), pp[5] * sigmoidf_(v1[1])); w.w = pk2(pp[6] * sigmoidf_(v1[2]), pp[7] * sigmoidf_(v1[3]));
                    *(u32x4*)ep = w; }
        }
    }
};
struct EpiRes16 {
    static constexpr bool PERM = false, AFTER_DRAIN = false;
    const float* xin; float* out;
    __device__ __forceinline__ void operator()(const f32x4 (&acc)[2][2][4][2], const pg8::Unit& u, int wr, int wc, int fr, int fq) const {
        const int row0 = u.pm * 256 + wr * 64 + fr, col0 = u.pn * 256 + wc * 32 + 4 * fq;
#pragma unroll
        for (int ai = 0; ai < 2; ++ai)
#pragma unroll
            for (int m = 0; m < 4; ++m) { const size_t ro = (size_t)(row0 + ai * 128 + m * 16) * DM + col0;
#pragma unroll
                for (int bj = 0; bj < 2; ++bj)
#pragma unroll
                    for (int n = 0; n < 2; ++n) { const size_t o = ro + bj * 128 + n * 16; const f32x4 xv = *(const f32x4*)(xin + o); *(f32x4*)(out + o) = xv * DN_ALPHA + acc[ai][bj][m][n]; } }
    }
};
template <class Epi>
__device__ __forceinline__ void gemm16(LAS unsigned char* lds, const bf16* A, const bf16* Bt, int N, int K, const Epi& e) {
    pg8::Gemm g{A, Bt, NT, N, K}; pg8::StaticOrder S; S.init(NT, N, (int)gridDim.x, (int)blockIdx.x);
    pg8::gemm_phase<Epi, pg8::StaticOrder, true, true>(lds, g, S, e);
}

__device__ __forceinline__ void tr_item(const float* W, int K, int N, bf16* WT, float* scr, int item, int nblk, int lane) {
    const int kb = item / nblk, nb = item - kb * nblk, k0 = 64 * kb, n0 = 32 * nb;
    const int n = n0 + (lane & 31); const bool ok = n < N;
#pragma unroll 8
    for (int i = 0; i < 32; ++i) { const int kk = 2 * i + (lane >> 5); scr[kk * 33 + (lane & 31)] = ok ? W[(size_t)(k0 + kk) * N + n] : 0.f; }
    asm volatile("s_waitcnt lgkmcnt(0)" ::: "memory");
    const int c = lane & 7;
#pragma unroll
    for (int j = 0; j < 4; ++j) { const int nn = (lane >> 3) + 8 * j; const float* sp = scr + (8 * c) * 33 + nn;
        uint4 o; o.x = pk2(sp[0 * 33], sp[1 * 33]); o.y = pk2(sp[2 * 33], sp[3 * 33]); o.z = pk2(sp[4 * 33], sp[5 * 33]); o.w = pk2(sp[6 * 33], sp[7 * 33]);
        *(uint4*)(WT + (size_t)(n0 + nn) * K + k0 + 8 * c) = o; }
    asm volatile("s_waitcnt lgkmcnt(0)" ::: "memory");
}
__device__ __forceinline__ void cvt_f32_bf16(const float* src, bf16* dst, size_t n8) {
    const size_t gt = (size_t)blockIdx.x * NTHR + threadIdx.x, GT = (size_t)gridDim.x * NTHR;
    for (size_t i = gt; i < n8; i += GT) {
        const float4 a = *(const float4*)(src + i * 8), b = *(const float4*)(src + i * 8 + 4);
        uint4 o; o.x = pk2(a.x, a.y); o.y = pk2(a.z, a.w); o.z = pk2(b.x, b.y); o.w = pk2(b.z, b.w);
        *(uint4*)(dst + i * 8) = o;
    }
}
__device__ __forceinline__ void p0_weights(const Params& p, float* lds) {
    const int lane = threadIdx.x & 63, wave = __builtin_amdgcn_readfirstlane((int)threadIdx.x >> 6);
    float* scr = lds + wave * (64 * 33);
    const int gw = blockIdx.x * NWAVE + wave, NGW = gridDim.x * NWAVE;
    constexpr int I_IN = 16 * (NZP / 32), I_OUT = 16 * 32, I_Q = 16 * 64, I_G = 16 * 32, I_P = 4 * 32, I_L = I_IN + I_OUT + I_Q + I_G + I_P;
    for (int it = gw; it < 2 * I_L; it += NGW) {
        const int li = it / I_L; int r = it - li * I_L;
        if (r < I_IN) { tr_item(p.w_in + (size_t)li * DM * NZ, DM, NZ, (bf16*)(p.ws + WS_WIN) + (size_t)li * NZP * DM, scr, r, NZP / 32, lane); continue; } r -= I_IN;
        if (r < I_OUT) { tr_item(p.w_out + (size_t)li * DM * DM, DM, DM, (bf16*)(p.ws + WS_WOUT) + (size_t)li * DM * DM, scr, r, 32, lane); continue; } r -= I_OUT;
        if (r < I_Q) { tr_item(p.wq + (size_t)li * DM * 2048, DM, 2048, (bf16*)(p.ws + WS_WQ) + (size_t)li * 2048 * DM, scr, r, 64, lane); continue; } r -= I_Q;
        if (r < I_G) { tr_item(p.wg + (size_t)li * DM * DM, DM, DM, (bf16*)(p.ws + WS_WG) + (size_t)li * DM * DM, scr, r, 32, lane); continue; } r -= I_G;
        tr_item(p.wp + (size_t)li * 256 * DM, 256, DM, (bf16*)(p.ws + WS_WP) + (size_t)li * DM * 256, scr, r, 32, lane);
    }
    cvt_f32_bf16(p.x, (bf16*)(p.ws + WS_XB), (size_t)NT * DM / 8);
    cvt_f32_bf16(p.p, (bf16*)(p.ws + WS_PB), (size_t)2 * NT * 256 / 8);
    cvt_f32_bf16(p.keys, (bf16*)(p.ws + WS_KEYS), (size_t)2 * 8 * 2 * 128 * 128 / 8);
}

__device__ __forceinline__ void p0_tables(const Params& p) {
    float* rcos = (float*)(p.ws + WS_RCOS); float* rsin = (float*)(p.ws + WS_RSIN); float* acos_ = (float*)(p.ws + WS_ACOS); float* asin_ = (float*)(p.ws + WS_ASIN);
    const int gt = blockIdx.x * NTHR + threadIdx.x, GT = gridDim.x * NTHR;
    for (int i = gt; i < SEQ * 32; i += GT) { const int pos = i >> 5, k = i & 31; const float inv = powf(10000.0f, -(float)k / 32.0f); const float ang = (float)pos * inv; rcos[i] = cosf(ang); rsin[i] = sinf(ang); }
    for (int i = gt; i < SEQ * 8; i += GT) { const int pos = i >> 3, k = i & 7; const float inv = powf(500000.0f, -(float)k / 8.0f); const float ang = (float)pos * inv; acos_[i] = cosf(ang); asin_[i] = sinf(ang); }
}

__device__ __forceinline__ float ret_lg(int h) { return logf(1.0f - exp2f(-5.0f - (float)h)); }

__device__ __forceinline__ void ret_state_item(const Params& p, int item, float* lds) {
    const int tid = threadIdx.x;
    const int c = item & 63, bh = item >> 6, h = bh & 3, b = bh >> 2;
    const int t0 = b * SEQ + c * 128, s0 = c * 128;
    const bf16* Z = (const bf16*)(p.ws + WS_Z);
    const float* rcos = (const float*)(p.ws + WS_RCOS); const float* rsin = (const float*)(p.ws + WS_RSIN);
    float* RST = (float*)(p.ws + WS_RST);
    float* Kz = lds; float* V = lds + 128 * 64;
    const float lg = ret_lg(h);
    for (int idx = tid; idx < 128 * 32; idx += NTHR) {
        const int row = idx >> 5, i = idx & 31;
        const bf16* zr = Z + (size_t)(t0 + row) * ZW + C_RK + h * 64;
        const float x1 = bf2f(zr[i]), x2 = bf2f(zr[i + 32]);
        const float cs = rcos[(s0 + row) * 32 + i], sn = rsin[(s0 + row) * 32 + i];
        const float sc = 0.125f * expf(lg * (float)(127 - row));
        Kz[row * 64 + i] = (x1 * cs - x2 * sn) * sc; Kz[row * 64 + i + 32] = (x2 * cs + x1 * sn) * sc;
    }
    for (int idx = tid; idx < 128 * 128; idx += NTHR) { const int row = idx >> 7, d = idx & 127; V[idx] = bf2f(Z[(size_t)(t0 + row) * ZW + C_RV + h * 128 + d]); }
    __syncthreads();
    const int k = tid >> 3, v0 = (tid & 7) * 16;
    float acc[16];
#pragma unroll
    for (int j = 0; j < 16; ++j) acc[j] = 0.f;
#pragma unroll 4
    for (int s = 0; s < 128; ++s) {
        const float kk = Kz[s * 64 + k];
#pragma unroll
        for (int j = 0; j < 16; ++j) acc[j] = fmaf(kk, V[s * 128 + v0 + j], acc[j]);
    }
    float* dst = RST + (size_t)item * 8192 + k * 128 + v0;
#pragma unroll
    for (int j = 0; j < 16; ++j) dst[j] = acc[j];
    __syncthreads();
}

__device__ __forceinline__ float logsigmoidf_(float f) { return fminf(f, 0.f) - log1pf(expf(-fabsf(f))); }

__device__ __forceinline__ void mls_state_item(const Params& p, int li, int item, float* lds) {
    const int tid = threadIdx.x;
    const int c = item & 63, bh = item >> 6, h = bh & 3, b = bh >> 2;
    const int t0 = b * SEQ + c * 128;
    const bf16* Z = (const bf16*)(p.ws + WS_Z);
    const float* gates = (const float*)(p.ws + WS_GATES);
    float* MC = (float*)(p.ws + WS_MC); float* MN = (float*)(p.ws + WS_MN); float* MA = (float*)(p.ws + WS_MA); float* MML = (float*)(p.ws + WS_MML);
    const float* cw = p.conv_w + (size_t)li * 4 * 512;
    float* Kc = lds; float* Vv = lds + 8192; float* ib = lds + 16384; float* bb = ib + 128; float* wk = bb + 128; float* scal = wk + 128;
    for (int idx = tid; idx < 128 * 64; idx += NTHR) {
        const int row = idx >> 6, d = idx & 63, ch = 256 + h * 64 + d;
        float a = 0.f;
#pragma unroll
        for (int j = 0; j < 4; ++j) { const int sp = c * 128 + row - 3 + j; if (sp >= 0) a = fmaf(cw[j * 512 + ch], bf2f(Z[(size_t)(t0 + row - 3 + j) * ZW + C_MK + h * 64 + d]), a); }
        Kc[idx] = siluf_(a) * 0.125f;
        Vv[idx] = bf2f(Z[(size_t)(t0 + row) * ZW + C_MV + h * 64 + d]);
    }
    if (tid < 128) {
        const int t = t0 + tid;
        const float ig = gates[(size_t)t * 8 + h] + p.b_if[li * 8 + h];
        const float fg = gates[(size_t)t * 8 + 4 + h] + p.b_if[li * 8 + 4 + h];
        ib[tid] = ig; bb[tid] = logsigmoidf_(fg);
    }
    __syncthreads();
    if (tid == 0) {
        float run = 0.f;
#pragma unroll 4
        for (int s = 0; s < 128; ++s) { run += bb[s]; bb[s] = run; }
        float ml = -INFINITY;
        for (int s = 0; s < 128; ++s) ml = fmaxf(ml, run - bb[s] + ib[s]);
        scal[0] = run; scal[1] = ml;
    }
    __syncthreads();
    const float a = scal[0], ml = scal[1];
    if (tid < 128) wk[tid] = expf(a - bb[tid] + ib[tid] - ml);
    __syncthreads();
    const int k = tid >> 3, v0 = (tid & 7) * 8;
    float acc[8], nacc = 0.f;
#pragma unroll
    for (int j = 0; j < 8; ++j) acc[j] = 0.f;
#pragma unroll 4
    for (int s = 0; s < 128; ++s) {
        const float kw = Kc[s * 64 + k] * wk[s];
        nacc += kw;
#pragma unroll
        for (int j = 0; j < 8; ++j) acc[j] = fmaf(kw, Vv[s * 64 + v0 + j], acc[j]);
    }
    float* dst = MC + (size_t)item * 4096 + k * 64 + v0;
#pragma unroll
    for (int j = 0; j < 8; ++j) dst[j] = acc[j];
    if ((tid & 7) == 0) MN[(size_t)item * 64 + k] = nacc;
    if (tid == 0) { MA[item] = a; MML[item] = ml; }
    __syncthreads();
}

typedef short bf16x8_t __attribute__((ext_vector_type(8)));
typedef short s16x4_t __attribute__((ext_vector_type(4)));
typedef float f32x16 __attribute__((ext_vector_type(16)));
typedef float f32x2_t __attribute__((ext_vector_type(2))); typedef __bf16 bf16x2_t __attribute__((ext_vector_type(2)));
__device__ __forceinline__ unsigned cvtpk(float lo, float hi) { f32x2_t v = {lo, hi}; bf16x2_t b = __builtin_convertvector(v, bf16x2_t); return __builtin_bit_cast(unsigned, b); }
__device__ __forceinline__ s16x4_t lds_tr(const LAS unsigned char* p) { return __builtin_bit_cast(s16x4_t, __builtin_amdgcn_ds_read_tr16_b64_v4i16((LAS s16x4_t*)p)); }

__device__ __forceinline__ void attn_unit(const Params& p, int unit, LAS unsigned char* lds) {
    const int tid = threadIdx.x, lane = tid & 63, wave = __builtin_amdgcn_readfirstlane(tid >> 6);
    const int r32 = lane & 31, hh = lane >> 5;
    const bf16* Z = (const bf16*)(p.ws + WS_Z);
    const int bh = unit / 96, uu = unit - bh * 96, r = uu >> 5, v = uu & 31;
    const int dl = 1 << (2 * r), nb = 32 >> (2 * r);
    const int x = v / nb, blk = v - x * nb, q0 = blk * 256;
    const int b = bh >> 2, h = bh & 3;
    bf16* AO = (bf16*)(p.ws + WS_AO) + (size_t)r * NT * 256; float* ALSE = (float*)(p.ws + WS_ALSE) + (size_t)r * NT * 4;
    LAS unsigned char* Ks = lds; LAS unsigned char* Vs = lds + 384 * 128;
    for (int idx = tid; idx < 384 * 8; idx += NTHR) {
        const int i = idx >> 3, c = idx & 7, jk = q0 - 128 + i;
        u32x4 kv = {0u, 0u, 0u, 0u}, vv = {0u, 0u, 0u, 0u};
        if (jk >= 0) { const bf16* zr = Z + (size_t)(b * SEQ + jk * dl + x) * ZW + h * 64 + c * 8; kv = *(const u32x4*)(zr + C_AK); vv = *(const u32x4*)(zr + C_AV); }
        const int off = i * 128 + ((c ^ (i & 7)) << 4);
        *(LAS u32x4*)(Ks + off) = kv; *(LAS u32x4*)(Vs + off) = vv;
    }
    const int jq = q0 + 32 * wave + r32;
    const int tokq = b * SEQ + jq * dl + x;
    bf16x8_t qf[4];
#pragma unroll
    for (int ks = 0; ks < 4; ++ks) qf[ks] = *(const bf16x8_t*)(Z + (size_t)tokq * ZW + C_AQ + h * 64 + 16 * ks + 8 * hh);
    __syncthreads();
    f32x16 st[5];
#pragma unroll
    for (int tl = 0; tl < 5; ++tl) {
        f32x16 a16 = {0.f, 0.f, 0.f, 0.f, 0.f, 0.f, 0.f, 0.f, 0.f, 0.f, 0.f, 0.f, 0.f, 0.f, 0.f, 0.f};
        const int i = 32 * wave + 32 * tl + r32;
#pragma unroll
        for (int ks = 0; ks < 4; ++ks) {
            const int c = 2 * ks + hh;
            const bf16x8_t kf = *(const LAS bf16x8_t*)(Ks + i * 128 + ((c ^ (i & 7)) << 4));
            a16 = __builtin_amdgcn_mfma_f32_32x32x16_bf16(kf, qf[ks], a16, 0, 0, 0);
        }
        st[tl] = a16;
    }
    const int kb = q0 + 32 * wave - 128;
    float m = -INFINITY;
#pragma unroll
    for (int tl = 0; tl < 5; ++tl)
#pragma unroll
        for (int rg = 0; rg < 16; ++rg) {
            const int c = 32 * tl + (rg & 3) + 8 * (rg >> 2) + 4 * hh;
            const bool valid = (c >= r32) && (c <= r32 + 128) && (kb + c >= 0);
            const float sv = valid ? st[tl][rg] : -INFINITY;
            st[tl][rg] = sv; m = fmaxf(m, sv);
        }
    m = fmaxf(m, __shfl_xor(m, 32));
    float den = 0.f;
#pragma unroll
    for (int tl = 0; tl < 5; ++tl)
#pragma unroll
        for (int rg = 0; rg < 16; ++rg) { const float pe = __expf(st[tl][rg] - m); st[tl][rg] = pe; den += pe; }
    den += __shfl_xor(den, 32);
    f32x16 o[2];
#pragma unroll
    for (int dt = 0; dt < 2; ++dt) o[dt] = (f32x16){0.f, 0.f, 0.f, 0.f, 0.f, 0.f, 0.f, 0.f, 0.f, 0.f, 0.f, 0.f, 0.f, 0.f, 0.f, 0.f};
    const int tq = (lane & 15) >> 2, tp = lane & 3, tg = (lane >> 4) & 1;
#pragma unroll
    for (int tl = 0; tl < 5; ++tl)
#pragma unroll
        for (int s2 = 0; s2 < 2; ++s2) {
            u32x4 pw; pw.x = cvtpk(st[tl][8 * s2 + 0], st[tl][8 * s2 + 1]); pw.y = cvtpk(st[tl][8 * s2 + 2], st[tl][8 * s2 + 3]); pw.z = cvtpk(st[tl][8 * s2 + 4], st[tl][8 * s2 + 5]); pw.w = cvtpk(st[tl][8 * s2 + 6], st[tl][8 * s2 + 7]);
            const bf16x8_t pb = __builtin_bit_cast(bf16x8_t, pw);
            const int i0 = 32 * wave + 32 * tl + 16 * s2 + 4 * hh + tq;
#pragma unroll
            for (int dt = 0; dt < 2; ++dt) {
                const int c = 4 * dt + 2 * tg + (tp >> 1);
                const int i1 = i0 + 8;
                const s16x4_t lo = lds_tr(Vs + i0 * 128 + ((c ^ (i0 & 7)) << 4) + 8 * (tp & 1));
                const s16x4_t hi = lds_tr(Vs + i1 * 128 + ((c ^ (i1 & 7)) << 4) + 8 * (tp & 1));
                const bf16x8_t vf = (bf16x8_t){lo[0], lo[1], lo[2], lo[3], hi[0], hi[1], hi[2], hi[3]};
                o[dt] = __builtin_amdgcn_mfma_f32_32x32x16_bf16(vf, pb, o[dt], 0, 0, 0);
            }
        }
    const float rden = 1.0f / den;
    bf16* orow = AO + (size_t)tokq * 256 + h * 64;
#pragma unroll
    for (int dt = 0; dt < 2; ++dt)
#pragma unroll
        for (int g4 = 0; g4 < 4; ++g4) {
            const int d = 32 * dt + 8 * g4 + 4 * hh;
            *(uint2*)(orow + d) = make_uint2(cvtpk(o[dt][4 * g4] * rden, o[dt][4 * g4 + 1] * rden), cvtpk(o[dt][4 * g4 + 2] * rden, o[dt][4 * g4 + 3] * rden));
        }
    if (hh == 0) ALSE[(size_t)tokq * 4 + h] = m + __logf(den);
    __syncthreads();
}

__device__ __forceinline__ void attn_merge(const Params& p) {
    const bf16* AO = (const bf16*)(p.ws + WS_AO); const float* ALSE = (const float*)(p.ws + WS_ALSE);
    bf16* MIX = (bf16*)(p.ws + WS_MIX);
    const int gt = blockIdx.x * NTHR + threadIdx.x, GT = gridDim.x * NTHR;
    for (int e = gt; e < NT * 32; e += GT) {
        const int t = e >> 5, c8 = e & 31, h = c8 >> 3;
        const float l0 = ALSE[(size_t)t * 4 + h], l1 = ALSE[(size_t)NT * 4 + (size_t)t * 4 + h], l2 = ALSE[(size_t)2 * NT * 4 + (size_t)t * 4 + h];
        const float M = fmaxf(fmaxf(l0, l1), l2);
        float w0 = __expf(l0 - M), w1 = __expf(l1 - M), w2 = __expf(l2 - M);
        const float rs = 1.0f / (w0 + w1 + w2); w0 *= rs; w1 *= rs; w2 *= rs;
        float a0[8], a1[8], a2[8];
        unpack8(*(const uint4*)(AO + (size_t)t * 256 + c8 * 8), a0);
        unpack8(*(const uint4*)(AO + (size_t)NT * 256 + (size_t)t * 256 + c8 * 8), a1);
        unpack8(*(const uint4*)(AO + (size_t)2 * NT * 256 + (size_t)t * 256 + c8 * 8), a2);
        float y[8];
#pragma unroll
        for (int j = 0; j < 8; ++j) y[j] = w0 * a0[j] + w1 * a1[j] + w2 * a2[j];
        *(uint4*)(MIX + (size_t)t * DM + 512 + c8 * 8) = make_uint4(pk2(y[0], y[1]), pk2(y[2], y[3]), pk2(y[4], y[5]), pk2(y[6], y[7]));
    }
}

__device__ __forceinline__ void p3_scans(const Params& p) {
    float* RST = (float*)(p.ws + WS_RST);
    float* MC = (float*)(p.ws + WS_MC); float* MN = (float*)(p.ws + WS_MN); const float* MA = (const float*)(p.ws + WS_MA); const float* MML = (const float*)(p.ws + WS_MML); float* MMP = (float*)(p.ws + WS_MMP);
    const int gt = blockIdx.x * NTHR + threadIdx.x, GT = gridDim.x * NTHR;
    for (int e = gt; e < 16 * 8192; e += GT) {
        const int bh = e >> 13, el = e & 8191, h = bh & 3;
        const float gL = expf(ret_lg(h) * 128.0f);
        float R = 0.f;
        float* ptr = RST + (size_t)bh * 64 * 8192 + el;
        for (int c = 0; c < 64; ++c) { const float sv = ptr[(size_t)c * 8192]; ptr[(size_t)c * 8192] = R; R = fmaf(gL, R, sv); }
    }
    for (int e = gt; e < 16 * 4160; e += GT) {
        const int bh = e / 4160, el = e - bh * 4160;
        float* ptr; size_t stride;
        if (el < 4096) { ptr = MC + (size_t)bh * 64 * 4096 + el; stride = 4096; } else { ptr = MN + (size_t)bh * 64 * 64 + (el - 4096); stride = 64; }
        float m = 0.f, C = 0.f;
        for (int c = 0; c < 64; ++c) {
            const float a = MA[bh * 64 + c], ml = MML[bh * 64 + c];
            const float mn = fmaxf(a + m, ml);
            const float f1 = expf(a + m - mn), f2 = expf(ml - mn);
            const float sv = ptr[(size_t)c * stride]; ptr[(size_t)c * stride] = C; C = f1 * C + f2 * sv;
            if (el == 0) MMP[bh * 64 + c] = m;
            m = mn;
        }
    }
}

__device__ __forceinline__ void ret_out_item(const Params& p, int li, int item, float* lds) {
    const int tid = threadIdx.x;
    const int c = item & 63, bh = item >> 6, h = bh & 3, b = bh >> 2;
    const int t0 = b * SEQ + c * 128, s0 = c * 128;
    const bf16* Z = (const bf16*)(p.ws + WS_Z);
    const float* rcos = (const float*)(p.ws + WS_RCOS); const float* rsin = (const float*)(p.ws + WS_RSIN);
    const float* RST = (const float*)(p.ws + WS_RST);
    bf16* MIX = (bf16*)(p.ws + WS_MIX);
    float* Q = lds; float* K = Q + 8320; float* SC = K + 8320; float* V = SC + 8256; float* R = V + 8192;
    const float lg = ret_lg(h);
    for (int idx = tid; idx < 128 * 32; idx += NTHR) {
        const int row = idx >> 5, i = idx & 31;
        const bf16* zq = Z + (size_t)(t0 + row) * ZW + C_RQ + h * 64; const bf16* zk = Z + (size_t)(t0 + row) * ZW + C_RK + h * 64;
        const float cs = rcos[(s0 + row) * 32 + i], sn = rsin[(s0 + row) * 32 + i];
        const float q1 = bf2f(zq[i]), q2 = bf2f(zq[i + 32]), k1 = bf2f(zk[i]), k2 = bf2f(zk[i + 32]);
        Q[row * 65 + i] = q1 * cs - q2 * sn; Q[row * 65 + i + 32] = q2 * cs + q1 * sn;
        K[row * 65 + i] = (k1 * cs - k2 * sn) * 0.125f; K[row * 65 + i + 32] = (k2 * cs + k1 * sn) * 0.125f;
    }
    __syncthreads();
    const int r = tid >> 3, d0 = (tid & 7) * 8;
#pragma unroll 1
    for (int rh = 0; rh < 2; ++rh) {
        const int t = rh * 64 + r;
#pragma unroll 1
        for (int j = 0; j < 16; ++j) {
            const int s = (tid & 7) + 8 * j;
            float dot = 0.f;
#pragma unroll 16
            for (int d = 0; d < 64; ++d) dot = fmaf(Q[t * 65 + d], K[s * 65 + d], dot);
            SC[r * 129 + s] = (s <= t) ? dot * expf(lg * (float)(t - s)) : 0.f;
        }
        __syncthreads();
        float o[2][8];
#pragma unroll
        for (int dh = 0; dh < 2; ++dh) {
            for (int idx = tid; idx < 128 * 64; idx += NTHR) { const int row = idx >> 6, d = idx & 63; V[idx] = bf2f(Z[(size_t)(t0 + row) * ZW + C_RV + h * 128 + dh * 64 + d]); }
            for (int idx = tid; idx < 64 * 64; idx += NTHR) { const int k = idx >> 6, d = idx & 63; R[idx] = RST[(size_t)item * 8192 + k * 128 + dh * 64 + d]; }
            __syncthreads();
            float acc[8], cr[8];
#pragma unroll
            for (int j = 0; j < 8; ++j) { acc[j] = 0.f; cr[j] = 0.f; }
#pragma unroll 4
            for (int s = 0; s < 128; ++s) {
                const float w = SC[r * 129 + s];
#pragma unroll
                for (int j = 0; j < 8; ++j) acc[j] = fmaf(w, V[s * 64 + d0 + j], acc[j]);
            }
#pragma unroll 4
            for (int k = 0; k < 64; ++k) {
                const float qv = Q[t * 65 + k];
#pragma unroll
                for (int j = 0; j < 8; ++j) cr[j] = fmaf(qv, R[k * 64 + d0 + j], cr[j]);
            }
            const float xi = expf(lg * (float)(t + 1));
#pragma unroll
            for (int j = 0; j < 8; ++j) o[dh][j] = acc[j] + xi * cr[j];
            __syncthreads();
        }
        float sum = 0.f;
#pragma unroll
        for (int dh = 0; dh < 2; ++dh)
#pragma unroll
            for (int j = 0; j < 8; ++j) sum += o[dh][j];
        sum += __shfl_xor(sum, 1); sum += __shfl_xor(sum, 2); sum += __shfl_xor(sum, 4);
        const float mean = sum * (1.0f / 128.0f);
        float sq = 0.f;
#pragma unroll
        for (int dh = 0; dh < 2; ++dh)
#pragma unroll
            for (int j = 0; j < 8; ++j) { const float dd = o[dh][j] - mean; sq += dd * dd; }
        sq += __shfl_xor(sq, 1); sq += __shfl_xor(sq, 2); sq += __shfl_xor(sq, 4);
        const float rstd = 1.0f / sqrtf(sq * (1.0f / 128.0f) + LN_EPS);
#pragma unroll
        for (int dh = 0; dh < 2; ++dh) {
            float y[8];
#pragma unroll
            for (int j = 0; j < 8; ++j) {
                const int d = dh * 64 + d0 + j;
                const float g = p.ret_g[li * 512 + h * 128 + d];
                const float rg = bf2f(Z[(size_t)(t0 + t) * ZW + C_RG + h * 128 + d]);
                y[j] = (o[dh][j] - mean) * rstd * g * siluf_(rg);
            }
            uint4 w; w.x = pk2(y[0], y[1]); w.y = pk2(y[2], y[3]); w.z = pk2(y[4], y[5]); w.w = pk2(y[6], y[7]);
            *(uint4*)(MIX + (size_t)(t0 + t) * DM + h * 128 + dh * 64 + d0) = w;
        }
    }
    __syncthreads();
}

__device__ __forceinline__ void mls_out_item(const Params& p, int li, int item, float* lds) {
    const int tid = threadIdx.x;
    const int c = item & 63, bh = item >> 6, h = bh & 3, b = bh >> 2;
    const int t0 = b * SEQ + c * 128;
    const bf16* Z = (const bf16*)(p.ws + WS_Z);
    const float* gates = (const float*)(p.ws + WS_GATES);
    const float* MC = (const float*)(p.ws + WS_MC); const float* MN = (const float*)(p.ws + WS_MN); const float* MMP = (const float*)(p.ws + WS_MMP);
    bf16* MIX = (bf16*)(p.ws + WS_MIX);
    const float* cw = p.conv_w + (size_t)li * 4 * 512;
    float* Q = lds; float* K = Q + 8320; float* SM = K + 8320; float* V = SM + 8256; float* C = V + 8192; float* nv = C + 4096; float* ib = nv + 64; float* bb = ib + 128; float* pm = bb + 128;
    for (int idx = tid; idx < 128 * 64; idx += NTHR) {
        const int row = idx >> 6, d = idx & 63, chq = h * 64 + d, chk = 256 + h * 64 + d;
        float aq = 0.f, ak = 0.f;
#pragma unroll
        for (int j = 0; j < 4; ++j) {
            const int sp = c * 128 + row - 3 + j;
            if (sp >= 0) {
                const bf16* zr = Z + (size_t)(t0 + row - 3 + j) * ZW;
                aq = fmaf(cw[j * 512 + chq], bf2f(zr[C_MQ + h * 64 + d]), aq);
                ak = fmaf(cw[j * 512 + chk], bf2f(zr[C_MK + h * 64 + d]), ak);
            }
        }
        Q[row * 65 + d] = siluf_(aq); K[row * 65 + d] = siluf_(ak) * 0.125f;
        V[idx] = bf2f(Z[(size_t)(t0 + row) * ZW + C_MV + h * 64 + d]);
    }
    for (int idx = tid; idx < 4096; idx += NTHR) C[idx] = MC[(size_t)item * 4096 + idx];
    if (tid < 64) nv[tid] = MN[(size_t)item * 64 + tid];
    if (tid < 128) {
        const int t = t0 + tid;
        ib[tid] = gates[(size_t)t * 8 + h] + p.b_if[li * 8 + h];
        bb[tid] = logsigmoidf_(gates[(size_t)t * 8 + 4 + h] + p.b_if[li * 8 + 4 + h]);
    }
    const float mprev = MMP[item];
    __syncthreads();
    if (tid == 0) {
        float run = 0.f, pmx = -INFINITY;
#pragma unroll 4
        for (int s = 0; s < 128; ++s) { run += bb[s]; bb[s] = run; pmx = fmaxf(pmx, ib[s] - run); pm[s] = pmx; }
    }
    __syncthreads();
    const int r = tid >> 3, d0 = (tid & 7) * 8;
#pragma unroll 1
    for (int rh = 0; rh < 2; ++rh) {
        const int t = rh * 64 + r;
        const float mt = bb[t] + fmaxf(mprev, pm[t]);
#pragma unroll 1
        for (int j = 0; j < 16; ++j) {
            const int s = (tid & 7) + 8 * j;
            float dot = 0.f;
#pragma unroll 16
            for (int d = 0; d < 64; ++d) dot = fmaf(Q[t * 65 + d], K[s * 65 + d], dot);
            SM[r * 129 + s] = (s <= t) ? dot * expf(bb[t] - bb[s] + ib[s] - mt) : 0.f;
        }
        __syncthreads();
        float acc[8], qc[8], den = 0.f, qn = 0.f;
#pragma unroll
        for (int j = 0; j < 8; ++j) { acc[j] = 0.f; qc[j] = 0.f; }
#pragma unroll 4
        for (int s = 0; s < 128; ++s) {
            const float w = SM[r * 129 + s]; den += w;
#pragma unroll
            for (int j = 0; j < 8; ++j) acc[j] = fmaf(w, V[s * 64 + d0 + j], acc[j]);
        }
#pragma unroll 4
        for (int k = 0; k < 64; ++k) {
            const float qv = Q[t * 65 + k]; qn = fmaf(qv, nv[k], qn);
#pragma unroll
            for (int j = 0; j < 8; ++j) qc[j] = fmaf(qv, C[k * 64 + d0 + j], qc[j]);
        }
        const float winter = expf(bb[t] + mprev - mt);
        den += winter * qn;
        const float denom = fmaxf(fabsf(den), expf(-mt));
        float hv[8], sum = 0.f;
#pragma unroll
        for (int j = 0; j < 8; ++j) { hv[j] = (acc[j] + winter * qc[j]) / denom; sum += hv[j]; }
        sum += __shfl_xor(sum, 1); sum += __shfl_xor(sum, 2); sum += __shfl_xor(sum, 4);
        const float mean = sum * (1.0f / 64.0f);
        float sq = 0.f;
#pragma unroll
        for (int j = 0; j < 8; ++j) { const float dd = hv[j] - mean; sq += dd * dd; }
        sq += __shfl_xor(sq, 1); sq += __shfl_xor(sq, 2); sq += __shfl_xor(sq, 4);
        const float rstd = 1.0f / sqrtf(sq * (1.0f / 64.0f) + LN_EPS);
        float y[8];
#pragma unroll
        for (int j = 0; j < 8; ++j) {
            const int d = d0 + j;
            const float g = p.mls_g[li * 256 + h * 64 + d];
            const float mo = bf2f(Z[(size_t)(t0 + t) * ZW + C_MO + h * 64 + d]);
            y[j] = (hv[j] - mean) * rstd * g * sigmoidf_(mo);
        }
        { uint4 w; w.x = pk2(y[0], y[1]); w.y = pk2(y[2], y[3]); w.z = pk2(y[4], y[5]); w.w = pk2(y[6], y[7]);
          *(uint4*)(MIX + (size_t)(t0 + t) * DM + 768 + h * 64 + d0) = w; }
        __syncthreads();
    }
}

__device__ __forceinline__ void ln_row_inplace(float* row, bf16* brow, const float* g, const float* bta, int lane) {
    float4 v[4]; float s = 0.f;
#pragma unroll
    for (int j = 0; j < 4; ++j) { v[j] = *(const float4*)(row + 256 * j + 4 * lane); s += (v[j].x + v[j].y) + (v[j].z + v[j].w); }
    const float mean = wave_sum(s) * (1.0f / DM);
    float s2 = 0.f;
#pragma unroll
    for (int j = 0; j < 4; ++j) { v[j].x -= mean; v[j].y -= mean; v[j].z -= mean; v[j].w -= mean; s2 += (v[j].x * v[j].x + v[j].y * v[j].y) + (v[j].z * v[j].z + v[j].w * v[j].w); }
    const float rstd = 1.0f / sqrtf(wave_sum(s2) * (1.0f / DM) + LN_EPS);
#pragma unroll
    for (int j = 0; j < 4; ++j) {
        const float4 gg = *(const float4*)(g + 256 * j + 4 * lane), bv = *(const float4*)(bta + 256 * j + 4 * lane);
        const float4 o = make_float4(v[j].x * rstd * gg.x + bv.x, v[j].y * rstd * gg.y + bv.y, v[j].z * rstd * gg.z + bv.z, v[j].w * rstd * gg.w + bv.w);
        *(float4*)(row + 256 * j + 4 * lane) = o;
        *(uint2*)(brow + 256 * j + 4 * lane) = make_uint2(pk2(o.x, o.y), pk2(o.z, o.w));
    }
}

__device__ __forceinline__ void topk_item(const Params& p, int li, int item, float* lds) {
    const int tid = threadIdx.x, lane = tid & 63, wave = tid >> 6;
    const int tile = item >> 3, h = item & 7, tok0 = tile * 64;
    const bf16* QRY = (const bf16*)(p.ws + WS_QRY);
    int* RI = (int*)(p.ws + WS_RI); float* RG = (float*)(p.ws + WS_RG);
    float* Kk = lds; float* Qt = Kk + 128 * 129; float* SC = Qt + 64 * 129; float* TKV = SC + 64 * 128; int* TKI = (int*)(TKV + 2048);
#pragma unroll 1
    for (int pp = 0; pp < 2; ++pp) {
        const float* kb = p.keys + ((size_t)((li * 8 + h) * 2 + pp)) * 128 * 128;
        for (int idx = tid; idx < 128 * 128; idx += NTHR) { const int n = idx >> 7, c = idx & 127; Kk[n * 129 + c] = kb[idx]; }
        for (int idx = tid; idx < 64 * 128; idx += NTHR) { const int tok = idx >> 7, c = idx & 127; Qt[tok * 129 + c] = bf2f(QRY[(size_t)(tok0 + tok) * 2048 + h * 256 + pp * 128 + c]); }
        __syncthreads();
        {
            const int tok = tid >> 3;
#pragma unroll 1
            for (int j = 0; j < 16; ++j) {
                const int n = (tid & 7) + 8 * j;
                float dot = 0.f;
#pragma unroll 16
                for (int c = 0; c < 128; ++c) dot = fmaf(Qt[tok * 129 + c], Kk[n * 129 + c], dot);
                SC[tok * 128 + n] = dot;
            }
        }
        __syncthreads();
#pragma unroll 1
        for (int q = 0; q < 8; ++q) {
            const int tok = wave * 8 + q;
            float v0 = SC[tok * 128 + lane], v1 = SC[tok * 128 + 64 + lane];
#pragma unroll 1
            for (int k = 0; k < 16; ++k) {
                const float wm = wave_max(fmaxf(v0, v1));
                const unsigned long long b0 = __ballot(v0 == wm);
                int idx;
                if (b0) { const int sl = __ffsll((long long)b0) - 1; idx = sl; if (lane == sl) v0 = -INFINITY; }
                else { const unsigned long long b1 = __ballot(v1 == wm); const int sl = __ffsll((long long)b1) - 1; idx = 64 + sl; if (lane == sl) v1 = -INFINITY; }
                if (lane == 0) { TKV[(tok * 2 + pp) * 16 + k] = wm; TKI[(tok * 2 + pp) * 16 + k] = idx; }
            }
        }
        __syncthreads();
    }
#pragma unroll 1
    for (int q = 0; q < 8; ++q) {
        const int tok = wave * 8 + q;
        const float s1 = TKV[(tok * 2) * 16 + (lane >> 2)];
        float cnd[4];
#pragma unroll
        for (int j = 0; j < 4; ++j) cnd[j] = s1 + TKV[(tok * 2 + 1) * 16 + (lane & 3) * 4 + j];
        float myval = 0.f; int myflat = 0;
#pragma unroll 1
        for (int k = 0; k < 16; ++k) {
            const float wm = wave_max(fmaxf(fmaxf(cnd[0], cnd[1]), fmaxf(cnd[2], cnd[3])));
            const bool has = (cnd[0] == wm) | (cnd[1] == wm) | (cnd[2] == wm) | (cnd[3] == wm);
            const unsigned long long bl = __ballot(has);
            const int sl = __ffsll((long long)bl) - 1;
            int fl = 0;
            if (lane == sl) {
                int j = (cnd[0] == wm) ? 0 : ((cnd[1] == wm) ? 1 : ((cnd[2] == wm) ? 2 : 3));
                fl = lane * 4 + j;
                if (j == 0) cnd[0] = -INFINITY; else if (j == 1) cnd[1] = -INFINITY; else if (j == 2) cnd[2] = -INFINITY; else cnd[3] = -INFINITY;
            }
            fl = __shfl(fl, sl);
            if (lane == k) { myval = wm; myflat = fl; }
        }
        const float m0 = __shfl(myval, 0);
        const float e = (lane < 16) ? expf(myval - m0) : 0.f;
        const float ssum = wave_sum(e);
        if (lane < 16) {
            const int a = myflat >> 4, bq = myflat & 15;
            const int eidx = TKI[(tok * 2) * 16 + a] * 128 + TKI[(tok * 2 + 1) * 16 + bq];
            RI[(size_t)(tok0 + tok) * 128 + h * 16 + lane] = eidx;
            RG[(size_t)(tok0 + tok) * 128 + h * 16 + lane] = e / ssum;
        }
    }
    __syncthreads();
}

__device__ __forceinline__ float key_embed(float v, unsigned idx, unsigned keepmask) { return __uint_as_float((__float_as_uint(v) & keepmask) | idx); }

__device__ __forceinline__ void topk_half(const bf16* qrow, const LAS unsigned char* kl, int r32, int hh, float (&out)[16]) {
    bf16x8_t qf[8];
#pragma unroll
    for (int ks = 0; ks < 8; ++ks) qf[ks] = *(const bf16x8_t*)(qrow + 16 * ks + 8 * hh);
    f32x16 st[4];
#pragma unroll
    for (int tl = 0; tl < 4; ++tl) {
        f32x16 a16 = {0.f, 0.f, 0.f, 0.f, 0.f, 0.f, 0.f, 0.f, 0.f, 0.f, 0.f, 0.f, 0.f, 0.f, 0.f, 0.f};
        const int n = 32 * tl + r32;
#pragma unroll
        for (int ks = 0; ks < 8; ++ks) {
            const int c = 2 * ks + hh;
            const bf16x8_t kf = *(const LAS bf16x8_t*)(kl + n * 256 + ((c ^ (n & 15)) << 4));
            a16 = __builtin_amdgcn_mfma_f32_32x32x16_bf16(kf, qf[ks], a16, 0, 0, 0);
        }
        st[tl] = a16;
    }
#pragma unroll
    for (int tl = 0; tl < 4; ++tl)
#pragma unroll
        for (int rg = 0; rg < 16; ++rg) st[tl][rg] = key_embed(st[tl][rg], (unsigned)(32 * tl + (rg & 3) + 8 * (rg >> 2)) | ((unsigned)hh << 2), 0xffffff80u);
#pragma unroll
    for (int k = 0; k < 16; ++k) {
        float lm = st[0][0];
#pragma unroll
        for (int tl = 0; tl < 4; ++tl)
#pragma unroll
            for (int rg = 0; rg < 16; ++rg) lm = fmaxf(lm, st[tl][rg]);
        const float km = fmaxf(lm, __shfl_xor(lm, 32));
        out[k] = km;
#pragma unroll
        for (int tl = 0; tl < 4; ++tl)
#pragma unroll
            for (int rg = 0; rg < 16; ++rg) st[tl][rg] = (st[tl][rg] == km) ? -INFINITY : st[tl][rg];
    }
}

__device__ __forceinline__ void topk_unit(const Params& p, int li, int item, LAS unsigned char* lds) {
    const int tid = threadIdx.x, lane = tid & 63, wave = __builtin_amdgcn_readfirstlane(tid >> 6);
    const int r32 = lane & 31, hh = lane >> 5;
    const int tile = item >> 3, h = item & 7;
    const int t = tile * 256 + 32 * wave + r32;
    const bf16* QRY = (const bf16*)(p.ws + WS_QRY);
    const bf16* KB = (const bf16*)(p.ws + WS_KEYS) + (size_t)((li * 8 + h) * 2) * 128 * 128;
    int* RI = (int*)(p.ws + WS_RI); float* RG = (float*)(p.ws + WS_RG);
    for (int idx = tid; idx < 2 * 128 * 16; idx += NTHR) {
        const int pp = idx >> 11, n = (idx >> 4) & 127, c = idx & 15;
        const u32x4 v = *(const u32x4*)(KB + (size_t)(pp * 128 + n) * 128 + c * 8);
        *(LAS u32x4*)(lds + pp * 32768 + n * 256 + ((c ^ (n & 15)) << 4)) = v;
    }
    __syncthreads();
    float sk0[16], sk1[16];
    topk_half(QRY + (size_t)t * 2048 + h * 256, lds, r32, hh, sk0);
    topk_half(QRY + (size_t)t * 2048 + h * 256 + 128, lds + 32768, r32, hh, sk1);
    unsigned i1s[16], i2[16];
#pragma unroll
    for (int a = 0; a < 16; ++a) { i1s[a] = (__float_as_uint(sk0[a]) & 127u) << 7; i2[a] = __float_as_uint(sk1[a]) & 127u; }
    float cd[50];
    {
        constexpr int CA[50] = {0, 0, 0, 0, 0, 0, 0, 0, 0, 0, 0, 0, 0, 0, 0, 0, 1, 1, 1, 1, 1, 1, 1, 1, 2, 2, 2, 2, 2, 3, 3, 3, 3, 4, 4, 4, 5, 5, 6, 6, 7, 7, 8, 9, 10, 11, 12, 13, 14, 15};
        constexpr int CB[50] = {0, 1, 2, 3, 4, 5, 6, 7, 8, 9, 10, 11, 12, 13, 14, 15, 0, 1, 2, 3, 4, 5, 6, 7, 0, 1, 2, 3, 4, 0, 1, 2, 3, 0, 1, 2, 0, 1, 0, 1, 0, 1, 0, 0, 0, 0, 0, 0, 0, 0};
#pragma unroll
        for (int n = 0; n < 50; ++n) cd[n] = key_embed(sk0[CA[n]] + sk1[CB[n]], i1s[CA[n]] | i2[CB[n]], 0xffffc000u);
    }
    float sel[16];
#pragma unroll
    for (int k = 0; k < 16; ++k) {
        float km = cd[0];
#pragma unroll
        for (int n = 1; n < 50; ++n) km = fmaxf(km, cd[n]);
        sel[k] = km;
#pragma unroll
        for (int n = 0; n < 50; ++n) cd[n] = (cd[n] == km) ? -INFINITY : cd[n];
    }
    float ev[16], es = 0.f;
    const float m0 = __uint_as_float((__float_as_uint(sel[0]) & 0xffffc000u) | 0x2000u);
#pragma unroll
    for (int k = 0; k < 16; ++k) { const float vk = __uint_as_float((__float_as_uint(sel[k]) & 0xffffc000u) | 0x2000u); ev[k] = __expf(vk - m0); es += ev[k]; }
    const float rs = 1.0f / es;
    int oi[8]; float og[8];
#pragma unroll
    for (int k = 0; k < 8; ++k) { float s_lo = sel[k], s_hi = sel[k + 8], g_lo = ev[k], g_hi = ev[k + 8]; asm volatile("" : "+v"(s_lo), "+v"(s_hi), "+v"(g_lo), "+v"(g_hi));
        const float sv = hh ? s_hi : s_lo; const float gv = hh ? g_hi : g_lo; oi[k] = (int)(__float_as_uint(sv) & 0x3fffu); og[k] = gv * rs; }
    int* rip = RI + (size_t)t * 128 + h * 16 + 8 * hh; float* rgp = RG + (size_t)t * 128 + h * 16 + 8 * hh;
    *(int4*)rip = make_int4(oi[0], oi[1], oi[2], oi[3]); *(int4*)(rip + 4) = make_int4(oi[4], oi[5], oi[6], oi[7]);
    *(float4*)rgp = make_float4(og[0], og[1], og[2], og[3]); *(float4*)(rgp + 4) = make_float4(og[4], og[5], og[6], og[7]);
    __syncthreads();
}

__device__ __forceinline__ void quant_rows(const float* src, unsigned char* dst, float* scl, int lane, int gw, int NGW) {
    for (int r = gw; r < 16384; r += NGW) {
        const float4* s4 = (const float4*)(src + (size_t)r * 1024 + 16 * lane);
        float4 a[4]; float am = 0.f;
#pragma unroll
        for (int j = 0; j < 4; ++j) { a[j] = s4[j]; am = fmaxf(am, fmaxf(fmaxf(fabsf(a[j].x), fabsf(a[j].y)), fmaxf(fabsf(a[j].z), fabsf(a[j].w)))); }
        am = wave_max(am);
        const float inv = am > 0.f ? 127.0f / am : 0.f;
        unsigned w[4];
#pragma unroll
        for (int j = 0; j < 4; ++j) {
            const unsigned q0 = (unsigned)(__float2int_rn(a[j].x * inv) + 128), q1 = (unsigned)(__float2int_rn(a[j].y * inv) + 128), q2 = (unsigned)(__float2int_rn(a[j].z * inv) + 128), q3 = (unsigned)(__float2int_rn(a[j].w * inv) + 128);
            w[j] = q0 | (q1 << 8) | (q2 << 16) | (q3 << 24);
        }
        *(uint4*)(dst + (size_t)r * 1024 + 16 * lane) = make_uint4(w[0], w[1], w[2], w[3]);
        if (lane == 0) scl[r] = am * (1.0f / 127.0f);
    }
}

__device__ __forceinline__ void ub4(unsigned w, float* o) { o[0] = (float)(w & 0xffu); o[1] = (float)((w >> 8) & 0xffu); o[2] = (float)((w >> 16) & 0xffu); o[3] = (float)(w >> 24); }

__device__ __forceinline__ void peer_token(const Params& p, int li, int t, int lane) {
    float* stream = p.out;
    const bf16* E = (const bf16*)(p.ws + WS_E); bf16* XB = (bf16*)(p.ws + WS_XB);
    const int* RI = (const int*)(p.ws + WS_RI); const float* RG = (const float*)(p.ws + WS_RG);
    const unsigned char* UQ = (const unsigned char*)(p.ws + WS_UQ); const unsigned char* VQ = (const unsigned char*)(p.ws + WS_VQ);
    const float* US = (const float*)(p.ws + WS_US); const float* VS = (const float*)(p.ws + WS_VS);
    float* row = stream + (size_t)t * DM + 16 * lane;
    float x[16], acc[16];
#pragma unroll
    for (int j = 0; j < 4; ++j) { const float4 v = *(const float4*)(row + 4 * j); x[4 * j] = v.x; x[4 * j + 1] = v.y; x[4 * j + 2] = v.z; x[4 * j + 3] = v.w; }
    float sx = 0.f;
#pragma unroll
    for (int j = 0; j < 16; ++j) { sx += x[j]; acc[j] = 0.f; }
    const float sumx128 = 128.0f * wave_sum(sx);
    const int e0 = RI[(size_t)t * 128 + lane], e1 = RI[(size_t)t * 128 + 64 + lane];
    const float g0 = RG[(size_t)t * 128 + lane], g1 = RG[(size_t)t * 128 + 64 + lane];
    const float su0 = US[e0], su1 = US[e1], sv0 = VS[e0], sv1 = VS[e1];
    float csum = 0.f;
    const int mi = (lane >> 3) & 7;
#pragma unroll 1
    for (int bt = 0; bt < 16; ++bt) {
        const bool lo = bt < 8;
        const int esel = lo ? e0 : e1;
        uint4 uq[8], vq[8];
#pragma unroll
        for (int i = 0; i < 8; ++i) {
            const int e = __builtin_amdgcn_readlane(esel, (bt * 8 + i) & 63);
            uq[i] = *(const uint4*)(UQ + (size_t)e * 1024 + 16 * lane);
            vq[i] = *(const uint4*)(VQ + (size_t)e * 1024 + 16 * lane);
        }
        float d[8];
#pragma unroll
        for (int i = 0; i < 8; ++i) {
            float f[16]; ub4(uq[i].x, f); ub4(uq[i].y, f + 4); ub4(uq[i].z, f + 8); ub4(uq[i].w, f + 12);
            float s = 0.f;
#pragma unroll
            for (int j = 0; j < 16; ++j) s = fmaf(x[j], f[j], s);
            d[i] = s;
        }
#pragma unroll
        for (int i = 0; i < 4; ++i) { const bool up = (lane & 32) != 0; const float send = up ? d[i] : d[i + 4]; const float keep = up ? d[i + 4] : d[i]; d[i] = keep + __shfl_xor(send, 32); }
#pragma unroll
        for (int i = 0; i < 2; ++i) { const bool up = (lane & 16) != 0; const float send = up ? d[i] : d[i + 2]; const float keep = up ? d[i + 2] : d[i]; d[i] = keep + __shfl_xor(send, 16); }
        { const bool up = (lane & 8) != 0; const float send = up ? d[0] : d[1]; const float keep = up ? d[1] : d[0]; d[0] = keep + __shfl_xor(send, 8); }
        float dq = d[0]; dq += __shfl_xor(dq, 4); dq += __shfl_xor(dq, 2); dq += __shfl_xor(dq, 1);
        const int src = (bt * 8 + mi) & 63;
        const float su = __shfl(lo ? su0 : su1, src), sv = __shfl(lo ? sv0 : sv1, src), gg = __shfl(lo ? g0 : g1, src);
        const float dot = su * (dq - sumx128);
        const float cf = 0.5f * dot * (1.0f + erff(dot * 0.70710678118f)) * gg * sv;
#pragma unroll
        for (int i = 0; i < 8; ++i) {
            const float c = __int_as_float(__builtin_amdgcn_readlane(__float_as_int(cf), 8 * i));
            csum += c;
            float f[16]; ub4(vq[i].x, f); ub4(vq[i].y, f + 4); ub4(vq[i].z, f + 8); ub4(vq[i].w, f + 12);
#pragma unroll
            for (int j = 0; j < 16; ++j) acc[j] = fmaf(c, f[j], acc[j]);
        }
    }
    const float off = 128.0f * csum;
    float s = 0.f;
    {
        const uint4 ea = *(const uint4*)(E + (size_t)t * DM + 16 * lane), eb = *(const uint4*)(E + (size_t)t * DM + 16 * lane + 8);
        float ev[16]; unpack8(ea, ev); unpack8(eb, ev + 8);
#pragma unroll
        for (int j = 0; j < 16; ++j) { acc[j] = (acc[j] - off) + DN_ALPHA * x[j] + ev[j]; s += acc[j]; }
    }
    const float mean = wave_sum(s) * (1.0f / DM);
    float s2 = 0.f;
#pragma unroll
    for (int j = 0; j < 16; ++j) { acc[j] -= mean; s2 += acc[j] * acc[j]; }
    const float rstd = 1.0f / sqrtf(wave_sum(s2) * (1.0f / DM) + LN_EPS);
    const float* g2 = p.ln2_g + li * DM + 16 * lane; const float* b2 = p.ln2_b + li * DM + 16 * lane;
    float o[16];
#pragma unroll
    for (int j = 0; j < 4; ++j) {
        const float4 gg = *(const float4*)(g2 + 4 * j), bv = *(const float4*)(b2 + 4 * j);
        o[4 * j] = acc[4 * j] * rstd * gg.x + bv.x; o[4 * j + 1] = acc[4 * j + 1] * rstd * gg.y + bv.y; o[4 * j + 2] = acc[4 * j + 2] * rstd * gg.z + bv.z; o[4 * j + 3] = acc[4 * j + 3] * rstd * gg.w + bv.w;
        *(float4*)(row + 4 * j) = make_float4(o[4 * j], o[4 * j + 1], o[4 * j + 2], o[4 * j + 3]);
    }
    if (li == 0) {
        bf16* xb = XB + (size_t)t * DM + 16 * lane;
        *(uint4*)xb = make_uint4(pk2(o[0], o[1]), pk2(o[2], o[3]), pk2(o[4], o[5]), pk2(o[6], o[7]));
        *(uint4*)(xb + 8) = make_uint4(pk2(o[8], o[9]), pk2(o[10], o[11]), pk2(o[12], o[13]), pk2(o[14], o[15]));
    }
}

constexpr int PH_PER_LAYER = 9, NPHASE = 1 + 2 * PH_PER_LAYER;

#ifndef PROBE_DUP
#define PROBE_DUP 0
#endif
#define PH_BEGIN(k) if (lo <= (k) && (k) < hi && ((k) == 0 || PHON(((k) - 1) % 9))) for (int rep_ = 0; rep_ < (((k) > 0 && ((PROBE_DUP >> (((k) - 1) % 9)) & 1)) ? 2 : 1); ++rep_) {
#define PH_SYNC_DUP() do { if (rep_ == 0) { asm volatile("s_waitcnt vmcnt(0)" ::: "memory"); __syncthreads(); } } while (0)
#define PH_END(k) if ((k) + 1 < hi) xcd_barrier(bar); }

template <int LI>
__device__ __forceinline__ void run_layer(const Params& p, float* lds, const XcdBarrier& bar, int lo, int hi) {
    constexpr int li = LI, base = 1 + LI * PH_PER_LAYER;
    const int tid = threadIdx.x, lane = tid & 63, wave = __builtin_amdgcn_readfirstlane(tid >> 6);
    const int G = gridDim.x;
    float* stream = p.out;
    LAS unsigned char* ldsb = (LAS unsigned char*)lds;
    PH_BEGIN(base + 0)
        EpiZ16 e{(bf16*)(p.ws + WS_Z), (float*)(p.ws + WS_GATES), (const float*)(p.ws + WS_ACOS), (const float*)(p.ws + WS_ASIN)};
        gemm16(ldsb, (const bf16*)(p.ws + WS_XB), (const bf16*)(p.ws + WS_WIN) + (size_t)li * NZP * DM, NZP, DM, e);
    PH_END(base + 0)
    PH_BEGIN(base + 1)
        for (int it = blockIdx.x; it < 2048 + 1536; it += G) {
            if (it < 1024) ret_state_item(p, it, lds);
            else if (it < 2048) mls_state_item(p, li, it - 1024, lds);
            else attn_unit(p, it - 2048, ldsb);
        }
    PH_END(base + 1)
    PH_BEGIN(base + 2)
        p3_scans(p);
        attn_merge(p);
    PH_END(base + 2)
    PH_BEGIN(base + 3)
        for (int it = blockIdx.x; it < 2048; it += G) { if (it < 1024) ret_out_item(p, li, it, lds); else mls_out_item(p, li, it - 1024, lds); }
    PH_END(base + 3)
    PH_BEGIN(base + 4)
        const float* xin = (li == 0) ? p.x : stream;
        EpiRes16 e{xin, stream};
        gemm16(ldsb, (const bf16*)(p.ws + WS_MIX), (const bf16*)(p.ws + WS_WOUT) + (size_t)li * DM * DM, DM, DM, e);
    PH_END(base + 4)
    PH_BEGIN(base + 5)
        for (int r = blockIdx.x * NWAVE + wave; r < NT; r += G * NWAVE) ln_row_inplace(stream + (size_t)r * DM, (bf16*)(p.ws + WS_XB) + (size_t)r * DM, p.ln1_g + li * DM, p.ln1_b + li * DM, lane);
        quant_rows(p.pu + (size_t)li * 16384 * 1024, (unsigned char*)(p.ws + WS_UQ), (float*)(p.ws + WS_US), lane, blockIdx.x * NWAVE + wave, G * NWAVE);
        quant_rows(p.pv + (size_t)li * 16384 * 1024, (unsigned char*)(p.ws + WS_VQ), (float*)(p.ws + WS_VS), lane, blockIdx.x * NWAVE + wave, G * NWAVE);
        EpiBf16Store e{(bf16*)(p.ws + WS_E), DM};
        gemm16(ldsb, (const bf16*)(p.ws + WS_PB) + (size_t)li * NT * 256, (const bf16*)(p.ws + WS_WP) + (size_t)li * DM * 256, DM, 256, e);
    PH_END(base + 5)
    PH_BEGIN(base + 6)
        EpiBf16Store eq{(bf16*)(p.ws + WS_QRY), 2048};
        gemm16(ldsb, (const bf16*)(p.ws + WS_XB), (const bf16*)(p.ws + WS_WQ) + (size_t)li * 2048 * DM, 2048, DM, eq);
        EpiGate16 eg{(bf16*)(p.ws + WS_E), p.bg + li * DM};
        gemm16(ldsb, (const bf16*)(p.ws + WS_XB), (const bf16*)(p.ws + WS_WG) + (size_t)li * DM * DM, DM, DM, eg);
    PH_END(base + 6)
    PH_BEGIN(base + 7)
        for (int it = blockIdx.x; it < (NT / 256) * 8; it += G) topk_unit(p, li, it, ldsb);
    PH_END(base + 7)
    PH_BEGIN(base + 8)
        for (int t = blockIdx.x * NWAVE + wave; t < NT; t += G * NWAVE) peer_token(p, li, t, lane);
    PH_END(base + 8)
}

__global__ void __launch_bounds__(NTHR, 2) mk_fwd(Params p) {
    extern __shared__ __attribute__((aligned(16))) unsigned char lds_raw[];
    float* lds = (float*)lds_raw;
    const int tid = threadIdx.x;
    volatile LAS unsigned* MISC = (volatile LAS unsigned*)((LAS unsigned char*)lds_raw + LDS_CTL_OFF);
    if (tid < 64) MISC[tid] = 0u;
    __syncthreads();
    const int lo = p.ph_lo, hi = p.ph_hi;
    XcdBarrier bar; bar.bar = (unsigned*)(p.ws + WS_CTL) + 1024; bar.x = 0; bar.st = nullptr;
    if (hi - lo > 1) bar = xcd_barrier_post((unsigned*)(p.ws + WS_CTL) + 1024, MISC + 8);
    PH_BEGIN(0)
        p0_tables(p);
        p0_weights(p, lds);
    PH_END(0)
    run_layer<0>(p, lds, bar, lo, hi);
    run_layer<1>(p, lds, bar, lo, hi);
}

extern "C" void kernel_launch(void* const* d_in, const int* in_sizes, int n_in, void* d_out, int out_size, void* d_ws, size_t ws_size, hipStream_t stream) {
    static int grid = 0;
    if (grid == 0) {
        if (n_in != 19 || in_sizes[0] != NT * DM || out_size != NT * DM || ws_size < WS_END) { fprintf(stderr, "kernel_launch: unexpected shapes (n_in %d in0 %d out %d ws %zu)\n", n_in, n_in > 0 ? in_sizes[0] : -1, out_size, ws_size); grid = -1; return; }
        int dev = 0, cus = 0;
        if (hipGetDevice(&dev) != hipSuccess || hipDeviceGetAttribute(&cus, hipDeviceAttributeMultiprocessorCount, dev) != hipSuccess) { grid = -1; return; }
        if (hipFuncSetAttribute((const void*)mk_fwd, hipFuncAttributeMaxDynamicSharedMemorySize, LDS_BYTES) != hipSuccess) { fprintf(stderr, "kernel_launch: hipFuncSetAttribute failed\n"); grid = -1; return; }
        int per_cu = 0;
        if (hipOccupancyMaxActiveBlocksPerMultiprocessor(&per_cu, (const void*)mk_fwd, NTHR, LDS_BYTES) != hipSuccess || per_cu < 1) fprintf(stderr, "kernel_launch: occupancy query says %d\n", per_cu);
        (void)hipGetLastError();
        grid = cus;
    }
    if (grid < 0) return;
    if (hipMemsetAsync((char*)d_ws + WS_CTL, 0, CTL_ZERO_BYTES, stream) != hipSuccess) return;
    Params a{};
    a.x = (const float*)d_in[0]; a.p = (const float*)d_in[1]; a.w_in = (const float*)d_in[2]; a.conv_w = (const float*)d_in[3]; a.b_if = (const float*)d_in[4];
    a.ret_g = (const float*)d_in[5]; a.mls_g = (const float*)d_in[6]; a.w_out = (const float*)d_in[7]; a.ln1_g = (const float*)d_in[8]; a.ln1_b = (const float*)d_in[9];
    a.wq = (const float*)d_in[10]; a.keys = (const float*)d_in[11]; a.pu = (const float*)d_in[12]; a.pv = (const float*)d_in[13]; a.wg = (const float*)d_in[14];
    a.bg = (const float*)d_in[15]; a.wp = (const float*)d_in[16]; a.ln2_g = (const float*)d_in[17]; a.ln2_b = (const float*)d_in[18];
    a.out = (float*)d_out; a.ws = (unsigned char*)d_ws;
#if MK_SPLIT
    for (int ph = 0; ph < NPHASE; ++ph) { a.ph_lo = ph; a.ph_hi = ph + 1; hipLaunchKernelGGL(mk_fwd, dim3(grid), dim3(NTHR), LDS_BYTES, stream, a); }
#else
    a.ph_lo = 0; a.ph_hi = NPHASE;
    hipLaunchKernelGGL(mk_fwd, dim3(grid), dim3(NTHR), LDS_BYTES, stream, a);
#endif
}
```

```cpp
#include <hip/hip_runtime.h>
#include <cstdio>
#include <cstdint>
#include <cmath>

#ifndef MK_SPLIT
#define MK_SPLIT 0
#endif

#ifndef ONLY
#define ONLY -1
#endif
#ifndef PMASK
#define PMASK 0xfff
#endif
#define PHON(k) ((ONLY < 0 || ONLY == (k)) && ((PMASK >> (k)) & 1))
#define LAS __attribute__((address_space(3)))
typedef unsigned short bf16;

#define XB_TMO      128
#define XB_XCNT(j)  (256  + 64 * (j))
#define XB_XSUB(j)  (1280 + 64 * (j))
#define XB_XGEN(j)  (2304 + 64 * (j))
#define XB_TOP      3328
#define XB_TOPGEN   3392
#define XCD_BAR_WORDS 3456
#define XB_SPIN_CAP (1u << 22)

__device__ __forceinline__ unsigned xb_ld(unsigned* p)              { return __hip_atomic_load(p, __ATOMIC_RELAXED, __HIP_MEMORY_SCOPE_AGENT); }
__device__ __forceinline__ unsigned xb_add(unsigned* p, unsigned v) { return __hip_atomic_fetch_add(p, v, __ATOMIC_RELAXED, __HIP_MEMORY_SCOPE_AGENT); }
__device__ __forceinline__ unsigned xb_xcc_id() { return (unsigned)__builtin_amdgcn_s_getreg((3 << 11) | 20) & 0xFu; }
#define XB_SPIN(cond, bar) do { unsigned _sp = 0; while (cond) { __builtin_amdgcn_s_sleep(1); \
    if ((++_sp & 255u) == 0u) { if (xb_ld(&(bar)[XB_TMO])) break; if (_sp > XB_SPIN_CAP) { atomicAdd(&(bar)[XB_TMO], 1u); break; } } } } while (0)

struct XcdBarrier { unsigned* bar; unsigned x; volatile LAS unsigned* st; };

__device__ __forceinline__ XcdBarrier xcd_barrier_post(unsigned* bar, volatile LAS unsigned* st) {
    XcdBarrier b; b.bar = bar; b.x = xb_xcc_id(); b.st = st;
    if (threadIdx.x == 0) (void)xb_add(&bar[XB_XCNT(b.x)], 1u);
    return b;
}
__device__ __forceinline__ void xcd_barrier_complete(unsigned* bar, unsigned x, unsigned& nloc, unsigned& nx) {
    const unsigned G = gridDim.x * gridDim.y * gridDim.z;
    unsigned sum, cnt, mine, sp = 0u;
    for (;;) {
        sum = 0u; cnt = 0u; mine = 0u;
#pragma unroll
        for (unsigned j = 0; j < 16; ++j) { const unsigned c = xb_ld(&bar[XB_XCNT(j)]); sum += c; cnt += (c > 0u) ? 1u : 0u; mine = (j == x) ? c : mine; }
        if (sum == G) break;
        __builtin_amdgcn_s_sleep(1);
        if ((++sp & 255u) == 0u) { if (xb_ld(&bar[XB_TMO])) break; if (sp > XB_SPIN_CAP) { atomicAdd(&bar[XB_TMO], 1u); break; } }
    }
    nloc = mine > 0u ? mine : 1u; nx = cnt > 0u ? cnt : 1u;
}
__device__ __forceinline__ void xcd_barrier(const XcdBarrier& b) {
    asm volatile("s_waitcnt vmcnt(0)" ::: "memory");
    __syncthreads();
    if (threadIdx.x == 0) {
        unsigned* bar = b.bar;
        __builtin_amdgcn_s_waitcnt(0);
        unsigned nloc = b.st[0], nx = b.st[1];
        if (nloc == 0u) { xcd_barrier_complete(bar, b.x, nloc, nx); b.st[0] = nloc; b.st[1] = nx; }
        const unsigned old = xb_add(&bar[XB_XSUB(b.x)], 1u);
        const unsigned gen = old / nloc;
        if (old + 1u == (gen + 1u) * nloc) {
            __builtin_amdgcn_fence(__ATOMIC_RELEASE, "agent");
            asm volatile("s_waitcnt vmcnt(0)" ::: "memory");
            const unsigned og = xb_add(&bar[XB_TOP], 1u);
            const unsigned tg = og / nx;
            if (og + 1u == (tg + 1u) * nx) xb_add(&bar[XB_TOPGEN], 1u);
            else XB_SPIN(xb_ld(&bar[XB_TOPGEN]) == tg, bar);
            __builtin_amdgcn_fence(__ATOMIC_ACQUIRE, "agent");
            xb_add(&bar[XB_XGEN(b.x)], 1u);
            asm volatile("s_waitcnt vmcnt(0)" ::: "memory");
        } else {
            XB_SPIN(xb_ld(&bar[XB_XGEN(b.x)]) == gen, bar);
            __builtin_amdgcn_fence(__ATOMIC_ACQUIRE, "agent");
            asm volatile("s_waitcnt vmcnt(0)" ::: "memory");
        }
    }
    __syncthreads();
}

namespace pg8 {
#define PG8_LAS __attribute__((address_space(3)))
typedef unsigned short bf16_t;
typedef short bf16x8 __attribute__((ext_vector_type(8)));
typedef float f32x4 __attribute__((ext_vector_type(4)));
typedef unsigned u32x4 __attribute__((ext_vector_type(4)));
constexpr int BM = 256, BK = 64, HALF = 128, HTB = HALF * BK * 2  , STAGE_BYTES = 8 * HTB, NXCD = 8, WGM = 8;

__host__ __device__ __forceinline__ int lds_byte(int r, int c) { const int st = (r >> 4) * 2 + (c >> 5), rr = r & 15, cc = c & 31, ob = rr * 64 + cc * 2; return st * 1024 + (ob ^ (((ob >> 9) & 1) << 5)); }
__host__ __device__ __forceinline__ void stage_rc(int b, int& R, int& C) { const int st = b / 1024, sb = b % 1024, swz = sb ^ (((sb >> 9) & 1) << 5); R = (st >> 1) * 16 + swz / 64; C = (st & 1) * 32 + (swz % 64) / 2; }
__host__ __device__ __forceinline__ int perm32(int rho) { const int n = rho >> 4, i = rho & 15; return 8 * (i >> 2) + 4 * n + (i & 3); }

struct Unit { int pm, pn; };
struct Gemm { const bf16_t* A; const bf16_t* Bt; int M, N, K; };

struct StaticOrder {
    int nM, nN, nwg, G, c;
    __host__ __device__ void init(int M, int N, int G_, int c_) { nM = M / BM; nN = N / BM; nwg = nM * nN; G = G_; c = c_; }
    __host__ __device__ bool next(int i, Unit& u) const {
        const long L = (long)i * G + c; if (L >= nwg) return false;
        int wgid = (int)L; { const int q = nwg / NXCD, r = nwg % NXCD, xcd = wgid % NXCD, off = wgid / NXCD; wgid = (xcd < r ? xcd * (q + 1) : r * (q + 1) + (xcd - r) * q) + off; }
        const int nig = WGM * nN, gid = wgid / nig, fm = gid * WGM, gsz = (nM - fm) < WGM ? (nM - fm) : WGM;
        u.pm = fm + ((wgid % nig) % gsz); u.pn = (wgid % nig) / gsz; return true;
    }
    __device__ __forceinline__ void a_ready(const Unit&) const {}
    __device__ __forceinline__ void done(const Unit&) const {}
};

__device__ __forceinline__ unsigned cvt_pk_bf16(float lo, float hi) { unsigned r; asm volatile("v_cvt_pk_bf16_f32 %0, %1, %2" : "=v"(r) : "v"(lo), "v"(hi)); return r; }
template <class Epi, class Sched, bool ALIGN_EPI = false, bool SP2 = false>
__device__ __forceinline__ void gemm_phase(PG8_LAS unsigned char* lds, const Gemm g, const Sched& S, const Epi& E) {
    const int tid = threadIdx.x, wid = __builtin_amdgcn_readfirstlane(tid >> 6), lane = tid & 63, wr = wid >> 2, wc = wid & 3, fr = lane & 15, fq = lane >> 4;
    const int K = g.K, nt = K / BK;
    unsigned voffA[2], voffB[2];
#pragma unroll
    for (int i = 0; i < 2; ++i) { int R, C; stage_rc(tid * 16 + i * 8192, R, C); const int Rb = Epi::PERM ? ((R & ~31) + perm32(R & 31)) : R;
        voffA[i] = (unsigned)(R * K + C) * 2u; voffB[i] = (unsigned)(Rb * K + C) * 2u; }
    const size_t kstep = (size_t)(BK * 2);
    const size_t hstep = (size_t)HALF * K * 2;
    const size_t tstep = 2 * hstep;
    const unsigned ldsw = (unsigned)wid * 1024u;
    const int aoff = lds_byte(wr * 64 + fr, fq * 8), boff = lds_byte(wc * 32 + fr, fq * 8);
#define PG8_SA(b, h) (((b) * 2 + (h)) * HTB)
#define PG8_SB(b, h) ((4 + (b) * 2 + (h)) * HTB)
#define PG8_STAGE(bufoff, gbase, voff) do { _Pragma("unroll") for (int _i = 0; _i < 2; ++_i) \
        __builtin_amdgcn_global_load_lds((const unsigned*)((const char*)(gbase) + (voff)[_i]), (PG8_LAS unsigned*)(lds + (bufoff) + ldsw + _i * 8192), 16, 0, 0); } while (0)
#define PG8_LDA(dst, b, h) do { _Pragma("unroll") for (int m = 0; m < 4; ++m) _Pragma("unroll") for (int k = 0; k < 2; ++k) dst[m][k] = *(const PG8_LAS bf16x8*)(lds + PG8_SA(b, h) + aoff + m * 2048 + k * 1024); } while (0)
#define PG8_LDB(dst, b, h) do { _Pragma("unroll") for (int n = 0; n < 2; ++n) _Pragma("unroll") for (int k = 0; k < 2; ++k) dst[n][k] = *(const PG8_LAS bf16x8*)(lds + PG8_SB(b, h) + boff + n * 2048 + k * 1024); } while (0)
#define PG8_MMA(ai, bj, At, Bt) do { __builtin_amdgcn_s_setprio(1); _Pragma("unroll") for (int m = 0; m < 4; ++m) _Pragma("unroll") for (int n = 0; n < 2; ++n) _Pragma("unroll") for (int k = 0; k < 2; ++k) \
        acc[ai][bj][m][n] = __builtin_amdgcn_mfma_f32_16x16x32_bf16(Bt[n][k], At[m][k], acc[ai][bj][m][n], 0, 0, 0); __builtin_amdgcn_s_setprio(0); } while (0)
#define PG8_WAIT_V(n) asm volatile("s_waitcnt vmcnt(" #n ")" ::: "memory")
#define PG8_WAIT_L(n) asm volatile("s_waitcnt lgkmcnt(" #n ")" ::: "memory")
#define PG8_BAR __builtin_amdgcn_s_barrier()
#define PG8_SCHED __builtin_amdgcn_sched_barrier(0)
    Unit cur, nxt; int ui = 0;
    if (!S.next(0, cur)) return;
    f32x4 acc[2][2][4][2];
#pragma unroll
    for (int a = 0; a < 2; ++a)
#pragma unroll
        for (int b = 0; b < 2; ++b)
#pragma unroll
            for (int m = 0; m < 4; ++m)
#pragma unroll
                for (int n = 0; n < 2; ++n) acc[a][b][m][n] = (f32x4){0.f, 0.f, 0.f, 0.f};
    bf16x8 At[4][2], B0[2][2], B1[2][2];
    const char* cA = (const char*)g.A + (size_t)cur.pm * tstep; const char* cB = (const char*)g.Bt + (size_t)cur.pn * tstep;
    S.a_ready(cur);
    if constexpr (SP2) {
        PG8_STAGE(PG8_SB(0, 0), cB, voffB); PG8_STAGE(PG8_SB(0, 1), cB + hstep, voffB); PG8_STAGE(PG8_SA(0, 0), cA, voffA); PG8_STAGE(PG8_SA(0, 1), cA + hstep, voffA);
        if (wr == 1) PG8_BAR;
        PG8_WAIT_V(2); PG8_BAR;
        PG8_STAGE(PG8_SB(1, 0), cB + kstep, voffB); PG8_STAGE(PG8_SA(1, 0), cA + kstep, voffA); PG8_STAGE(PG8_SB(1, 1), cB + hstep + kstep, voffB);
        PG8_WAIT_V(6); PG8_BAR;
    } else {
        PG8_STAGE(PG8_SB(0, 0), cB, voffB); PG8_STAGE(PG8_SA(0, 0), cA, voffA); PG8_STAGE(PG8_SB(0, 1), cB + hstep, voffB); PG8_STAGE(PG8_SA(0, 1), cA + hstep, voffA);
        if (wr == 1) PG8_BAR;
        PG8_WAIT_V(4); PG8_BAR;
        PG8_STAGE(PG8_SB(1, 0), cB + kstep, voffB); PG8_STAGE(PG8_SA(1, 0), cA + kstep, voffA); PG8_STAGE(PG8_SB(1, 1), cB + hstep + kstep, voffB);
        PG8_WAIT_V(6); PG8_BAR;
    }
    for (;;) {
        const bool has_next = S.next(ui + 1, nxt);
        const char* nA = has_next ? (const char*)g.A + (size_t)nxt.pm * tstep : cA; const char* nB = has_next ? (const char*)g.Bt + (size_t)nxt.pn * tstep : cB;
        for (int t = 0; t < nt; t += 2) {
            const bool last = (t == nt - 2);
            const char* a1 = cA + (size_t)(t + 1) * kstep;
            const char* a2 = last ? nA : cA + (size_t)(t + 2) * kstep; const char* b2 = last ? nB : cB + (size_t)(t + 2) * kstep;
            const char* a3 = a2 + kstep; const char* b3 = b2 + kstep;
            if (last && has_next) S.a_ready(nxt);
            if constexpr (SP2) {
            PG8_LDB(B0, 0, 0); PG8_LDB(B1, 0, 1); PG8_SCHED; PG8_LDA(At, 0, 0); PG8_STAGE(PG8_SA(1, 1), a1 + hstep, voffA);
            PG8_WAIT_V(8); PG8_WAIT_L(0); PG8_BAR; PG8_MMA(0, 0, At, B0); PG8_MMA(0, 1, At, B1); PG8_BAR; PG8_SCHED;
            PG8_LDA(At, 0, 1); PG8_STAGE(PG8_SB(0, 0), b2, voffB); PG8_STAGE(PG8_SB(0, 1), b2 + hstep, voffB); PG8_STAGE(PG8_SA(0, 0), a2, voffA);
            PG8_WAIT_V(8); PG8_WAIT_L(0); PG8_BAR; PG8_MMA(1, 0, At, B0); PG8_MMA(1, 1, At, B1); PG8_BAR; PG8_SCHED;
            PG8_LDB(B0, 1, 0); PG8_LDB(B1, 1, 1); PG8_SCHED; PG8_LDA(At, 1, 0); PG8_STAGE(PG8_SA(0, 1), a2 + hstep, voffA);
            PG8_WAIT_V(8); PG8_WAIT_L(0); PG8_BAR; PG8_MMA(0, 0, At, B0); PG8_MMA(0, 1, At, B1); PG8_BAR; PG8_SCHED;
            PG8_LDA(At, 1, 1); PG8_STAGE(PG8_SB(1, 0), b3, voffB); PG8_STAGE(PG8_SB(1, 1), b3 + hstep, voffB); PG8_STAGE(PG8_SA(1, 0), a3, voffA);
            PG8_WAIT_V(8); PG8_WAIT_L(0); PG8_BAR; PG8_MMA(1, 0, At, B0); PG8_MMA(1, 1, At, B1); PG8_BAR; PG8_SCHED;
            } else {
            PG8_LDB(B0, 0, 0); PG8_SCHED; PG8_LDA(At, 0, 0); PG8_STAGE(PG8_SA(1, 1), a1 + hstep, voffA);
            PG8_WAIT_L(8); PG8_BAR; PG8_WAIT_L(0); PG8_MMA(0, 0, At, B0); PG8_BAR; PG8_SCHED;
            PG8_LDB(B1, 0, 1); PG8_STAGE(PG8_SB(0, 0), b2, voffB);
            PG8_BAR; PG8_WAIT_L(0); PG8_MMA(0, 1, At, B1); PG8_BAR;
            PG8_LDA(At, 0, 1); PG8_STAGE(PG8_SA(0, 0), a2, voffA);
            PG8_BAR; PG8_WAIT_L(0); PG8_MMA(1, 0, At, B0); PG8_BAR; PG8_SCHED;
            PG8_STAGE(PG8_SB(0, 1), b2 + hstep, voffB);
            PG8_WAIT_V(6); PG8_BAR; PG8_MMA(1, 1, At, B1); PG8_BAR;
            PG8_LDB(B0, 1, 0); PG8_SCHED; PG8_LDA(At, 1, 0); PG8_STAGE(PG8_SA(0, 1), a2 + hstep, voffA);
            PG8_WAIT_L(8); PG8_BAR; PG8_WAIT_L(0); PG8_MMA(0, 0, At, B0); PG8_BAR; PG8_SCHED;
            PG8_LDB(B1, 1, 1); PG8_STAGE(PG8_SB(1, 0), b3, voffB);
            PG8_BAR; PG8_WAIT_L(0); PG8_MMA(0, 1, At, B1); PG8_BAR;
            PG8_LDA(At, 1, 1); PG8_STAGE(PG8_SA(1, 0), a3, voffA);
            PG8_BAR; PG8_WAIT_L(0); PG8_MMA(1, 0, At, B0); PG8_BAR; PG8_SCHED;
            PG8_STAGE(PG8_SB(1, 1), b3 + hstep, voffB);
            PG8_WAIT_V(6); PG8_BAR; PG8_MMA(1, 1, At, B1); PG8_BAR;
            }
        }
        if constexpr (ALIGN_EPI) { if (wr == 0) PG8_BAR; }
        if constexpr (!Epi::AFTER_DRAIN) { E(acc, cur, wr, wc, fr, fq); S.done(cur); }
        if (!has_next) break;
#pragma unroll
        for (int a = 0; a < 2; ++a)
#pragma unroll
            for (int b = 0; b < 2; ++b)
#pragma unroll
                for (int m = 0; m < 4; ++m)
#pragma unroll
                    for (int n = 0; n < 2; ++n) acc[a][b][m][n] = (f32x4){0.f, 0.f, 0.f, 0.f};
        cur = nxt; cA = nA; cB = nB; ++ui;
        if constexpr (ALIGN_EPI) { if (wr == 1) PG8_BAR; }
    }
    PG8_WAIT_V(0);
    if constexpr (!ALIGN_EPI) { if (wr == 0) PG8_BAR; }
    PG8_BAR;
    if constexpr (Epi::AFTER_DRAIN) { E.fused(acc, cur, wr, wc, fr, fq, lds, wid, lane); S.done(cur); }
#undef PG8_SA
#undef PG8_SB
#undef PG8_STAGE
#undef PG8_LDA
#undef PG8_LDB
#undef PG8_MMA
#undef PG8_WAIT_V
#undef PG8_WAIT_L
#undef PG8_BAR
#undef PG8_SCHED
}
}

constexpr int NB = 4, SEQ = 8192, NT = NB * SEQ, DM = 1024;
constexpr int ZW = 3328, NZ = 3336;
constexpr int C_RQ = 0, C_RK = 256, C_RV = 512, C_RG = 1024, C_AQ = 1536, C_AK = 1792, C_AV = 2048, C_MQ = 2304, C_MK = 2560, C_MV = 2816, C_MO = 3072;
constexpr float DN_ALPHA = 1.41421356237f;
constexpr float LN_EPS = 1e-5f;
constexpr int NTHR = 512, NWAVE = 8;
constexpr int LDS_BYTES = 160 * 1024;
constexpr int LDS_CTL_OFF = 159 * 1024;

constexpr size_t MiB = 1u << 20;
constexpr size_t WS_CTL = 0, CTL_ZERO_BYTES = 64 * 1024;
constexpr size_t WS_RCOS = 1 * MiB, WS_RSIN = 2 * MiB, WS_ACOS = 3 * MiB, WS_ASIN = 3 * MiB + 512 * 1024;
constexpr size_t WS_RST = 4 * MiB;
constexpr size_t WS_MC = 36 * MiB;
constexpr size_t WS_MN = 52 * MiB;
constexpr size_t WS_MA = 52 * MiB + 512 * 1024, WS_MML = WS_MA + 4096, WS_MMP = WS_MML + 4096;
constexpr size_t WS_GATES = 54 * MiB;
constexpr int NZP = 3584;
constexpr size_t WS_WIN = 56 * MiB;
constexpr size_t WS_WOUT = 70 * MiB;
constexpr size_t WS_WQ = 74 * MiB;
constexpr size_t WS_WG = 82 * MiB;
constexpr size_t WS_WP = 86 * MiB;
constexpr size_t WS_KEYS = 87 * MiB;
constexpr size_t WS_PB = 88 * MiB;
constexpr size_t WS_XB = 120 * MiB;
constexpr size_t WS_AO = 120 * MiB;
constexpr size_t WS_ALSE = 168 * MiB;
constexpr size_t WS_Z = 184 * MiB;
constexpr size_t WS_MIX = 392 * MiB;
constexpr size_t WS_QRY = 184 * MiB;
constexpr size_t WS_E = 312 * MiB;
constexpr size_t WS_UQ = 376 * MiB, WS_VQ = 392 * MiB;
constexpr size_t WS_US = 408 * MiB, WS_VS = 408 * MiB + 65536;
constexpr size_t WS_X1Q = 4 * MiB;
constexpr size_t WS_X1S = 53 * MiB;
constexpr size_t WS_PC = 36 * MiB;
constexpr size_t WS_PCS = 53 * MiB + 256 * 1024;
constexpr size_t WS_PI = 184 * MiB;
constexpr size_t WS_Y = 184 * MiB;
constexpr int CW_PQ = 8192;
constexpr size_t WS_RI = 456 * MiB, WS_RG = 472 * MiB;
constexpr size_t WS_END = 488 * MiB;

struct Params {
    const float *x, *p, *w_in, *conv_w, *b_if, *ret_g, *mls_g, *w_out, *ln1_g, *ln1_b, *wq, *keys, *pu, *pv, *wg, *bg, *wp, *ln2_g, *ln2_b;
    float* out; unsigned char* ws; int ph_lo, ph_hi;
};

__device__ __forceinline__ float bf2f(bf16 h) { return __uint_as_float(((unsigned)h) << 16); }
__device__ __forceinline__ unsigned f2bf(float f) { unsigned u = __float_as_uint(f); return (u + 0x7fffu + ((u >> 16) & 1u)) >> 16; }
__device__ __forceinline__ unsigned pk2(float lo, float hi) { return f2bf(lo) | (f2bf(hi) << 16); }
__device__ __forceinline__ float wave_sum(float v) {
#pragma unroll
    for (int o = 1; o < 64; o <<= 1) v += __shfl_xor(v, o);
    return v;
}
__device__ __forceinline__ float wave_max(float v) {
#pragma unroll
    for (int o = 1; o < 64; o <<= 1) v = fmaxf(v, __shfl_xor(v, o));
    return v;
}
__device__ __forceinline__ float sigmoidf_(float x) { return 1.f / (1.f + expf(-x)); }
__device__ __forceinline__ float siluf_(float x) { return x / (1.f + expf(-x)); }
__device__ __forceinline__ void unpack8(const uint4 v, float* o) {
    o[0] = __uint_as_float(v.x << 16); o[1] = __uint_as_float(v.x & 0xffff0000u);
    o[2] = __uint_as_float(v.y << 16); o[3] = __uint_as_float(v.y & 0xffff0000u);
    o[4] = __uint_as_float(v.z << 16); o[5] = __uint_as_float(v.z & 0xffff0000u);
    o[6] = __uint_as_float(v.w << 16); o[7] = __uint_as_float(v.w & 0xffff0000u);
}

template <class Epi>
__device__ __forceinline__ void gemm_tile_f32(const float* __restrict__ A, int lda, const float* __restrict__ W, int N, int K, int m0, int n0, float* lds, const Epi& epi) {
    float* As = lds; float* Bs = lds + 16 * 132;
    const int tid = threadIdx.x, ty = tid >> 4, tx = tid & 15;
    float acc[4][8];
#pragma unroll
    for (int i = 0; i < 4; ++i)
#pragma unroll
        for (int j = 0; j < 8; ++j) acc[i][j] = 0.f;
    const int arow = tid >> 2, akq = (tid & 3) * 4;
    const int bk = tid >> 5, bn = (tid & 31) * 4;
    const bool bvalid = (n0 + bn) < N;
    const float* ap = A + (size_t)(m0 + arow) * lda + akq;
    const float* bp = W + (size_t)bk * N + n0 + bn;
    for (int k0 = 0; k0 < K; k0 += 16) {
        const float4 av = *(const float4*)(ap + k0);
        float4 bv = make_float4(0.f, 0.f, 0.f, 0.f);
        if (bvalid) bv = *(const float4*)(bp + (size_t)k0 * N);
        __syncthreads();
        As[(akq + 0) * 132 + arow] = av.x; As[(akq + 1) * 132 + arow] = av.y; As[(akq + 2) * 132 + arow] = av.z; As[(akq + 3) * 132 + arow] = av.w;
        *(float4*)(Bs + bk * 128 + bn) = bv;
        __syncthreads();
#pragma unroll
        for (int k = 0; k < 16; ++k) {
            const float4 a = *(const float4*)(As + k * 132 + ty * 4);
            const float4 b0 = *(const float4*)(Bs + k * 128 + tx * 8);
            const float4 b1 = *(const float4*)(Bs + k * 128 + tx * 8 + 4);
            const float aa[4] = {a.x, a.y, a.z, a.w};
            const float bb[8] = {b0.x, b0.y, b0.z, b0.w, b1.x, b1.y, b1.z, b1.w};
#pragma unroll
            for (int i = 0; i < 4; ++i)
#pragma unroll
                for (int j = 0; j < 8; ++j) acc[i][j] = fmaf(aa[i], bb[j], acc[i][j]);
        }
    }
#pragma unroll
    for (int i = 0; i < 4; ++i) epi(m0 + ty * 4 + i, n0 + tx * 8, acc[i]);
    __syncthreads();
}

struct EpiZ {
    bf16* Z; float* gates;
    __device__ __forceinline__ void operator()(int row, int col0, const float (&v)[8]) const {
        if (col0 < ZW) { uint4 w; w.x = pk2(v[0], v[1]); w.y = pk2(v[2], v[3]); w.z = pk2(v[4], v[5]); w.w = pk2(v[6], v[7]); *(uint4*)(Z + (size_t)row * ZW + col0) = w; }
        else if (col0 == ZW) { float* g = gates + (size_t)row * 8; *(float4*)g = make_float4(v[0], v[1], v[2], v[3]); *(float4*)(g + 4) = make_float4(v[4], v[5], v[6], v[7]); }
    }
};
struct EpiRes {
    const float* xin; float* out;
    __device__ __forceinline__ void operator()(int row, int col0, const float (&v)[8]) const {
        const size_t o = (size_t)row * DM + col0;
        const float4 a = *(const float4*)(xin + o), b = *(const float4*)(xin + o + 4);
        *(float4*)(out + o) = make_float4(DN_ALPHA * a.x + v[0], DN_ALPHA * a.y + v[1], DN_ALPHA * a.z + v[2], DN_ALPHA * a.w + v[3]);
        *(float4*)(out + o + 4) = make_float4(DN_ALPHA * b.x + v[4], DN_ALPHA * b.y + v[5], DN_ALPHA * b.z + v[6], DN_ALPHA * b.w + v[7]);
    }
};
struct EpiStore {
    float* out; int ld;
    __device__ __forceinline__ void operator()(int row, int col0, const float (&v)[8]) const {
        const size_t o = (size_t)row * ld + col0;
        *(float4*)(out + o) = make_float4(v[0], v[1], v[2], v[3]); *(float4*)(out + o + 4) = make_float4(v[4], v[5], v[6], v[7]);
    }
};
struct EpiGate {
    float* E; const float* bg;
    __device__ __forceinline__ void operator()(int row, int col0, const float (&v)[8]) const {
        const size_t o = (size_t)row * DM + col0;
        float4 a = *(const float4*)(E + o), b = *(const float4*)(E + o + 4);
        a.x *= sigmoidf_(v[0] + bg[col0 + 0]); a.y *= sigmoidf_(v[1] + bg[col0 + 1]); a.z *= sigmoidf_(v[2] + bg[col0 + 2]); a.w *= sigmoidf_(v[3] + bg[col0 + 3]);
        b.x *= sigmoidf_(v[4] + bg[col0 + 4]); b.y *= sigmoidf_(v[5] + bg[col0 + 5]); b.z *= sigmoidf_(v[6] + bg[col0 + 6]); b.w *= sigmoidf_(v[7] + bg[col0 + 7]);
        *(float4*)(E + o) = a; *(float4*)(E + o + 4) = b;
    }
};

template <class Epi>
__device__ __forceinline__ void gemm_phase_f32(const float* A, int lda, const float* W, int N, int K, float* lds, const Epi& epi) {
    const int ntn = (N + 127) / 128, ntm = NT / 128, nit = ntn * ntm;
    for (int it = blockIdx.x; it < nit; it += gridDim.x) { const int mt = it / ntn, nt = it - mt * ntn; gemm_tile_f32(A, lda, W, N, K, mt * 128, nt * 128, lds, epi); }
}

typedef float f32x4 __attribute__((ext_vector_type(4)));
typedef unsigned u32x4 __attribute__((ext_vector_type(4)));
struct EpiZ16 {
    static constexpr bool PERM = true, AFTER_DRAIN = false;
    bf16* Z; float* gates; const float* acos_; const float* asin_;
    __device__ __forceinline__ void operator()(const f32x4 (&acc)[2][2][4][2], const pg8::Unit& u, int wr, int wc, int fr, int fq) const {
        const int row0 = u.pm * 256 + wr * 64 + fr;
        if (u.pn < 13) {
            const int col0 = u.pn * 256 + wc * 32 + 8 * fq;
            const bool rot = (u.pn == 6 || u.pn == 7) && ((wc & 1) == 0);
            const float qs = (u.pn == 6) ? 0.125f : 1.0f;
#pragma unroll
            for (int ai = 0; ai < 2; ++ai)
#pragma unroll
                for (int m = 0; m < 4; ++m) { const int row = row0 + ai * 128 + m * 16; bf16* rowp = Z + (size_t)row * ZW + col0;
#pragma unroll
                    for (int bj = 0; bj < 2; ++bj) { f32x4 v0 = acc[ai][bj][m][0], v1 = acc[ai][bj][m][1];
                        if (rot) {
                            f32x4 p0, p1;
#pragma unroll
                            for (int j = 0; j < 4; ++j) { p0[j] = __shfl_xor(v0[j], 16); p1[j] = __shfl_xor(v1[j], 16); }
                            if (fq < 2) {
                                const int pos = row & (SEQ - 1);
                                const f32x4 c0 = *(const f32x4*)(acos_ + pos * 8), c1 = *(const f32x4*)(acos_ + pos * 8 + 4), s0 = *(const f32x4*)(asin_ + pos * 8), s1 = *(const f32x4*)(asin_ + pos * 8 + 4);
                                const float sg = (fq == 0) ? -1.0f : 1.0f;
                                v0 = v0 * c0 + p0 * s0 * sg; v1 = v1 * c1 + p1 * s1 * sg;
                            }
                        }
                        v0 = v0 * qs; v1 = v1 * qs;
                        u32x4 w; w.x = pk2(v0[0], v0[1]); w.y = pk2(v0[2], v0[3]); w.z = pk2(v1[0], v1[1]); w.w = pk2(v1[2], v1[3]);
                        *(u32x4*)(rowp + bj * 128) = w; } }
        } else if (wc == 0 && fq == 0) {
#pragma unroll
            for (int ai = 0; ai < 2; ++ai)
#pragma unroll
                for (int m = 0; m < 4; ++m) { float* g = gates + (size_t)(row0 + ai * 128 + m * 16) * 8; *(f32x4*)g = acc[ai][0][m][0]; *(f32x4*)(g + 4) = acc[ai][0][m][1]; }
        }
    }
};
struct EpiBf16Store {
    static constexpr bool PERM = true, AFTER_DRAIN = false;
    bf16* O; int ldc;
    __device__ __forceinline__ void operator()(const f32x4 (&acc)[2][2][4][2], const pg8::Unit& u, int wr, int wc, int fr, int fq) const {
        const int row0 = u.pm * 256 + wr * 64 + fr, col0 = u.pn * 256 + wc * 32 + 8 * fq;
#pragma unroll
        for (int ai = 0; ai < 2; ++ai)
#pragma unroll
            for (int m = 0; m < 4; ++m) { bf16* rowp = O + (size_t)(row0 + ai * 128 + m * 16) * ldc + col0;
#pragma unroll
                for (int bj = 0; bj < 2; ++bj) { const f32x4 v0 = acc[ai][bj][m][0], v1 = acc[ai][bj][m][1];
                    u32x4 w; w.x = pk2(v0[0], v0[1]); w.y = pk2(v0[2], v0[3]); w.z = pk2(v1[0], v1[1]); w.w = pk2(v1[2], v1[3]);
                    *(u32x4*)(rowp + bj * 128) = w; } }
    }
};
struct EpiGate16 {
    static constexpr bool PERM = true, AFTER_DRAIN = false;
    bf16* E; const float* bg;
    __device__ __forceinline__ void operator()(const f32x4 (&acc)[2][2][4][2], const pg8::Unit& u, int wr, int wc, int fr, int fq) const {
        const int row0 = u.pm * 256 + wr * 64 + fr, col0 = u.pn * 256 + wc * 32 + 8 * fq;
#pragma unroll
        for (int bj = 0; bj < 2; ++bj) {
            const f32x4 b0 = *(const f32x4*)(bg + col0 + bj * 128), b1 = *(const f32x4*)(bg + col0 + bj * 128 + 4);
#pragma unroll
            for (int ai = 0; ai < 2; ++ai)
#pragma unroll
                for (int m = 0; m < 4; ++m) { bf16* ep = E + (size_t)(row0 + ai * 128 + m * 16) * DM + col0 + bj * 128;
                    const uint4 pv = *(const uint4*)ep; float pp[8]; unpack8(pv, pp);
                    const f32x4 v0 = acc[ai][bj][m][0] + b0, v1 = acc[ai][bj][m][1] + b1;
                    u32x4 w; w.x = pk2(pp[0] * sigmoidf_(v0[0]), pp[1] * sigmoidf_(v0[1])); w.y = pk2(pp[2] * sigmoidf_(v0[2]), pp[3] * sigmoidf_(v0[3]));
                    w.z = pk2(pp[4] * sigmoidf_(v1[0]), pp[5] * sigmoidf_(v1[1])); w.w = pk2(pp[6] * sigmoidf_(v1[2]), pp[7] * sigmoidf_(v1[3]));
                    *(u32x4*)ep = w; }
        }
    }
};
struct EpiRes16 {
    static constexpr bool PERM = false, AFTER_DRAIN = false;
    const float* xin; float* out;
    __device__ __forceinline__ void operator()(const f32x4 (&acc)[2][2][4][2], const pg8::Unit& u, int wr, int wc, int fr, int fq) const {
        const int row0 = u.pm * 256 + wr * 64 + fr, col0 = u.pn * 256 + wc * 32 + 4 * fq;
#pragma unroll
        for (int ai = 0; ai < 2; ++ai)
#pragma unroll
            for (int m = 0; m < 4; ++m) { const size_t ro = (size_t)(row0 + ai * 128 + m * 16) * DM + col0;
#pragma unroll
                for (int bj = 0; bj < 2; ++bj)
#pragma unroll
                    for (int n = 0; n < 2; ++n) { const size_t o = ro + bj * 128 + n * 16; const f32x4 xv = *(const f32x4*)(xin + o); *(f32x4*)(out + o) = xv * DN_ALPHA + acc[ai][bj][m][n]; } }
    }
};
template <class Epi>
__device__ __forceinline__ void gemm16(LAS unsigned char* lds, const bf16* A, const bf16* Bt, int N, int K, const Epi& e) {
    pg8::Gemm g{A, Bt, NT, N, K}; pg8::StaticOrder S; S.init(NT, N, (int)gridDim.x, (int)blockIdx.x);
    pg8::gemm_phase<Epi, pg8::StaticOrder, true, true>(lds, g, S, e);
}

__device__ __forceinline__ void tr_item(const float* W, int K, int N, bf16* WT, float* scr, int item, int nblk, int lane) {
    const int kb = item / nblk, nb = item - kb * nblk, k0 = 64 * kb, n0 = 32 * nb;
    const int n = n0 + (lane & 31); const bool ok = n < N;
#pragma unroll 8
    for (int i = 0; i < 32; ++i) { const int kk = 2 * i + (lane >> 5); scr[kk * 33 + (lane & 31)] = ok ? W[(size_t)(k0 + kk) * N + n] : 0.f; }
    asm volatile("s_waitcnt lgkmcnt(0)" ::: "memory");
    const int c = lane & 7;
#pragma unroll
    for (int j = 0; j < 4; ++j) { const int nn = (lane >> 3) + 8 * j; const float* sp = scr + (8 * c) * 33 + nn;
        uint4 o; o.x = pk2(sp[0 * 33], sp[1 * 33]); o.y = pk2(sp[2 * 33], sp[3 * 33]); o.z = pk2(sp[4 * 33], sp[5 * 33]); o.w = pk2(sp[6 * 33], sp[7 * 33]);
        *(uint4*)(WT + (size_t)(n0 + nn) * K + k0 + 8 * c) = o; }
    asm volatile("s_waitcnt lgkmcnt(0)" ::: "memory");
}
__device__ __forceinline__ void cvt_f32_bf16(const float* src, bf16* dst, size_t n8) {
    const size_t gt = (size_t)blockIdx.x * NTHR + threadIdx.x, GT = (size_t)gridDim.x * NTHR;
    for (size_t i = gt; i < n8; i += GT) {
        const float4 a = *(const float4*)(src + i * 8), b = *(const float4*)(src + i * 8 + 4);
        uint4 o; o.x = pk2(a.x, a.y); o.y = pk2(a.z, a.w); o.z = pk2(b.x, b.y); o.w = pk2(b.z, b.w);
        *(uint4*)(dst + i * 8) = o;
    }
}
__device__ __forceinline__ void p0_weights(const Params& p, float* lds) {
    const int lane = threadIdx.x & 63, wave = __builtin_amdgcn_readfirstlane((int)threadIdx.x >> 6);
    float* scr = lds + wave * (64 * 33);
    const int gw = blockIdx.x * NWAVE + wave, NGW = gridDim.x * NWAVE;
    constexpr int I_IN = 16 * (NZP / 32), I_OUT = 16 * 32, I_Q = 16 * 64, I_G = 16 * 32, I_P = 4 * 32, I_L = I_IN + I_OUT + I_Q + I_G + I_P;
    for (int it = gw; it < 2 * I_L; it += NGW) {
        const int li = it / I_L; int r = it - li * I_L;
        if (r < I_IN) { tr_item(p.w_in + (size_t)li * DM * NZ, DM, NZ, (bf16*)(p.ws + WS_WIN) + (size_t)li * NZP * DM, scr, r, NZP / 32, lane); continue; } r -= I_IN;
        if (r < I_OUT) { tr_item(p.w_out + (size_t)li * DM * DM, DM, DM, (bf16*)(p.ws + WS_WOUT) + (size_t)li * DM * DM, scr, r, 32, lane); continue; } r -= I_OUT;
        if (r < I_Q) { tr_item(p.wq + (size_t)li * DM * 2048, DM, 2048, (bf16*)(p.ws + WS_WQ) + (size_t)li * 2048 * DM, scr, r, 64, lane); continue; } r -= I_Q;
        if (r < I_G) { tr_item(p.wg + (size_t)li * DM * DM, DM, DM, (bf16*)(p.ws + WS_WG) + (size_t)li * DM * DM, scr, r, 32, lane); continue; } r -= I_G;
        tr_item(p.wp + (size_t)li * 256 * DM, 256, DM, (bf16*)(p.ws + WS_WP) + (size_t)li * DM * 256, scr, r, 32, lane);
    }
    cvt_f32_bf16(p.x, (bf16*)(p.ws + WS_XB), (size_t)NT * DM / 8);
    cvt_f32_bf16(p.p, (bf16*)(p.ws + WS_PB), (size_t)2 * NT * 256 / 8);
    cvt_f32_bf16(p.keys, (bf16*)(p.ws + WS_KEYS), (size_t)2 * 8 * 2 * 128 * 128 / 8);
}

__device__ __forceinline__ void p0_tables(const Params& p) {
    float* rcos = (float*)(p.ws + WS_RCOS); float* rsin = (float*)(p.ws + WS_RSIN); float* acos_ = (float*)(p.ws + WS_ACOS); float* asin_ = (float*)(p.ws + WS_ASIN);
    const int gt = blockIdx.x * NTHR + threadIdx.x, GT = gridDim.x * NTHR;
    for (int i = gt; i < SEQ * 32; i += GT) { const int pos = i >> 5, k = i & 31; const float inv = powf(10000.0f, -(float)k / 32.0f); const float ang = (float)pos * inv; rcos[i] = cosf(ang); rsin[i] = sinf(ang); }
    for (int i = gt; i < SEQ * 8; i += GT) { const int pos = i >> 3, k = i & 7; const float inv = powf(500000.0f, -(float)k / 8.0f); const float ang = (float)pos * inv; acos_[i] = cosf(ang); asin_[i] = sinf(ang); }
}

__device__ __forceinline__ float ret_lg(int h) { return logf(1.0f - exp2f(-5.0f - (float)h)); }

__device__ __forceinline__ void ret_state_item(const Params& p, int item, float* lds) {
    const int tid = threadIdx.x;
    const int c = item & 63, bh = item >> 6, h = bh & 3, b = bh >> 2;
    const int t0 = b * SEQ + c * 128, s0 = c * 128;
    const bf16* Z = (const bf16*)(p.ws + WS_Z);
    const float* rcos = (const float*)(p.ws + WS_RCOS); const float* rsin = (const float*)(p.ws + WS_RSIN);
    float* RST = (float*)(p.ws + WS_RST);
    float* Kz = lds; float* V = lds + 128 * 64;
    const float lg = ret_lg(h);
    for (int idx = tid; idx < 128 * 32; idx += NTHR) {
        const int row = idx >> 5, i = idx & 31;
        const bf16* zr = Z + (size_t)(t0 + row) * ZW + C_RK + h * 64;
        const float x1 = bf2f(zr[i]), x2 = bf2f(zr[i + 32]);
        const float cs = rcos[(s0 + row) * 32 + i], sn = rsin[(s0 + row) * 32 + i];
        const float sc = 0.125f * expf(lg * (float)(127 - row));
        Kz[row * 64 + i] = (x1 * cs - x2 * sn) * sc; Kz[row * 64 + i + 32] = (x2 * cs + x1 * sn) * sc;
    }
    for (int idx = tid; idx < 128 * 128; idx += NTHR) { const int row = idx >> 7, d = idx & 127; V[idx] = bf2f(Z[(size_t)(t0 + row) * ZW + C_RV + h * 128 + d]); }
    __syncthreads();
    const int k = tid >> 3, v0 = (tid & 7) * 16;
    float acc[16];
#pragma unroll
    for (int j = 0; j < 16; ++j) acc[j] = 0.f;
#pragma unroll 4
    for (int s = 0; s < 128; ++s) {
        const float kk = Kz[s * 64 + k];
#pragma unroll
        for (int j = 0; j < 16; ++j) acc[j] = fmaf(kk, V[s * 128 + v0 + j], acc[j]);
    }
    float* dst = RST + (size_t)item * 8192 + k * 128 + v0;
#pragma unroll
    for (int j = 0; j < 16; ++j) dst[j] = acc[j];
    __syncthreads();
}

__device__ __forceinline__ float logsigmoidf_(float f) { return fminf(f, 0.f) - log1pf(expf(-fabsf(f))); }

__device__ __forceinline__ void mls_state_item(const Params& p, int li, int item, float* lds) {
    const int tid = threadIdx.x;
    const int c = item & 63, bh = item >> 6, h = bh & 3, b = bh >> 2;
    const int t0 = b * SEQ + c * 128;
    const bf16* Z = (const bf16*)(p.ws + WS_Z);
    const float* gates = (const float*)(p.ws + WS_GATES);
    float* MC = (float*)(p.ws + WS_MC); float* MN = (float*)(p.ws + WS_MN); float* MA = (float*)(p.ws + WS_MA); float* MML = (float*)(p.ws + WS_MML);
    const float* cw = p.conv_w + (size_t)li * 4 * 512;
    float* Kc = lds; float* Vv = lds + 8192; float* ib = lds + 16384; float* bb = ib + 128; float* wk = bb + 128; float* scal = wk + 128;
    for (int idx = tid; idx < 128 * 64; idx += NTHR) {
        const int row = idx >> 6, d = idx & 63, ch = 256 + h * 64 + d;
        float a = 0.f;
#pragma unroll
        for (int j = 0; j < 4; ++j) { const int sp = c * 128 + row - 3 + j; if (sp >= 0) a = fmaf(cw[j * 512 + ch], bf2f(Z[(size_t)(t0 + row - 3 + j) * ZW + C_MK + h * 64 + d]), a); }
        Kc[idx] = siluf_(a) * 0.125f;
        Vv[idx] = bf2f(Z[(size_t)(t0 + row) * ZW + C_MV + h * 64 + d]);
    }
    if (tid < 128) {
        const int t = t0 + tid;
        const float ig = gates[(size_t)t * 8 + h] + p.b_if[li * 8 + h];
        const float fg = gates[(size_t)t * 8 + 4 + h] + p.b_if[li * 8 + 4 + h];
        ib[tid] = ig; bb[tid] = logsigmoidf_(fg);
    }
    __syncthreads();
    if (tid == 0) {
        float run = 0.f;
#pragma unroll 4
        for (int s = 0; s < 128; ++s) { run += bb[s]; bb[s] = run; }
        float ml = -INFINITY;
        for (int s = 0; s < 128; ++s) ml = fmaxf(ml, run - bb[s] + ib[s]);
        scal[0] = run; scal[1] = ml;
    }
    __syncthreads();
    const float a = scal[0], ml = scal[1];
    if (tid < 128) wk[tid] = expf(a - bb[tid] + ib[tid] - ml);
    __syncthreads();
    const int k = tid >> 3, v0 = (tid & 7) * 8;
    float acc[8], nacc = 0.f;
#pragma unroll
    for (int j = 0; j < 8; ++j) acc[j] = 0.f;
#pragma unroll 4
    for (int s = 0; s < 128; ++s) {
        const float kw = Kc[s * 64 + k] * wk[s];
        nacc += kw;
#pragma unroll
        for (int j = 0; j < 8; ++j) acc[j] = fmaf(kw, Vv[s * 64 + v0 + j], acc[j]);
    }
    float* dst = MC + (size_t)item * 4096 + k * 64 + v0;
#pragma unroll
    for (int j = 0; j < 8; ++j) dst[j] = acc[j];
    if ((tid & 7) == 0) MN[(size_t)item * 64 + k] = nacc;
    if (tid == 0) { MA[item] = a; MML[item] = ml; }
    __syncthreads();
}

typedef short bf16x8_t __attribute__((ext_vector_type(8)));
typedef short s16x4_t __attribute__((ext_vector_type(4)));
typedef float f32x16 __attribute__((ext_vector_type(16)));
typedef float f32x2_t __attribute__((ext_vector_type(2))); typedef __bf16 bf16x2_t __attribute__((ext_vector_type(2)));
__device__ __forceinline__ unsigned cvtpk(float lo, float hi) { f32x2_t v = {lo, hi}; bf16x2_t b = __builtin_convertvector(v, bf16x2_t); return __builtin_bit_cast(unsigned, b); }
__device__ __forceinline__ s16x4_t lds_tr(const LAS unsigned char* p) { return __builtin_bit_cast(s16x4_t, __builtin_amdgcn_ds_read_tr16_b64_v4i16((LAS s16x4_t*)p)); }

__device__ __forceinline__ void attn_unit(const Params& p, int unit, LAS unsigned char* lds) {
    const int tid = threadIdx.x, lane = tid & 63, wave = __builtin_amdgcn_readfirstlane(tid >> 6);
    const int r32 = lane & 31, hh = lane >> 5;
    const bf16* Z = (const bf16*)(p.ws + WS_Z);
    const int bh = unit / 96, uu = unit - bh * 96, r = uu >> 5, v = uu & 31;
    const int dl = 1 << (2 * r), nb = 32 >> (2 * r);
    const int x = v / nb, blk = v - x * nb, q0 = blk * 256;
    const int b = bh >> 2, h = bh & 3;
    bf16* AO = (bf16*)(p.ws + WS_AO) + (size_t)r * NT * 256; float* ALSE = (float*)(p.ws + WS_ALSE) + (size_t)r * NT * 4;
    LAS unsigned char* Ks = lds; LAS unsigned char* Vs = lds + 384 * 128;
    for (int idx = tid; idx < 384 * 8; idx += NTHR) {
        const int i = idx >> 3, c = idx & 7, jk = q0 - 128 + i;
        u32x4 kv = {0u, 0u, 0u, 0u}, vv = {0u, 0u, 0u, 0u};
        if (jk >= 0) { const bf16* zr = Z + (size_t)(b * SEQ + jk * dl + x) * ZW + h * 64 + c * 8; kv = *(const u32x4*)(zr + C_AK); vv = *(const u32x4*)(zr + C_AV); }
        const int off = i * 128 + ((c ^ (i & 7)) << 4);
        *(LAS u32x4*)(Ks + off) = kv; *(LAS u32x4*)(Vs + off) = vv;
    }
    const int jq = q0 + 32 * wave + r32;
    const int tokq = b * SEQ + jq * dl + x;
    bf16x8_t qf[4];
#pragma unroll
    for (int ks = 0; ks < 4; ++ks) qf[ks] = *(const bf16x8_t*)(Z + (size_t)tokq * ZW + C_AQ + h * 64 + 16 * ks + 8 * hh);
    __syncthreads();
    f32x16 st[5];
#pragma unroll
    for (int tl = 0; tl < 5; ++tl) {
        f32x16 a16 = {0.f, 0.f, 0.f, 0.f, 0.f, 0.f, 0.f, 0.f, 0.f, 0.f, 0.f, 0.f, 0.f, 0.f, 0.f, 0.f};
        const int i = 32 * wave + 32 * tl + r32;
#pragma unroll
        for (int ks = 0; ks < 4; ++ks) {
            const int c = 2 * ks + hh;
            const bf16x8_t kf = *(const LAS bf16x8_t*)(Ks + i * 128 + ((c ^ (i & 7)) << 4));
            a16 = __builtin_amdgcn_mfma_f32_32x32x16_bf16(kf, qf[ks], a16, 0, 0, 0);
        }
        st[tl] = a16;
    }
    const int kb = q0 + 32 * wave - 128;
    float m = -INFINITY;
#pragma unroll
    for (int tl = 0; tl < 5; ++tl)
#pragma unroll
        for (int rg = 0; rg < 16; ++rg) {
            const int c = 32 * tl + (rg & 3) + 8 * (rg >> 2) + 4 * hh;
            const bool valid = (c >= r32) && (c <= r32 + 128) && (kb + c >= 0);
            const float sv = valid ? st[tl][rg] : -INFINITY;
            st[tl][rg] = sv; m = fmaxf(m, sv);
        }
    m = fmaxf(m, __shfl_xor(m, 32));
    float den = 0.f;
#pragma unroll
    for (int tl = 0; tl < 5; ++tl)
#pragma unroll
        for (int rg = 0; rg < 16; ++rg) { const float pe = __expf(st[tl][rg] - m); st[tl][rg] = pe; den += pe; }
    den += __shfl_xor(den, 32);
    f32x16 o[2];
#pragma unroll
    for (int dt = 0; dt < 2; ++dt) o[dt] = (f32x16){0.f, 0.f, 0.f, 0.f, 0.f, 0.f, 0.f, 0.f, 0.f, 0.f, 0.f, 0.f, 0.f, 0.f, 0.f, 0.f};
    const int tq = (lane & 15) >> 2, tp = lane & 3, tg = (lane >> 4) & 1;
#pragma unroll
    for (int tl = 0; tl < 5; ++tl)
#pragma unroll
        for (int s2 = 0; s2 < 2; ++s2) {
            u32x4 pw; pw.x = cvtpk(st[tl][8 * s2 + 0], st[tl][8 * s2 + 1]); pw.y = cvtpk(st[tl][8 * s2 + 2], st[tl][8 * s2 + 3]); pw.z = cvtpk(st[tl][8 * s2 + 4], st[tl][8 * s2 + 5]); pw.w = cvtpk(st[tl][8 * s2 + 6], st[tl][8 * s2 + 7]);
            const bf16x8_t pb = __builtin_bit_cast(bf16x8_t, pw);
            const int i0 = 32 * wave + 32 * tl + 16 * s2 + 4 * hh + tq;
#pragma unroll
            for (int dt = 0; dt < 2; ++dt) {
                const int c = 4 * dt + 2 * tg + (tp >> 1);
                const int i1 = i0 + 8;
                const s16x4_t lo = lds_tr(Vs + i0 * 128 + ((c ^ (i0 & 7)) << 4) + 8 * (tp & 1));
                const s16x4_t hi = lds_tr(Vs + i1 * 128 + ((c ^ (i1 & 7)) << 4) + 8 * (tp & 1));
                const bf16x8_t vf = (bf16x8_t){lo[0], lo[1], lo[2], lo[3], hi[0], hi[1], hi[2], hi[3]};
                o[dt] = __builtin_amdgcn_mfma_f32_32x32x16_bf16(vf, pb, o[dt], 0, 0, 0);
            }
        }
    const float rden = 1.0f / den;
    bf16* orow = AO + (size_t)tokq * 256 + h * 64;
#pragma unroll
    for (int dt = 0; dt < 2; ++dt)
#pragma unroll
        for (int g4 = 0; g4 < 4; ++g4) {
            const int d = 32 * dt + 8 * g4 + 4 * hh;
            *(uint2*)(orow + d) = make_uint2(cvtpk(o[dt][4 * g4] * rden, o[dt][4 * g4 + 1] * rden), cvtpk(o[dt][4 * g4 + 2] * rden, o[dt][4 * g4 + 3] * rden));
        }
    if (hh == 0) ALSE[(size_t)tokq * 4 + h] = m + __logf(den);
    __syncthreads();
}

__device__ __forceinline__ void attn_merge(const Params& p) {
    const bf16* AO = (const bf16*)(p.ws + WS_AO); const float* ALSE = (const float*)(p.ws + WS_ALSE);
    bf16* MIX = (bf16*)(p.ws + WS_MIX);
    const int gt = blockIdx.x * NTHR + threadIdx.x, GT = gridDim.x * NTHR;
    for (int e = gt; e < NT * 32; e += GT) {
        const int t = e >> 5, c8 = e & 31, h = c8 >> 3;
        const float l0 = ALSE[(size_t)t * 4 + h], l1 = ALSE[(size_t)NT * 4 + (size_t)t * 4 + h], l2 = ALSE[(size_t)2 * NT * 4 + (size_t)t * 4 + h];
        const float M = fmaxf(fmaxf(l0, l1), l2);
        float w0 = __expf(l0 - M), w1 = __expf(l1 - M), w2 = __expf(l2 - M);
        const float rs = 1.0f / (w0 + w1 + w2); w0 *= rs; w1 *= rs; w2 *= rs;
        float a0[8], a1[8], a2[8];
        unpack8(*(const uint4*)(AO + (size_t)t * 256 + c8 * 8), a0);
        unpack8(*(const uint4*)(AO + (size_t)NT * 256 + (size_t)t * 256 + c8 * 8), a1);
        unpack8(*(const uint4*)(AO + (size_t)2 * NT * 256 + (size_t)t * 256 + c8 * 8), a2);
        float y[8];
#pragma unroll
        for (int j = 0; j < 8; ++j) y[j] = w0 * a0[j] + w1 * a1[j] + w2 * a2[j];
        *(uint4*)(MIX + (size_t)t * DM + 512 + c8 * 8) = make_uint4(pk2(y[0], y[1]), pk2(y[2], y[3]), pk2(y[4], y[5]), pk2(y[6], y[7]));
    }
}

constexpr int UNIT_LDS = 79360;
__device__ __forceinline__ int swz16(int row, int chunk) { return (chunk ^ (row & 7)) << 4; }
template <bool ACCPERM>
__device__ __forceinline__ bf16x8_t frag_tr(const LAS unsigned char* img, int RB, int kbase, int cbase, int lane) {
    const int tq = (lane & 15) >> 2, tp = lane & 3, tg = (lane >> 4) & 1, hh = lane >> 5;
    const int r0 = kbase + (ACCPERM ? 4 : 8) * hh + tq, r1 = r0 + (ACCPERM ? 8 : 4);
    const int colb = (cbase + 16 * tg + 4 * tp) * 2, ch = colb >> 4, sub = colb & 15;
    const s16x4_t lo = lds_tr(img + r0 * RB + swz16(r0, ch) + sub);
    const s16x4_t hi = lds_tr(img + r1 * RB + swz16(r1, ch) + sub);
    return (bf16x8_t){lo[0], lo[1], lo[2], lo[3], hi[0], hi[1], hi[2], hi[3]};
}
__device__ __forceinline__ bf16x8_t frag_row(const LAS unsigned char* img, int RB, int row, int chunk) { return *(const LAS bf16x8_t*)(img + row * RB + swz16(row, chunk)); }
__device__ __forceinline__ u32x4 pack8(const float* v) { u32x4 w; w.x = pk2(v[0], v[1]); w.y = pk2(v[2], v[3]); w.z = pk2(v[4], v[5]); w.w = pk2(v[6], v[7]); return w; }
__device__ __forceinline__ void unpack8v(const u32x4 v, float* o) {
    o[0] = __uint_as_float(v.x << 16); o[1] = __uint_as_float(v.x & 0xffff0000u); o[2] = __uint_as_float(v.y << 16); o[3] = __uint_as_float(v.y & 0xffff0000u);
    o[4] = __uint_as_float(v.z << 16); o[5] = __uint_as_float(v.z & 0xffff0000u); o[6] = __uint_as_float(v.w << 16); o[7] = __uint_as_float(v.w & 0xffff0000u);
}
#define F16Z ((f32x16){0.f, 0.f, 0.f, 0.f, 0.f, 0.f, 0.f, 0.f, 0.f, 0.f, 0.f, 0.f, 0.f, 0.f, 0.f, 0.f})
__device__ __forceinline__ int acc_row(int rg, int hh) { return (rg & 3) + 8 * (rg >> 2) + 4 * hh; }

template <bool ZETA>
__device__ __forceinline__ void stage_ret_k(const Params& p, LAS unsigned char* Ks, int t0, int s0, int h, float lg, int tidU) {
    const bf16* Z = (const bf16*)(p.ws + WS_Z);
    const float* rcos = (const float*)(p.ws + WS_RCOS); const float* rsin = (const float*)(p.ws + WS_RSIN);
    for (int task = tidU; task < 512; task += 256) {
        const int row = task >> 2, pc = task & 3;
        const bf16* zr = Z + (size_t)(t0 + row) * ZW + C_RK + h * 64;
        float a[8], bq[8], o1[8], o2[8];
        unpack8v(*(const u32x4*)(zr + 8 * pc), a); unpack8v(*(const u32x4*)(zr + 32 + 8 * pc), bq);
        const f32x4 c0 = *(const f32x4*)(rcos + (s0 + row) * 32 + 8 * pc), c1 = *(const f32x4*)(rcos + (s0 + row) * 32 + 8 * pc + 4);
        const f32x4 n0 = *(const f32x4*)(rsin + (s0 + row) * 32 + 8 * pc), n1 = *(const f32x4*)(rsin + (s0 + row) * 32 + 8 * pc + 4);
        const float sc = ZETA ? 0.125f * __expf(lg * (float)(127 - row)) : 0.125f;
#pragma unroll
        for (int j = 0; j < 8; ++j) { const float cs = j < 4 ? c0[j & 3] : c1[j & 3], sn = j < 4 ? n0[j & 3] : n1[j & 3]; o1[j] = (a[j] * cs - bq[j] * sn) * sc; o2[j] = (bq[j] * cs + a[j] * sn) * sc; }
        *(LAS u32x4*)(Ks + row * 128 + swz16(row, pc)) = pack8(o1); *(LAS u32x4*)(Ks + row * 128 + swz16(row, pc + 4)) = pack8(o2);
    }
}
__device__ __forceinline__ void stage_copy(const bf16* src0, int ld, LAS unsigned char* img, int RB, int nrows, int nchunks, int tidU) {
    for (int task = tidU; task < nrows * nchunks; task += 256) {
        const int row = task / nchunks, c = task - row * nchunks;
        *(LAS u32x4*)(img + row * RB + swz16(row, c)) = *(const u32x4*)(src0 + (size_t)row * ld + 8 * c);
    }
}

__device__ __forceinline__ void ret_state_u(const Params& p, int unit, LAS unsigned char* ldsU, int wl, int tidU, int lane) {
    const int c = unit & 63, bh = unit >> 6, h = bh & 3, b = bh >> 2, t0 = b * SEQ + c * 128, s0 = c * 128;
    const bf16* Z = (const bf16*)(p.ws + WS_Z); float* RST = (float*)(p.ws + WS_RST);
    LAS unsigned char* Ks = ldsU; LAS unsigned char* Vs = ldsU + 16384;
    stage_ret_k<true>(p, Ks, t0, s0, h, ret_lg(h), tidU);
    stage_copy(Z + (size_t)t0 * ZW + C_RV + h * 128, ZW, Vs, 256, 128, 16, tidU);
    __syncthreads();
    f32x16 a0 = F16Z, a1 = F16Z;
#pragma unroll 2
    for (int ks = 0; ks < 8; ++ks) {
        const bf16x8_t A = frag_tr<false>(Vs, 256, 16 * ks, 32 * wl, lane);
        const bf16x8_t B0 = frag_tr<false>(Ks, 128, 16 * ks, 0, lane), B1 = frag_tr<false>(Ks, 128, 16 * ks, 32, lane);
        a0 = __builtin_amdgcn_mfma_f32_32x32x16_bf16(A, B0, a0, 0, 0, 0); a1 = __builtin_amdgcn_mfma_f32_32x32x16_bf16(A, B1, a1, 0, 0, 0);
    }
    float* dst = RST + (size_t)unit * 8192; const int r32 = lane & 31, hh = lane >> 5;
#pragma unroll
    for (int rg = 0; rg < 16; ++rg) { const int dv = 32 * wl + acc_row(rg, hh); dst[dv * 64 + r32] = a0[rg]; dst[dv * 64 + 32 + r32] = a1[rg]; }
    __syncthreads();
}

__device__ __forceinline__ void mls_gates(const Params& p, int li, int t0, int h, int lane, float& b0, float& b1, float& g0, float& g1) {
    const float* gates = (const float*)(p.ws + WS_GATES);
    const float bi = p.b_if[li * 8 + h], bf = p.b_if[li * 8 + 4 + h];
    const int t = t0 + 2 * lane;
    const float i0 = gates[(size_t)t * 8 + h] + bi, i1 = gates[(size_t)(t + 1) * 8 + h] + bi;
    const float f0 = logsigmoidf_(gates[(size_t)t * 8 + 4 + h] + bf), f1 = logsigmoidf_(gates[(size_t)(t + 1) * 8 + 4 + h] + bf);
    const float tot = f0 + f1; float v = tot;
#pragma unroll
    for (int o = 1; o < 64; o <<= 1) { const float u = __shfl_up(v, o); if (lane >= o) v += u; }
    const float ex = v - tot;
    b0 = ex + f0; b1 = ex + tot; g0 = i0 - b0; g1 = i1 - b1;
}
__device__ __forceinline__ void conv8(const bf16* zq, const float* cw, int nprev, float scale, float* o) {
    float acc[8];
#pragma unroll
    for (int e = 0; e < 8; ++e) acc[e] = 0.f;
#pragma unroll
    for (int j = 0; j < 4; ++j) {
        if (3 - j <= nprev) {
            float xv[8]; unpack8v(*(const u32x4*)(zq - (size_t)(3 - j) * ZW), xv);
            const f32x4 w0 = *(const f32x4*)(cw + j * 512), w1 = *(const f32x4*)(cw + j * 512 + 4);
#pragma unroll
            for (int e = 0; e < 8; ++e) acc[e] = fmaf(e < 4 ? w0[e & 3] : w1[e & 3], xv[e], acc[e]);
        }
    }
#pragma unroll
    for (int e = 0; e < 8; ++e) o[e] = siluf_(acc[e]) * scale;
}
__device__ __forceinline__ void stage_vext(const bf16* src0, LAS unsigned char* Vs, int tidU) {
    for (int task = tidU; task < 128 * 12; task += 256) {
        const int row = task / 12, c = task - row * 12;
        u32x4 v = {0u, 0u, 0u, 0u};
        if (c < 8) v = *(const u32x4*)(src0 + (size_t)row * ZW + 8 * c); else if (c == 8) v.x = 0x3F80u;
        *(LAS u32x4*)(Vs + row * 256 + swz16(row, c)) = v;
    }
}

__device__ __forceinline__ void mls_state_u(const Params& p, int li, int unit, LAS unsigned char* ldsU, int wl, int tidU, int lane) {
    const int c = unit & 63, bh = unit >> 6, h = bh & 3, b = bh >> 2, t0 = b * SEQ + c * 128;
    const bf16* Z = (const bf16*)(p.ws + WS_Z);
    float* MC = (float*)(p.ws + WS_MC); float* MN = (float*)(p.ws + WS_MN); float* MA = (float*)(p.ws + WS_MA); float* MML = (float*)(p.ws + WS_MML);
    LAS unsigned char* Ks = ldsU; LAS unsigned char* Vs = ldsU + 16384; LAS float* wk = (LAS float*)(ldsU + 49152);
    if (wl == 0) {
        float b0, b1, g0, g1; mls_gates(p, li, t0, h, lane, b0, b1, g0, g1);
        const float gmax = wave_max(fmaxf(g0, g1));
        const float a = __shfl(b1, 63);
        wk[2 * lane] = __expf(g0 - gmax); wk[2 * lane + 1] = __expf(g1 - gmax);
        if (lane == 0) { MA[unit] = a; MML[unit] = a + gmax; }
    }
    stage_vext(Z + (size_t)t0 * ZW + C_MV + h * 64, Vs, tidU);
    __syncthreads();
    for (int task = tidU; task < 1024; task += 256) {
        const int row = task >> 3, cc = task & 7;
        float o[8]; conv8(Z + (size_t)(t0 + row) * ZW + C_MK + h * 64 + 8 * cc, p.conv_w + (size_t)li * 2048 + 256 + h * 64 + 8 * cc, c * 128 + row, 0.125f * wk[row], o);
        *(LAS u32x4*)(Ks + row * 128 + swz16(row, cc)) = pack8(o);
    }
    __syncthreads();
    if (wl < 3) {
        f32x16 a0 = F16Z, a1 = F16Z;
#pragma unroll 2
        for (int ks = 0; ks < 8; ++ks) {
            const bf16x8_t A = frag_tr<false>(Vs, 256, 16 * ks, 32 * wl, lane);
            const bf16x8_t B0 = frag_tr<false>(Ks, 128, 16 * ks, 0, lane), B1 = frag_tr<false>(Ks, 128, 16 * ks, 32, lane);
            a0 = __builtin_amdgcn_mfma_f32_32x32x16_bf16(A, B0, a0, 0, 0, 0); a1 = __builtin_amdgcn_mfma_f32_32x32x16_bf16(A, B1, a1, 0, 0, 0);
        }
        const int r32 = lane & 31, hh = lane >> 5;
        if (wl < 2) {
            float* dst = MC + (size_t)unit * 4096;
#pragma unroll
            for (int rg = 0; rg < 16; ++rg) { const int v = 32 * wl + acc_row(rg, hh); dst[v * 64 + r32] = a0[rg]; dst[v * 64 + 32 + r32] = a1[rg]; }
        } else if (hh == 0) { MN[(size_t)unit * 64 + r32] = a0[0]; MN[(size_t)unit * 64 + 32 + r32] = a1[0]; }
    }
    __syncthreads();
}

__device__ __forceinline__ void ret_out_u(const Params& p, int li, int unit, LAS unsigned char* ldsU, int wl, int tidU, int lane) {
    const int c = unit & 63, bh = unit >> 6, h = bh & 3, b = bh >> 2, t0 = b * SEQ + c * 128, s0 = c * 128;
    const int r32 = lane & 31, hh = lane >> 5;
    const bf16* Z = (const bf16*)(p.ws + WS_Z); const float* RST = (const float*)(p.ws + WS_RST); bf16* MIX = (bf16*)(p.ws + WS_MIX);
    const float* rcos = (const float*)(p.ws + WS_RCOS); const float* rsin = (const float*)(p.ws + WS_RSIN);
    LAS unsigned char* Ks = ldsU; LAS unsigned char* Vs = ldsU + 16384; LAS unsigned char* Rs = ldsU + 49152;
    const float lg = ret_lg(h);
    stage_ret_k<false>(p, Ks, t0, s0, h, lg, tidU);
    stage_copy(Z + (size_t)t0 * ZW + C_RV + h * 128, ZW, Vs, 256, 128, 16, tidU);
    for (int task = tidU; task < 1024; task += 256) {
        const int row = task >> 3, cc = task & 7;
        const float* src = RST + (size_t)unit * 8192 + row * 64 + 8 * cc;
        const f32x4 x0 = *(const f32x4*)src, x1 = *(const f32x4*)(src + 4);
        const float v[8] = {x0[0], x0[1], x0[2], x0[3], x1[0], x1[1], x1[2], x1[3]};
        *(LAS u32x4*)(Rs + row * 128 + swz16(row, cc)) = pack8(v);
    }
    const int t = 32 * wl + r32, tok = t0 + t, pos = s0 + t;
    bf16x8_t qf[4];
    {
        float f[4][8];
#pragma unroll
        for (int ks = 0; ks < 4; ++ks) unpack8v(*(const u32x4*)(Z + (size_t)tok * ZW + C_RQ + h * 64 + 16 * ks + 8 * hh), f[ks]);
#pragma unroll
        for (int ks = 0; ks < 2; ++ks) {
            const float* cp = rcos + pos * 32 + 16 * ks + 8 * hh; const float* sp = rsin + pos * 32 + 16 * ks + 8 * hh;
            const f32x4 c0 = *(const f32x4*)cp, c1 = *(const f32x4*)(cp + 4), n0 = *(const f32x4*)sp, n1 = *(const f32x4*)(sp + 4);
#pragma unroll
            for (int j = 0; j < 8; ++j) { const float cs = j < 4 ? c0[j & 3] : c1[j & 3], sn = j < 4 ? n0[j & 3] : n1[j & 3]; const float x1 = f[ks][j], x2 = f[ks + 2][j]; f[ks][j] = x1 * cs - x2 * sn; f[ks + 2][j] = x2 * cs + x1 * sn; }
        }
#pragma unroll
        for (int ks = 0; ks < 4; ++ks) qf[ks] = __builtin_bit_cast(bf16x8_t, pack8(f[ks]));
    }
    __syncthreads();
    f32x16 o[4];
#pragma unroll
    for (int dt = 0; dt < 4; ++dt) {
        f32x16 a = F16Z;
#pragma unroll
        for (int ks = 0; ks < 4; ++ks) a = __builtin_amdgcn_mfma_f32_32x32x16_bf16(frag_row(Rs, 128, 32 * dt + r32, 2 * ks + hh), qf[ks], a, 0, 0, 0);
        o[dt] = a;
    }
    const float xi = __expf(lg * (float)(t + 1));
#pragma unroll
    for (int dt = 0; dt < 4; ++dt)
#pragma unroll
        for (int rg = 0; rg < 16; ++rg) o[dt][rg] *= xi;
#pragma unroll 1
    for (int tl = 0; tl <= wl; ++tl) {
        {
            f32x16 st = F16Z;
#pragma unroll
            for (int ks = 0; ks < 4; ++ks) st = __builtin_amdgcn_mfma_f32_32x32x16_bf16(frag_row(Ks, 128, 32 * tl + r32, 2 * ks + hh), qf[ks], st, 0, 0, 0);
#pragma unroll
            for (int rg = 0; rg < 16; ++rg) { const int s = 32 * tl + acc_row(rg, hh); st[rg] = (s <= t) ? st[rg] * __expf(lg * (float)(t - s)) : 0.f; }
#pragma unroll
            for (int s2 = 0; s2 < 2; ++s2) {
                u32x4 pw; pw.x = cvtpk(st[8 * s2 + 0], st[8 * s2 + 1]); pw.y = cvtpk(st[8 * s2 + 2], st[8 * s2 + 3]); pw.z = cvtpk(st[8 * s2 + 4], st[8 * s2 + 5]); pw.w = cvtpk(st[8 * s2 + 6], st[8 * s2 + 7]);
                const bf16x8_t pb = __builtin_bit_cast(bf16x8_t, pw);
#pragma unroll
                for (int dt = 0; dt < 4; ++dt) o[dt] = __builtin_amdgcn_mfma_f32_32x32x16_bf16(frag_tr<true>(Vs, 256, 32 * tl + 16 * s2, 32 * dt, lane), pb, o[dt], 0, 0, 0);
            }
        }
    }
    float sum = 0.f, sq = 0.f;
#pragma unroll
    for (int dt = 0; dt < 4; ++dt)
#pragma unroll
        for (int rg = 0; rg < 16; ++rg) { sum += o[dt][rg]; sq += o[dt][rg] * o[dt][rg]; }
    sum += __shfl_xor(sum, 32); sq += __shfl_xor(sq, 32);
    const float mean = sum * (1.0f / 128.0f);
    const float rstd = 1.0f / sqrtf(fmaxf(sq * (1.0f / 128.0f) - mean * mean, 0.f) + LN_EPS);
#pragma unroll
    for (int dt = 0; dt < 4; ++dt)
#pragma unroll
        for (int g4 = 0; g4 < 4; ++g4) {
            const int dv = 32 * dt + 8 * g4 + 4 * hh;
            const f32x4 gg = *(const f32x4*)(p.ret_g + li * 512 + h * 128 + dv);
            const uint2 rgb = *(const uint2*)(Z + (size_t)tok * ZW + C_RG + h * 128 + dv);
            const float r0 = __uint_as_float(rgb.x << 16), r1 = __uint_as_float(rgb.x & 0xffff0000u), r2 = __uint_as_float(rgb.y << 16), r3 = __uint_as_float(rgb.y & 0xffff0000u);
            const float y0 = (o[dt][4 * g4 + 0] - mean) * rstd * gg[0] * siluf_(r0), y1 = (o[dt][4 * g4 + 1] - mean) * rstd * gg[1] * siluf_(r1);
            const float y2 = (o[dt][4 * g4 + 2] - mean) * rstd * gg[2] * siluf_(r2), y3 = (o[dt][4 * g4 + 3] - mean) * rstd * gg[3] * siluf_(r3);
            *(uint2*)(MIX + (size_t)tok * DM + h * 128 + dv) = make_uint2(pk2(y0, y1), pk2(y2, y3));
        }
    __syncthreads();
}

__device__ __forceinline__ void mls_out_u(const Params& p, int li, int unit, LAS unsigned char* ldsU, int wl, int tidU, int lane) {
    const int c = unit & 63, bh = unit >> 6, h = bh & 3, b = bh >> 2, t0 = b * SEQ + c * 128;
    const int r32 = lane & 31, hh = lane >> 5;
    const bf16* Z = (const bf16*)(p.ws + WS_Z); bf16* MIX = (bf16*)(p.ws + WS_MIX);
    const float* MC = (const float*)(p.ws + WS_MC); const float* MN = (const float*)(p.ws + WS_MN); const float* MMP = (const float*)(p.ws + WS_MMP);
    LAS unsigned char* Ks = ldsU; LAS unsigned char* Qs = ldsU + 16384; LAS unsigned char* Vs = ldsU + 32768; LAS unsigned char* Cs = ldsU + 65536;
    LAS float* bb = (LAS float*)(ldsU + 77824); LAS float* gg = bb + 128; LAS float* pm = gg + 128;
    if (wl == 0) {
        float b0, b1, g0, g1; mls_gates(p, li, t0, h, lane, b0, b1, g0, g1);
        const float p1 = fmaxf(g0, g1); float v = p1;
#pragma unroll
        for (int o = 1; o < 64; o <<= 1) { const float u = __shfl_up(v, o); if (lane >= o) v = fmaxf(v, u); }
        const float prev = __shfl_up(v, 1);
        const float ex = (lane == 0) ? -INFINITY : prev;
        bb[2 * lane] = b0; bb[2 * lane + 1] = b1; gg[2 * lane] = g0; gg[2 * lane + 1] = g1;
        pm[2 * lane] = fmaxf(ex, g0); pm[2 * lane + 1] = fmaxf(ex, p1);
    }
    stage_vext(Z + (size_t)t0 * ZW + C_MV + h * 64, Vs, tidU);
    for (int task = tidU; task < 2048; task += 256) {
        const int isq = task >> 10, row = (task >> 3) & 127, cc = task & 7;
        float o[8]; conv8(Z + (size_t)(t0 + row) * ZW + (isq ? C_MQ : C_MK) + h * 64 + 8 * cc, p.conv_w + (size_t)li * 2048 + (isq ? 0 : 256) + h * 64 + 8 * cc, c * 128 + row, isq ? 1.0f : 0.125f, o);
        *(LAS u32x4*)((isq ? Qs : Ks) + row * 128 + swz16(row, cc)) = pack8(o);
    }
    for (int task = tidU; task < 96 * 8; task += 256) {
        const int row = task >> 3, cc = task & 7;
        float v[8] = {0.f, 0.f, 0.f, 0.f, 0.f, 0.f, 0.f, 0.f};
        if (row <= 64) { const float* src = (row < 64) ? (MC + (size_t)unit * 4096 + row * 64 + 8 * cc) : (MN + (size_t)unit * 64 + 8 * cc);
            const f32x4 x0 = *(const f32x4*)src, x1 = *(const f32x4*)(src + 4); v[0] = x0[0]; v[1] = x0[1]; v[2] = x0[2]; v[3] = x0[3]; v[4] = x1[0]; v[5] = x1[1]; v[6] = x1[2]; v[7] = x1[3]; }
        *(LAS u32x4*)(Cs + row * 128 + swz16(row, cc)) = pack8(v);
    }
    const float mprev = MMP[unit];
    __syncthreads();
    const int t = 32 * wl + r32, tok = t0 + t;
    const float Mt = fmaxf(mprev, pm[t]), bt = bb[t];
    const float winter = __expf(mprev - Mt);
    bf16x8_t qf[4];
#pragma unroll
    for (int ks = 0; ks < 4; ++ks) qf[ks] = frag_row(Qs, 128, t, 2 * ks + hh);
    f32x16 o[3];
#pragma unroll
    for (int dt = 0; dt < 3; ++dt) {
        f32x16 a = F16Z;
#pragma unroll
        for (int ks = 0; ks < 4; ++ks) a = __builtin_amdgcn_mfma_f32_32x32x16_bf16(frag_row(Cs, 128, 32 * dt + r32, 2 * ks + hh), qf[ks], a, 0, 0, 0);
#pragma unroll
        for (int rg = 0; rg < 16; ++rg) a[rg] *= winter;
        o[dt] = a;
    }
#pragma unroll 1
    for (int tl = 0; tl <= wl; ++tl) {
        {
            f32x16 st = F16Z;
#pragma unroll
            for (int ks = 0; ks < 4; ++ks) st = __builtin_amdgcn_mfma_f32_32x32x16_bf16(frag_row(Ks, 128, 32 * tl + r32, 2 * ks + hh), qf[ks], st, 0, 0, 0);
#pragma unroll
            for (int g4 = 0; g4 < 4; ++g4) {
                const int sb = 32 * tl + 8 * g4 + 4 * hh;
                const f32x4 gv = *(const LAS f32x4*)(gg + sb);
#pragma unroll
                for (int j = 0; j < 4; ++j) st[4 * g4 + j] = (sb + j <= t) ? st[4 * g4 + j] * __expf(gv[j] - Mt) : 0.f;
            }
#pragma unroll
            for (int s2 = 0; s2 < 2; ++s2) {
                u32x4 pw; pw.x = cvtpk(st[8 * s2 + 0], st[8 * s2 + 1]); pw.y = cvtpk(st[8 * s2 + 2], st[8 * s2 + 3]); pw.z = cvtpk(st[8 * s2 + 4], st[8 * s2 + 5]); pw.w = cvtpk(st[8 * s2 + 6], st[8 * s2 + 7]);
                const bf16x8_t pb = __builtin_bit_cast(bf16x8_t, pw);
#pragma unroll
                for (int dt = 0; dt < 3; ++dt) o[dt] = __builtin_amdgcn_mfma_f32_32x32x16_bf16(frag_tr<true>(Vs, 256, 32 * tl + 16 * s2, 32 * dt, lane), pb, o[dt], 0, 0, 0);
            }
        }
    }
    const float den = __shfl(o[2][0], r32);
    const float rden = 1.0f / fmaxf(fabsf(den), __expf(-(bt + Mt)));
    float sum = 0.f, sq = 0.f;
#pragma unroll
    for (int dt = 0; dt < 2; ++dt)
#pragma unroll
        for (int rg = 0; rg < 16; ++rg) { o[dt][rg] *= rden; sum += o[dt][rg]; sq += o[dt][rg] * o[dt][rg]; }
    sum += __shfl_xor(sum, 32); sq += __shfl_xor(sq, 32);
    const float mean = sum * (1.0f / 64.0f);
    const float rstd = 1.0f / sqrtf(fmaxf(sq * (1.0f / 64.0f) - mean * mean, 0.f) + LN_EPS);
#pragma unroll
    for (int dt = 0; dt < 2; ++dt)
#pragma unroll
        for (int g4 = 0; g4 < 4; ++g4) {
            const int d = 32 * dt + 8 * g4 + 4 * hh;
            const f32x4 gn = *(const f32x4*)(p.mls_g + li * 256 + h * 64 + d);
            const uint2 mob = *(const uint2*)(Z + (size_t)tok * ZW + C_MO + h * 64 + d);
            const float m0 = __uint_as_float(mob.x << 16), m1 = __uint_as_float(mob.x & 0xffff0000u), m2 = __uint_as_float(mob.y << 16), m3 = __uint_as_float(mob.y & 0xffff0000u);
            const float y0 = (o[dt][4 * g4 + 0] - mean) * rstd * gn[0] * sigmoidf_(m0), y1 = (o[dt][4 * g4 + 1] - mean) * rstd * gn[1] * sigmoidf_(m1);
            const float y2 = (o[dt][4 * g4 + 2] - mean) * rstd * gn[2] * sigmoidf_(m2), y3 = (o[dt][4 * g4 + 3] - mean) * rstd * gn[3] * sigmoidf_(m3);
            *(uint2*)(MIX + (size_t)tok * DM + 768 + h * 64 + d) = make_uint2(pk2(y0, y1), pk2(y2, y3));
        }
    __syncthreads();
}

__device__ __forceinline__ void p3_scans(const Params& p) {
    float* RST = (float*)(p.ws + WS_RST);
    float* MC = (float*)(p.ws + WS_MC); float* MN = (float*)(p.ws + WS_MN); const float* MA = (const float*)(p.ws + WS_MA); const float* MML = (const float*)(p.ws + WS_MML); float* MMP = (float*)(p.ws + WS_MMP);
    const int gt = blockIdx.x * NTHR + threadIdx.x, GT = gridDim.x * NTHR;
    for (int e = gt; e < 16 * 8192; e += GT) {
        const int bh = e >> 13, el = e & 8191, h = bh & 3;
        const float gL = expf(ret_lg(h) * 128.0f);
        float R = 0.f;
        float* ptr = RST + (size_t)bh * 64 * 8192 + el;
        for (int c = 0; c < 64; ++c) { const float sv = ptr[(size_t)c * 8192]; ptr[(size_t)c * 8192] = R; R = fmaf(gL, R, sv); }
    }
    for (int e = gt; e < 16 * 4160; e += GT) {
        const int bh = e / 4160, el = e - bh * 4160;
        float* ptr; size_t stride;
        if (el < 4096) { ptr = MC + (size_t)bh * 64 * 4096 + el; stride = 4096; } else { ptr = MN + (size_t)bh * 64 * 64 + (el - 4096); stride = 64; }
        float m = 0.f, C = 0.f;
        for (int c = 0; c < 64; ++c) {
            const float a = MA[bh * 64 + c], ml = MML[bh * 64 + c];
            const float mn = fmaxf(a + m, ml);
            const float f1 = expf(a + m - mn), f2 = expf(ml - mn);
            const float sv = ptr[(size_t)c * stride]; ptr[(size_t)c * stride] = C; C = f1 * C + f2 * sv;
            if (el == 0) MMP[bh * 64 + c] = m;
            m = mn;
        }
    }
}

__device__ __forceinline__ void ret_out_item(const Params& p, int li, int item, float* lds) {
    const int tid = threadIdx.x;
    const int c = item & 63, bh = item >> 6, h = bh & 3, b = bh >> 2;
    const int t0 = b * SEQ + c * 128, s0 = c * 128;
    const bf16* Z = (const bf16*)(p.ws + WS_Z);
    const float* rcos = (const float*)(p.ws + WS_RCOS); const float* rsin = (const float*)(p.ws + WS_RSIN);
    const float* RST = (const float*)(p.ws + WS_RST);
    bf16* MIX = (bf16*)(p.ws + WS_MIX);
    float* Q = lds; float* K = Q + 8320; float* SC = K + 8320; float* V = SC + 8256; float* R = V + 8192;
    const float lg = ret_lg(h);
    for (int idx = tid; idx < 128 * 32; idx += NTHR) {
        const int row = idx >> 5, i = idx & 31;
        const bf16* zq = Z + (size_t)(t0 + row) * ZW + C_RQ + h * 64; const bf16* zk = Z + (size_t)(t0 + row) * ZW + C_RK + h * 64;
        const float cs = rcos[(s0 + row) * 32 + i], sn = rsin[(s0 + row) * 32 + i];
        const float q1 = bf2f(zq[i]), q2 = bf2f(zq[i + 32]), k1 = bf2f(zk[i]), k2 = bf2f(zk[i + 32]);
        Q[row * 65 + i] = q1 * cs - q2 * sn; Q[row * 65 + i + 32] = q2 * cs + q1 * sn;
        K[row * 65 + i] = (k1 * cs - k2 * sn) * 0.125f; K[row * 65 + i + 32] = (k2 * cs + k1 * sn) * 0.125f;
    }
    __syncthreads();
    const int r = tid >> 3, d0 = (tid & 7) * 8;
#pragma unroll 1
    for (int rh = 0; rh < 2; ++rh) {
        const int t = rh * 64 + r;
#pragma unroll 1
        for (int j = 0; j < 16; ++j) {
            const int s = (tid & 7) + 8 * j;
            float dot = 0.f;
#pragma unroll 16
            for (int d = 0; d < 64; ++d) dot = fmaf(Q[t * 65 + d], K[s * 65 + d], dot);
            SC[r * 129 + s] = (s <= t) ? dot * expf(lg * (float)(t - s)) : 0.f;
        }
        __syncthreads();
        float o[2][8];
#pragma unroll
        for (int dh = 0; dh < 2; ++dh) {
            for (int idx = tid; idx < 128 * 64; idx += NTHR) { const int row = idx >> 6, d = idx & 63; V[idx] = bf2f(Z[(size_t)(t0 + row) * ZW + C_RV + h * 128 + dh * 64 + d]); }
            for (int idx = tid; idx < 64 * 64; idx += NTHR) { const int k = idx >> 6, d = idx & 63; R[idx] = RST[(size_t)item * 8192 + k * 128 + dh * 64 + d]; }
            __syncthreads();
            float acc[8], cr[8];
#pragma unroll
            for (int j = 0; j < 8; ++j) { acc[j] = 0.f; cr[j] = 0.f; }
#pragma unroll 4
            for (int s = 0; s < 128; ++s) {
                const float w = SC[r * 129 + s];
#pragma unroll
                for (int j = 0; j < 8; ++j) acc[j] = fmaf(w, V[s * 64 + d0 + j], acc[j]);
            }
#pragma unroll 4
            for (int k = 0; k < 64; ++k) {
                const float qv = Q[t * 65 + k];
#pragma unroll
                for (int j = 0; j < 8; ++j) cr[j] = fmaf(qv, R[k * 64 + d0 + j], cr[j]);
            }
            const float xi = expf(lg * (float)(t + 1));
#pragma unroll
            for (int j = 0; j < 8; ++j) o[dh][j] = acc[j] + xi * cr[j];
            __syncthreads();
        }
        float sum = 0.f;
#pragma unroll
        for (int dh = 0; dh < 2; ++dh)
#pragma unroll
            for (int j = 0; j < 8; ++j) sum += o[dh][j];
        sum += __shfl_xor(sum, 1); sum += __shfl_xor(sum, 2); sum += __shfl_xor(sum, 4);
        const float mean = sum * (1.0f / 128.0f);
        float sq = 0.f;
#pragma unroll
        for (int dh = 0; dh < 2; ++dh)
#pragma unroll
            for (int j = 0; j < 8; ++j) { const float dd = o[dh][j] - mean; sq += dd * dd; }
        sq += __shfl_xor(sq, 1); sq += __shfl_xor(sq, 2); sq += __shfl_xor(sq, 4);
        const float rstd = 1.0f / sqrtf(sq * (1.0f / 128.0f) + LN_EPS);
#pragma unroll
        for (int dh = 0; dh < 2; ++dh) {
            float y[8];
#pragma unroll
            for (int j = 0; j < 8; ++j) {
                const int d = dh * 64 + d0 + j;
                const float g = p.ret_g[li * 512 + h * 128 + d];
                const float rg = bf2f(Z[(size_t)(t0 + t) * ZW + C_RG + h * 128 + d]);
                y[j] = (o[dh][j] - mean) * rstd * g * siluf_(rg);
            }
            uint4 w; w.x = pk2(y[0], y[1]); w.y = pk2(y[2], y[3]); w.z = pk2(y[4], y[5]); w.w = pk2(y[6], y[7]);
            *(uint4*)(MIX + (size_t)(t0 + t) * DM + h * 128 + dh * 64 + d0) = w;
        }
    }
    __syncthreads();
}

__device__ __forceinline__ void mls_out_item(const Params& p, int li, int item, float* lds) {
    const int tid = threadIdx.x;
    const int c = item & 63, bh = item >> 6, h = bh & 3, b = bh >> 2;
    const int t0 = b * SEQ + c * 128;
    const bf16* Z = (const bf16*)(p.ws + WS_Z);
    const float* gates = (const float*)(p.ws + WS_GATES);
    const float* MC = (const float*)(p.ws + WS_MC); const float* MN = (const float*)(p.ws + WS_MN); const float* MMP = (const float*)(p.ws + WS_MMP);
    bf16* MIX = (bf16*)(p.ws + WS_MIX);
    const float* cw = p.conv_w + (size_t)li * 4 * 512;
    float* Q = lds; float* K = Q + 8320; float* SM = K + 8320; float* V = SM + 8256; float* C = V + 8192; float* nv = C + 4096; float* ib = nv + 64; float* bb = ib + 128; float* pm = bb + 128;
    for (int idx = tid; idx < 128 * 64; idx += NTHR) {
        const int row = idx >> 6, d = idx & 63, chq = h * 64 + d, chk = 256 + h * 64 + d;
        float aq = 0.f, ak = 0.f;
#pragma unroll
        for (int j = 0; j < 4; ++j) {
            const int sp = c * 128 + row - 3 + j;
            if (sp >= 0) {
                const bf16* zr = Z + (size_t)(t0 + row - 3 + j) * ZW;
                aq = fmaf(cw[j * 512 + chq], bf2f(zr[C_MQ + h * 64 + d]), aq);
                ak = fmaf(cw[j * 512 + chk], bf2f(zr[C_MK + h * 64 + d]), ak);
            }
        }
        Q[row * 65 + d] = siluf_(aq); K[row * 65 + d] = siluf_(ak) * 0.125f;
        V[idx] = bf2f(Z[(size_t)(t0 + row) * ZW + C_MV + h * 64 + d]);
    }
    for (int idx = tid; idx < 4096; idx += NTHR) C[idx] = MC[(size_t)item * 4096 + idx];
    if (tid < 64) nv[tid] = MN[(size_t)item * 64 + tid];
    if (tid < 128) {
        const int t = t0 + tid;
        ib[tid] = gates[(size_t)t * 8 + h] + p.b_if[li * 8 + h];
        bb[tid] = logsigmoidf_(gates[(size_t)t * 8 + 4 + h] + p.b_if[li * 8 + 4 + h]);
    }
    const float mprev = MMP[item];
    __syncthreads();
    if (tid == 0) {
        float run = 0.f, pmx = -INFINITY;
#pragma unroll 4
        for (int s = 0; s < 128; ++s) { run += bb[s]; bb[s] = run; pmx = fmaxf(pmx, ib[s] - run); pm[s] = pmx; }
    }
    __syncthreads();
    const int r = tid >> 3, d0 = (tid & 7) * 8;
#pragma unroll 1
    for (int rh = 0; rh < 2; ++rh) {
        const int t = rh * 64 + r;
        const float mt = bb[t] + fmaxf(mprev, pm[t]);
#pragma unroll 1
        for (int j = 0; j < 16; ++j) {
            const int s = (tid & 7) + 8 * j;
            float dot = 0.f;
#pragma unroll 16
            for (int d = 0; d < 64; ++d) dot = fmaf(Q[t * 65 + d], K[s * 65 + d], dot);
            SM[r * 129 + s] = (s <= t) ? dot * expf(bb[t] - bb[s] + ib[s] - mt) : 0.f;
        }
        __syncthreads();
        float acc[8], qc[8], den = 0.f, qn = 0.f;
#pragma unroll
        for (int j = 0; j < 8; ++j) { acc[j] = 0.f; qc[j] = 0.f; }
#pragma unroll 4
        for (int s = 0; s < 128; ++s) {
            const float w = SM[r * 129 + s]; den += w;
#pragma unroll
            for (int j = 0; j < 8; ++j) acc[j] = fmaf(w, V[s * 64 + d0 + j], acc[j]);
        }
#pragma unroll 4
        for (int k = 0; k < 64; ++k) {
            const float qv = Q[t * 65 + k]; qn = fmaf(qv, nv[k], qn);
#pragma unroll
            for (int j = 0; j < 8; ++j) qc[j] = fmaf(qv, C[k * 64 + d0 + j], qc[j]);
        }
        const float winter = expf(bb[t] + mprev - mt);
        den += winter * qn;
        const float denom = fmaxf(fabsf(den), expf(-mt));
        float hv[8], sum = 0.f;
#pragma unroll
        for (int j = 0; j < 8; ++j) { hv[j] = (acc[j] + winter * qc[j]) / denom; sum += hv[j]; }
        sum += __shfl_xor(sum, 1); sum += __shfl_xor(sum, 2); sum += __shfl_xor(sum, 4);
        const float mean = sum * (1.0f / 64.0f);
        float sq = 0.f;
#pragma unroll
        for (int j = 0; j < 8; ++j) { const float dd = hv[j] - mean; sq += dd * dd; }
        sq += __shfl_xor(sq, 1); sq += __shfl_xor(sq, 2); sq += __shfl_xor(sq, 4);
        const float rstd = 1.0f / sqrtf(sq * (1.0f / 64.0f) + LN_EPS);
        float y[8];
#pragma unroll
        for (int j = 0; j < 8; ++j) {
            const int d = d0 + j;
            const float g = p.mls_g[li * 256 + h * 64 + d];
            const float mo = bf2f(Z[(size_t)(t0 + t) * ZW + C_MO + h * 64 + d]);
            y[j] = (hv[j] - mean) * rstd * g * sigmoidf_(mo);
        }
        { uint4 w; w.x = pk2(y[0], y[1]); w.y = pk2(y[2], y[3]); w.z = pk2(y[4], y[5]); w.w = pk2(y[6], y[7]);
          *(uint4*)(MIX + (size_t)(t0 + t) * DM + 768 + h * 64 + d0) = w; }
        __syncthreads();
    }
}

__device__ __forceinline__ void ln_row_inplace(float* row, bf16* brow, signed char* qrow, float* qscale, const float* g, const float* bta, int lane) {
    float4 v[4]; float s = 0.f;
#pragma unroll
    for (int j = 0; j < 4; ++j) { v[j] = *(const float4*)(row + 256 * j + 4 * lane); s += (v[j].x + v[j].y) + (v[j].z + v[j].w); }
    const float mean = wave_sum(s) * (1.0f / DM);
    float s2 = 0.f;
#pragma unroll
    for (int j = 0; j < 4; ++j) { v[j].x -= mean; v[j].y -= mean; v[j].z -= mean; v[j].w -= mean; s2 += (v[j].x * v[j].x + v[j].y * v[j].y) + (v[j].z * v[j].z + v[j].w * v[j].w); }
    const float rstd = 1.0f / sqrtf(wave_sum(s2) * (1.0f / DM) + LN_EPS);
#pragma unroll
    for (int j = 0; j < 4; ++j) {
        const float4 gg = *(const float4*)(g + 256 * j + 4 * lane), bv = *(const float4*)(bta + 256 * j + 4 * lane);
        const float4 o = make_float4(v[j].x * rstd * gg.x + bv.x, v[j].y * rstd * gg.y + bv.y, v[j].z * rstd * gg.z + bv.z, v[j].w * rstd * gg.w + bv.w);
        *(float4*)(row + 256 * j + 4 * lane) = o;
        *(uint2*)(brow + 256 * j + 4 * lane) = make_uint2(pk2(o.x, o.y), pk2(o.z, o.w));
        v[j] = o;
    }
    float am = 0.f;
#pragma unroll
    for (int j = 0; j < 4; ++j) am = fmaxf(am, fmaxf(fmaxf(fabsf(v[j].x), fabsf(v[j].y)), fmaxf(fabsf(v[j].z), fabsf(v[j].w))));
    am = wave_max(am);
    const float inv = am > 0.f ? 127.0f / am : 0.f;
#pragma unroll
    for (int j = 0; j < 4; ++j) {
        const unsigned q0 = (unsigned)__float2int_rn(v[j].x * inv) & 0xffu, q1 = (unsigned)__float2int_rn(v[j].y * inv) & 0xffu, q2 = (unsigned)__float2int_rn(v[j].z * inv) & 0xffu, q3 = (unsigned)__float2int_rn(v[j].w * inv) & 0xffu;
        *(unsigned*)(qrow + 256 * j + 4 * lane) = q0 | (q1 << 8) | (q2 << 16) | (q3 << 24);
    }
    if (lane == 0) *qscale = am * (1.0f / 127.0f);
}

__device__ __forceinline__ void topk_item(const Params& p, int li, int item, float* lds) {
    const int tid = threadIdx.x, lane = tid & 63, wave = tid >> 6;
    const int tile = item >> 3, h = item & 7, tok0 = tile * 64;
    const bf16* QRY = (const bf16*)(p.ws + WS_QRY);
    int* RI = (int*)(p.ws + WS_RI); float* RG = (float*)(p.ws + WS_RG);
    float* Kk = lds; float* Qt = Kk + 128 * 129; float* SC = Qt + 64 * 129; float* TKV = SC + 64 * 128; int* TKI = (int*)(TKV + 2048);
#pragma unroll 1
    for (int pp = 0; pp < 2; ++pp) {
        const float* kb = p.keys + ((size_t)((li * 8 + h) * 2 + pp)) * 128 * 128;
        for (int idx = tid; idx < 128 * 128; idx += NTHR) { const int n = idx >> 7, c = idx & 127; Kk[n * 129 + c] = kb[idx]; }
        for (int idx = tid; idx < 64 * 128; idx += NTHR) { const int tok = idx >> 7, c = idx & 127; Qt[tok * 129 + c] = bf2f(QRY[(size_t)(tok0 + tok) * 2048 + h * 256 + pp * 128 + c]); }
        __syncthreads();
        {
            const int tok = tid >> 3;
#pragma unroll 1
            for (int j = 0; j < 16; ++j) {
                const int n = (tid & 7) + 8 * j;
                float dot = 0.f;
#pragma unroll 16
                for (int c = 0; c < 128; ++c) dot = fmaf(Qt[tok * 129 + c], Kk[n * 129 + c], dot);
                SC[tok * 128 + n] = dot;
            }
        }
        __syncthreads();
#pragma unroll 1
        for (int q = 0; q < 8; ++q) {
            const int tok = wave * 8 + q;
            float v0 = SC[tok * 128 + lane], v1 = SC[tok * 128 + 64 + lane];
#pragma unroll 1
            for (int k = 0; k < 16; ++k) {
                const float wm = wave_max(fmaxf(v0, v1));
                const unsigned long long b0 = __ballot(v0 == wm);
                int idx;
                if (b0) { const int sl = __ffsll((long long)b0) - 1; idx = sl; if (lane == sl) v0 = -INFINITY; }
                else { const unsigned long long b1 = __ballot(v1 == wm); const int sl = __ffsll((long long)b1) - 1; idx = 64 + sl; if (lane == sl) v1 = -INFINITY; }
                if (lane == 0) { TKV[(tok * 2 + pp) * 16 + k] = wm; TKI[(tok * 2 + pp) * 16 + k] = idx; }
            }
        }
        __syncthreads();
    }
#pragma unroll 1
    for (int q = 0; q < 8; ++q) {
        const int tok = wave * 8 + q;
        const float s1 = TKV[(tok * 2) * 16 + (lane >> 2)];
        float cnd[4];
#pragma unroll
        for (int j = 0; j < 4; ++j) cnd[j] = s1 + TKV[(tok * 2 + 1) * 16 + (lane & 3) * 4 + j];
        float myval = 0.f; int myflat = 0;
#pragma unroll 1
        for (int k = 0; k < 16; ++k) {
            const float wm = wave_max(fmaxf(fmaxf(cnd[0], cnd[1]), fmaxf(cnd[2], cnd[3])));
            const bool has = (cnd[0] == wm) | (cnd[1] == wm) | (cnd[2] == wm) | (cnd[3] == wm);
            const unsigned long long bl = __ballot(has);
            const int sl = __ffsll((long long)bl) - 1;
            int fl = 0;
            if (lane == sl) {
                int j = (cnd[0] == wm) ? 0 : ((cnd[1] == wm) ? 1 : ((cnd[2] == wm) ? 2 : 3));
                fl = lane * 4 + j;
                if (j == 0) cnd[0] = -INFINITY; else if (j == 1) cnd[1] = -INFINITY; else if (j == 2) cnd[2] = -INFINITY; else cnd[3] = -INFINITY;
            }
            fl = __shfl(fl, sl);
            if (lane == k) { myval = wm; myflat = fl; }
        }
        const float m0 = __shfl(myval, 0);
        const float e = (lane < 16) ? expf(myval - m0) : 0.f;
        const float ssum = wave_sum(e);
        if (lane < 16) {
            const int a = myflat >> 4, bq = myflat & 15;
            const int eidx = TKI[(tok * 2) * 16 + a] * 128 + TKI[(tok * 2 + 1) * 16 + bq];
            RI[(size_t)(tok0 + tok) * 128 + h * 16 + lane] = eidx;
            RG[(size_t)(tok0 + tok) * 128 + h * 16 + lane] = e / ssum;
        }
    }
    __syncthreads();
}

__device__ __forceinline__ float key_embed(float v, unsigned idx, unsigned keepmask) { return __uint_as_float((__float_as_uint(v) & keepmask) | idx); }

__device__ __forceinline__ void topk_half(const bf16* qrow, const LAS unsigned char* kl, int r32, int hh, float (&out)[16]) {
    bf16x8_t qf[8];
#pragma unroll
    for (int ks = 0; ks < 8; ++ks) qf[ks] = *(const bf16x8_t*)(qrow + 16 * ks + 8 * hh);
    f32x16 st[4];
#pragma unroll
    for (int tl = 0; tl < 4; ++tl) {
        f32x16 a16 = {0.f, 0.f, 0.f, 0.f, 0.f, 0.f, 0.f, 0.f, 0.f, 0.f, 0.f, 0.f, 0.f, 0.f, 0.f, 0.f};
        const int n = 32 * tl + r32;
#pragma unroll
        for (int ks = 0; ks < 8; ++ks) {
            const int c = 2 * ks + hh;
            const bf16x8_t kf = *(const LAS bf16x8_t*)(kl + n * 256 + ((c ^ (n & 15)) << 4));
            a16 = __builtin_amdgcn_mfma_f32_32x32x16_bf16(kf, qf[ks], a16, 0, 0, 0);
        }
        st[tl] = a16;
    }
#pragma unroll
    for (int tl = 0; tl < 4; ++tl)
#pragma unroll
        for (int rg = 0; rg < 16; ++rg) st[tl][rg] = key_embed(st[tl][rg], (unsigned)(32 * tl + (rg & 3) + 8 * (rg >> 2)) | ((unsigned)hh << 2), 0xffffff80u);
#pragma unroll
    for (int k = 0; k < 16; ++k) {
        float lm = st[0][0];
#pragma unroll
        for (int tl = 0; tl < 4; ++tl)
#pragma unroll
            for (int rg = 0; rg < 16; ++rg) lm = fmaxf(lm, st[tl][rg]);
        const float km = fmaxf(lm, __shfl_xor(lm, 32));
        out[k] = km;
#pragma unroll
        for (int tl = 0; tl < 4; ++tl)
#pragma unroll
            for (int rg = 0; rg < 16; ++rg) st[tl][rg] = (st[tl][rg] == km) ? -INFINITY : st[tl][rg];
    }
}

__device__ __forceinline__ void topk_unit(const Params& p, int li, int item, LAS unsigned char* lds) {
    const int tid = threadIdx.x, lane = tid & 63, wave = __builtin_amdgcn_readfirstlane(tid >> 6);
    const int r32 = lane & 31, hh = lane >> 5;
    const int tile = item >> 3, h = item & 7;
    const int t = tile * 256 + 32 * wave + r32;
    const bf16* QRY = (const bf16*)(p.ws + WS_QRY);
    const bf16* KB = (const bf16*)(p.ws + WS_KEYS) + (size_t)((li * 8 + h) * 2) * 128 * 128;
    int* RI = (int*)(p.ws + WS_RI); float* RG = (float*)(p.ws + WS_RG);
    for (int idx = tid; idx < 2 * 128 * 16; idx += NTHR) {
        const int pp = idx >> 11, n = (idx >> 4) & 127, c = idx & 15;
        const u32x4 v = *(const u32x4*)(KB + (size_t)(pp * 128 + n) * 128 + c * 8);
        *(LAS u32x4*)(lds + pp * 32768 + n * 256 + ((c ^ (n & 15)) << 4)) = v;
    }
    __syncthreads();
    float sk0[16], sk1[16];
    topk_half(QRY + (size_t)t * 2048 + h * 256, lds, r32, hh, sk0);
    topk_half(QRY + (size_t)t * 2048 + h * 256 + 128, lds + 32768, r32, hh, sk1);
    unsigned i1s[16], i2[16];
#pragma unroll
    for (int a = 0; a < 16; ++a) { i1s[a] = (__float_as_uint(sk0[a]) & 127u) << 7; i2[a] = __float_as_uint(sk1[a]) & 127u; }
    float cd[50];
    {
        constexpr int CA[50] = {0, 0, 0, 0, 0, 0, 0, 0, 0, 0, 0, 0, 0, 0, 0, 0, 1, 1, 1, 1, 1, 1, 1, 1, 2, 2, 2, 2, 2, 3, 3, 3, 3, 4, 4, 4, 5, 5, 6, 6, 7, 7, 8, 9, 10, 11, 12, 13, 14, 15};
        constexpr int CB[50] = {0, 1, 2, 3, 4, 5, 6, 7, 8, 9, 10, 11, 12, 13, 14, 15, 0, 1, 2, 3, 4, 5, 6, 7, 0, 1, 2, 3, 4, 0, 1, 2, 3, 0, 1, 2, 0, 1, 0, 1, 0, 1, 0, 0, 0, 0, 0, 0, 0, 0};
#pragma unroll
        for (int n = 0; n < 50; ++n) cd[n] = key_embed(sk0[CA[n]] + sk1[CB[n]], i1s[CA[n]] | i2[CB[n]], 0xffffc000u);
    }
    float sel[16];
#pragma unroll
    for (int k = 0; k < 16; ++k) {
        float km = cd[0];
#pragma unroll
        for (int n = 1; n < 50; ++n) km = fmaxf(km, cd[n]);
        sel[k] = km;
#pragma unroll
        for (int n = 0; n < 50; ++n) cd[n] = (cd[n] == km) ? -INFINITY : cd[n];
    }
    float ev[16], es = 0.f;
    const float m0 = __uint_as_float((__float_as_uint(sel[0]) & 0xffffc000u) | 0x2000u);
#pragma unroll
    for (int k = 0; k < 16; ++k) { const float vk = __uint_as_float((__float_as_uint(sel[k]) & 0xffffc000u) | 0x2000u); ev[k] = __expf(vk - m0); es += ev[k]; }
    const float rs = 1.0f / es;
    int oi[8]; float og[8];
#pragma unroll
    for (int k = 0; k < 8; ++k) { float s_lo = sel[k], s_hi = sel[k + 8], g_lo = ev[k], g_hi = ev[k + 8]; asm volatile("" : "+v"(s_lo), "+v"(s_hi), "+v"(g_lo), "+v"(g_hi));
        const float sv = hh ? s_hi : s_lo; const float gv = hh ? g_hi : g_lo; oi[k] = (int)(__float_as_uint(sv) & 0x3fffu); og[k] = gv * rs; }
    int* rip = RI + (size_t)t * 128 + 2 * h + hh; float* rgp = RG + (size_t)t * 128 + 2 * h + hh;
#pragma unroll
    for (int j = 0; j < 8; ++j) { rip[16 * j] = oi[j]; rgp[16 * j] = og[j]; }
    __syncthreads();
}

template <bool SIGNED>
__device__ __forceinline__ void quant_rows(const float* src, unsigned char* dst, float* scl, int lane, int gw, int NGW) {
    for (int r = gw; r < 16384; r += NGW) {
        const float4* s4 = (const float4*)(src + (size_t)r * 1024 + 16 * lane);
        float4 a[4]; float am = 0.f;
#pragma unroll
        for (int j = 0; j < 4; ++j) { a[j] = s4[j]; am = fmaxf(am, fmaxf(fmaxf(fabsf(a[j].x), fabsf(a[j].y)), fmaxf(fabsf(a[j].z), fabsf(a[j].w)))); }
        am = wave_max(am);
        const float inv = am > 0.f ? 127.0f / am : 0.f;
        unsigned w[4];
#pragma unroll
        for (int j = 0; j < 4; ++j) {
            constexpr int OFS = SIGNED ? 0 : 128;
            const unsigned q0 = (unsigned)(__float2int_rn(a[j].x * inv) + OFS) & 0xffu, q1 = (unsigned)(__float2int_rn(a[j].y * inv) + OFS) & 0xffu, q2 = (unsigned)(__float2int_rn(a[j].z * inv) + OFS) & 0xffu, q3 = (unsigned)(__float2int_rn(a[j].w * inv) + OFS) & 0xffu;
            w[j] = q0 | (q1 << 8) | (q2 << 16) | (q3 << 24);
        }
        *(uint4*)(dst + (size_t)(lane >> 3) * (16384 * 128) + (size_t)r * 128 + 16 * (lane & 7)) = make_uint4(w[0], w[1], w[2], w[3]);
        if (lane == 0) scl[r] = am * (1.0f / 127.0f);
    }
}

__device__ __forceinline__ void ub4(unsigned w, float* o) { o[0] = (float)(w & 0xffu); o[1] = (float)((w >> 8) & 0xffu); o[2] = (float)((w >> 16) & 0xffu); o[3] = (float)(w >> 24); }

__device__ __forceinline__ void peer_token(const Params& p, int li, int t, int lane) {
    float* stream = p.out;
    const bf16* E = (const bf16*)(p.ws + WS_E); bf16* XB = (bf16*)(p.ws + WS_XB);
    const int* RI = (const int*)(p.ws + WS_RI); const float* RG = (const float*)(p.ws + WS_RG);
    const unsigned char* UQ = (const unsigned char*)(p.ws + WS_UQ); const unsigned char* VQ = (const unsigned char*)(p.ws + WS_VQ);
    const float* US = (const float*)(p.ws + WS_US); const float* VS = (const float*)(p.ws + WS_VS);
    float* row = stream + (size_t)t * DM + 16 * lane;
    float x[16], acc[16];
#pragma unroll
    for (int j = 0; j < 4; ++j) { const float4 v = *(const float4*)(row + 4 * j); x[4 * j] = v.x; x[4 * j + 1] = v.y; x[4 * j + 2] = v.z; x[4 * j + 3] = v.w; }
    float sx = 0.f;
#pragma unroll
    for (int j = 0; j < 16; ++j) { sx += x[j]; acc[j] = 0.f; }
    const float sumx128 = 128.0f * wave_sum(sx);
    const int e0 = RI[(size_t)t * 128 + lane], e1 = RI[(size_t)t * 128 + 64 + lane];
    const float g0 = RG[(size_t)t * 128 + lane], g1 = RG[(size_t)t * 128 + 64 + lane];
    const float su0 = US[e0], su1 = US[e1], sv0 = VS[e0], sv1 = VS[e1];
    float csum = 0.f;
    const int mi = (lane >> 3) & 7;
#pragma unroll 1
    for (int bt = 0; bt < 16; ++bt) {
        const bool lo = bt < 8;
        const int esel = lo ? e0 : e1;
        uint4 uq[8], vq[8];
#pragma unroll
        for (int i = 0; i < 8; ++i) {
            const int e = __builtin_amdgcn_readlane(esel, (bt * 8 + i) & 63);
            uq[i] = *(const uint4*)(UQ + (size_t)e * 1024 + 16 * lane);
            vq[i] = *(const uint4*)(VQ + (size_t)e * 1024 + 16 * lane);
        }
        float d[8];
#pragma unroll
        for (int i = 0; i < 8; ++i) {
            float f[16]; ub4(uq[i].x, f); ub4(uq[i].y, f + 4); ub4(uq[i].z, f + 8); ub4(uq[i].w, f + 12);
            float s = 0.f;
#pragma unroll
            for (int j = 0; j < 16; ++j) s = fmaf(x[j], f[j], s);
            d[i] = s;
        }
#pragma unroll
        for (int i = 0; i < 4; ++i) { const bool up = (lane & 32) != 0; const float send = up ? d[i] : d[i + 4]; const float keep = up ? d[i + 4] : d[i]; d[i] = keep + __shfl_xor(send, 32); }
#pragma unroll
        for (int i = 0; i < 2; ++i) { const bool up = (lane & 16) != 0; const float send = up ? d[i] : d[i + 2]; const float keep = up ? d[i + 2] : d[i]; d[i] = keep + __shfl_xor(send, 16); }
        { const bool up = (lane & 8) != 0; const float send = up ? d[0] : d[1]; const float keep = up ? d[1] : d[0]; d[0] = keep + __shfl_xor(send, 8); }
        float dq = d[0]; dq += __shfl_xor(dq, 4); dq += __shfl_xor(dq, 2); dq += __shfl_xor(dq, 1);
        const int src = (bt * 8 + mi) & 63;
        const float su = __shfl(lo ? su0 : su1, src), sv = __shfl(lo ? sv0 : sv1, src), gg = __shfl(lo ? g0 : g1, src);
        const float dot = su * (dq - sumx128);
        const float cf = 0.5f * dot * (1.0f + erff(dot * 0.70710678118f)) * gg * sv;
#pragma unroll
        for (int i = 0; i < 8; ++i) {
            const float c = __int_as_float(__builtin_amdgcn_readlane(__float_as_int(cf), 8 * i));
            csum += c;
            float f[16]; ub4(vq[i].x, f); ub4(vq[i].y, f + 4); ub4(vq[i].z, f + 8); ub4(vq[i].w, f + 12);
#pragma unroll
            for (int j = 0; j < 16; ++j) acc[j] = fmaf(c, f[j], acc[j]);
        }
    }
    const float off = 128.0f * csum;
    float s = 0.f;
    {
        const uint4 ea = *(const uint4*)(E + (size_t)t * DM + 16 * lane), eb = *(const uint4*)(E + (size_t)t * DM + 16 * lane + 8);
        float ev[16]; unpack8(ea, ev); unpack8(eb, ev + 8);
#pragma unroll
        for (int j = 0; j < 16; ++j) { acc[j] = (acc[j] - off) + DN_ALPHA * x[j] + ev[j]; s += acc[j]; }
    }
    const float mean = wave_sum(s) * (1.0f / DM);
    float s2 = 0.f;
#pragma unroll
    for (int j = 0; j < 16; ++j) { acc[j] -= mean; s2 += acc[j] * acc[j]; }
    const float rstd = 1.0f / sqrtf(wave_sum(s2) * (1.0f / DM) + LN_EPS);
    const float* g2 = p.ln2_g + li * DM + 16 * lane; const float* b2 = p.ln2_b + li * DM + 16 * lane;
    float o[16];
#pragma unroll
    for (int j = 0; j < 4; ++j) {
        const float4 gg = *(const float4*)(g2 + 4 * j), bv = *(const float4*)(b2 + 4 * j);
        o[4 * j] = acc[4 * j] * rstd * gg.x + bv.x; o[4 * j + 1] = acc[4 * j + 1] * rstd * gg.y + bv.y; o[4 * j + 2] = acc[4 * j + 2] * rstd * gg.z + bv.z; o[4 * j + 3] = acc[4 * j + 3] * rstd * gg.w + bv.w;
        *(float4*)(row + 4 * j) = make_float4(o[4 * j], o[4 * j + 1], o[4 * j + 2], o[4 * j + 3]);
    }
    if (li == 0) {
        bf16* xb = XB + (size_t)t * DM + 16 * lane;
        *(uint4*)xb = make_uint4(pk2(o[0], o[1]), pk2(o[2], o[3]), pk2(o[4], o[5]), pk2(o[6], o[7]));
        *(uint4*)(xb + 8) = make_uint4(pk2(o[8], o[9]), pk2(o[10], o[11]), pk2(o[12], o[13]), pk2(o[14], o[15]));
    }
}

template <class F>
__device__ __forceinline__ void slice_queue(const Params& p, int qbase, LAS unsigned* lw, const F& body) {
    unsigned* cnt = (unsigned*)(p.ws + WS_CTL) + CW_PQ + qbase * 64;
    const int x0 = (int)(xb_xcc_id() & 7u);
    for (int i = 0; i < 8; ++i) {
        const int xs = (x0 + i) & 7;
        for (;;) {
            __syncthreads();
            if (threadIdx.x == 0) lw[0] = xb_add(cnt + xs * 64, 1u);
            __syncthreads();
            const unsigned c = lw[0];
            if (c >= (unsigned)(NT / 128)) break;
            body(xs, (int)c);
        }
    }
}
#define PEER_TPW 16
__device__ __forceinline__ void peer_u_chunk(const Params& p, int xs, int chunk, int wave, int lane) {
    const int* RI = (const int*)(p.ws + WS_RI);
    const signed char* X1Q = (const signed char*)(p.ws + WS_X1Q); const signed char* UQ = (const signed char*)(p.ws + WS_UQ);
    int* PI = (int*)(p.ws + WS_PI) + (size_t)xs * NT * 128;
    const int g = lane >> 3, q = lane & 7, loff = 128 * xs + 16 * q;
    const signed char* UQs = UQ + (size_t)xs * (16384 * 128) + 16 * q;
    const int tb = chunk * (8 * PEER_TPW) + wave * PEER_TPW;
    int ee[16]; int4 uA[16], uB[16]; int4 xA, xB;
#define PU_E(E, t) do { const int4* rp_ = (const int4*)(RI + (size_t)(t) * 128 + 16 * g); _Pragma("unroll") for (int b4 = 0; b4 < 4; ++b4) { const int4 r_ = rp_[b4]; E[4 * b4] = r_.x; E[4 * b4 + 1] = r_.y; E[4 * b4 + 2] = r_.z; E[4 * b4 + 3] = r_.w; } } while (0)
#define PU_U(U, X, E, t) do { X = *(const int4*)(X1Q + (size_t)(t) * DM + loff); _Pragma("unroll") for (int bt = 0; bt < 16; ++bt) U[bt] = *(const int4*)(UQs + (size_t)E[bt] * 128); } while (0)
#define PU_C(U, X, t) do { int dd_[16]; _Pragma("unroll") for (int bt = 0; bt < 16; ++bt) { \
        int d = __builtin_amdgcn_sdot4(X.x, U[bt].x, 0, false); d = __builtin_amdgcn_sdot4(X.y, U[bt].y, d, false); d = __builtin_amdgcn_sdot4(X.z, U[bt].z, d, false); d = __builtin_amdgcn_sdot4(X.w, U[bt].w, d, false); \
        d += __shfl_xor(d, 1); d += __shfl_xor(d, 2); d += __shfl_xor(d, 4); dd_[bt] = d; } \
        if (q == 0) { int4* pp_ = (int4*)(PI + (size_t)(t) * 128 + 16 * g); _Pragma("unroll") for (int b4 = 0; b4 < 4; ++b4) pp_[b4] = make_int4(dd_[4 * b4], dd_[4 * b4 + 1], dd_[4 * b4 + 2], dd_[4 * b4 + 3]); } } while (0)
    PU_E(ee, tb); PU_U(uA, xA, ee, tb); PU_E(ee, tb + 1);
#pragma unroll 1
    for (int i = 0; i < PEER_TPW; i += 2) {
        PU_U(uB, xB, ee, tb + i + 1);
        if (i + 2 < PEER_TPW) PU_E(ee, tb + i + 2);
        asm volatile("" ::: "memory");
        PU_C(uA, xA, tb + i);
        if (i + 2 < PEER_TPW) PU_U(uA, xA, ee, tb + i + 2);
        if (i + 3 < PEER_TPW) PU_E(ee, tb + i + 3);
        asm volatile("" ::: "memory");
        PU_C(uB, xB, tb + i + 1);
    }
#undef PU_E
#undef PU_U
#undef PU_C
}
__device__ __forceinline__ void peer_coef_token(const Params& p, int t, int lane) {
    const int* RI = (const int*)(p.ws + WS_RI); const float* RG = (const float*)(p.ws + WS_RG);
    const float* US = (const float*)(p.ws + WS_US); const float* VS = (const float*)(p.ws + WS_VS);
    const int* PI = (const int*)(p.ws + WS_PI);
    bf16* PC = (bf16*)(p.ws + WS_PC); float* PCS = (float*)(p.ws + WS_PCS);
    const float sx = ((const float*)(p.ws + WS_X1S))[t];
    float cs = 0.f;
#pragma unroll
    for (int hf = 0; hf < 2; ++hf) {
        const int k = lane + 64 * hf;
        const int e = RI[(size_t)t * 128 + k];
        int acc = 0;
#pragma unroll
        for (int x = 0; x < 8; ++x) acc += PI[((size_t)x * NT + t) * 128 + k];
        const float dot = US[e] * sx * (float)acc;
        const float c = 0.5f * dot * (1.0f + erff(dot * 0.70710678118f)) * RG[(size_t)t * 128 + k] * VS[e];
        const unsigned cb = f2bf(c);
        PC[(size_t)t * 128 + k] = (bf16)cb; cs += __uint_as_float(cb << 16);
    }
    cs = wave_sum(cs);
    if (lane == 0) PCS[t] = cs;
}
__device__ __forceinline__ void peer_v_token(const uint4 (&vq)[16], const uint4 (&cp)[2], float off128, float* yrow, int lane) {
    float c[16]; unpack8(cp[0], c); unpack8(cp[1], c + 8);
    float acc[16];
#pragma unroll
    for (int j = 0; j < 16; ++j) acc[j] = 0.f;
#pragma unroll
    for (int bt = 0; bt < 16; ++bt) {
        float f[16]; ub4(vq[bt].x, f); ub4(vq[bt].y, f + 4); ub4(vq[bt].z, f + 8); ub4(vq[bt].w, f + 12);
#pragma unroll
        for (int j = 0; j < 16; ++j) acc[j] = fmaf(c[bt], f[j], acc[j]);
    }
#pragma unroll
    for (int j = 0; j < 8; ++j) { const bool up = (lane & 32) != 0; const float send = up ? acc[j] : acc[j + 8]; const float keep = up ? acc[j + 8] : acc[j]; acc[j] = keep + __shfl_xor(send, 32); }
#pragma unroll
    for (int j = 0; j < 4; ++j) { const bool up = (lane & 16) != 0; const float send = up ? acc[j] : acc[j + 4]; const float keep = up ? acc[j + 4] : acc[j]; acc[j] = keep + __shfl_xor(send, 16); }
#pragma unroll
    for (int j = 0; j < 2; ++j) { const bool up = (lane & 8) != 0; const float send = up ? acc[j] : acc[j + 2]; const float keep = up ? acc[j + 2] : acc[j]; acc[j] = keep + __shfl_xor(send, 8); }
    const int j0 = 2 * ((lane >> 3) & 1) + 4 * ((lane >> 4) & 1) + 8 * ((lane >> 5) & 1);
    *(float2*)(yrow + j0) = make_float2(acc[0] - off128, acc[1] - off128);
}
__device__ __forceinline__ void peer_v_chunk(const Params& p, int xs, int chunk, int wave, int lane) {
    const int* RI = (const int*)(p.ws + WS_RI);
    const unsigned char* VQ = (const unsigned char*)(p.ws + WS_VQ);
    const bf16* PC = (const bf16*)(p.ws + WS_PC); const float* PCS = (const float*)(p.ws + WS_PCS);
    float* Y = (float*)(p.ws + WS_Y);
    const int g = lane >> 3, q = lane & 7, loff = 128 * xs + 16 * q;
    const unsigned char* VQs = VQ + (size_t)xs * (16384 * 128) + 16 * q;
    const int tb = chunk * (8 * PEER_TPW) + wave * PEER_TPW;
    int ee[16]; uint4 vA[16], vB[16]; uint4 cA[2], cB[2]; float oA, oB;
#define PV_E(E, t) do { const int4* rp_ = (const int4*)(RI + (size_t)(t) * 128 + 16 * g); _Pragma("unroll") for (int b4 = 0; b4 < 4; ++b4) { const int4 r_ = rp_[b4]; E[4 * b4] = r_.x; E[4 * b4 + 1] = r_.y; E[4 * b4 + 2] = r_.z; E[4 * b4 + 3] = r_.w; } } while (0)
#define PV_U(V, C, O, E, t) do { O = PCS[(t)]; C[0] = *(const uint4*)(PC + (size_t)(t) * 128 + 16 * g); C[1] = *(const uint4*)(PC + (size_t)(t) * 128 + 16 * g + 8); _Pragma("unroll") for (int bt = 0; bt < 16; ++bt) V[bt] = *(const uint4*)(VQs + (size_t)E[bt] * 128); } while (0)
    PV_E(ee, tb); PV_U(vA, cA, oA, ee, tb); PV_E(ee, tb + 1);
#pragma unroll 1
    for (int i = 0; i < PEER_TPW; i += 2) {
        PV_U(vB, cB, oB, ee, tb + i + 1);
        if (i + 2 < PEER_TPW) PV_E(ee, tb + i + 2);
        asm volatile("" ::: "memory");
        peer_v_token(vA, cA, 128.0f * oA, Y + (size_t)(tb + i) * DM + loff, lane);
        if (i + 2 < PEER_TPW) PV_U(vA, cA, oA, ee, tb + i + 2);
        if (i + 3 < PEER_TPW) PV_E(ee, tb + i + 3);
        asm volatile("" ::: "memory");
        peer_v_token(vB, cB, 128.0f * oB, Y + (size_t)(tb + i + 1) * DM + loff, lane);
    }
#undef PV_E
#undef PV_U
}
__device__ __forceinline__ void peer_ln_token(const Params& p, int li, int t, int lane) {
    const bf16* E = (const bf16*)(p.ws + WS_E); bf16* XB = (bf16*)(p.ws + WS_XB); const float* Y = (const float*)(p.ws + WS_Y);
    float* row = p.out + (size_t)t * DM;
    float4 v[4]; float s = 0.f;
#pragma unroll
    for (int j = 0; j < 4; ++j) {
        const float4 x = *(const float4*)(row + 256 * j + 4 * lane), y = *(const float4*)(Y + (size_t)t * DM + 256 * j + 4 * lane);
        const uint2 eb = *(const uint2*)(E + (size_t)t * DM + 256 * j + 4 * lane);
        v[j].x = DN_ALPHA * x.x + y.x + __uint_as_float(eb.x << 16); v[j].y = DN_ALPHA * x.y + y.y + __uint_as_float(eb.x & 0xffff0000u);
        v[j].z = DN_ALPHA * x.z + y.z + __uint_as_float(eb.y << 16); v[j].w = DN_ALPHA * x.w + y.w + __uint_as_float(eb.y & 0xffff0000u);
        s += (v[j].x + v[j].y) + (v[j].z + v[j].w);
    }
    const float mean = wave_sum(s) * (1.0f / DM);
    float s2 = 0.f;
#pragma unroll
    for (int j = 0; j < 4; ++j) { v[j].x -= mean; v[j].y -= mean; v[j].z -= mean; v[j].w -= mean; s2 += (v[j].x * v[j].x + v[j].y * v[j].y) + (v[j].z * v[j].z + v[j].w * v[j].w); }
    const float rstd = 1.0f / sqrtf(wave_sum(s2) * (1.0f / DM) + LN_EPS);
    const float* g2 = p.ln2_g + li * DM; const float* b2 = p.ln2_b + li * DM;
#pragma unroll
    for (int j = 0; j < 4; ++j) {
        const float4 gg = *(const float4*)(g2 + 256 * j + 4 * lane), bv = *(const float4*)(b2 + 256 * j + 4 * lane);
        const float4 o = make_float4(v[j].x * rstd * gg.x + bv.x, v[j].y * rstd * gg.y + bv.y, v[j].z * rstd * gg.z + bv.z, v[j].w * rstd * gg.w + bv.w);
        *(float4*)(row + 256 * j + 4 * lane) = o;
        if (li == 0) *(uint2*)(XB + (size_t)t * DM + 256 * j + 4 * lane) = make_uint2(pk2(o.x, o.y), pk2(o.z, o.w));
    }
}

constexpr int PH_PER_LAYER = 12, NPHASE = 1 + 2 * PH_PER_LAYER;

#ifndef PROBE_DUP
#define PROBE_DUP 0
#endif
#define PH_BEGIN(k) if (lo <= (k) && (k) < hi && ((k) == 0 || PHON(((k) - 1) % PH_PER_LAYER))) for (int rep_ = 0; rep_ < (((k) > 0 && ((PROBE_DUP >> (((k) - 1) % PH_PER_LAYER)) & 1)) ? 2 : 1); ++rep_) { unsigned long long probe_t0 = 0; if ((PROBE_T >> PH_BIT(k)) & 1) probe_t0 = __builtin_amdgcn_s_memrealtime();
#define PH_SYNC_DUP() do { if (rep_ == 0) { asm volatile("s_waitcnt vmcnt(0)" ::: "memory"); __syncthreads(); } } while (0)
#ifndef PROBE_T
#define PROBE_T 0
#endif
#define PH_BIT(k) ((k) == 0 ? 15 : (((k) - 1) % PH_PER_LAYER))
#define PH_END(k) if ((k) + 1 < hi) xcd_barrier(bar); if ((PROBE_T >> PH_BIT(k)) & 1) { const unsigned long long tn_ = __builtin_amdgcn_s_memrealtime(); probe_ticks += tn_ - probe_t0; } }

template <int LI>
__device__ __forceinline__ void run_layer(const Params& p, float* lds, const XcdBarrier& bar, int lo, int hi, unsigned long long& probe_ticks) {
    constexpr int li = LI, base = 1 + LI * PH_PER_LAYER;
    const int tid = threadIdx.x, lane = tid & 63, wave = __builtin_amdgcn_readfirstlane(tid >> 6);
    const int G = gridDim.x;
    float* stream = p.out;
    LAS unsigned char* ldsb = (LAS unsigned char*)lds;
    PH_BEGIN(base + 0)
        EpiZ16 e{(bf16*)(p.ws + WS_Z), (float*)(p.ws + WS_GATES), (const float*)(p.ws + WS_ACOS), (const float*)(p.ws + WS_ASIN)};
        gemm16(ldsb, (const bf16*)(p.ws + WS_XB), (const bf16*)(p.ws + WS_WIN) + (size_t)li * NZP * DM, NZP, DM, e);
    PH_END(base + 0)
    PH_BEGIN(base + 1)
        for (int it = blockIdx.x; it < 1024 + 1536; it += G) {
            if (it < 512) ret_state_u(p, 2 * it + (wave >> 2), ldsb + (wave >> 2) * UNIT_LDS, wave & 3, tid & 255, lane);
            else if (it < 1024) mls_state_u(p, li, 2 * (it - 512) + (wave >> 2), ldsb + (wave >> 2) * UNIT_LDS, wave & 3, tid & 255, lane);
            else attn_unit(p, it - 1024, ldsb);
        }
    PH_END(base + 1)
    PH_BEGIN(base + 2)
        p3_scans(p);
        attn_merge(p);
    PH_END(base + 2)
    PH_BEGIN(base + 3)
        for (int it = blockIdx.x; it < 1024; it += G) {
            if (it < 512) ret_out_u(p, li, 2 * it + (wave >> 2), ldsb + (wave >> 2) * UNIT_LDS, wave & 3, tid & 255, lane);
            else mls_out_u(p, li, 2 * (it - 512) + (wave >> 2), ldsb + (wave >> 2) * UNIT_LDS, wave & 3, tid & 255, lane);
        }
    PH_END(base + 3)
    PH_BEGIN(base + 4)
        const float* xin = (li == 0) ? p.x : stream;
        EpiRes16 e{xin, stream};
        gemm16(ldsb, (const bf16*)(p.ws + WS_MIX), (const bf16*)(p.ws + WS_WOUT) + (size_t)li * DM * DM, DM, DM, e);
    PH_END(base + 4)
    PH_BEGIN(base + 5)
        for (int r = blockIdx.x * NWAVE + wave; r < NT; r += G * NWAVE) ln_row_inplace(stream + (size_t)r * DM, (bf16*)(p.ws + WS_XB) + (size_t)r * DM, (signed char*)(p.ws + WS_X1Q) + (size_t)r * DM, (float*)(p.ws + WS_X1S) + r, p.ln1_g + li * DM, p.ln1_b + li * DM, lane);
        quant_rows<true>(p.pu + (size_t)li * 16384 * 1024, (unsigned char*)(p.ws + WS_UQ), (float*)(p.ws + WS_US), lane, blockIdx.x * NWAVE + wave, G * NWAVE);
        quant_rows<false>(p.pv + (size_t)li * 16384 * 1024, (unsigned char*)(p.ws + WS_VQ), (float*)(p.ws + WS_VS), lane, blockIdx.x * NWAVE + wave, G * NWAVE);
        EpiBf16Store e{(bf16*)(p.ws + WS_E), DM};
        gemm16(ldsb, (const bf16*)(p.ws + WS_PB) + (size_t)li * NT * 256, (const bf16*)(p.ws + WS_WP) + (size_t)li * DM * 256, DM, 256, e);
    PH_END(base + 5)
    PH_BEGIN(base + 6)
        EpiBf16Store eq{(bf16*)(p.ws + WS_QRY), 2048};
        gemm16(ldsb, (const bf16*)(p.ws + WS_XB), (const bf16*)(p.ws + WS_WQ) + (size_t)li * 2048 * DM, 2048, DM, eq);
        EpiGate16 eg{(bf16*)(p.ws + WS_E), p.bg + li * DM};
        gemm16(ldsb, (const bf16*)(p.ws + WS_XB), (const bf16*)(p.ws + WS_WG) + (size_t)li * DM * DM, DM, DM, eg);
    PH_END(base + 6)
    PH_BEGIN(base + 7)
        for (int it = blockIdx.x; it < (NT / 256) * 8; it += G) topk_unit(p, li, it, ldsb);
    PH_END(base + 7)
    PH_BEGIN(base + 8)
        slice_queue(p, (li * 2 + 0) * 8, (LAS unsigned*)(ldsb + 1024), [&](int xs, int c) { peer_u_chunk(p, xs, c, wave, lane); });
    PH_END(base + 8)
    PH_BEGIN(base + 9)
        for (int t = blockIdx.x * NWAVE + wave; t < NT; t += G * NWAVE) peer_coef_token(p, t, lane);
    PH_END(base + 9)
    PH_BEGIN(base + 10)
        slice_queue(p, (li * 2 + 1) * 8, (LAS unsigned*)(ldsb + 1024), [&](int xs, int c) { peer_v_chunk(p, xs, c, wave, lane); });
    PH_END(base + 10)
    PH_BEGIN(base + 11)
        for (int t = blockIdx.x * NWAVE + wave; t < NT; t += G * NWAVE) peer_ln_token(p, li, t, lane);
    PH_END(base + 11)
}

__global__ void __launch_bounds__(NTHR, 2) mk_fwd(Params p) {
    extern __shared__ __attribute__((aligned(16))) unsigned char lds_raw[];
    float* lds = (float*)lds_raw;
    const int tid = threadIdx.x;
    volatile LAS unsigned* MISC = (volatile LAS unsigned*)((LAS unsigned char*)lds_raw + LDS_CTL_OFF);
    if (tid < 64) MISC[tid] = 0u;
    __syncthreads();
    const int lo = p.ph_lo, hi = p.ph_hi;
    XcdBarrier bar; bar.bar = (unsigned*)(p.ws + WS_CTL) + 1024; bar.x = 0; bar.st = nullptr;
    if (hi - lo > 1) bar = xcd_barrier_post((unsigned*)(p.ws + WS_CTL) + 1024, MISC + 8);
    unsigned long long probe_ticks = 0;
    PH_BEGIN(0)
        p0_tables(p);
        p0_weights(p, lds);
    PH_END(0)
    run_layer<0>(p, lds, bar, lo, hi, probe_ticks);
    run_layer<1>(p, lds, bar, lo, hi, probe_ticks);
    if (PROBE_T) { const unsigned long long te_ = __builtin_amdgcn_s_memrealtime(); while (__builtin_amdgcn_s_memrealtime() - te_ < probe_ticks) __builtin_amdgcn_s_sleep(8); }
}

extern "C" void kernel_launch(void* const* d_in, const int* in_sizes, int n_in, void* d_out, int out_size, void* d_ws, size_t ws_size, hipStream_t stream) {
    static int grid = 0;
    if (grid == 0) {
        if (n_in != 19 || in_sizes[0] != NT * DM || out_size != NT * DM || ws_size < WS_END) { fprintf(stderr, "kernel_launch: unexpected shapes (n_in %d in0 %d out %d ws %zu)\n", n_in, n_in > 0 ? in_sizes[0] : -1, out_size, ws_size); grid = -1; return; }
        int dev = 0, cus = 0;
        if (hipGetDevice(&dev) != hipSuccess || hipDeviceGetAttribute(&cus, hipDeviceAttributeMultiprocessorCount, dev) != hipSuccess) { grid = -1; return; }
        if (hipFuncSetAttribute((const void*)mk_fwd, hipFuncAttributeMaxDynamicSharedMemorySize, LDS_BYTES) != hipSuccess) { fprintf(stderr, "kernel_launch: hipFuncSetAttribute failed\n"); grid = -1; return; }
        int per_cu = 0;
        if (hipOccupancyMaxActiveBlocksPerMultiprocessor(&per_cu, (const void*)mk_fwd, NTHR, LDS_BYTES) != hipSuccess || per_cu < 1) fprintf(stderr, "kernel_launch: occupancy query says %d\n", per_cu);
        (void)hipGetLastError();
        grid = cus;
    }
    if (grid < 0) return;
    if (hipMemsetAsync((char*)d_ws + WS_CTL, 0, CTL_ZERO_BYTES, stream) != hipSuccess) return;
    Params a{};
    a.x = (const float*)d_in[0]; a.p = (const float*)d_in[1]; a.w_in = (const float*)d_in[2]; a.conv_w = (const float*)d_in[3]; a.b_if = (const float*)d_in[4];
    a.ret_g = (const float*)d_in[5]; a.mls_g = (const float*)d_in[6]; a.w_out = (const float*)d_in[7]; a.ln1_g = (const float*)d_in[8]; a.ln1_b = (const float*)d_in[9];
    a.wq = (const float*)d_in[10]; a.keys = (const float*)d_in[11]; a.pu = (const float*)d_in[12]; a.pv = (const float*)d_in[13]; a.wg = (const float*)d_in[14];
    a.bg = (const float*)d_in[15]; a.wp = (const float*)d_in[16]; a.ln2_g = (const float*)d_in[17]; a.ln2_b = (const float*)d_in[18];
    a.out = (float*)d_out; a.ws = (unsigned char*)d_ws;
#if MK_SPLIT
    for (int ph = 0; ph < NPHASE; ++ph) { a.ph_lo = ph; a.ph_hi = ph + 1; hipLaunchKernelGGL(mk_fwd, dim3(grid), dim3(NTHR), LDS_BYTES, stream, a); }
#else
    a.ph_lo = 0; a.ph_hi = NPHASE;
    hipLaunchKernelGGL(mk_fwd, dim3(grid), dim3(NTHR), LDS_BYTES, stream, a);
#endif
}
```

```cpp
#include <hip/hip_runtime.h>
#include <cstdio>
#include <cstdint>
#include <cmath>

#ifndef MK_SPLIT
#define MK_SPLIT 0
#endif

#ifndef ONLY
#define ONLY -1
#endif
#ifndef PMASK
#define PMASK 0xfff
#endif
#define PHON(k) ((ONLY < 0 || ONLY == (k)) && ((PMASK >> (k)) & 1))
#define LAS __attribute__((address_space(3)))
typedef unsigned short bf16;

#define XB_TMO      128
#define XB_XCNT(j)  (256  + 64 * (j))
#define XB_XSUB(j)  (1280 + 64 * (j))
#define XB_XGEN(j)  (2304 + 64 * (j))
#define XB_TOP      3328
#define XB_TOPGEN   3392
#define XCD_BAR_WORDS 3456
#define XB_SPIN_CAP (1u << 22)

__device__ __forceinline__ unsigned xb_ld(unsigned* p)              { return __hip_atomic_load(p, __ATOMIC_RELAXED, __HIP_MEMORY_SCOPE_AGENT); }
__device__ __forceinline__ unsigned xb_add(unsigned* p, unsigned v) { return __hip_atomic_fetch_add(p, v, __ATOMIC_RELAXED, __HIP_MEMORY_SCOPE_AGENT); }
__device__ __forceinline__ unsigned xb_xcc_id() { return (unsigned)__builtin_amdgcn_s_getreg((3 << 11) | 20) & 0xFu; }
#define XB_SPIN(cond, bar) do { unsigned _sp = 0; while (cond) { __builtin_amdgcn_s_sleep(1); \
    if ((++_sp & 255u) == 0u) { if (xb_ld(&(bar)[XB_TMO])) break; if (_sp > XB_SPIN_CAP) { atomicAdd(&(bar)[XB_TMO], 1u); break; } } } } while (0)

struct XcdBarrier { unsigned* bar; unsigned x; volatile LAS unsigned* st; };

__device__ __forceinline__ XcdBarrier xcd_barrier_post(unsigned* bar, volatile LAS unsigned* st) {
    XcdBarrier b; b.bar = bar; b.x = xb_xcc_id(); b.st = st;
    if (threadIdx.x == 0) st[2] = xb_add(&bar[XB_XCNT(b.x)], 1u);
    return b;
}
__device__ __forceinline__ void xcd_barrier_complete(unsigned* bar, unsigned x, unsigned& nloc, unsigned& nx) {
    const unsigned G = gridDim.x * gridDim.y * gridDim.z;
    unsigned sum, cnt, mine, sp = 0u;
    for (;;) {
        sum = 0u; cnt = 0u; mine = 0u;
#pragma unroll
        for (unsigned j = 0; j < 16; ++j) { const unsigned c = xb_ld(&bar[XB_XCNT(j)]); sum += c; cnt += (c > 0u) ? 1u : 0u; mine = (j == x) ? c : mine; }
        if (sum == G) break;
        __builtin_amdgcn_s_sleep(1);
        if ((++sp & 255u) == 0u) { if (xb_ld(&bar[XB_TMO])) break; if (sp > XB_SPIN_CAP) { atomicAdd(&bar[XB_TMO], 1u); break; } }
    }
    nloc = mine > 0u ? mine : 1u; nx = cnt > 0u ? cnt : 1u;
}
__device__ __forceinline__ void xcd_barrier(const XcdBarrier& b) {
    asm volatile("s_waitcnt vmcnt(0)" ::: "memory");
    __syncthreads();
    if (threadIdx.x == 0) {
        unsigned* bar = b.bar;
        __builtin_amdgcn_s_waitcnt(0);
        unsigned nloc = b.st[0], nx = b.st[1];
        if (nloc == 0u) { xcd_barrier_complete(bar, b.x, nloc, nx); b.st[0] = nloc; b.st[1] = nx; }
        const unsigned old = xb_add(&bar[XB_XSUB(b.x)], 1u);
        const unsigned gen = old / nloc;
        if (old + 1u == (gen + 1u) * nloc) {
            __builtin_amdgcn_fence(__ATOMIC_RELEASE, "agent");
            asm volatile("s_waitcnt vmcnt(0)" ::: "memory");
            const unsigned og = xb_add(&bar[XB_TOP], 1u);
            const unsigned tg = og / nx;
            if (og + 1u == (tg + 1u) * nx) xb_add(&bar[XB_TOPGEN], 1u);
            else XB_SPIN(xb_ld(&bar[XB_TOPGEN]) == tg, bar);
            __builtin_amdgcn_fence(__ATOMIC_ACQUIRE, "agent");
            xb_add(&bar[XB_XGEN(b.x)], 1u);
            asm volatile("s_waitcnt vmcnt(0)" ::: "memory");
        } else {
            XB_SPIN(xb_ld(&bar[XB_XGEN(b.x)]) == gen, bar);
            __builtin_amdgcn_fence(__ATOMIC_ACQUIRE, "agent");
            asm volatile("s_waitcnt vmcnt(0)" ::: "memory");
        }
    }
    __syncthreads();
}

namespace pg8 {
#define PG8_LAS __attribute__((address_space(3)))
typedef unsigned short bf16_t;
typedef short bf16x8 __attribute__((ext_vector_type(8)));
typedef float f32x4 __attribute__((ext_vector_type(4)));
typedef unsigned u32x4 __attribute__((ext_vector_type(4)));
constexpr int BM = 256, BK = 64, HALF = 128, HTB = HALF * BK * 2  , STAGE_BYTES = 8 * HTB, NXCD = 8, WGM = 8;

__host__ __device__ __forceinline__ int lds_byte(int r, int c) { const int st = (r >> 4) * 2 + (c >> 5), rr = r & 15, cc = c & 31, ob = rr * 64 + cc * 2; return st * 1024 + (ob ^ (((ob >> 9) & 1) << 5)); }
__host__ __device__ __forceinline__ void stage_rc(int b, int& R, int& C) { const int st = b / 1024, sb = b % 1024, swz = sb ^ (((sb >> 9) & 1) << 5); R = (st >> 1) * 16 + swz / 64; C = (st & 1) * 32 + (swz % 64) / 2; }
__host__ __device__ __forceinline__ int perm32(int rho) { const int n = rho >> 4, i = rho & 15; return 8 * (i >> 2) + 4 * n + (i & 3); }

struct Unit { int pm, pn; };
struct Gemm { const bf16_t* A; const bf16_t* Bt; int M, N, K; };

struct StaticOrder {
    int nM, nN, nwg, G, c;
    __host__ __device__ void init(int M, int N, int G_, int c_) { nM = M / BM; nN = N / BM; nwg = nM * nN; G = G_; c = c_; }
    __host__ __device__ bool next(int i, Unit& u) const {
        const long L = (long)i * G + c; if (L >= nwg) return false;
        int wgid = (int)L; { const int q = nwg / NXCD, r = nwg % NXCD, xcd = wgid % NXCD, off = wgid / NXCD; wgid = (xcd < r ? xcd * (q + 1) : r * (q + 1) + (xcd - r) * q) + off; }
        const int nig = WGM * nN, gid = wgid / nig, fm = gid * WGM, gsz = (nM - fm) < WGM ? (nM - fm) : WGM;
        u.pm = fm + ((wgid % nig) % gsz); u.pn = (wgid % nig) / gsz; return true;
    }
    __device__ __forceinline__ void a_ready(const Unit&) const {}
    __device__ __forceinline__ void done(const Unit&) const {}
};

__device__ __forceinline__ unsigned cvt_pk_bf16(float lo, float hi) { unsigned r; asm volatile("v_cvt_pk_bf16_f32 %0, %1, %2" : "=v"(r) : "v"(lo), "v"(hi)); return r; }
template <class Epi, class Sched, bool ALIGN_EPI = false, bool SP2 = false>
__device__ __forceinline__ void gemm_phase(PG8_LAS unsigned char* lds, const Gemm g, const Sched& S, const Epi& E) {
    const int tid = threadIdx.x, wid = __builtin_amdgcn_readfirstlane(tid >> 6), lane = tid & 63, wr = wid >> 2, wc = wid & 3, fr = lane & 15, fq = lane >> 4;
    const int K = g.K, nt = K / BK;
    unsigned voffA[2], voffB[2];
#pragma unroll
    for (int i = 0; i < 2; ++i) { int R, C; stage_rc(tid * 16 + i * 8192, R, C); const int Rb = Epi::PERM ? ((R & ~31) + perm32(R & 31)) : R;
        voffA[i] = (unsigned)(R * K + C) * 2u; voffB[i] = (unsigned)(Rb * K + C) * 2u; }
    const size_t kstep = (size_t)(BK * 2);
    const size_t hstep = (size_t)HALF * K * 2;
    const size_t tstep = 2 * hstep;
    const unsigned ldsw = (unsigned)wid * 1024u;
    const int aoff = lds_byte(wr * 64 + fr, fq * 8), boff = lds_byte(wc * 32 + fr, fq * 8);
#define PG8_SA(b, h) (((b) * 2 + (h)) * HTB)
#define PG8_SB(b, h) ((4 + (b) * 2 + (h)) * HTB)
#define PG8_STAGE(bufoff, gbase, voff) do { _Pragma("unroll") for (int _i = 0; _i < 2; ++_i) \
        __builtin_amdgcn_global_load_lds((const unsigned*)((const char*)(gbase) + (voff)[_i]), (PG8_LAS unsigned*)(lds + (bufoff) + ldsw + _i * 8192), 16, 0, 0); } while (0)
#define PG8_LDA(dst, b, h) do { _Pragma("unroll") for (int m = 0; m < 4; ++m) _Pragma("unroll") for (int k = 0; k < 2; ++k) dst[m][k] = *(const PG8_LAS bf16x8*)(lds + PG8_SA(b, h) + aoff + m * 2048 + k * 1024); } while (0)
#define PG8_LDB(dst, b, h) do { _Pragma("unroll") for (int n = 0; n < 2; ++n) _Pragma("unroll") for (int k = 0; k < 2; ++k) dst[n][k] = *(const PG8_LAS bf16x8*)(lds + PG8_SB(b, h) + boff + n * 2048 + k * 1024); } while (0)
#define PG8_MMA(ai, bj, At, Bt) do { __builtin_amdgcn_s_setprio(1); _Pragma("unroll") for (int m = 0; m < 4; ++m) _Pragma("unroll") for (int n = 0; n < 2; ++n) _Pragma("unroll") for (int k = 0; k < 2; ++k) \
        acc[ai][bj][m][n] = __builtin_amdgcn_mfma_f32_16x16x32_bf16(Bt[n][k], At[m][k], acc[ai][bj][m][n], 0, 0, 0); __builtin_amdgcn_s_setprio(0); } while (0)
#define PG8_WAIT_V(n) asm volatile("s_waitcnt vmcnt(" #n ")" ::: "memory")
#define PG8_WAIT_L(n) asm volatile("s_waitcnt lgkmcnt(" #n ")" ::: "memory")
#define PG8_BAR __builtin_amdgcn_s_barrier()
#define PG8_SCHED __builtin_amdgcn_sched_barrier(0)
    Unit cur, nxt; int ui = 0;
    if (!S.next(0, cur)) return;
    f32x4 acc[2][2][4][2];
#pragma unroll
    for (int a = 0; a < 2; ++a)
#pragma unroll
        for (int b = 0; b < 2; ++b)
#pragma unroll
            for (int m = 0; m < 4; ++m)
#pragma unroll
                for (int n = 0; n < 2; ++n) acc[a][b][m][n] = (f32x4){0.f, 0.f, 0.f, 0.f};
    bf16x8 At[4][2], B0[2][2], B1[2][2];
    const char* cA = (const char*)g.A + (size_t)cur.pm * tstep; const char* cB = (const char*)g.Bt + (size_t)cur.pn * tstep;
    S.a_ready(cur);
    if constexpr (SP2) {
        PG8_STAGE(PG8_SB(0, 0), cB, voffB); PG8_STAGE(PG8_SB(0, 1), cB + hstep, voffB); PG8_STAGE(PG8_SA(0, 0), cA, voffA); PG8_STAGE(PG8_SA(0, 1), cA + hstep, voffA);
        if (wr == 1) PG8_BAR;
        PG8_WAIT_V(2); PG8_BAR;
        PG8_STAGE(PG8_SB(1, 0), cB + kstep, voffB); PG8_STAGE(PG8_SA(1, 0), cA + kstep, voffA); PG8_STAGE(PG8_SB(1, 1), cB + hstep + kstep, voffB);
        PG8_WAIT_V(6); PG8_BAR;
    } else {
        PG8_STAGE(PG8_SB(0, 0), cB, voffB); PG8_STAGE(PG8_SA(0, 0), cA, voffA); PG8_STAGE(PG8_SB(0, 1), cB + hstep, voffB); PG8_STAGE(PG8_SA(0, 1), cA + hstep, voffA);
        if (wr == 1) PG8_BAR;
        PG8_WAIT_V(4); PG8_BAR;
        PG8_STAGE(PG8_SB(1, 0), cB + kstep, voffB); PG8_STAGE(PG8_SA(1, 0), cA + kstep, voffA); PG8_STAGE(PG8_SB(1, 1), cB + hstep + kstep, voffB);
        PG8_WAIT_V(6); PG8_BAR;
    }
    for (;;) {
        const bool has_next = S.next(ui + 1, nxt);
        const char* nA = has_next ? (const char*)g.A + (size_t)nxt.pm * tstep : cA; const char* nB = has_next ? (const char*)g.Bt + (size_t)nxt.pn * tstep : cB;
        for (int t = 0; t < nt; t += 2) {
            const bool last = (t == nt - 2);
            const char* a1 = cA + (size_t)(t + 1) * kstep;
            const char* a2 = last ? nA : cA + (size_t)(t + 2) * kstep; const char* b2 = last ? nB : cB + (size_t)(t + 2) * kstep;
            const char* a3 = a2 + kstep; const char* b3 = b2 + kstep;
            if (last && has_next) S.a_ready(nxt);
            if constexpr (SP2) {
            PG8_LDB(B0, 0, 0); PG8_LDB(B1, 0, 1); PG8_SCHED; PG8_LDA(At, 0, 0); PG8_STAGE(PG8_SA(1, 1), a1 + hstep, voffA);
            PG8_WAIT_V(8); PG8_WAIT_L(0); PG8_BAR; PG8_MMA(0, 0, At, B0); PG8_MMA(0, 1, At, B1); PG8_BAR; PG8_SCHED;
            PG8_LDA(At, 0, 1); PG8_STAGE(PG8_SB(0, 0), b2, voffB); PG8_STAGE(PG8_SB(0, 1), b2 + hstep, voffB); PG8_STAGE(PG8_SA(0, 0), a2, voffA);
            PG8_WAIT_V(8); PG8_WAIT_L(0); PG8_BAR; PG8_MMA(1, 0, At, B0); PG8_MMA(1, 1, At, B1); PG8_BAR; PG8_SCHED;
            PG8_LDB(B0, 1, 0); PG8_LDB(B1, 1, 1); PG8_SCHED; PG8_LDA(At, 1, 0); PG8_STAGE(PG8_SA(0, 1), a2 + hstep, voffA);
            PG8_WAIT_V(8); PG8_WAIT_L(0); PG8_BAR; PG8_MMA(0, 0, At, B0); PG8_MMA(0, 1, At, B1); PG8_BAR; PG8_SCHED;
            PG8_LDA(At, 1, 1); PG8_STAGE(PG8_SB(1, 0), b3, voffB); PG8_STAGE(PG8_SB(1, 1), b3 + hstep, voffB); PG8_STAGE(PG8_SA(1, 0), a3, voffA);
            PG8_WAIT_V(8); PG8_WAIT_L(0); PG8_BAR; PG8_MMA(1, 0, At, B0); PG8_MMA(1, 1, At, B1); PG8_BAR; PG8_SCHED;
            } else {
            PG8_LDB(B0, 0, 0); PG8_SCHED; PG8_LDA(At, 0, 0); PG8_STAGE(PG8_SA(1, 1), a1 + hstep, voffA);
            PG8_WAIT_L(8); PG8_BAR; PG8_WAIT_L(0); PG8_MMA(0, 0, At, B0); PG8_BAR; PG8_SCHED;
            PG8_LDB(B1, 0, 1); PG8_STAGE(PG8_SB(0, 0), b2, voffB);
            PG8_BAR; PG8_WAIT_L(0); PG8_MMA(0, 1, At, B1); PG8_BAR;
            PG8_LDA(At, 0, 1); PG8_STAGE(PG8_SA(0, 0), a2, voffA);
            PG8_BAR; PG8_WAIT_L(0); PG8_MMA(1, 0, At, B0); PG8_BAR; PG8_SCHED;
            PG8_STAGE(PG8_SB(0, 1), b2 + hstep, voffB);
            PG8_WAIT_V(6); PG8_BAR; PG8_MMA(1, 1, At, B1); PG8_BAR;
            PG8_LDB(B0, 1, 0); PG8_SCHED; PG8_LDA(At, 1, 0); PG8_STAGE(PG8_SA(0, 1), a2 + hstep, voffA);
            PG8_WAIT_L(8); PG8_BAR; PG8_WAIT_L(0); PG8_MMA(0, 0, At, B0); PG8_BAR; PG8_SCHED;
            PG8_LDB(B1, 1, 1); PG8_STAGE(PG8_SB(1, 0), b3, voffB);
            PG8_BAR; PG8_WAIT_L(0); PG8_MMA(0, 1, At, B1); PG8_BAR;
            PG8_LDA(At, 1, 1); PG8_STAGE(PG8_SA(1, 0), a3, voffA);
            PG8_BAR; PG8_WAIT_L(0); PG8_MMA(1, 0, At, B0); PG8_BAR; PG8_SCHED;
            PG8_STAGE(PG8_SB(1, 1), b3 + hstep, voffB);
            PG8_WAIT_V(6); PG8_BAR; PG8_MMA(1, 1, At, B1); PG8_BAR;
            }
        }
        if constexpr (ALIGN_EPI) { if (wr == 0) PG8_BAR; }
        if constexpr (!Epi::AFTER_DRAIN) { E(acc, cur, wr, wc, fr, fq); S.done(cur); }
        if (!has_next) break;
#pragma unroll
        for (int a = 0; a < 2; ++a)
#pragma unroll
            for (int b = 0; b < 2; ++b)
#pragma unroll
                for (int m = 0; m < 4; ++m)
#pragma unroll
                    for (int n = 0; n < 2; ++n) acc[a][b][m][n] = (f32x4){0.f, 0.f, 0.f, 0.f};
        cur = nxt; cA = nA; cB = nB; ++ui;
        if constexpr (ALIGN_EPI) { if (wr == 1) PG8_BAR; }
    }
    PG8_WAIT_V(0);
    if constexpr (!ALIGN_EPI) { if (wr == 0) PG8_BAR; }
    PG8_BAR;
    if constexpr (Epi::AFTER_DRAIN) { E.fused(acc, cur, wr, wc, fr, fq, lds, wid, lane); S.done(cur); }
#undef PG8_SA
#undef PG8_SB
#undef PG8_STAGE
#undef PG8_LDA
#undef PG8_LDB
#undef PG8_MMA
#undef PG8_WAIT_V
#undef PG8_WAIT_L
#undef PG8_BAR
#undef PG8_SCHED
}
}

constexpr int NB = 4, SEQ = 8192, NT = NB * SEQ, DM = 1024;
constexpr int ZW = 3328, NZ = 3336;
constexpr int C_RQ = 0, C_RK = 256, C_RV = 512, C_RG = 1024, C_AQ = 1536, C_AK = 1792, C_AV = 2048, C_MQ = 2304, C_MK = 2560, C_MV = 2816, C_MO = 3072;
constexpr float DN_ALPHA = 1.41421356237f;
constexpr float LN_EPS = 1e-5f;
constexpr int NTHR = 512, NWAVE = 8;
constexpr int LDS_BYTES = 160 * 1024;
constexpr int LDS_CTL_OFF = 159 * 1024;

constexpr size_t MiB = 1u << 20;
constexpr size_t WS_CTL = 0, CTL_ZERO_BYTES = 64 * 1024;
constexpr size_t WS_RCOS = 1 * MiB, WS_RSIN = 2 * MiB, WS_ACOS = 3 * MiB, WS_ASIN = 3 * MiB + 512 * 1024;
constexpr size_t WS_RST = 4 * MiB;
constexpr size_t WS_MC = 36 * MiB;
constexpr size_t WS_MN = 52 * MiB;
constexpr size_t WS_MA = 52 * MiB + 512 * 1024, WS_MML = WS_MA + 4096, WS_MMP = WS_MML + 4096;
constexpr size_t WS_GATES = 54 * MiB;
constexpr int NZP = 3584;
constexpr size_t WS_WIN = 56 * MiB;
constexpr size_t WS_WOUT = 70 * MiB;
constexpr size_t WS_WQ = 74 * MiB;
constexpr size_t WS_WG = 82 * MiB;
constexpr size_t WS_WP = 86 * MiB;
constexpr size_t WS_KEYS = 87 * MiB;
constexpr size_t WS_PB = 88 * MiB;
constexpr size_t WS_XB = 120 * MiB;
constexpr size_t WS_AO = 456 * MiB;
constexpr size_t WS_ALSE = 504 * MiB;
constexpr size_t WS_Z = 184 * MiB;
constexpr size_t WS_MIX = 392 * MiB;
constexpr size_t WS_U16 = 184 * MiB;
constexpr size_t WS_QRY = 184 * MiB;
constexpr size_t WS_E = 312 * MiB;
constexpr size_t WS_UQ = 376 * MiB, WS_VQ = 392 * MiB;
constexpr size_t WS_US = 408 * MiB, WS_VS = 408 * MiB + 65536;
constexpr size_t WS_X1Q = 4 * MiB;
constexpr size_t WS_X1S = 53 * MiB;
constexpr size_t WS_PC = 36 * MiB;
constexpr size_t WS_PCS = 53 * MiB + 256 * 1024;
constexpr size_t WS_PI = 184 * MiB;
constexpr size_t WS_Y = 184 * MiB;
constexpr int CW_PQ = 8192;
constexpr size_t WS_RI = 456 * MiB, WS_RG = 472 * MiB;
constexpr size_t WS_END = 506 * MiB;

struct Params {
    const float *x, *p, *w_in, *conv_w, *b_if, *ret_g, *mls_g, *w_out, *ln1_g, *ln1_b, *wq, *keys, *pu, *pv, *wg, *bg, *wp, *ln2_g, *ln2_b;
    float* out; unsigned char* ws; int ph_lo, ph_hi;
};

__device__ __forceinline__ float bf2f(bf16 h) { return __uint_as_float(((unsigned)h) << 16); }
__device__ __forceinline__ unsigned f2bf(float f) { unsigned u = __float_as_uint(f); return (u + 0x7fffu + ((u >> 16) & 1u)) >> 16; }
__device__ __forceinline__ unsigned pk2(float lo, float hi) { return f2bf(lo) | (f2bf(hi) << 16); }
__device__ __forceinline__ float wave_sum(float v) {
#pragma unroll
    for (int o = 1; o < 64; o <<= 1) v += __shfl_xor(v, o);
    return v;
}
__device__ __forceinline__ float wave_max(float v) {
#pragma unroll
    for (int o = 1; o < 64; o <<= 1) v = fmaxf(v, __shfl_xor(v, o));
    return v;
}
__device__ __forceinline__ float sigmoidf_(float x) { return __builtin_amdgcn_rcpf(1.f + __expf(-x)); }
__device__ __forceinline__ float siluf_(float x) { return x * __builtin_amdgcn_rcpf(1.f + __expf(-x)); }
__device__ __forceinline__ void unpack8(const uint4 v, float* o) {
    o[0] = __uint_as_float(v.x << 16); o[1] = __uint_as_float(v.x & 0xffff0000u);
    o[2] = __uint_as_float(v.y << 16); o[3] = __uint_as_float(v.y & 0xffff0000u);
    o[4] = __uint_as_float(v.z << 16); o[5] = __uint_as_float(v.z & 0xffff0000u);
    o[6] = __uint_as_float(v.w << 16); o[7] = __uint_as_float(v.w & 0xffff0000u);
}

template <class Epi>
__device__ __forceinline__ void gemm_tile_f32(const float* __restrict__ A, int lda, const float* __restrict__ W, int N, int K, int m0, int n0, float* lds, const Epi& epi) {
    float* As = lds; float* Bs = lds + 16 * 132;
    const int tid = threadIdx.x, ty = tid >> 4, tx = tid & 15;
    float acc[4][8];
#pragma unroll
    for (int i = 0; i < 4; ++i)
#pragma unroll
        for (int j = 0; j < 8; ++j) acc[i][j] = 0.f;
    const int arow = tid >> 2, akq = (tid & 3) * 4;
    const int bk = tid >> 5, bn = (tid & 31) * 4;
    const bool bvalid = (n0 + bn) < N;
    const float* ap = A + (size_t)(m0 + arow) * lda + akq;
    const float* bp = W + (size_t)bk * N + n0 + bn;
    for (int k0 = 0; k0 < K; k0 += 16) {
        const float4 av = *(const float4*)(ap + k0);
        float4 bv = make_float4(0.f, 0.f, 0.f, 0.f);
        if (bvalid) bv = *(const float4*)(bp + (size_t)k0 * N);
        __syncthreads();
        As[(akq + 0) * 132 + arow] = av.x; As[(akq + 1) * 132 + arow] = av.y; As[(akq + 2) * 132 + arow] = av.z; As[(akq + 3) * 132 + arow] = av.w;
        *(float4*)(Bs + bk * 128 + bn) = bv;
        __syncthreads();
#pragma unroll
        for (int k = 0; k < 16; ++k) {
            const float4 a = *(const float4*)(As + k * 132 + ty * 4);
            const float4 b0 = *(const float4*)(Bs + k * 128 + tx * 8);
            const float4 b1 = *(const float4*)(Bs + k * 128 + tx * 8 + 4);
            const float aa[4] = {a.x, a.y, a.z, a.w};
            const float bb[8] = {b0.x, b0.y, b0.z, b0.w, b1.x, b1.y, b1.z, b1.w};
#pragma unroll
            for (int i = 0; i < 4; ++i)
#pragma unroll
                for (int j = 0; j < 8; ++j) acc[i][j] = fmaf(aa[i], bb[j], acc[i][j]);
        }
    }
#pragma unroll
    for (int i = 0; i < 4; ++i) epi(m0 + ty * 4 + i, n0 + tx * 8, acc[i]);
    __syncthreads();
}

struct EpiZ {
    bf16* Z; float* gates;
    __device__ __forceinline__ void operator()(int row, int col0, const float (&v)[8]) const {
        if (col0 < ZW) { uint4 w; w.x = pk2(v[0], v[1]); w.y = pk2(v[2], v[3]); w.z = pk2(v[4], v[5]); w.w = pk2(v[6], v[7]); *(uint4*)(Z + (size_t)row * ZW + col0) = w; }
        else if (col0 == ZW) { float* g = gates + (size_t)row * 8; *(float4*)g = make_float4(v[0], v[1], v[2], v[3]); *(float4*)(g + 4) = make_float4(v[4], v[5], v[6], v[7]); }
    }
};
struct EpiRes {
    const float* xin; float* out;
    __device__ __forceinline__ void operator()(int row, int col0, const float (&v)[8]) const {
        const size_t o = (size_t)row * DM + col0;
        const float4 a = *(const float4*)(xin + o), b = *(const float4*)(xin + o + 4);
        *(float4*)(out + o) = make_float4(DN_ALPHA * a.x + v[0], DN_ALPHA * a.y + v[1], DN_ALPHA * a.z + v[2], DN_ALPHA * a.w + v[3]);
        *(float4*)(out + o + 4) = make_float4(DN_ALPHA * b.x + v[4], DN_ALPHA * b.y + v[5], DN_ALPHA * b.z + v[6], DN_ALPHA * b.w + v[7]);
    }
};
struct EpiStore {
    float* out; int ld;
    __device__ __forceinline__ void operator()(int row, int col0, const float (&v)[8]) const {
        const size_t o = (size_t)row * ld + col0;
        *(float4*)(out + o) = make_float4(v[0], v[1], v[2], v[3]); *(float4*)(out + o + 4) = make_float4(v[4], v[5], v[6], v[7]);
    }
};
struct EpiGate {
    float* E; const float* bg;
    __device__ __forceinline__ void operator()(int row, int col0, const float (&v)[8]) const {
        const size_t o = (size_t)row * DM + col0;
        float4 a = *(const float4*)(E + o), b = *(const float4*)(E + o + 4);
        a.x *= sigmoidf_(v[0] + bg[col0 + 0]); a.y *= sigmoidf_(v[1] + bg[col0 + 1]); a.z *= sigmoidf_(v[2] + bg[col0 + 2]); a.w *= sigmoidf_(v[3] + bg[col0 + 3]);
        b.x *= sigmoidf_(v[4] + bg[col0 + 4]); b.y *= sigmoidf_(v[5] + bg[col0 + 5]); b.z *= sigmoidf_(v[6] + bg[col0 + 6]); b.w *= sigmoidf_(v[7] + bg[col0 + 7]);
        *(float4*)(E + o) = a; *(float4*)(E + o + 4) = b;
    }
};

template <class Epi>
__device__ __forceinline__ void gemm_phase_f32(const float* A, int lda, const float* W, int N, int K, float* lds, const Epi& epi) {
    const int ntn = (N + 127) / 128, ntm = NT / 128, nit = ntn * ntm;
    for (int it = blockIdx.x; it < nit; it += gridDim.x) { const int mt = it / ntn, nt = it - mt * ntn; gemm_tile_f32(A, lda, W, N, K, mt * 128, nt * 128, lds, epi); }
}

typedef float f32x4 __attribute__((ext_vector_type(4)));
typedef unsigned u32x4 __attribute__((ext_vector_type(4)));
__device__ __forceinline__ void unpack8v(const u32x4 v, float* o) {
    o[0] = __uint_as_float(v.x << 16); o[1] = __uint_as_float(v.x & 0xffff0000u); o[2] = __uint_as_float(v.y << 16); o[3] = __uint_as_float(v.y & 0xffff0000u);
    o[4] = __uint_as_float(v.z << 16); o[5] = __uint_as_float(v.z & 0xffff0000u); o[6] = __uint_as_float(v.w << 16); o[7] = __uint_as_float(v.w & 0xffff0000u);
}
struct EpiZ16 {
    static constexpr bool PERM = true, AFTER_DRAIN = false;
    bf16* Z; float* gates; const float* acos_; const float* asin_;
    __device__ __forceinline__ void operator()(const f32x4 (&acc)[2][2][4][2], const pg8::Unit& u, int wr, int wc, int fr, int fq) const {
        const int row0 = u.pm * 256 + wr * 64 + fr;
        if (u.pn < 13) {
            const int col0 = u.pn * 256 + wc * 32 + 8 * fq;
            const bool rot = (u.pn == 6 || u.pn == 7) && ((wc & 1) == 0);
            const float qs = (u.pn == 6) ? 0.125f : 1.0f;
#pragma unroll
            for (int ai = 0; ai < 2; ++ai)
#pragma unroll
                for (int m = 0; m < 4; ++m) { const int row = row0 + ai * 128 + m * 16; bf16* rowp = Z + (size_t)row * ZW + col0;
#pragma unroll
                    for (int bj = 0; bj < 2; ++bj) { f32x4 v0 = acc[ai][bj][m][0], v1 = acc[ai][bj][m][1];
                        if (rot) {
                            f32x4 p0, p1;
#pragma unroll
                            for (int j = 0; j < 4; ++j) { p0[j] = __shfl_xor(v0[j], 16); p1[j] = __shfl_xor(v1[j], 16); }
                            if (fq < 2) {
                                const int pos = row & (SEQ - 1);
                                const f32x4 c0 = *(const f32x4*)(acos_ + pos * 8), c1 = *(const f32x4*)(acos_ + pos * 8 + 4), s0 = *(const f32x4*)(asin_ + pos * 8), s1 = *(const f32x4*)(asin_ + pos * 8 + 4);
                                const float sg = (fq == 0) ? -1.0f : 1.0f;
                                v0 = v0 * c0 + p0 * s0 * sg; v1 = v1 * c1 + p1 * s1 * sg;
                            }
                        }
                        v0 = v0 * qs; v1 = v1 * qs;
                        u32x4 w; w.x = pk2(v0[0], v0[1]); w.y = pk2(v0[2], v0[3]); w.z = pk2(v1[0], v1[1]); w.w = pk2(v1[2], v1[3]);
                        *(u32x4*)(rowp + bj * 128) = w; } }
        } else if (wc == 0 && fq == 0) {
#pragma unroll
            for (int ai = 0; ai < 2; ++ai)
#pragma unroll
                for (int m = 0; m < 4; ++m) { float* g = gates + (size_t)(row0 + ai * 128 + m * 16) * 8; *(f32x4*)g = acc[ai][0][m][0]; *(f32x4*)(g + 4) = acc[ai][0][m][1]; }
        }
    }
};
struct EpiBf16Store {
    static constexpr bool PERM = true, AFTER_DRAIN = false;
    bf16* O; int ldc;
    __device__ __forceinline__ void operator()(const f32x4 (&acc)[2][2][4][2], const pg8::Unit& u, int wr, int wc, int fr, int fq) const {
        const int row0 = u.pm * 256 + wr * 64 + fr, col0 = u.pn * 256 + wc * 32 + 8 * fq;
#pragma unroll
        for (int ai = 0; ai < 2; ++ai)
#pragma unroll
            for (int m = 0; m < 4; ++m) { bf16* rowp = O + (size_t)(row0 + ai * 128 + m * 16) * ldc + col0;
#pragma unroll
                for (int bj = 0; bj < 2; ++bj) { const f32x4 v0 = acc[ai][bj][m][0], v1 = acc[ai][bj][m][1];
                    u32x4 w; w.x = pk2(v0[0], v0[1]); w.y = pk2(v0[2], v0[3]); w.z = pk2(v1[0], v1[1]); w.w = pk2(v1[2], v1[3]);
                    *(u32x4*)(rowp + bj * 128) = w; } }
    }
};
struct EpiGate16 {
    static constexpr bool PERM = true, AFTER_DRAIN = false;
    bf16* E; const float* bg;
    __device__ __forceinline__ void operator()(const f32x4 (&acc)[2][2][4][2], const pg8::Unit& u, int wr, int wc, int fr, int fq) const {
        const int row0 = u.pm * 256 + wr * 64 + fr, col0 = u.pn * 256 + wc * 32 + 8 * fq;
#pragma unroll
        for (int bj = 0; bj < 2; ++bj) {
            const f32x4 b0 = *(const f32x4*)(bg + col0 + bj * 128), b1 = *(const f32x4*)(bg + col0 + bj * 128 + 4);
#pragma unroll
            for (int ai = 0; ai < 2; ++ai)
#pragma unroll
                for (int m = 0; m < 4; ++m) { bf16* ep = E + (size_t)(row0 + ai * 128 + m * 16) * DM + col0 + bj * 128;
                    const uint4 pv = *(const uint4*)ep; float pp[8]; unpack8(pv, pp);
                    const f32x4 v0 = acc[ai][bj][m][0] + b0, v1 = acc[ai][bj][m][1] + b1;
                    u32x4 w; w.x = pk2(pp[0] * sigmoidf_(v0[0]), pp[1] * sigmoidf_(v0[1])); w.y = pk2(pp[2] * sigmoidf_(v0[2]), pp[3] * sigmoidf_(v0[3]));
                    w.z = pk2(pp[4] * sigmoidf_(v1[0]), pp[5] * sigmoidf_(v1[1])); w.w = pk2(pp[6] * sigmoidf_(v1[2]), pp[7] * sigmoidf_(v1[3]));
                    *(u32x4*)ep = w; }
        }
    }
};
struct EpiRes16 {
    static constexpr bool PERM = true, AFTER_DRAIN = false;
    const bf16* xinb; bf16* out;
    __device__ __forceinline__ void operator()(const f32x4 (&acc)[2][2][4][2], const pg8::Unit& u, int wr, int wc, int fr, int fq) const {
        const int row0 = u.pm * 256 + wr * 64 + fr, col0 = u.pn * 256 + wc * 32 + 8 * fq;
#pragma unroll
        for (int ai = 0; ai < 2; ++ai)
#pragma unroll
            for (int m = 0; m < 4; ++m) { const size_t ro = (size_t)(row0 + ai * 128 + m * 16) * DM + col0;
#pragma unroll
                for (int bj = 0; bj < 2; ++bj) { float xv[8]; unpack8v(*(const u32x4*)(xinb + ro + bj * 128), xv);
                    const f32x4 v0 = acc[ai][bj][m][0], v1 = acc[ai][bj][m][1];
                    u32x4 w; w.x = pk2(DN_ALPHA * xv[0] + v0[0], DN_ALPHA * xv[1] + v0[1]); w.y = pk2(DN_ALPHA * xv[2] + v0[2], DN_ALPHA * xv[3] + v0[3]);
                    w.z = pk2(DN_ALPHA * xv[4] + v1[0], DN_ALPHA * xv[5] + v1[1]); w.w = pk2(DN_ALPHA * xv[6] + v1[2], DN_ALPHA * xv[7] + v1[3]);
                    *(u32x4*)(out + ro + bj * 128) = w; } }
    }
};
template <class Epi>
__device__ __forceinline__ void gemm16(LAS unsigned char* lds, const bf16* A, const bf16* Bt, int N, int K, const Epi& e) {
    pg8::Gemm g{A, Bt, NT, N, K}; pg8::StaticOrder S; S.init(NT, N, (int)gridDim.x, (int)blockIdx.x);
    pg8::gemm_phase<Epi, pg8::StaticOrder, true, true>(lds, g, S, e);
}

__device__ __forceinline__ void tr_item(const float* W, int K, int N, bf16* WT, float* scr, int item, int nblk, int lane) {
    const int kb = item / nblk, nb = item - kb * nblk, k0 = 64 * kb, n0 = 32 * nb;
    const int n = n0 + (lane & 31); const bool ok = n < N;
#pragma unroll 8
    for (int i = 0; i < 32; ++i) { const int kk = 2 * i + (lane >> 5); scr[kk * 33 + (lane & 31)] = ok ? W[(size_t)(k0 + kk) * N + n] : 0.f; }
    asm volatile("s_waitcnt lgkmcnt(0)" ::: "memory");
    const int c = lane & 7;
#pragma unroll
    for (int j = 0; j < 4; ++j) { const int nn = (lane >> 3) + 8 * j; const float* sp = scr + (8 * c) * 33 + nn;
        uint4 o; o.x = pk2(sp[0 * 33], sp[1 * 33]); o.y = pk2(sp[2 * 33], sp[3 * 33]); o.z = pk2(sp[4 * 33], sp[5 * 33]); o.w = pk2(sp[6 * 33], sp[7 * 33]);
        *(uint4*)(WT + (size_t)(n0 + nn) * K + k0 + 8 * c) = o; }
    asm volatile("s_waitcnt lgkmcnt(0)" ::: "memory");
}
__device__ __forceinline__ void cvt_f32_bf16(const float* src, bf16* dst, size_t n8) {
    const size_t gt = (size_t)blockIdx.x * NTHR + threadIdx.x, GT = (size_t)gridDim.x * NTHR;
    for (size_t i = gt; i < n8; i += GT) {
        const float4 a = *(const float4*)(src + i * 8), b = *(const float4*)(src + i * 8 + 4);
        uint4 o; o.x = pk2(a.x, a.y); o.y = pk2(a.z, a.w); o.z = pk2(b.x, b.y); o.w = pk2(b.z, b.w);
        *(uint4*)(dst + i * 8) = o;
    }
}
__device__ __forceinline__ void p0_weights(const Params& p, float* lds) {
    const int lane = threadIdx.x & 63, wave = __builtin_amdgcn_readfirstlane((int)threadIdx.x >> 6);
    float* scr = lds + wave * (64 * 33);
    const int gw = blockIdx.x * NWAVE + wave, NGW = gridDim.x * NWAVE;
    constexpr int I_IN = 16 * (NZP / 32), I_OUT = 16 * 32, I_Q = 16 * 64, I_G = 16 * 32, I_P = 4 * 32, I_L = I_IN + I_OUT + I_Q + I_G + I_P;
    for (int it = gw; it < 2 * I_L; it += NGW) {
        const int li = it / I_L; int r = it - li * I_L;
        if (r < I_IN) { tr_item(p.w_in + (size_t)li * DM * NZ, DM, NZ, (bf16*)(p.ws + WS_WIN) + (size_t)li * NZP * DM, scr, r, NZP / 32, lane); continue; } r -= I_IN;
        if (r < I_OUT) { tr_item(p.w_out + (size_t)li * DM * DM, DM, DM, (bf16*)(p.ws + WS_WOUT) + (size_t)li * DM * DM, scr, r, 32, lane); continue; } r -= I_OUT;
        if (r < I_Q) { tr_item(p.wq + (size_t)li * DM * 2048, DM, 2048, (bf16*)(p.ws + WS_WQ) + (size_t)li * 2048 * DM, scr, r, 64, lane); continue; } r -= I_Q;
        if (r < I_G) { tr_item(p.wg + (size_t)li * DM * DM, DM, DM, (bf16*)(p.ws + WS_WG) + (size_t)li * DM * DM, scr, r, 32, lane); continue; } r -= I_G;
        tr_item(p.wp + (size_t)li * 256 * DM, 256, DM, (bf16*)(p.ws + WS_WP) + (size_t)li * DM * 256, scr, r, 32, lane);
    }
    cvt_f32_bf16(p.x, (bf16*)(p.ws + WS_XB), (size_t)NT * DM / 8);
    cvt_f32_bf16(p.p, (bf16*)(p.ws + WS_PB), (size_t)2 * NT * 256 / 8);
    cvt_f32_bf16(p.keys, (bf16*)(p.ws + WS_KEYS), (size_t)2 * 8 * 2 * 128 * 128 / 8);
}

__device__ __forceinline__ void p0_tables(const Params& p) {
    float* rcos = (float*)(p.ws + WS_RCOS); float* rsin = (float*)(p.ws + WS_RSIN); float* acos_ = (float*)(p.ws + WS_ACOS); float* asin_ = (float*)(p.ws + WS_ASIN);
    const int gt = blockIdx.x * NTHR + threadIdx.x, GT = gridDim.x * NTHR;
    for (int i = gt; i < SEQ * 32; i += GT) { const int pos = i >> 5, k = i & 31; const float inv = powf(10000.0f, -(float)k / 32.0f); const float ang = (float)pos * inv; rcos[i] = cosf(ang); rsin[i] = sinf(ang); }
    for (int i = gt; i < SEQ * 8; i += GT) { const int pos = i >> 3, k = i & 7; const float inv = powf(500000.0f, -(float)k / 8.0f); const float ang = (float)pos * inv; acos_[i] = cosf(ang); asin_[i] = sinf(ang); }
}

__device__ __forceinline__ float ret_lg(int h) { return logf(1.0f - exp2f(-5.0f - (float)h)); }

__device__ __forceinline__ void ret_state_item(const Params& p, int item, float* lds) {
    const int tid = threadIdx.x;
    const int c = item & 63, bh = item >> 6, h = bh & 3, b = bh >> 2;
    const int t0 = b * SEQ + c * 128, s0 = c * 128;
    const bf16* Z = (const bf16*)(p.ws + WS_Z);
    const float* rcos = (const float*)(p.ws + WS_RCOS); const float* rsin = (const float*)(p.ws + WS_RSIN);
    float* RST = (float*)(p.ws + WS_RST);
    float* Kz = lds; float* V = lds + 128 * 64;
    const float lg = ret_lg(h);
    for (int idx = tid; idx < 128 * 32; idx += NTHR) {
        const int row = idx >> 5, i = idx & 31;
        const bf16* zr = Z + (size_t)(t0 + row) * ZW + C_RK + h * 64;
        const float x1 = bf2f(zr[i]), x2 = bf2f(zr[i + 32]);
        const float cs = rcos[(s0 + row) * 32 + i], sn = rsin[(s0 + row) * 32 + i];
        const float sc = 0.125f * expf(lg * (float)(127 - row));
        Kz[row * 64 + i] = (x1 * cs - x2 * sn) * sc; Kz[row * 64 + i + 32] = (x2 * cs + x1 * sn) * sc;
    }
    for (int idx = tid; idx < 128 * 128; idx += NTHR) { const int row = idx >> 7, d = idx & 127; V[idx] = bf2f(Z[(size_t)(t0 + row) * ZW + C_RV + h * 128 + d]); }
    __syncthreads();
    const int k = tid >> 3, v0 = (tid & 7) * 16;
    float acc[16];
#pragma unroll
    for (int j = 0; j < 16; ++j) acc[j] = 0.f;
#pragma unroll 4
    for (int s = 0; s < 128; ++s) {
        const float kk = Kz[s * 64 + k];
#pragma unroll
        for (int j = 0; j < 16; ++j) acc[j] = fmaf(kk, V[s * 128 + v0 + j], acc[j]);
    }
    float* dst = RST + (size_t)item * 8192 + k * 128 + v0;
#pragma unroll
    for (int j = 0; j < 16; ++j) dst[j] = acc[j];
    __syncthreads();
}

__device__ __forceinline__ float logsigmoidf_(float f) { return fminf(f, 0.f) - log1pf(expf(-fabsf(f))); }

__device__ __forceinline__ void mls_state_item(const Params& p, int li, int item, float* lds) {
    const int tid = threadIdx.x;
    const int c = item & 63, bh = item >> 6, h = bh & 3, b = bh >> 2;
    const int t0 = b * SEQ + c * 128;
    const bf16* Z = (const bf16*)(p.ws + WS_Z);
    const float* gates = (const float*)(p.ws + WS_GATES);
    float* MC = (float*)(p.ws + WS_MC); float* MN = (float*)(p.ws + WS_MN); float* MA = (float*)(p.ws + WS_MA); float* MML = (float*)(p.ws + WS_MML);
    const float* cw = p.conv_w + (size_t)li * 4 * 512;
    float* Kc = lds; float* Vv = lds + 8192; float* ib = lds + 16384; float* bb = ib + 128; float* wk = bb + 128; float* scal = wk + 128;
    for (int idx = tid; idx < 128 * 64; idx += NTHR) {
        const int row = idx >> 6, d = idx & 63, ch = 256 + h * 64 + d;
        float a = 0.f;
#pragma unroll
        for (int j = 0; j < 4; ++j) { const int sp = c * 128 + row - 3 + j; if (sp >= 0) a = fmaf(cw[j * 512 + ch], bf2f(Z[(size_t)(t0 + row - 3 + j) * ZW + C_MK + h * 64 + d]), a); }
        Kc[idx] = siluf_(a) * 0.125f;
        Vv[idx] = bf2f(Z[(size_t)(t0 + row) * ZW + C_MV + h * 64 + d]);
    }
    if (tid < 128) {
        const int t = t0 + tid;
        const float ig = gates[(size_t)t * 8 + h] + p.b_if[li * 8 + h];
        const float fg = gates[(size_t)t * 8 + 4 + h] + p.b_if[li * 8 + 4 + h];
        ib[tid] = ig; bb[tid] = logsigmoidf_(fg);
    }
    __syncthreads();
    if (tid == 0) {
        float run = 0.f;
#pragma unroll 4
        for (int s = 0; s < 128; ++s) { run += bb[s]; bb[s] = run; }
        float ml = -INFINITY;
        for (int s = 0; s < 128; ++s) ml = fmaxf(ml, run - bb[s] + ib[s]);
        scal[0] = run; scal[1] = ml;
    }
    __syncthreads();
    const float a = scal[0], ml = scal[1];
    if (tid < 128) wk[tid] = expf(a - bb[tid] + ib[tid] - ml);
    __syncthreads();
    const int k = tid >> 3, v0 = (tid & 7) * 8;
    float acc[8], nacc = 0.f;
#pragma unroll
    for (int j = 0; j < 8; ++j) acc[j] = 0.f;
#pragma unroll 4
    for (int s = 0; s < 128; ++s) {
        const float kw = Kc[s * 64 + k] * wk[s];
        nacc += kw;
#pragma unroll
        for (int j = 0; j < 8; ++j) acc[j] = fmaf(kw, Vv[s * 64 + v0 + j], acc[j]);
    }
    float* dst = MC + (size_t)item * 4096 + k * 64 + v0;
#pragma unroll
    for (int j = 0; j < 8; ++j) dst[j] = acc[j];
    if ((tid & 7) == 0) MN[(size_t)item * 64 + k] = nacc;
    if (tid == 0) { MA[item] = a; MML[item] = ml; }
    __syncthreads();
}

typedef short bf16x8_t __attribute__((ext_vector_type(8)));
typedef short s16x4_t __attribute__((ext_vector_type(4)));
typedef float f32x16 __attribute__((ext_vector_type(16)));
typedef float f32x2_t __attribute__((ext_vector_type(2))); typedef __bf16 bf16x2_t __attribute__((ext_vector_type(2)));
__device__ __forceinline__ unsigned cvtpk(float lo, float hi) { f32x2_t v = {lo, hi}; bf16x2_t b = __builtin_convertvector(v, bf16x2_t); return __builtin_bit_cast(unsigned, b); }
__device__ __forceinline__ s16x4_t lds_tr(const LAS unsigned char* p) { return __builtin_bit_cast(s16x4_t, __builtin_amdgcn_ds_read_tr16_b64_v4i16((LAS s16x4_t*)p)); }

__device__ __forceinline__ void attn_unit(const Params& p, int unit, LAS unsigned char* lds) {
    const int tid = threadIdx.x, lane = tid & 63, wave = __builtin_amdgcn_readfirstlane(tid >> 6);
    const int r32 = lane & 31, hh = lane >> 5;
    const bf16* Z = (const bf16*)(p.ws + WS_Z);
    const int bh = unit / 96, uu = unit - bh * 96, r = uu >> 5, v = uu & 31;
    const int dl = 1 << (2 * r), nb = 32 >> (2 * r);
    const int x = v / nb, blk = v - x * nb, q0 = blk * 256;
    const int b = bh >> 2, h = bh & 3;
    bf16* AO = (bf16*)(p.ws + WS_AO) + (size_t)r * NT * 256; float* ALSE = (float*)(p.ws + WS_ALSE) + (size_t)r * NT * 4;
    LAS unsigned char* Ks = lds; LAS unsigned char* Vs = lds + 384 * 128;
    for (int idx = tid; idx < 384 * 8; idx += NTHR) {
        const int i = idx >> 3, c = idx & 7, jk = q0 - 128 + i;
        u32x4 kv = {0u, 0u, 0u, 0u}, vv = {0u, 0u, 0u, 0u};
        if (jk >= 0) { const bf16* zr = Z + (size_t)(b * SEQ + jk * dl + x) * ZW + h * 64 + c * 8; kv = *(const u32x4*)(zr + C_AK); vv = *(const u32x4*)(zr + C_AV); }
        const int off = i * 128 + ((c ^ (i & 7)) << 4);
        *(LAS u32x4*)(Ks + off) = kv; *(LAS u32x4*)(Vs + off) = vv;
    }
    const int jq = q0 + 32 * wave + r32;
    const int tokq = b * SEQ + jq * dl + x;
    bf16x8_t qf[4];
#pragma unroll
    for (int ks = 0; ks < 4; ++ks) qf[ks] = *(const bf16x8_t*)(Z + (size_t)tokq * ZW + C_AQ + h * 64 + 16 * ks + 8 * hh);
    __syncthreads();
    f32x16 st[5];
#pragma unroll
    for (int tl = 0; tl < 5; ++tl) {
        f32x16 a16 = {0.f, 0.f, 0.f, 0.f, 0.f, 0.f, 0.f, 0.f, 0.f, 0.f, 0.f, 0.f, 0.f, 0.f, 0.f, 0.f};
        const int i = 32 * wave + 32 * tl + r32;
#pragma unroll
        for (int ks = 0; ks < 4; ++ks) {
            const int c = 2 * ks + hh;
            const bf16x8_t kf = *(const LAS bf16x8_t*)(Ks + i * 128 + ((c ^ (i & 7)) << 4));
            a16 = __builtin_amdgcn_mfma_f32_32x32x16_bf16(kf, qf[ks], a16, 0, 0, 0);
        }
        st[tl] = a16;
    }
    const int kb = q0 + 32 * wave - 128;
    float m = -INFINITY;
#pragma unroll
    for (int tl = 0; tl < 5; ++tl)
#pragma unroll
        for (int rg = 0; rg < 16; ++rg) {
            const int c = 32 * tl + (rg & 3) + 8 * (rg >> 2) + 4 * hh;
            const bool valid = (c >= r32) && (c <= r32 + 128) && (kb + c >= 0);
            const float sv = valid ? st[tl][rg] : -INFINITY;
            st[tl][rg] = sv; m = fmaxf(m, sv);
        }
    m = fmaxf(m, __shfl_xor(m, 32));
    float den = 0.f;
#pragma unroll
    for (int tl = 0; tl < 5; ++tl)
#pragma unroll
        for (int rg = 0; rg < 16; ++rg) { const float pe = __expf(st[tl][rg] - m); st[tl][rg] = pe; den += pe; }
    den += __shfl_xor(den, 32);
    f32x16 o[2];
#pragma unroll
    for (int dt = 0; dt < 2; ++dt) o[dt] = (f32x16){0.f, 0.f, 0.f, 0.f, 0.f, 0.f, 0.f, 0.f, 0.f, 0.f, 0.f, 0.f, 0.f, 0.f, 0.f, 0.f};
    const int tq = (lane & 15) >> 2, tp = lane & 3, tg = (lane >> 4) & 1;
#pragma unroll
    for (int tl = 0; tl < 5; ++tl)
#pragma unroll
        for (int s2 = 0; s2 < 2; ++s2) {
            u32x4 pw; pw.x = cvtpk(st[tl][8 * s2 + 0], st[tl][8 * s2 + 1]); pw.y = cvtpk(st[tl][8 * s2 + 2], st[tl][8 * s2 + 3]); pw.z = cvtpk(st[tl][8 * s2 + 4], st[tl][8 * s2 + 5]); pw.w = cvtpk(st[tl][8 * s2 + 6], st[tl][8 * s2 + 7]);
            const bf16x8_t pb = __builtin_bit_cast(bf16x8_t, pw);
            const int i0 = 32 * wave + 32 * tl + 16 * s2 + 4 * hh + tq;
#pragma unroll
            for (int dt = 0; dt < 2; ++dt) {
                const int c = 4 * dt + 2 * tg + (tp >> 1);
                const int i1 = i0 + 8;
                const s16x4_t lo = lds_tr(Vs + i0 * 128 + ((c ^ (i0 & 7)) << 4) + 8 * (tp & 1));
                const s16x4_t hi = lds_tr(Vs + i1 * 128 + ((c ^ (i1 & 7)) << 4) + 8 * (tp & 1));
                const bf16x8_t vf = (bf16x8_t){lo[0], lo[1], lo[2], lo[3], hi[0], hi[1], hi[2], hi[3]};
                o[dt] = __builtin_amdgcn_mfma_f32_32x32x16_bf16(vf, pb, o[dt], 0, 0, 0);
            }
        }
    const float rden = 1.0f / den;
    bf16* orow = AO + (size_t)tokq * 256 + h * 64;
#pragma unroll
    for (int dt = 0; dt < 2; ++dt)
#pragma unroll
        for (int g4 = 0; g4 < 4; ++g4) {
            const int d = 32 * dt + 8 * g4 + 4 * hh;
            *(uint2*)(orow + d) = make_uint2(cvtpk(o[dt][4 * g4] * rden, o[dt][4 * g4 + 1] * rden), cvtpk(o[dt][4 * g4 + 2] * rden, o[dt][4 * g4 + 3] * rden));
        }
    if (hh == 0) ALSE[(size_t)tokq * 4 + h] = m + __logf(den);
    __syncthreads();
}

__device__ __forceinline__ void attn_merge(const Params& p) {
    const bf16* AO = (const bf16*)(p.ws + WS_AO); const float* ALSE = (const float*)(p.ws + WS_ALSE);
    bf16* MIX = (bf16*)(p.ws + WS_MIX);
    const int gt = blockIdx.x * NTHR + threadIdx.x, GT = gridDim.x * NTHR;
    for (int e = gt; e < NT * 32; e += GT) {
        const int t = e >> 5, c8 = e & 31, h = c8 >> 3;
        const float l0 = ALSE[(size_t)t * 4 + h], l1 = ALSE[(size_t)NT * 4 + (size_t)t * 4 + h], l2 = ALSE[(size_t)2 * NT * 4 + (size_t)t * 4 + h];
        const float M = fmaxf(fmaxf(l0, l1), l2);
        float w0 = __expf(l0 - M), w1 = __expf(l1 - M), w2 = __expf(l2 - M);
        const float rs = 1.0f / (w0 + w1 + w2); w0 *= rs; w1 *= rs; w2 *= rs;
        float a0[8], a1[8], a2[8];
        unpack8(*(const uint4*)(AO + (size_t)t * 256 + c8 * 8), a0);
        unpack8(*(const uint4*)(AO + (size_t)NT * 256 + (size_t)t * 256 + c8 * 8), a1);
        unpack8(*(const uint4*)(AO + (size_t)2 * NT * 256 + (size_t)t * 256 + c8 * 8), a2);
        float y[8];
#pragma unroll
        for (int j = 0; j < 8; ++j) y[j] = w0 * a0[j] + w1 * a1[j] + w2 * a2[j];
        *(uint4*)(MIX + (size_t)t * DM + 512 + c8 * 8) = make_uint4(pk2(y[0], y[1]), pk2(y[2], y[3]), pk2(y[4], y[5]), pk2(y[6], y[7]));
    }
}

constexpr int UNIT_LDS = 79360;
__device__ __forceinline__ int swz16(int row, int chunk) { return (chunk ^ (row & 7)) << 4; }
template <bool ACCPERM>
__device__ __forceinline__ bf16x8_t frag_tr(const LAS unsigned char* img, int RB, int kbase, int cbase, int lane) {
    const int tq = (lane & 15) >> 2, tp = lane & 3, tg = (lane >> 4) & 1, hh = lane >> 5;
    const int r0 = kbase + (ACCPERM ? 4 : 8) * hh + tq, r1 = r0 + (ACCPERM ? 8 : 4);
    const int colb = (cbase + 16 * tg + 4 * tp) * 2, ch = colb >> 4, sub = colb & 15;
    const s16x4_t lo = lds_tr(img + r0 * RB + swz16(r0, ch) + sub);
    const s16x4_t hi = lds_tr(img + r1 * RB + swz16(r1, ch) + sub);
    return (bf16x8_t){lo[0], lo[1], lo[2], lo[3], hi[0], hi[1], hi[2], hi[3]};
}
__device__ __forceinline__ bf16x8_t frag_row(const LAS unsigned char* img, int RB, int row, int chunk) { return *(const LAS bf16x8_t*)(img + row * RB + swz16(row, chunk)); }
__device__ __forceinline__ u32x4 pack8(const float* v) { u32x4 w; w.x = pk2(v[0], v[1]); w.y = pk2(v[2], v[3]); w.z = pk2(v[4], v[5]); w.w = pk2(v[6], v[7]); return w; }
#define F16Z ((f32x16){0.f, 0.f, 0.f, 0.f, 0.f, 0.f, 0.f, 0.f, 0.f, 0.f, 0.f, 0.f, 0.f, 0.f, 0.f, 0.f})
__device__ __forceinline__ int acc_row(int rg, int hh) { return (rg & 3) + 8 * (rg >> 2) + 4 * hh; }

template <bool ZETA>
__device__ __forceinline__ void stage_ret_k(const Params& p, LAS unsigned char* Ks, int t0, int s0, int h, float lg, int tidU) {
    const bf16* Z = (const bf16*)(p.ws + WS_Z);
    const float* rcos = (const float*)(p.ws + WS_RCOS); const float* rsin = (const float*)(p.ws + WS_RSIN);
    for (int task = tidU; task < 512; task += 256) {
        const int row = task >> 2, pc = task & 3;
        const bf16* zr = Z + (size_t)(t0 + row) * ZW + C_RK + h * 64;
        float a[8], bq[8], o1[8], o2[8];
        unpack8v(*(const u32x4*)(zr + 8 * pc), a); unpack8v(*(const u32x4*)(zr + 32 + 8 * pc), bq);
        const f32x4 c0 = *(const f32x4*)(rcos + (s0 + row) * 32 + 8 * pc), c1 = *(const f32x4*)(rcos + (s0 + row) * 32 + 8 * pc + 4);
        const f32x4 n0 = *(const f32x4*)(rsin + (s0 + row) * 32 + 8 * pc), n1 = *(const f32x4*)(rsin + (s0 + row) * 32 + 8 * pc + 4);
        const float sc = ZETA ? 0.125f * __expf(lg * (float)(127 - row)) : 0.125f;
#pragma unroll
        for (int j = 0; j < 8; ++j) { const float cs = j < 4 ? c0[j & 3] : c1[j & 3], sn = j < 4 ? n0[j & 3] : n1[j & 3]; o1[j] = (a[j] * cs - bq[j] * sn) * sc; o2[j] = (bq[j] * cs + a[j] * sn) * sc; }
        *(LAS u32x4*)(Ks + row * 128 + swz16(row, pc)) = pack8(o1); *(LAS u32x4*)(Ks + row * 128 + swz16(row, pc + 4)) = pack8(o2);
    }
}
__device__ __forceinline__ void stage_copy(const bf16* src0, int ld, LAS unsigned char* img, int RB, int nrows, int nchunks, int tidU) {
    for (int task = tidU; task < nrows * nchunks; task += 256) {
        const int row = task / nchunks, c = task - row * nchunks;
        *(LAS u32x4*)(img + row * RB + swz16(row, c)) = *(const u32x4*)(src0 + (size_t)row * ld + 8 * c);
    }
}

__device__ __forceinline__ void ret_state_u(const Params& p, int unit, LAS unsigned char* ldsU, int wl, int tidU, int lane) {
    const int c = unit & 63, bh = unit >> 6, h = bh & 3, b = bh >> 2, t0 = b * SEQ + c * 128, s0 = c * 128;
    const bf16* Z = (const bf16*)(p.ws + WS_Z); float* RST = (float*)(p.ws + WS_RST);
    LAS unsigned char* Ks = ldsU; LAS unsigned char* Vs = ldsU + 16384;
    stage_ret_k<true>(p, Ks, t0, s0, h, ret_lg(h), tidU);
    stage_copy(Z + (size_t)t0 * ZW + C_RV + h * 128, ZW, Vs, 256, 128, 16, tidU);
    __syncthreads();
    f32x16 a0 = F16Z, a1 = F16Z;
#pragma unroll 2
    for (int ks = 0; ks < 8; ++ks) {
        const bf16x8_t A = frag_tr<false>(Vs, 256, 16 * ks, 32 * wl, lane);
        const bf16x8_t B0 = frag_tr<false>(Ks, 128, 16 * ks, 0, lane), B1 = frag_tr<false>(Ks, 128, 16 * ks, 32, lane);
        a0 = __builtin_amdgcn_mfma_f32_32x32x16_bf16(A, B0, a0, 0, 0, 0); a1 = __builtin_amdgcn_mfma_f32_32x32x16_bf16(A, B1, a1, 0, 0, 0);
    }
    float* dst = RST + (size_t)unit * 8192; const int r32 = lane & 31, hh = lane >> 5;
#pragma unroll
    for (int rg = 0; rg < 16; ++rg) { const int dv = 32 * wl + acc_row(rg, hh); dst[dv * 64 + r32] = a0[rg]; dst[dv * 64 + 32 + r32] = a1[rg]; }
    __syncthreads();
}

__device__ __forceinline__ void mls_gates(const Params& p, int li, int t0, int h, int lane, float& b0, float& b1, float& g0, float& g1) {
    const float* gates = (const float*)(p.ws + WS_GATES);
    const float bi = p.b_if[li * 8 + h], bf = p.b_if[li * 8 + 4 + h];
    const int t = t0 + 2 * lane;
    const float i0 = gates[(size_t)t * 8 + h] + bi, i1 = gates[(size_t)(t + 1) * 8 + h] + bi;
    const float f0 = logsigmoidf_(gates[(size_t)t * 8 + 4 + h] + bf), f1 = logsigmoidf_(gates[(size_t)(t + 1) * 8 + 4 + h] + bf);
    const float tot = f0 + f1; float v = tot;
#pragma unroll
    for (int o = 1; o < 64; o <<= 1) { const float u = __shfl_up(v, o); if (lane >= o) v += u; }
    const float ex = v - tot;
    b0 = ex + f0; b1 = ex + tot; g0 = i0 - b0; g1 = i1 - b1;
}
__device__ __forceinline__ void conv8(const bf16* zq, const float* cw, int nprev, float scale, float* o) {
    float acc[8];
#pragma unroll
    for (int e = 0; e < 8; ++e) acc[e] = 0.f;
#pragma unroll
    for (int j = 0; j < 4; ++j) {
        if (3 - j <= nprev) {
            float xv[8]; unpack8v(*(const u32x4*)(zq - (size_t)(3 - j) * ZW), xv);
            const f32x4 w0 = *(const f32x4*)(cw + j * 512), w1 = *(const f32x4*)(cw + j * 512 + 4);
#pragma unroll
            for (int e = 0; e < 8; ++e) acc[e] = fmaf(e < 4 ? w0[e & 3] : w1[e & 3], xv[e], acc[e]);
        }
    }
#pragma unroll
    for (int e = 0; e < 8; ++e) o[e] = siluf_(acc[e]) * scale;
}
__device__ __forceinline__ void stage_vext(const bf16* src0, LAS unsigned char* Vs, int tidU) {
    for (int task = tidU; task < 128 * 12; task += 256) {
        const int row = task / 12, c = task - row * 12;
        u32x4 v = {0u, 0u, 0u, 0u};
        if (c < 8) v = *(const u32x4*)(src0 + (size_t)row * ZW + 8 * c); else if (c == 8) v.x = 0x3F80u;
        *(LAS u32x4*)(Vs + row * 256 + swz16(row, c)) = v;
    }
}

__device__ __forceinline__ void mls_state_u(const Params& p, int li, int unit, LAS unsigned char* ldsU, int wl, int tidU, int lane) {
    const int c = unit & 63, bh = unit >> 6, h = bh & 3, b = bh >> 2, t0 = b * SEQ + c * 128;
    const bf16* Z = (const bf16*)(p.ws + WS_Z);
    float* MC = (float*)(p.ws + WS_MC); float* MN = (float*)(p.ws + WS_MN); float* MA = (float*)(p.ws + WS_MA); float* MML = (float*)(p.ws + WS_MML);
    LAS unsigned char* Ks = ldsU; LAS unsigned char* Vs = ldsU + 16384; LAS float* wk = (LAS float*)(ldsU + 49152);
    if (wl == 0) {
        float b0, b1, g0, g1; mls_gates(p, li, t0, h, lane, b0, b1, g0, g1);
        const float gmax = wave_max(fmaxf(g0, g1));
        const float a = __shfl(b1, 63);
        wk[2 * lane] = __expf(g0 - gmax); wk[2 * lane + 1] = __expf(g1 - gmax);
        if (lane == 0) { MA[unit] = a; MML[unit] = a + gmax; }
    }
    stage_vext(Z + (size_t)t0 * ZW + C_MV + h * 64, Vs, tidU);
    __syncthreads();
    for (int task = tidU; task < 1024; task += 256) {
        const int row = task >> 3, cc = task & 7;
        float o[8]; conv8(Z + (size_t)(t0 + row) * ZW + C_MK + h * 64 + 8 * cc, p.conv_w + (size_t)li * 2048 + 256 + h * 64 + 8 * cc, c * 128 + row, 0.125f * wk[row], o);
        *(LAS u32x4*)(Ks + row * 128 + swz16(row, cc)) = pack8(o);
    }
    __syncthreads();
    if (wl < 3) {
        f32x16 a0 = F16Z, a1 = F16Z;
#pragma unroll 2
        for (int ks = 0; ks < 8; ++ks) {
            const bf16x8_t A = frag_tr<false>(Vs, 256, 16 * ks, 32 * wl, lane);
            const bf16x8_t B0 = frag_tr<false>(Ks, 128, 16 * ks, 0, lane), B1 = frag_tr<false>(Ks, 128, 16 * ks, 32, lane);
            a0 = __builtin_amdgcn_mfma_f32_32x32x16_bf16(A, B0, a0, 0, 0, 0); a1 = __builtin_amdgcn_mfma_f32_32x32x16_bf16(A, B1, a1, 0, 0, 0);
        }
        const int r32 = lane & 31, hh = lane >> 5;
        if (wl < 2) {
            float* dst = MC + (size_t)unit * 4096;
#pragma unroll
            for (int rg = 0; rg < 16; ++rg) { const int v = 32 * wl + acc_row(rg, hh); dst[v * 64 + r32] = a0[rg]; dst[v * 64 + 32 + r32] = a1[rg]; }
        } else if (hh == 0) { MN[(size_t)unit * 64 + r32] = a0[0]; MN[(size_t)unit * 64 + 32 + r32] = a1[0]; }
    }
    __syncthreads();
}

__device__ __forceinline__ void ret_out_u(const Params& p, int li, int unit, LAS unsigned char* ldsU, int wl, int tidU, int lane) {
    const int c = unit & 63, bh = unit >> 6, h = bh & 3, b = bh >> 2, t0 = b * SEQ + c * 128, s0 = c * 128;
    const int r32 = lane & 31, hh = lane >> 5;
    const bf16* Z = (const bf16*)(p.ws + WS_Z); const float* RST = (const float*)(p.ws + WS_RST); bf16* MIX = (bf16*)(p.ws + WS_MIX);
    const float* rcos = (const float*)(p.ws + WS_RCOS); const float* rsin = (const float*)(p.ws + WS_RSIN);
    LAS unsigned char* Ks = ldsU; LAS unsigned char* Vs = ldsU + 16384; LAS unsigned char* Rs = ldsU + 49152;
    const float lg = ret_lg(h);
    stage_ret_k<false>(p, Ks, t0, s0, h, lg, tidU);
    stage_copy(Z + (size_t)t0 * ZW + C_RV + h * 128, ZW, Vs, 256, 128, 16, tidU);
    for (int task = tidU; task < 1024; task += 256) {
        const int row = task >> 3, cc = task & 7;
        const float* src = RST + (size_t)unit * 8192 + row * 64 + 8 * cc;
        const f32x4 x0 = *(const f32x4*)src, x1 = *(const f32x4*)(src + 4);
        const float v[8] = {x0[0], x0[1], x0[2], x0[3], x1[0], x1[1], x1[2], x1[3]};
        *(LAS u32x4*)(Rs + row * 128 + swz16(row, cc)) = pack8(v);
    }
    const int t = 32 * wl + r32, tok = t0 + t, pos = s0 + t;
    bf16x8_t qf[4];
    {
        float f[4][8];
#pragma unroll
        for (int ks = 0; ks < 4; ++ks) unpack8v(*(const u32x4*)(Z + (size_t)tok * ZW + C_RQ + h * 64 + 16 * ks + 8 * hh), f[ks]);
#pragma unroll
        for (int ks = 0; ks < 2; ++ks) {
            const float* cp = rcos + pos * 32 + 16 * ks + 8 * hh; const float* sp = rsin + pos * 32 + 16 * ks + 8 * hh;
            const f32x4 c0 = *(const f32x4*)cp, c1 = *(const f32x4*)(cp + 4), n0 = *(const f32x4*)sp, n1 = *(const f32x4*)(sp + 4);
#pragma unroll
            for (int j = 0; j < 8; ++j) { const float cs = j < 4 ? c0[j & 3] : c1[j & 3], sn = j < 4 ? n0[j & 3] : n1[j & 3]; const float x1 = f[ks][j], x2 = f[ks + 2][j]; f[ks][j] = x1 * cs - x2 * sn; f[ks + 2][j] = x2 * cs + x1 * sn; }
        }
#pragma unroll
        for (int ks = 0; ks < 4; ++ks) qf[ks] = __builtin_bit_cast(bf16x8_t, pack8(f[ks]));
    }
    __syncthreads();
    f32x16 o[4];
#pragma unroll
    for (int dt = 0; dt < 4; ++dt) {
        f32x16 a = F16Z;
#pragma unroll
        for (int ks = 0; ks < 4; ++ks) a = __builtin_amdgcn_mfma_f32_32x32x16_bf16(frag_row(Rs, 128, 32 * dt + r32, 2 * ks + hh), qf[ks], a, 0, 0, 0);
        o[dt] = a;
    }
    const float xi = __expf(lg * (float)(t + 1));
#pragma unroll
    for (int dt = 0; dt < 4; ++dt)
#pragma unroll
        for (int rg = 0; rg < 16; ++rg) o[dt][rg] *= xi;
#pragma unroll 1
    for (int tl = 0; tl <= wl; ++tl) {
        {
            f32x16 st = F16Z;
#pragma unroll
            for (int ks = 0; ks < 4; ++ks) st = __builtin_amdgcn_mfma_f32_32x32x16_bf16(frag_row(Ks, 128, 32 * tl + r32, 2 * ks + hh), qf[ks], st, 0, 0, 0);
#pragma unroll
            for (int rg = 0; rg < 16; ++rg) { const int s = 32 * tl + acc_row(rg, hh); st[rg] = (s <= t) ? st[rg] * __expf(lg * (float)(t - s)) : 0.f; }
#pragma unroll
            for (int s2 = 0; s2 < 2; ++s2) {
                u32x4 pw; pw.x = cvtpk(st[8 * s2 + 0], st[8 * s2 + 1]); pw.y = cvtpk(st[8 * s2 + 2], st[8 * s2 + 3]); pw.z = cvtpk(st[8 * s2 + 4], st[8 * s2 + 5]); pw.w = cvtpk(st[8 * s2 + 6], st[8 * s2 + 7]);
                const bf16x8_t pb = __builtin_bit_cast(bf16x8_t, pw);
#pragma unroll
                for (int dt = 0; dt < 4; ++dt) o[dt] = __builtin_amdgcn_mfma_f32_32x32x16_bf16(frag_tr<true>(Vs, 256, 32 * tl + 16 * s2, 32 * dt, lane), pb, o[dt], 0, 0, 0);
            }
        }
    }
    float sum = 0.f, sq = 0.f;
#pragma unroll
    for (int dt = 0; dt < 4; ++dt)
#pragma unroll
        for (int rg = 0; rg < 16; ++rg) { sum += o[dt][rg]; sq += o[dt][rg] * o[dt][rg]; }
    sum += __shfl_xor(sum, 32); sq += __shfl_xor(sq, 32);
    const float mean = sum * (1.0f / 128.0f);
    const float rstd = 1.0f / sqrtf(fmaxf(sq * (1.0f / 128.0f) - mean * mean, 0.f) + LN_EPS);
#pragma unroll
    for (int dt = 0; dt < 4; ++dt)
#pragma unroll
        for (int g4 = 0; g4 < 4; ++g4) {
            const int dv = 32 * dt + 8 * g4 + 4 * hh;
            const f32x4 gg = *(const f32x4*)(p.ret_g + li * 512 + h * 128 + dv);
            const uint2 rgb = *(const uint2*)(Z + (size_t)tok * ZW + C_RG + h * 128 + dv);
            const float r0 = __uint_as_float(rgb.x << 16), r1 = __uint_as_float(rgb.x & 0xffff0000u), r2 = __uint_as_float(rgb.y << 16), r3 = __uint_as_float(rgb.y & 0xffff0000u);
            const float y0 = (o[dt][4 * g4 + 0] - mean) * rstd * gg[0] * siluf_(r0), y1 = (o[dt][4 * g4 + 1] - mean) * rstd * gg[1] * siluf_(r1);
            const float y2 = (o[dt][4 * g4 + 2] - mean) * rstd * gg[2] * siluf_(r2), y3 = (o[dt][4 * g4 + 3] - mean) * rstd * gg[3] * siluf_(r3);
            *(uint2*)(MIX + (size_t)tok * DM + h * 128 + dv) = make_uint2(pk2(y0, y1), pk2(y2, y3));
        }
    __syncthreads();
}

__device__ __forceinline__ void mls_out_u(const Params& p, int li, int unit, LAS unsigned char* ldsU, int wl, int tidU, int lane) {
    const int c = unit & 63, bh = unit >> 6, h = bh & 3, b = bh >> 2, t0 = b * SEQ + c * 128;
    const int r32 = lane & 31, hh = lane >> 5;
    const bf16* Z = (const bf16*)(p.ws + WS_Z); bf16* MIX = (bf16*)(p.ws + WS_MIX);
    const float* MC = (const float*)(p.ws + WS_MC); const float* MN = (const float*)(p.ws + WS_MN); const float* MMP = (const float*)(p.ws + WS_MMP);
    LAS unsigned char* Ks = ldsU; LAS unsigned char* Qs = ldsU + 16384; LAS unsigned char* Vs = ldsU + 32768; LAS unsigned char* Cs = ldsU + 65536;
    LAS float* bb = (LAS float*)(ldsU + 77824); LAS float* gg = bb + 128; LAS float* pm = gg + 128;
    if (wl == 0) {
        float b0, b1, g0, g1; mls_gates(p, li, t0, h, lane, b0, b1, g0, g1);
        const float p1 = fmaxf(g0, g1); float v = p1;
#pragma unroll
        for (int o = 1; o < 64; o <<= 1) { const float u = __shfl_up(v, o); if (lane >= o) v = fmaxf(v, u); }
        const float prev = __shfl_up(v, 1);
        const float ex = (lane == 0) ? -INFINITY : prev;
        bb[2 * lane] = b0; bb[2 * lane + 1] = b1; gg[2 * lane] = g0; gg[2 * lane + 1] = g1;
        pm[2 * lane] = fmaxf(ex, g0); pm[2 * lane + 1] = fmaxf(ex, p1);
    }
    stage_vext(Z + (size_t)t0 * ZW + C_MV + h * 64, Vs, tidU);
    for (int task = tidU; task < 2048; task += 256) {
        const int isq = task >> 10, row = (task >> 3) & 127, cc = task & 7;
        float o[8]; conv8(Z + (size_t)(t0 + row) * ZW + (isq ? C_MQ : C_MK) + h * 64 + 8 * cc, p.conv_w + (size_t)li * 2048 + (isq ? 0 : 256) + h * 64 + 8 * cc, c * 128 + row, isq ? 1.0f : 0.125f, o);
        *(LAS u32x4*)((isq ? Qs : Ks) + row * 128 + swz16(row, cc)) = pack8(o);
    }
    for (int task = tidU; task < 96 * 8; task += 256) {
        const int row = task >> 3, cc = task & 7;
        float v[8] = {0.f, 0.f, 0.f, 0.f, 0.f, 0.f, 0.f, 0.f};
        if (row <= 64) { const float* src = (row < 64) ? (MC + (size_t)unit * 4096 + row * 64 + 8 * cc) : (MN + (size_t)unit * 64 + 8 * cc);
            const f32x4 x0 = *(const f32x4*)src, x1 = *(const f32x4*)(src + 4); v[0] = x0[0]; v[1] = x0[1]; v[2] = x0[2]; v[3] = x0[3]; v[4] = x1[0]; v[5] = x1[1]; v[6] = x1[2]; v[7] = x1[3]; }
        *(LAS u32x4*)(Cs + row * 128 + swz16(row, cc)) = pack8(v);
    }
    const float mprev = MMP[unit];
    __syncthreads();
    const int t = 32 * wl + r32, tok = t0 + t;
    const float Mt = fmaxf(mprev, pm[t]), bt = bb[t];
    const float winter = __expf(mprev - Mt);
    bf16x8_t qf[4];
#pragma unroll
    for (int ks = 0; ks < 4; ++ks) qf[ks] = frag_row(Qs, 128, t, 2 * ks + hh);
    f32x16 o[3];
#pragma unroll
    for (int dt = 0; dt < 3; ++dt) {
        f32x16 a = F16Z;
#pragma unroll
        for (int ks = 0; ks < 4; ++ks) a = __builtin_amdgcn_mfma_f32_32x32x16_bf16(frag_row(Cs, 128, 32 * dt + r32, 2 * ks + hh), qf[ks], a, 0, 0, 0);
#pragma unroll
        for (int rg = 0; rg < 16; ++rg) a[rg] *= winter;
        o[dt] = a;
    }
#pragma unroll 1
    for (int tl = 0; tl <= wl; ++tl) {
        {
            f32x16 st = F16Z;
#pragma unroll
            for (int ks = 0; ks < 4; ++ks) st = __builtin_amdgcn_mfma_f32_32x32x16_bf16(frag_row(Ks, 128, 32 * tl + r32, 2 * ks + hh), qf[ks], st, 0, 0, 0);
#pragma unroll
            for (int g4 = 0; g4 < 4; ++g4) {
                const int sb = 32 * tl + 8 * g4 + 4 * hh;
                const f32x4 gv = *(const LAS f32x4*)(gg + sb);
#pragma unroll
                for (int j = 0; j < 4; ++j) st[4 * g4 + j] = (sb + j <= t) ? st[4 * g4 + j] * __expf(gv[j] - Mt) : 0.f;
            }
#pragma unroll
            for (int s2 = 0; s2 < 2; ++s2) {
                u32x4 pw; pw.x = cvtpk(st[8 * s2 + 0], st[8 * s2 + 1]); pw.y = cvtpk(st[8 * s2 + 2], st[8 * s2 + 3]); pw.z = cvtpk(st[8 * s2 + 4], st[8 * s2 + 5]); pw.w = cvtpk(st[8 * s2 + 6], st[8 * s2 + 7]);
                const bf16x8_t pb = __builtin_bit_cast(bf16x8_t, pw);
#pragma unroll
                for (int dt = 0; dt < 3; ++dt) o[dt] = __builtin_amdgcn_mfma_f32_32x32x16_bf16(frag_tr<true>(Vs, 256, 32 * tl + 16 * s2, 32 * dt, lane), pb, o[dt], 0, 0, 0);
            }
        }
    }
    const float den = __shfl(o[2][0], r32);
    const float rden = 1.0f / fmaxf(fabsf(den), __expf(-(bt + Mt)));
    float sum = 0.f, sq = 0.f;
#pragma unroll
    for (int dt = 0; dt < 2; ++dt)
#pragma unroll
        for (int rg = 0; rg < 16; ++rg) { o[dt][rg] *= rden; sum += o[dt][rg]; sq += o[dt][rg] * o[dt][rg]; }
    sum += __shfl_xor(sum, 32); sq += __shfl_xor(sq, 32);
    const float mean = sum * (1.0f / 64.0f);
    const float rstd = 1.0f / sqrtf(fmaxf(sq * (1.0f / 64.0f) - mean * mean, 0.f) + LN_EPS);
#pragma unroll
    for (int dt = 0; dt < 2; ++dt)
#pragma unroll
        for (int g4 = 0; g4 < 4; ++g4) {
            const int d = 32 * dt + 8 * g4 + 4 * hh;
            const f32x4 gn = *(const f32x4*)(p.mls_g + li * 256 + h * 64 + d);
            const uint2 mob = *(const uint2*)(Z + (size_t)tok * ZW + C_MO + h * 64 + d);
            const float m0 = __uint_as_float(mob.x << 16), m1 = __uint_as_float(mob.x & 0xffff0000u), m2 = __uint_as_float(mob.y << 16), m3 = __uint_as_float(mob.y & 0xffff0000u);
            const float y0 = (o[dt][4 * g4 + 0] - mean) * rstd * gn[0] * sigmoidf_(m0), y1 = (o[dt][4 * g4 + 1] - mean) * rstd * gn[1] * sigmoidf_(m1);
            const float y2 = (o[dt][4 * g4 + 2] - mean) * rstd * gn[2] * sigmoidf_(m2), y3 = (o[dt][4 * g4 + 3] - mean) * rstd * gn[3] * sigmoidf_(m3);
            *(uint2*)(MIX + (size_t)tok * DM + 768 + h * 64 + d) = make_uint2(pk2(y0, y1), pk2(y2, y3));
        }
    __syncthreads();
}

__device__ __forceinline__ void p3_scans(const Params& p) {
    float* RST = (float*)(p.ws + WS_RST);
    float* MC = (float*)(p.ws + WS_MC); float* MN = (float*)(p.ws + WS_MN); const float* MA = (const float*)(p.ws + WS_MA); const float* MML = (const float*)(p.ws + WS_MML); float* MMP = (float*)(p.ws + WS_MMP);
    const int gt = blockIdx.x * NTHR + threadIdx.x, GT = gridDim.x * NTHR;
    for (int e = gt; e < 16 * 8192; e += GT) {
        const int bh = e >> 13, el = e & 8191, h = bh & 3;
        const float gL = expf(ret_lg(h) * 128.0f);
        float R = 0.f;
        float* ptr = RST + (size_t)bh * 64 * 8192 + el;
        for (int c = 0; c < 64; ++c) { const float sv = ptr[(size_t)c * 8192]; ptr[(size_t)c * 8192] = R; R = fmaf(gL, R, sv); }
    }
    for (int e = gt; e < 16 * 4160; e += GT) {
        const int bh = e / 4160, el = e - bh * 4160;
        float* ptr; size_t stride;
        if (el < 4096) { ptr = MC + (size_t)bh * 64 * 4096 + el; stride = 4096; } else { ptr = MN + (size_t)bh * 64 * 64 + (el - 4096); stride = 64; }
        float m = 0.f, C = 0.f;
        for (int c = 0; c < 64; ++c) {
            const float a = MA[bh * 64 + c], ml = MML[bh * 64 + c];
            const float mn = fmaxf(a + m, ml);
            const float f1 = expf(a + m - mn), f2 = expf(ml - mn);
            const float sv = ptr[(size_t)c * stride]; ptr[(size_t)c * stride] = C; C = f1 * C + f2 * sv;
            if (el == 0) MMP[bh * 64 + c] = m;
            m = mn;
        }
    }
}

__device__ __forceinline__ void ret_out_item(const Params& p, int li, int item, float* lds) {
    const int tid = threadIdx.x;
    const int c = item & 63, bh = item >> 6, h = bh & 3, b = bh >> 2;
    const int t0 = b * SEQ + c * 128, s0 = c * 128;
    const bf16* Z = (const bf16*)(p.ws + WS_Z);
    const float* rcos = (const float*)(p.ws + WS_RCOS); const float* rsin = (const float*)(p.ws + WS_RSIN);
    const float* RST = (const float*)(p.ws + WS_RST);
    bf16* MIX = (bf16*)(p.ws + WS_MIX);
    float* Q = lds; float* K = Q + 8320; float* SC = K + 8320; float* V = SC + 8256; float* R = V + 8192;
    const float lg = ret_lg(h);
    for (int idx = tid; idx < 128 * 32; idx += NTHR) {
        const int row = idx >> 5, i = idx & 31;
        const bf16* zq = Z + (size_t)(t0 + row) * ZW + C_RQ + h * 64; const bf16* zk = Z + (size_t)(t0 + row) * ZW + C_RK + h * 64;
        const float cs = rcos[(s0 + row) * 32 + i], sn = rsin[(s0 + row) * 32 + i];
        const float q1 = bf2f(zq[i]), q2 = bf2f(zq[i + 32]), k1 = bf2f(zk[i]), k2 = bf2f(zk[i + 32]);
        Q[row * 65 + i] = q1 * cs - q2 * sn; Q[row * 65 + i + 32] = q2 * cs + q1 * sn;
        K[row * 65 + i] = (k1 * cs - k2 * sn) * 0.125f; K[row * 65 + i + 32] = (k2 * cs + k1 * sn) * 0.125f;
    }
    __syncthreads();
    const int r = tid >> 3, d0 = (tid & 7) * 8;
#pragma unroll 1
    for (int rh = 0; rh < 2; ++rh) {
        const int t = rh * 64 + r;
#pragma unroll 1
        for (int j = 0; j < 16; ++j) {
            const int s = (tid & 7) + 8 * j;
            float dot = 0.f;
#pragma unroll 16
            for (int d = 0; d < 64; ++d) dot = fmaf(Q[t * 65 + d], K[s * 65 + d], dot);
            SC[r * 129 + s] = (s <= t) ? dot * expf(lg * (float)(t - s)) : 0.f;
        }
        __syncthreads();
        float o[2][8];
#pragma unroll
        for (int dh = 0; dh < 2; ++dh) {
            for (int idx = tid; idx < 128 * 64; idx += NTHR) { const int row = idx >> 6, d = idx & 63; V[idx] = bf2f(Z[(size_t)(t0 + row) * ZW + C_RV + h * 128 + dh * 64 + d]); }
            for (int idx = tid; idx < 64 * 64; idx += NTHR) { const int k = idx >> 6, d = idx & 63; R[idx] = RST[(size_t)item * 8192 + k * 128 + dh * 64 + d]; }
            __syncthreads();
            float acc[8], cr[8];
#pragma unroll
            for (int j = 0; j < 8; ++j) { acc[j] = 0.f; cr[j] = 0.f; }
#pragma unroll 4
            for (int s = 0; s < 128; ++s) {
                const float w = SC[r * 129 + s];
#pragma unroll
                for (int j = 0; j < 8; ++j) acc[j] = fmaf(w, V[s * 64 + d0 + j], acc[j]);
            }
#pragma unroll 4
            for (int k = 0; k < 64; ++k) {
                const float qv = Q[t * 65 + k];
#pragma unroll
                for (int j = 0; j < 8; ++j) cr[j] = fmaf(qv, R[k * 64 + d0 + j], cr[j]);
            }
            const float xi = expf(lg * (float)(t + 1));
#pragma unroll
            for (int j = 0; j < 8; ++j) o[dh][j] = acc[j] + xi * cr[j];
            __syncthreads();
        }
        float sum = 0.f;
#pragma unroll
        for (int dh = 0; dh < 2; ++dh)
#pragma unroll
            for (int j = 0; j < 8; ++j) sum += o[dh][j];
        sum += __shfl_xor(sum, 1); sum += __shfl_xor(sum, 2); sum += __shfl_xor(sum, 4);
        const float mean = sum * (1.0f / 128.0f);
        float sq = 0.f;
#pragma unroll
        for (int dh = 0; dh < 2; ++dh)
#pragma unroll
            for (int j = 0; j < 8; ++j) { const float dd = o[dh][j] - mean; sq += dd * dd; }
        sq += __shfl_xor(sq, 1); sq += __shfl_xor(sq, 2); sq += __shfl_xor(sq, 4);
        const float rstd = 1.0f / sqrtf(sq * (1.0f / 128.0f) + LN_EPS);
#pragma unroll
        for (int dh = 0; dh < 2; ++dh) {
            float y[8];
#pragma unroll
            for (int j = 0; j < 8; ++j) {
                const int d = dh * 64 + d0 + j;
                const float g = p.ret_g[li * 512 + h * 128 + d];
                const float rg = bf2f(Z[(size_t)(t0 + t) * ZW + C_RG + h * 128 + d]);
                y[j] = (o[dh][j] - mean) * rstd * g * siluf_(rg);
            }
            uint4 w; w.x = pk2(y[0], y[1]); w.y = pk2(y[2], y[3]); w.z = pk2(y[4], y[5]); w.w = pk2(y[6], y[7]);
            *(uint4*)(MIX + (size_t)(t0 + t) * DM + h * 128 + dh * 64 + d0) = w;
        }
    }
    __syncthreads();
}

__device__ __forceinline__ void mls_out_item(const Params& p, int li, int item, float* lds) {
    const int tid = threadIdx.x;
    const int c = item & 63, bh = item >> 6, h = bh & 3, b = bh >> 2;
    const int t0 = b * SEQ + c * 128;
    const bf16* Z = (const bf16*)(p.ws + WS_Z);
    const float* gates = (const float*)(p.ws + WS_GATES);
    const float* MC = (const float*)(p.ws + WS_MC); const float* MN = (const float*)(p.ws + WS_MN); const float* MMP = (const float*)(p.ws + WS_MMP);
    bf16* MIX = (bf16*)(p.ws + WS_MIX);
    const float* cw = p.conv_w + (size_t)li * 4 * 512;
    float* Q = lds; float* K = Q + 8320; float* SM = K + 8320; float* V = SM + 8256; float* C = V + 8192; float* nv = C + 4096; float* ib = nv + 64; float* bb = ib + 128; float* pm = bb + 128;
    for (int idx = tid; idx < 128 * 64; idx += NTHR) {
        const int row = idx >> 6, d = idx & 63, chq = h * 64 + d, chk = 256 + h * 64 + d;
        float aq = 0.f, ak = 0.f;
#pragma unroll
        for (int j = 0; j < 4; ++j) {
            const int sp = c * 128 + row - 3 + j;
            if (sp >= 0) {
                const bf16* zr = Z + (size_t)(t0 + row - 3 + j) * ZW;
                aq = fmaf(cw[j * 512 + chq], bf2f(zr[C_MQ + h * 64 + d]), aq);
                ak = fmaf(cw[j * 512 + chk], bf2f(zr[C_MK + h * 64 + d]), ak);
            }
        }
        Q[row * 65 + d] = siluf_(aq); K[row * 65 + d] = siluf_(ak) * 0.125f;
        V[idx] = bf2f(Z[(size_t)(t0 + row) * ZW + C_MV + h * 64 + d]);
    }
    for (int idx = tid; idx < 4096; idx += NTHR) C[idx] = MC[(size_t)item * 4096 + idx];
    if (tid < 64) nv[tid] = MN[(size_t)item * 64 + tid];
    if (tid < 128) {
        const int t = t0 + tid;
        ib[tid] = gates[(size_t)t * 8 + h] + p.b_if[li * 8 + h];
        bb[tid] = logsigmoidf_(gates[(size_t)t * 8 + 4 + h] + p.b_if[li * 8 + 4 + h]);
    }
    const float mprev = MMP[item];
    __syncthreads();
    if (tid == 0) {
        float run = 0.f, pmx = -INFINITY;
#pragma unroll 4
        for (int s = 0; s < 128; ++s) { run += bb[s]; bb[s] = run; pmx = fmaxf(pmx, ib[s] - run); pm[s] = pmx; }
    }
    __syncthreads();
    const int r = tid >> 3, d0 = (tid & 7) * 8;
#pragma unroll 1
    for (int rh = 0; rh < 2; ++rh) {
        const int t = rh * 64 + r;
        const float mt = bb[t] + fmaxf(mprev, pm[t]);
#pragma unroll 1
        for (int j = 0; j < 16; ++j) {
            const int s = (tid & 7) + 8 * j;
            float dot = 0.f;
#pragma unroll 16
            for (int d = 0; d < 64; ++d) dot = fmaf(Q[t * 65 + d], K[s * 65 + d], dot);
            SM[r * 129 + s] = (s <= t) ? dot * expf(bb[t] - bb[s] + ib[s] - mt) : 0.f;
        }
        __syncthreads();
        float acc[8], qc[8], den = 0.f, qn = 0.f;
#pragma unroll
        for (int j = 0; j < 8; ++j) { acc[j] = 0.f; qc[j] = 0.f; }
#pragma unroll 4
        for (int s = 0; s < 128; ++s) {
            const float w = SM[r * 129 + s]; den += w;
#pragma unroll
            for (int j = 0; j < 8; ++j) acc[j] = fmaf(w, V[s * 64 + d0 + j], acc[j]);
        }
#pragma unroll 4
        for (int k = 0; k < 64; ++k) {
            const float qv = Q[t * 65 + k]; qn = fmaf(qv, nv[k], qn);
#pragma unroll
            for (int j = 0; j < 8; ++j) qc[j] = fmaf(qv, C[k * 64 + d0 + j], qc[j]);
        }
        const float winter = expf(bb[t] + mprev - mt);
        den += winter * qn;
        const float denom = fmaxf(fabsf(den), expf(-mt));
        float hv[8], sum = 0.f;
#pragma unroll
        for (int j = 0; j < 8; ++j) { hv[j] = (acc[j] + winter * qc[j]) / denom; sum += hv[j]; }
        sum += __shfl_xor(sum, 1); sum += __shfl_xor(sum, 2); sum += __shfl_xor(sum, 4);
        const float mean = sum * (1.0f / 64.0f);
        float sq = 0.f;
#pragma unroll
        for (int j = 0; j < 8; ++j) { const float dd = hv[j] - mean; sq += dd * dd; }
        sq += __shfl_xor(sq, 1); sq += __shfl_xor(sq, 2); sq += __shfl_xor(sq, 4);
        const float rstd = 1.0f / sqrtf(sq * (1.0f / 64.0f) + LN_EPS);
        float y[8];
#pragma unroll
        for (int j = 0; j < 8; ++j) {
            const int d = d0 + j;
            const float g = p.mls_g[li * 256 + h * 64 + d];
            const float mo = bf2f(Z[(size_t)(t0 + t) * ZW + C_MO + h * 64 + d]);
            y[j] = (hv[j] - mean) * rstd * g * sigmoidf_(mo);
        }
        { uint4 w; w.x = pk2(y[0], y[1]); w.y = pk2(y[2], y[3]); w.z = pk2(y[4], y[5]); w.w = pk2(y[6], y[7]);
          *(uint4*)(MIX + (size_t)(t0 + t) * DM + 768 + h * 64 + d0) = w; }
        __syncthreads();
    }
}

__device__ __forceinline__ void ln_row_inplace(const bf16* row, bf16* brow, signed char* qrow, float* qscale, const float* g, const float* bta, int lane) {
    float4 v[4]; float s = 0.f;
#pragma unroll
    for (int j = 0; j < 4; ++j) { const uint2 ub = *(const uint2*)(row + 256 * j + 4 * lane); v[j] = make_float4(__uint_as_float(ub.x << 16), __uint_as_float(ub.x & 0xffff0000u), __uint_as_float(ub.y << 16), __uint_as_float(ub.y & 0xffff0000u)); s += (v[j].x + v[j].y) + (v[j].z + v[j].w); }
    const float mean = wave_sum(s) * (1.0f / DM);
    float s2 = 0.f;
#pragma unroll
    for (int j = 0; j < 4; ++j) { v[j].x -= mean; v[j].y -= mean; v[j].z -= mean; v[j].w -= mean; s2 += (v[j].x * v[j].x + v[j].y * v[j].y) + (v[j].z * v[j].z + v[j].w * v[j].w); }
    const float rstd = 1.0f / sqrtf(wave_sum(s2) * (1.0f / DM) + LN_EPS);
#pragma unroll
    for (int j = 0; j < 4; ++j) {
        const float4 gg = *(const float4*)(g + 256 * j + 4 * lane), bv = *(const float4*)(bta + 256 * j + 4 * lane);
        const float4 o = make_float4(v[j].x * rstd * gg.x + bv.x, v[j].y * rstd * gg.y + bv.y, v[j].z * rstd * gg.z + bv.z, v[j].w * rstd * gg.w + bv.w);
        *(uint2*)(brow + 256 * j + 4 * lane) = make_uint2(pk2(o.x, o.y), pk2(o.z, o.w));
        v[j] = o;
    }
    float am = 0.f;
#pragma unroll
    for (int j = 0; j < 4; ++j) am = fmaxf(am, fmaxf(fmaxf(fabsf(v[j].x), fabsf(v[j].y)), fmaxf(fabsf(v[j].z), fabsf(v[j].w))));
    am = wave_max(am);
    const float inv = am > 0.f ? 127.0f / am : 0.f;
#pragma unroll
    for (int j = 0; j < 4; ++j) {
        const unsigned q0 = (unsigned)__float2int_rn(v[j].x * inv) & 0xffu, q1 = (unsigned)__float2int_rn(v[j].y * inv) & 0xffu, q2 = (unsigned)__float2int_rn(v[j].z * inv) & 0xffu, q3 = (unsigned)__float2int_rn(v[j].w * inv) & 0xffu;
        *(unsigned*)(qrow + 256 * j + 4 * lane) = q0 | (q1 << 8) | (q2 << 16) | (q3 << 24);
    }
    if (lane == 0) *qscale = am * (1.0f / 127.0f);
}

__device__ __forceinline__ void topk_item(const Params& p, int li, int item, float* lds) {
    const int tid = threadIdx.x, lane = tid & 63, wave = tid >> 6;
    const int tile = item >> 3, h = item & 7, tok0 = tile * 64;
    const bf16* QRY = (const bf16*)(p.ws + WS_QRY);
    int* RI = (int*)(p.ws + WS_RI); float* RG = (float*)(p.ws + WS_RG);
    float* Kk = lds; float* Qt = Kk + 128 * 129; float* SC = Qt + 64 * 129; float* TKV = SC + 64 * 128; int* TKI = (int*)(TKV + 2048);
#pragma unroll 1
    for (int pp = 0; pp < 2; ++pp) {
        const float* kb = p.keys + ((size_t)((li * 8 + h) * 2 + pp)) * 128 * 128;
        for (int idx = tid; idx < 128 * 128; idx += NTHR) { const int n = idx >> 7, c = idx & 127; Kk[n * 129 + c] = kb[idx]; }
        for (int idx = tid; idx < 64 * 128; idx += NTHR) { const int tok = idx >> 7, c = idx & 127; Qt[tok * 129 + c] = bf2f(QRY[(size_t)(tok0 + tok) * 2048 + h * 256 + pp * 128 + c]); }
        __syncthreads();
        {
            const int tok = tid >> 3;
#pragma unroll 1
            for (int j = 0; j < 16; ++j) {
                const int n = (tid & 7) + 8 * j;
                float dot = 0.f;
#pragma unroll 16
                for (int c = 0; c < 128; ++c) dot = fmaf(Qt[tok * 129 + c], Kk[n * 129 + c], dot);
                SC[tok * 128 + n] = dot;
            }
        }
        __syncthreads();
#pragma unroll 1
        for (int q = 0; q < 8; ++q) {
            const int tok = wave * 8 + q;
            float v0 = SC[tok * 128 + lane], v1 = SC[tok * 128 + 64 + lane];
#pragma unroll 1
            for (int k = 0; k < 16; ++k) {
                const float wm = wave_max(fmaxf(v0, v1));
                const unsigned long long b0 = __ballot(v0 == wm);
                int idx;
                if (b0) { const int sl = __ffsll((long long)b0) - 1; idx = sl; if (lane == sl) v0 = -INFINITY; }
                else { const unsigned long long b1 = __ballot(v1 == wm); const int sl = __ffsll((long long)b1) - 1; idx = 64 + sl; if (lane == sl) v1 = -INFINITY; }
                if (lane == 0) { TKV[(tok * 2 + pp) * 16 + k] = wm; TKI[(tok * 2 + pp) * 16 + k] = idx; }
            }
        }
        __syncthreads();
    }
#pragma unroll 1
    for (int q = 0; q < 8; ++q) {
        const int tok = wave * 8 + q;
        const float s1 = TKV[(tok * 2) * 16 + (lane >> 2)];
        float cnd[4];
#pragma unroll
        for (int j = 0; j < 4; ++j) cnd[j] = s1 + TKV[(tok * 2 + 1) * 16 + (lane & 3) * 4 + j];
        float myval = 0.f; int myflat = 0;
#pragma unroll 1
        for (int k = 0; k < 16; ++k) {
            const float wm = wave_max(fmaxf(fmaxf(cnd[0], cnd[1]), fmaxf(cnd[2], cnd[3])));
            const bool has = (cnd[0] == wm) | (cnd[1] == wm) | (cnd[2] == wm) | (cnd[3] == wm);
            const unsigned long long bl = __ballot(has);
            const int sl = __ffsll((long long)bl) - 1;
            int fl = 0;
            if (lane == sl) {
                int j = (cnd[0] == wm) ? 0 : ((cnd[1] == wm) ? 1 : ((cnd[2] == wm) ? 2 : 3));
                fl = lane * 4 + j;
                if (j == 0) cnd[0] = -INFINITY; else if (j == 1) cnd[1] = -INFINITY; else if (j == 2) cnd[2] = -INFINITY; else cnd[3] = -INFINITY;
            }
            fl = __shfl(fl, sl);
            if (lane == k) { myval = wm; myflat = fl; }
        }
        const float m0 = __shfl(myval, 0);
        const float e = (lane < 16) ? expf(myval - m0) : 0.f;
        const float ssum = wave_sum(e);
        if (lane < 16) {
            const int a = myflat >> 4, bq = myflat & 15;
            const int eidx = TKI[(tok * 2) * 16 + a] * 128 + TKI[(tok * 2 + 1) * 16 + bq];
            RI[(size_t)(tok0 + tok) * 128 + h * 16 + lane] = eidx;
            RG[(size_t)(tok0 + tok) * 128 + h * 16 + lane] = e / ssum;
        }
    }
    __syncthreads();
}

__device__ __forceinline__ float key_embed(float v, unsigned idx, unsigned keepmask) { return __uint_as_float((__float_as_uint(v) & keepmask) | idx); }

template <int N>
__device__ __forceinline__ void bitonic_desc(float (&a)[N]) {
#pragma unroll
    for (int k = 2; k <= N; k <<= 1)
#pragma unroll
        for (int j = k >> 1; j > 0; j >>= 1)
#pragma unroll
            for (int i = 0; i < N; ++i) {
                const int l = i ^ j;
                if (l > i) { const float hi = fmaxf(a[i], a[l]), lo = fminf(a[i], a[l]); if ((i & k) == 0) { a[i] = hi; a[l] = lo; } else { a[i] = lo; a[l] = hi; } }
            }
}
__device__ __forceinline__ void merge_top16(float (&a)[16], const float (&b)[16]) {
#pragma unroll
    for (int i = 0; i < 16; ++i) a[i] = fmaxf(a[i], b[15 - i]);
#pragma unroll
    for (int j = 8; j > 0; j >>= 1)
#pragma unroll
        for (int i = 0; i < 16; ++i) { const int l = i ^ j; if (l > i) { const float hi = fmaxf(a[i], a[l]), lo = fminf(a[i], a[l]); a[i] = hi; a[l] = lo; } }
}
__device__ __forceinline__ void topk_half(const bf16* qrow, const LAS unsigned char* kl, int r32, int hh, float (&out)[16]) {
    bf16x8_t qf[8];
#pragma unroll
    for (int ks = 0; ks < 8; ++ks) qf[ks] = *(const bf16x8_t*)(qrow + 16 * ks + 8 * hh);
    f32x16 st[4];
#pragma unroll
    for (int tl = 0; tl < 4; ++tl) {
        f32x16 a16 = {0.f, 0.f, 0.f, 0.f, 0.f, 0.f, 0.f, 0.f, 0.f, 0.f, 0.f, 0.f, 0.f, 0.f, 0.f, 0.f};
        const int n = 32 * tl + r32;
#pragma unroll
        for (int ks = 0; ks < 8; ++ks) {
            const int c = 2 * ks + hh;
            const bf16x8_t kf = *(const LAS bf16x8_t*)(kl + n * 256 + ((c ^ (n & 15)) << 4));
            a16 = __builtin_amdgcn_mfma_f32_32x32x16_bf16(kf, qf[ks], a16, 0, 0, 0);
        }
        st[tl] = a16;
    }
#pragma unroll
    for (int tl = 0; tl < 4; ++tl)
#pragma unroll
        for (int rg = 0; rg < 16; ++rg) st[tl][rg] = key_embed(st[tl][rg], (unsigned)(32 * tl + (rg & 3) + 8 * (rg >> 2)) | ((unsigned)hh << 2), 0xffffff80u);
    float g0[16], g1[16], g2[16], g3[16];
#pragma unroll
    for (int rg = 0; rg < 16; ++rg) { g0[rg] = st[0][rg]; g1[rg] = st[1][rg]; g2[rg] = st[2][rg]; g3[rg] = st[3][rg]; }
    bitonic_desc<16>(g0); bitonic_desc<16>(g1); bitonic_desc<16>(g2); bitonic_desc<16>(g3);
    merge_top16(g0, g1); merge_top16(g2, g3); merge_top16(g0, g2);
#pragma unroll
    for (int i = 0; i < 16; ++i) g1[i] = __shfl_xor(g0[i], 32);
    merge_top16(g0, g1);
#pragma unroll
    for (int i = 0; i < 16; ++i) out[i] = g0[i];
}

__device__ __forceinline__ void topk_unit(const Params& p, int li, int item, LAS unsigned char* lds) {
    const int tid = threadIdx.x, lane = tid & 63, wave = __builtin_amdgcn_readfirstlane(tid >> 6);
    const int r32 = lane & 31, hh = lane >> 5;
    const int tile = item >> 3, h = item & 7;
    const int t = tile * 256 + 32 * wave + r32;
    const bf16* QRY = (const bf16*)(p.ws + WS_QRY);
    const bf16* KB = (const bf16*)(p.ws + WS_KEYS) + (size_t)((li * 8 + h) * 2) * 128 * 128;
    int* RI = (int*)(p.ws + WS_RI); float* RG = (float*)(p.ws + WS_RG);
    for (int idx = tid; idx < 2 * 128 * 16; idx += NTHR) {
        const int pp = idx >> 11, n = (idx >> 4) & 127, c = idx & 15;
        const u32x4 v = *(const u32x4*)(KB + (size_t)(pp * 128 + n) * 128 + c * 8);
        *(LAS u32x4*)(lds + pp * 32768 + n * 256 + ((c ^ (n & 15)) << 4)) = v;
    }
    __syncthreads();
    float sk0[16], sk1[16];
    topk_half(QRY + (size_t)t * 2048 + h * 256, lds, r32, hh, sk0);
    topk_half(QRY + (size_t)t * 2048 + h * 256 + 128, lds + 32768, r32, hh, sk1);
    unsigned i1s[16], i2[16];
#pragma unroll
    for (int a = 0; a < 16; ++a) { i1s[a] = (__float_as_uint(sk0[a]) & 127u) << 7; i2[a] = __float_as_uint(sk1[a]) & 127u; }
    float cd[50];
    {
        constexpr int CA[50] = {0, 0, 0, 0, 0, 0, 0, 0, 0, 0, 0, 0, 0, 0, 0, 0, 1, 1, 1, 1, 1, 1, 1, 1, 2, 2, 2, 2, 2, 3, 3, 3, 3, 4, 4, 4, 5, 5, 6, 6, 7, 7, 8, 9, 10, 11, 12, 13, 14, 15};
        constexpr int CB[50] = {0, 1, 2, 3, 4, 5, 6, 7, 8, 9, 10, 11, 12, 13, 14, 15, 0, 1, 2, 3, 4, 5, 6, 7, 0, 1, 2, 3, 4, 0, 1, 2, 3, 0, 1, 2, 0, 1, 0, 1, 0, 1, 0, 0, 0, 0, 0, 0, 0, 0};
#pragma unroll
        for (int n = 0; n < 50; ++n) cd[n] = key_embed(sk0[CA[n]] + sk1[CB[n]], i1s[CA[n]] | i2[CB[n]], 0xffffc000u);
    }
    float sel[16], h1[16], h2[16], h3[16];
#pragma unroll
    for (int i = 0; i < 16; ++i) { sel[i] = cd[i]; h1[i] = cd[16 + i]; h2[i] = cd[32 + i]; h3[i] = -INFINITY; }
    h3[0] = fmaxf(cd[48], cd[49]); h3[1] = fminf(cd[48], cd[49]);
    bitonic_desc<16>(sel); bitonic_desc<16>(h1); bitonic_desc<16>(h2);
    merge_top16(sel, h1); merge_top16(h2, h3); merge_top16(sel, h2);
    float ev[16], es = 0.f;
    const float m0 = __uint_as_float((__float_as_uint(sel[0]) & 0xffffc000u) | 0x2000u);
#pragma unroll
    for (int k = 0; k < 16; ++k) { const float vk = __uint_as_float((__float_as_uint(sel[k]) & 0xffffc000u) | 0x2000u); ev[k] = __expf(vk - m0); es += ev[k]; }
    const float rs = 1.0f / es;
    int oi[8]; float og[8];
#pragma unroll
    for (int k = 0; k < 8; ++k) { float s_lo = sel[k], s_hi = sel[k + 8], g_lo = ev[k], g_hi = ev[k + 8]; asm volatile("" : "+v"(s_lo), "+v"(s_hi), "+v"(g_lo), "+v"(g_hi));
        const float sv = hh ? s_hi : s_lo; const float gv = hh ? g_hi : g_lo; oi[k] = (int)(__float_as_uint(sv) & 0x3fffu); og[k] = gv * rs; }
    int* rip = RI + (size_t)t * 128 + 2 * h + hh; float* rgp = RG + (size_t)t * 128 + 2 * h + hh;
#pragma unroll
    for (int j = 0; j < 8; ++j) { rip[16 * j] = oi[j]; rgp[16 * j] = og[j]; }
    __syncthreads();
}

template <bool SIGNED>
__device__ __forceinline__ void quant_rows(const float* src, unsigned char* dst, float* scl, int lane, int gw, int NGW) {
    for (int r = gw; r < 16384; r += NGW) {
        const float4* s4 = (const float4*)(src + (size_t)r * 1024 + 16 * lane);
        float4 a[4]; float am = 0.f;
#pragma unroll
        for (int j = 0; j < 4; ++j) { a[j] = s4[j]; am = fmaxf(am, fmaxf(fmaxf(fabsf(a[j].x), fabsf(a[j].y)), fmaxf(fabsf(a[j].z), fabsf(a[j].w)))); }
        am = wave_max(am);
        const float inv = am > 0.f ? 127.0f / am : 0.f;
        unsigned w[4];
#pragma unroll
        for (int j = 0; j < 4; ++j) {
            constexpr int OFS = SIGNED ? 0 : 128;
            const unsigned q0 = (unsigned)(__float2int_rn(a[j].x * inv) + OFS) & 0xffu, q1 = (unsigned)(__float2int_rn(a[j].y * inv) + OFS) & 0xffu, q2 = (unsigned)(__float2int_rn(a[j].z * inv) + OFS) & 0xffu, q3 = (unsigned)(__float2int_rn(a[j].w * inv) + OFS) & 0xffu;
            w[j] = q0 | (q1 << 8) | (q2 << 16) | (q3 << 24);
        }
        *(uint4*)(dst + (size_t)(lane >> 3) * (16384 * 128) + (size_t)r * 128 + 16 * (lane & 7)) = make_uint4(w[0], w[1], w[2], w[3]);
        if (lane == 0) scl[r] = am * (1.0f / 127.0f);
    }
}

__device__ __forceinline__ void ub4(unsigned w, float* o) { o[0] = (float)(w & 0xffu); o[1] = (float)((w >> 8) & 0xffu); o[2] = (float)((w >> 16) & 0xffu); o[3] = (float)(w >> 24); }

__device__ __forceinline__ void peer_token(const Params& p, int li, int t, int lane) {
    float* stream = p.out;
    const bf16* E = (const bf16*)(p.ws + WS_E); bf16* XB = (bf16*)(p.ws + WS_XB);
    const int* RI = (const int*)(p.ws + WS_RI); const float* RG = (const float*)(p.ws + WS_RG);
    const unsigned char* UQ = (const unsigned char*)(p.ws + WS_UQ); const unsigned char* VQ = (const unsigned char*)(p.ws + WS_VQ);
    const float* US = (const float*)(p.ws + WS_US); const float* VS = (const float*)(p.ws + WS_VS);
    float* row = stream + (size_t)t * DM + 16 * lane;
    float x[16], acc[16];
#pragma unroll
    for (int j = 0; j < 4; ++j) { const float4 v = *(const float4*)(row + 4 * j); x[4 * j] = v.x; x[4 * j + 1] = v.y; x[4 * j + 2] = v.z; x[4 * j + 3] = v.w; }
    float sx = 0.f;
#pragma unroll
    for (int j = 0; j < 16; ++j) { sx += x[j]; acc[j] = 0.f; }
    const float sumx128 = 128.0f * wave_sum(sx);
    const int e0 = RI[(size_t)t * 128 + lane], e1 = RI[(size_t)t * 128 + 64 + lane];
    const float g0 = RG[(size_t)t * 128 + lane], g1 = RG[(size_t)t * 128 + 64 + lane];
    const float su0 = US[e0], su1 = US[e1], sv0 = VS[e0], sv1 = VS[e1];
    float csum = 0.f;
    const int mi = (lane >> 3) & 7;
#pragma unroll 1
    for (int bt = 0; bt < 16; ++bt) {
        const bool lo = bt < 8;
        const int esel = lo ? e0 : e1;
        uint4 uq[8], vq[8];
#pragma unroll
        for (int i = 0; i < 8; ++i) {
            const int e = __builtin_amdgcn_readlane(esel, (bt * 8 + i) & 63);
            uq[i] = *(const uint4*)(UQ + (size_t)e * 1024 + 16 * lane);
            vq[i] = *(const uint4*)(VQ + (size_t)e * 1024 + 16 * lane);
        }
        float d[8];
#pragma unroll
        for (int i = 0; i < 8; ++i) {
            float f[16]; ub4(uq[i].x, f); ub4(uq[i].y, f + 4); ub4(uq[i].z, f + 8); ub4(uq[i].w, f + 12);
            float s = 0.f;
#pragma unroll
            for (int j = 0; j < 16; ++j) s = fmaf(x[j], f[j], s);
            d[i] = s;
        }
#pragma unroll
        for (int i = 0; i < 4; ++i) { const bool up = (lane & 32) != 0; const float send = up ? d[i] : d[i + 4]; const float keep = up ? d[i + 4] : d[i]; d[i] = keep + __shfl_xor(send, 32); }
#pragma unroll
        for (int i = 0; i < 2; ++i) { const bool up = (lane & 16) != 0; const float send = up ? d[i] : d[i + 2]; const float keep = up ? d[i + 2] : d[i]; d[i] = keep + __shfl_xor(send, 16); }
        { const bool up = (lane & 8) != 0; const float send = up ? d[0] : d[1]; const float keep = up ? d[1] : d[0]; d[0] = keep + __shfl_xor(send, 8); }
        float dq = d[0]; dq += __shfl_xor(dq, 4); dq += __shfl_xor(dq, 2); dq += __shfl_xor(dq, 1);
        const int src = (bt * 8 + mi) & 63;
        const float su = __shfl(lo ? su0 : su1, src), sv = __shfl(lo ? sv0 : sv1, src), gg = __shfl(lo ? g0 : g1, src);
        const float dot = su * (dq - sumx128);
        const float cf = 0.5f * dot * (1.0f + erff(dot * 0.70710678118f)) * gg * sv;
#pragma unroll
        for (int i = 0; i < 8; ++i) {
            const float c = __int_as_float(__builtin_amdgcn_readlane(__float_as_int(cf), 8 * i));
            csum += c;
            float f[16]; ub4(vq[i].x, f); ub4(vq[i].y, f + 4); ub4(vq[i].z, f + 8); ub4(vq[i].w, f + 12);
#pragma unroll
            for (int j = 0; j < 16; ++j) acc[j] = fmaf(c, f[j], acc[j]);
        }
    }
    const float off = 128.0f * csum;
    float s = 0.f;
    {
        const uint4 ea = *(const uint4*)(E + (size_t)t * DM + 16 * lane), eb = *(const uint4*)(E + (size_t)t * DM + 16 * lane + 8);
        float ev[16]; unpack8(ea, ev); unpack8(eb, ev + 8);
#pragma unroll
        for (int j = 0; j < 16; ++j) { acc[j] = (acc[j] - off) + DN_ALPHA * x[j] + ev[j]; s += acc[j]; }
    }
    const float mean = wave_sum(s) * (1.0f / DM);
    float s2 = 0.f;
#pragma unroll
    for (int j = 0; j < 16; ++j) { acc[j] -= mean; s2 += acc[j] * acc[j]; }
    const float rstd = 1.0f / sqrtf(wave_sum(s2) * (1.0f / DM) + LN_EPS);
    const float* g2 = p.ln2_g + li * DM + 16 * lane; const float* b2 = p.ln2_b + li * DM + 16 * lane;
    float o[16];
#pragma unroll
    for (int j = 0; j < 4; ++j) {
        const float4 gg = *(const float4*)(g2 + 4 * j), bv = *(const float4*)(b2 + 4 * j);
        o[4 * j] = acc[4 * j] * rstd * gg.x + bv.x; o[4 * j + 1] = acc[4 * j + 1] * rstd * gg.y + bv.y; o[4 * j + 2] = acc[4 * j + 2] * rstd * gg.z + bv.z; o[4 * j + 3] = acc[4 * j + 3] * rstd * gg.w + bv.w;
        *(float4*)(row + 4 * j) = make_float4(o[4 * j], o[4 * j + 1], o[4 * j + 2], o[4 * j + 3]);
    }
    if (li == 0) {
        bf16* xb = XB + (size_t)t * DM + 16 * lane;
        *(uint4*)xb = make_uint4(pk2(o[0], o[1]), pk2(o[2], o[3]), pk2(o[4], o[5]), pk2(o[6], o[7]));
        *(uint4*)(xb + 8) = make_uint4(pk2(o[8], o[9]), pk2(o[10], o[11]), pk2(o[12], o[13]), pk2(o[14], o[15]));
    }
}

struct SlicePlan { int m, mi, wid, wstride; };
__device__ __forceinline__ SlicePlan slice_plan(const Params& p, unsigned rank, int wave) {
    unsigned* bar = (unsigned*)(p.ws + WS_CTL) + 1024;
    const unsigned x = xb_xcc_id();
    SlicePlan sp; sp.m = 0; sp.mi = 0; int nloc = 1;
#pragma unroll
    for (unsigned j = 0; j < 16; ++j) { const unsigned c = xb_ld(&bar[XB_XCNT(j)]); if (j == x) { sp.mi = sp.m; nloc = (int)c; } if (c > 0u) ++sp.m; }
    sp.wid = (int)rank * NWAVE + wave; sp.wstride = nloc * NWAVE;
    return sp;
}
#define PEER_TPW 16
__device__ __forceinline__ int peer_tok(int n, int wid, int wstride) { return ((n >> 4) * wstride + wid) * PEER_TPW + (n & 15); }
__device__ __forceinline__ void peer_u_slice(const Params& p, int xs, int wid, int wstride, int lane) {
    const int* RI = (const int*)(p.ws + WS_RI);
    const signed char* X1Q = (const signed char*)(p.ws + WS_X1Q); const signed char* UQ = (const signed char*)(p.ws + WS_UQ);
    int* PI = (int*)(p.ws + WS_PI) + (size_t)xs * NT * 128;
    const int g = lane >> 3, q = lane & 7, loff = 128 * xs + 16 * q;
    const signed char* UQs = UQ + (size_t)xs * (16384 * 128) + 16 * q;
    const int ngrp = (NT / PEER_TPW - wid + wstride - 1) / wstride, N = ngrp * PEER_TPW;
    if (N <= 0) return;
    int ee[16]; int4 uA[16], uB[16]; int4 xA, xB;
#define PU_E(E, t) do { const int4* rp_ = (const int4*)(RI + (size_t)(t) * 128 + 16 * g); _Pragma("unroll") for (int b4 = 0; b4 < 4; ++b4) { const int4 r_ = rp_[b4]; E[4 * b4] = r_.x; E[4 * b4 + 1] = r_.y; E[4 * b4 + 2] = r_.z; E[4 * b4 + 3] = r_.w; } } while (0)
#define PU_U(U, X, E, t) do { X = *(const int4*)(X1Q + (size_t)(t) * DM + loff); _Pragma("unroll") for (int bt = 0; bt < 16; ++bt) U[bt] = *(const int4*)(UQs + (size_t)E[bt] * 128); } while (0)
#define PU_C(U, X, t) do { int dd_[16]; _Pragma("unroll") for (int bt = 0; bt < 16; ++bt) { \
        int d = __builtin_amdgcn_sdot4(X.x, U[bt].x, 0, false); d = __builtin_amdgcn_sdot4(X.y, U[bt].y, d, false); d = __builtin_amdgcn_sdot4(X.z, U[bt].z, d, false); d = __builtin_amdgcn_sdot4(X.w, U[bt].w, d, false); \
        d += __shfl_xor(d, 1); d += __shfl_xor(d, 2); d += __shfl_xor(d, 4); dd_[bt] = d; } \
        if (q == 0) { int4* pp_ = (int4*)(PI + (size_t)(t) * 128 + 16 * g); _Pragma("unroll") for (int b4 = 0; b4 < 4; ++b4) pp_[b4] = make_int4(dd_[4 * b4], dd_[4 * b4 + 1], dd_[4 * b4 + 2], dd_[4 * b4 + 3]); } } while (0)
#define TK(n) peer_tok((n), wid, wstride)
    PU_E(ee, TK(0)); PU_U(uA, xA, ee, TK(0)); PU_E(ee, TK(1));
#pragma unroll 1
    for (int i = 0; i < N; i += 2) {
        PU_U(uB, xB, ee, TK(i + 1));
        if (i + 2 < N) PU_E(ee, TK(i + 2));
        asm volatile("" ::: "memory");
        PU_C(uA, xA, TK(i));
        if (i + 2 < N) PU_U(uA, xA, ee, TK(i + 2));
        if (i + 3 < N) PU_E(ee, TK(i + 3));
        asm volatile("" ::: "memory");
        PU_C(uB, xB, TK(i + 1));
    }
#undef PU_E
#undef PU_U
#undef PU_C
}
__device__ __forceinline__ void peer_coef_token(const Params& p, int t, int lane) {
    const int* RI = (const int*)(p.ws + WS_RI); const float* RG = (const float*)(p.ws + WS_RG);
    const float* US = (const float*)(p.ws + WS_US); const float* VS = (const float*)(p.ws + WS_VS);
    const int* PI = (const int*)(p.ws + WS_PI);
    signed char* PC = (signed char*)(p.ws + WS_PC); float* PCS = (float*)(p.ws + WS_PCS);
    const float sx = ((const float*)(p.ws + WS_X1S))[t];
    float c[2];
#pragma unroll
    for (int hf = 0; hf < 2; ++hf) {
        const int k = lane + 64 * hf;
        const int e = RI[(size_t)t * 128 + k];
        int acc = 0;
#pragma unroll
        for (int x = 0; x < 8; ++x) acc += PI[((size_t)x * NT + t) * 128 + k];
        const float dot = US[e] * sx * (float)acc;
        c[hf] = 0.5f * dot * (1.0f + erff(dot * 0.70710678118f)) * RG[(size_t)t * 128 + k] * VS[e];
    }
    const float cm = wave_max(fmaxf(fabsf(c[0]), fabsf(c[1])));
    const float inv = cm > 0.f ? 127.0f / cm : 0.f;
    PC[(size_t)t * 128 + lane] = (signed char)__float2int_rn(c[0] * inv);
    PC[(size_t)t * 128 + 64 + lane] = (signed char)__float2int_rn(c[1] * inv);
    if (lane == 0) PCS[t] = cm * (1.0f / 127.0f);
}
__device__ __forceinline__ void peer_v_token(const uint4 (&vq)[16], const int4 cq, float cscale, bf16* yrow, int lane) {
    int acc[16];
#pragma unroll
    for (int j = 0; j < 16; ++j) acc[j] = 0;
    const int c4[4] = {cq.x, cq.y, cq.z, cq.w};
#pragma unroll
    for (int b4 = 0; b4 < 4; ++b4) {
#pragma unroll
        for (int dc = 0; dc < 4; ++dc) {
            const unsigned w0 = dc == 0 ? vq[4 * b4].x : dc == 1 ? vq[4 * b4].y : dc == 2 ? vq[4 * b4].z : vq[4 * b4].w;
            const unsigned w1 = dc == 0 ? vq[4 * b4 + 1].x : dc == 1 ? vq[4 * b4 + 1].y : dc == 2 ? vq[4 * b4 + 1].z : vq[4 * b4 + 1].w;
            const unsigned w2 = dc == 0 ? vq[4 * b4 + 2].x : dc == 1 ? vq[4 * b4 + 2].y : dc == 2 ? vq[4 * b4 + 2].z : vq[4 * b4 + 2].w;
            const unsigned w3 = dc == 0 ? vq[4 * b4 + 3].x : dc == 1 ? vq[4 * b4 + 3].y : dc == 2 ? vq[4 * b4 + 3].z : vq[4 * b4 + 3].w;
            const unsigned t0 = __builtin_amdgcn_perm(w1, w0, 0x05010400u), t1 = __builtin_amdgcn_perm(w1, w0, 0x07030602u);
            const unsigned t2 = __builtin_amdgcn_perm(w3, w2, 0x05010400u), t3 = __builtin_amdgcn_perm(w3, w2, 0x07030602u);
            const unsigned f0 = __builtin_amdgcn_perm(t2, t0, 0x05040100u), f1 = __builtin_amdgcn_perm(t2, t0, 0x07060302u);
            const unsigned f2 = __builtin_amdgcn_perm(t3, t1, 0x05040100u), f3 = __builtin_amdgcn_perm(t3, t1, 0x07060302u);
            acc[4 * dc + 0] = __builtin_amdgcn_sdot4((int)f0, c4[b4], acc[4 * dc + 0], false);
            acc[4 * dc + 1] = __builtin_amdgcn_sdot4((int)f1, c4[b4], acc[4 * dc + 1], false);
            acc[4 * dc + 2] = __builtin_amdgcn_sdot4((int)f2, c4[b4], acc[4 * dc + 2], false);
            acc[4 * dc + 3] = __builtin_amdgcn_sdot4((int)f3, c4[b4], acc[4 * dc + 3], false);
        }
    }
#pragma unroll
    for (int j = 0; j < 8; ++j) { const bool up = (lane & 32) != 0; const int send = up ? acc[j] : acc[j + 8]; const int keep = up ? acc[j + 8] : acc[j]; acc[j] = keep + __shfl_xor(send, 32); }
#pragma unroll
    for (int j = 0; j < 4; ++j) { const bool up = (lane & 16) != 0; const int send = up ? acc[j] : acc[j + 4]; const int keep = up ? acc[j + 4] : acc[j]; acc[j] = keep + __shfl_xor(send, 16); }
#pragma unroll
    for (int j = 0; j < 2; ++j) { const bool up = (lane & 8) != 0; const int send = up ? acc[j] : acc[j + 2]; const int keep = up ? acc[j + 2] : acc[j]; acc[j] = keep + __shfl_xor(send, 8); }
    const int j0 = 2 * ((lane >> 3) & 1) + 4 * ((lane >> 4) & 1) + 8 * ((lane >> 5) & 1);
    *(unsigned*)(yrow + j0) = pk2((float)acc[0] * cscale, (float)acc[1] * cscale);
}
__device__ __forceinline__ void peer_v_slice(const Params& p, int xs, int wid, int wstride, int lane) {
    const int* RI = (const int*)(p.ws + WS_RI);
    const unsigned char* VQ = (const unsigned char*)(p.ws + WS_VQ);
    const signed char* PC = (const signed char*)(p.ws + WS_PC); const float* PCS = (const float*)(p.ws + WS_PCS);
    bf16* Y = (bf16*)(p.ws + WS_Y);
    const int g = lane >> 3, q = lane & 7, loff = 128 * xs + 16 * q;
    const unsigned char* VQs = VQ + (size_t)xs * (16384 * 128) + 16 * q;
    const int ngrp = (NT / PEER_TPW - wid + wstride - 1) / wstride, N = ngrp * PEER_TPW;
    if (N <= 0) return;
    int ee[16]; uint4 vA[16], vB[16]; int4 cA, cB; float oA, oB;
#define PV_E(E, t) do { const int4* rp_ = (const int4*)(RI + (size_t)(t) * 128 + 16 * g); _Pragma("unroll") for (int b4 = 0; b4 < 4; ++b4) { const int4 r_ = rp_[b4]; E[4 * b4] = r_.x; E[4 * b4 + 1] = r_.y; E[4 * b4 + 2] = r_.z; E[4 * b4 + 3] = r_.w; } } while (0)
#define PV_U(V, C, O, E, t) do { O = PCS[(t)]; C = *(const int4*)(PC + (size_t)(t) * 128 + 16 * g); _Pragma("unroll") for (int bt = 0; bt < 16; ++bt) V[bt] = *(const uint4*)(VQs + (size_t)E[bt] * 128); } while (0)
    PV_E(ee, TK(0)); PV_U(vA, cA, oA, ee, TK(0)); PV_E(ee, TK(1));
#pragma unroll 1
    for (int i = 0; i < N; i += 2) {
        PV_U(vB, cB, oB, ee, TK(i + 1));
        if (i + 2 < N) PV_E(ee, TK(i + 2));
        asm volatile("" ::: "memory");
        peer_v_token(vA, cA, oA, Y + (size_t)TK(i) * DM + loff, lane);
        if (i + 2 < N) PV_U(vA, cA, oA, ee, TK(i + 2));
        if (i + 3 < N) PV_E(ee, TK(i + 3));
        asm volatile("" ::: "memory");
        peer_v_token(vB, cB, oB, Y + (size_t)TK(i + 1) * DM + loff, lane);
    }
#undef PV_E
#undef PV_U
#undef TK
}
__device__ __forceinline__ void up4(const uint2 w, float* o) { o[0] = __uint_as_float(w.x << 16); o[1] = __uint_as_float(w.x & 0xffff0000u); o[2] = __uint_as_float(w.y << 16); o[3] = __uint_as_float(w.y & 0xffff0000u); }
__device__ __forceinline__ void peer_ln_token(const Params& p, int li, int t, int lane) {
    const bf16* E = (const bf16*)(p.ws + WS_E); bf16* XB = (bf16*)(p.ws + WS_XB); const bf16* Y = (const bf16*)(p.ws + WS_Y);
    float4 v[4]; float s = 0.f;
#pragma unroll
    for (int j = 0; j < 4; ++j) {
        const size_t o = (size_t)t * DM + 256 * j + 4 * lane;
        float x[4], y[4], e[4]; up4(*(const uint2*)(XB + o), x); up4(*(const uint2*)(Y + o), y); up4(*(const uint2*)(E + o), e);
        v[j].x = DN_ALPHA * x[0] + y[0] + e[0]; v[j].y = DN_ALPHA * x[1] + y[1] + e[1]; v[j].z = DN_ALPHA * x[2] + y[2] + e[2]; v[j].w = DN_ALPHA * x[3] + y[3] + e[3];
        s += (v[j].x + v[j].y) + (v[j].z + v[j].w);
    }
    const float mean = wave_sum(s) * (1.0f / DM);
    float s2 = 0.f;
#pragma unroll
    for (int j = 0; j < 4; ++j) { v[j].x -= mean; v[j].y -= mean; v[j].z -= mean; v[j].w -= mean; s2 += (v[j].x * v[j].x + v[j].y * v[j].y) + (v[j].z * v[j].z + v[j].w * v[j].w); }
    const float rstd = 1.0f / sqrtf(wave_sum(s2) * (1.0f / DM) + LN_EPS);
    const float* g2 = p.ln2_g + li * DM; const float* b2 = p.ln2_b + li * DM;
#pragma unroll
    for (int j = 0; j < 4; ++j) {
        const float4 gg = *(const float4*)(g2 + 256 * j + 4 * lane), bv = *(const float4*)(b2 + 256 * j + 4 * lane);
        const float4 o = make_float4(v[j].x * rstd * gg.x + bv.x, v[j].y * rstd * gg.y + bv.y, v[j].z * rstd * gg.z + bv.z, v[j].w * rstd * gg.w + bv.w);
        if (li == 0) *(uint2*)(XB + (size_t)t * DM + 256 * j + 4 * lane) = make_uint2(pk2(o.x, o.y), pk2(o.z, o.w));
        else *(float4*)(p.out + (size_t)t * DM + 256 * j + 4 * lane) = o;
    }
}

constexpr int PH_PER_LAYER = 12, NPHASE = 1 + 2 * PH_PER_LAYER;

#ifndef PROBE_DUP
#define PROBE_DUP 0
#endif
#define PH_BEGIN(k) if (lo <= (k) && (k) < hi && ((k) == 0 || PHON(((k) - 1) % PH_PER_LAYER))) for (int rep_ = 0; rep_ < (((k) > 0 && ((PROBE_DUP >> (((k) - 1) % PH_PER_LAYER)) & 1)) ? 2 : 1); ++rep_) { unsigned long long probe_t0 = 0; if ((PROBE_T >> PH_BIT(k)) & 1) probe_t0 = __builtin_amdgcn_s_memrealtime();
#define PH_SYNC_DUP() do { if (rep_ == 0) { asm volatile("s_waitcnt vmcnt(0)" ::: "memory"); __syncthreads(); } } while (0)
#ifndef PROBE_T
#define PROBE_T 0
#endif
#define PH_BIT(k) ((k) == 0 ? 15 : (((k) - 1) % PH_PER_LAYER))
#define PH_END(k) if ((k) + 1 < hi) xcd_barrier(bar); if ((PROBE_T >> PH_BIT(k)) & 1) { const unsigned long long tn_ = __builtin_amdgcn_s_memrealtime(); probe_ticks += tn_ - probe_t0; } }

template <int LI>
__device__ __forceinline__ void run_layer(const Params& p, float* lds, const XcdBarrier& bar, int lo, int hi, unsigned long long& probe_ticks, unsigned rank) {
    constexpr int li = LI, base = 1 + LI * PH_PER_LAYER;
    const int tid = threadIdx.x, lane = tid & 63, wave = __builtin_amdgcn_readfirstlane(tid >> 6);
    const int G = gridDim.x;
    float* stream = p.out;
    LAS unsigned char* ldsb = (LAS unsigned char*)lds;
    PH_BEGIN(base + 0)
        EpiZ16 e{(bf16*)(p.ws + WS_Z), (float*)(p.ws + WS_GATES), (const float*)(p.ws + WS_ACOS), (const float*)(p.ws + WS_ASIN)};
        gemm16(ldsb, (const bf16*)(p.ws + WS_XB), (const bf16*)(p.ws + WS_WIN) + (size_t)li * NZP * DM, NZP, DM, e);
    PH_END(base + 0)
    PH_BEGIN(base + 1)
        for (int it = blockIdx.x; it < 1024 + 1536; it += G) {
            if (it < 512) ret_state_u(p, 2 * it + (wave >> 2), ldsb + (wave >> 2) * UNIT_LDS, wave & 3, tid & 255, lane);
            else if (it < 1024) mls_state_u(p, li, 2 * (it - 512) + (wave >> 2), ldsb + (wave >> 2) * UNIT_LDS, wave & 3, tid & 255, lane);
            else attn_unit(p, it - 1024, ldsb);
        }
    PH_END(base + 1)
    PH_BEGIN(base + 2)
        p3_scans(p);
        attn_merge(p);
    PH_END(base + 2)
    PH_BEGIN(base + 3)
        for (int it = blockIdx.x; it < 1024; it += G) {
            if (it < 512) ret_out_u(p, li, 2 * it + (wave >> 2), ldsb + (wave >> 2) * UNIT_LDS, wave & 3, tid & 255, lane);
            else mls_out_u(p, li, 2 * (it - 512) + (wave >> 2), ldsb + (wave >> 2) * UNIT_LDS, wave & 3, tid & 255, lane);
        }
    PH_END(base + 3)
    PH_BEGIN(base + 4)
        EpiRes16 e{(const bf16*)(p.ws + WS_XB), (bf16*)(p.ws + WS_U16)};
        gemm16(ldsb, (const bf16*)(p.ws + WS_MIX), (const bf16*)(p.ws + WS_WOUT) + (size_t)li * DM * DM, DM, DM, e);
    PH_END(base + 4)
    PH_BEGIN(base + 5)
        for (int r = blockIdx.x * NWAVE + wave; r < NT; r += G * NWAVE) ln_row_inplace((const bf16*)(p.ws + WS_U16) + (size_t)r * DM, (bf16*)(p.ws + WS_XB) + (size_t)r * DM, (signed char*)(p.ws + WS_X1Q) + (size_t)r * DM, (float*)(p.ws + WS_X1S) + r, p.ln1_g + li * DM, p.ln1_b + li * DM, lane);
        quant_rows<true>(p.pu + (size_t)li * 16384 * 1024, (unsigned char*)(p.ws + WS_UQ), (float*)(p.ws + WS_US), lane, blockIdx.x * NWAVE + wave, G * NWAVE);
        quant_rows<true>(p.pv + (size_t)li * 16384 * 1024, (unsigned char*)(p.ws + WS_VQ), (float*)(p.ws + WS_VS), lane, blockIdx.x * NWAVE + wave, G * NWAVE);
        EpiBf16Store e{(bf16*)(p.ws + WS_E), DM};
        gemm16(ldsb, (const bf16*)(p.ws + WS_PB) + (size_t)li * NT * 256, (const bf16*)(p.ws + WS_WP) + (size_t)li * DM * 256, DM, 256, e);
    PH_END(base + 5)
    PH_BEGIN(base + 6)
        EpiBf16Store eq{(bf16*)(p.ws + WS_QRY), 2048};
        gemm16(ldsb, (const bf16*)(p.ws + WS_XB), (const bf16*)(p.ws + WS_WQ) + (size_t)li * 2048 * DM, 2048, DM, eq);
        EpiGate16 eg{(bf16*)(p.ws + WS_E), p.bg + li * DM};
        gemm16(ldsb, (const bf16*)(p.ws + WS_XB), (const bf16*)(p.ws + WS_WG) + (size_t)li * DM * DM, DM, DM, eg);
    PH_END(base + 6)
    PH_BEGIN(base + 7)
        for (int it = blockIdx.x; it < (NT / 256) * 8; it += G) topk_unit(p, li, it, ldsb);
    PH_END(base + 7)
    PH_BEGIN(base + 8)
        const SlicePlan sp = slice_plan(p, rank, wave);
        for (int xs = 0; xs < 8; ++xs) if ((xs % sp.m) == sp.mi) peer_u_slice(p, xs, sp.wid, sp.wstride, lane);
    PH_END(base + 8)
    PH_BEGIN(base + 9)
        for (int t = blockIdx.x * NWAVE + wave; t < NT; t += G * NWAVE) peer_coef_token(p, t, lane);
    PH_END(base + 9)
    PH_BEGIN(base + 10)
        const SlicePlan sp = slice_plan(p, rank, wave);
        for (int xs = 0; xs < 8; ++xs) if ((xs % sp.m) == sp.mi) peer_v_slice(p, xs, sp.wid, sp.wstride, lane);
    PH_END(base + 10)
    PH_BEGIN(base + 11)
        for (int t = blockIdx.x * NWAVE + wave; t < NT; t += G * NWAVE) peer_ln_token(p, li, t, lane);
    PH_END(base + 11)
}

__global__ void __launch_bounds__(NTHR, 2) mk_fwd(Params p) {
    extern __shared__ __attribute__((aligned(16))) unsigned char lds_raw[];
    float* lds = (float*)lds_raw;
    const int tid = threadIdx.x;
    volatile LAS unsigned* MISC = (volatile LAS unsigned*)((LAS unsigned char*)lds_raw + LDS_CTL_OFF);
    if (tid < 64) MISC[tid] = 0u;
    __syncthreads();
    const int lo = p.ph_lo, hi = p.ph_hi;
    XcdBarrier bar; bar.bar = (unsigned*)(p.ws + WS_CTL) + 1024; bar.x = 0; bar.st = nullptr;
    if (hi - lo > 1) bar = xcd_barrier_post((unsigned*)(p.ws + WS_CTL) + 1024, MISC + 8);
    __syncthreads();
    const unsigned rank = MISC[10];
    unsigned long long probe_ticks = 0;
    PH_BEGIN(0)
        p0_tables(p);
        p0_weights(p, lds);
    PH_END(0)
    run_layer<0>(p, lds, bar, lo, hi, probe_ticks, rank);
    run_layer<1>(p, lds, bar, lo, hi, probe_ticks, rank);
    if (PROBE_T) { const unsigned long long te_ = __builtin_amdgcn_s_memrealtime(); while (__builtin_amdgcn_s_memrealtime() - te_ < probe_ticks) __builtin_amdgcn_s_sleep(8); }
}

extern "C" void kernel_launch(void* const* d_in, const int* in_sizes, int n_in, void* d_out, int out_size, void* d_ws, size_t ws_size, hipStream_t stream) {
    static int grid = 0;
    if (grid == 0) {
        if (n_in != 19 || in_sizes[0] != NT * DM || out_size != NT * DM || ws_size < WS_END) { fprintf(stderr, "kernel_launch: unexpected shapes (n_in %d in0 %d out %d ws %zu)\n", n_in, n_in > 0 ? in_sizes[0] : -1, out_size, ws_size); grid = -1; return; }
        int dev = 0, cus = 0;
        if (hipGetDevice(&dev) != hipSuccess || hipDeviceGetAttribute(&cus, hipDeviceAttributeMultiprocessorCount, dev) != hipSuccess) { grid = -1; return; }
        if (hipFuncSetAttribute((const void*)mk_fwd, hipFuncAttributeMaxDynamicSharedMemorySize, LDS_BYTES) != hipSuccess) { fprintf(stderr, "kernel_launch: hipFuncSetAttribute failed\n"); grid = -1; return; }
        int per_cu = 0;
        if (hipOccupancyMaxActiveBlocksPerMultiprocessor(&per_cu, (const void*)mk_fwd, NTHR, LDS_BYTES) != hipSuccess || per_cu < 1) fprintf(stderr, "kernel_launch: occupancy query says %d\n", per_cu);
        (void)hipGetLastError();
        grid = cus;
    }
    if (grid < 0) return;
    if (hipMemsetAsync((char*)d_ws + WS_CTL, 0, CTL_ZERO_BYTES, stream) != hipSuccess) return;
    Params a{};
    a.x = (const float*)d_in[0]; a.p = (const float*)d_in[1]; a.w_in = (const float*)d_in[2]; a.conv_w = (const float*)d_in[3]; a.b_if = (const float*)d_in[4];
    a.ret_g = (const float*)d_in[5]; a.mls_g = (const float*)d_in[6]; a.w_out = (const float*)d_in[7]; a.ln1_g = (const float*)d_in[8]; a.ln1_b = (const float*)d_in[9];
    a.wq = (const float*)d_in[10]; a.keys = (const float*)d_in[11]; a.pu = (const float*)d_in[12]; a.pv = (const float*)d_in[13]; a.wg = (const float*)d_in[14];
    a.bg = (const float*)d_in[15]; a.wp = (const float*)d_in[16]; a.ln2_g = (const float*)d_in[17]; a.ln2_b = (const float*)d_in[18];
    a.out = (float*)d_out; a.ws = (unsigned char*)d_ws;
#if MK_SPLIT
    for (int ph = 0; ph < NPHASE; ++ph) { a.ph_lo = ph; a.ph_hi = ph + 1; hipLaunchKernelGGL(mk_fwd, dim3(grid), dim3(NTHR), LDS_BYTES, stream, a); }
#else
    a.ph_lo = 0; a.ph_hi = NPHASE;
    hipLaunchKernelGGL(mk_fwd, dim3(grid), dim3(NTHR), LDS_BYTES, stream, a);
#endif
}
```

```cpp
#include <hip/hip_runtime.h>
#include <cstdio>
#include <cstdint>
#include <cmath>

#ifndef MK_SPLIT
#define MK_SPLIT 0
#endif

#ifndef ONLY
#define ONLY -1
#endif
#ifndef PMASK
#define PMASK 0xfff
#endif
#define PHON(k) ((ONLY < 0 || ONLY == (k)) && ((PMASK >> (k)) & 1))
#define LAS __attribute__((address_space(3)))
typedef unsigned short bf16;
#ifndef PROBE_R
#define PROBE_R 0
#endif
#define RGN_T0(id) unsigned long long rgn_t0_##id = 0; if (PROBE_R == (id) && threadIdx.x == 0) rgn_t0_##id = __builtin_amdgcn_s_memrealtime();
#define RGN_T1(id, ldsbase) if (PROBE_R == (id) && threadIdx.x == 0) { volatile LAS unsigned* w_ = (volatile LAS unsigned*)((LAS unsigned char*)(ldsbase) + 159 * 1024 + 128); w_[0] = w_[0] + (unsigned)(__builtin_amdgcn_s_memrealtime() - rgn_t0_##id); }

#define XB_TMO      128
#define XB_XCNT(j)  (256  + 64 * (j))
#define XB_XSUB(j)  (1280 + 64 * (j))
#define XB_XGEN(j)  (2304 + 64 * (j))
#define XB_TOP      3328
#define XB_TOPGEN   3392
#define XCD_BAR_WORDS 3456
#define XB_SPIN_CAP (1u << 22)

__device__ __forceinline__ unsigned xb_ld(unsigned* p)              { return __hip_atomic_load(p, __ATOMIC_RELAXED, __HIP_MEMORY_SCOPE_AGENT); }
__device__ __forceinline__ unsigned xb_add(unsigned* p, unsigned v) { return __hip_atomic_fetch_add(p, v, __ATOMIC_RELAXED, __HIP_MEMORY_SCOPE_AGENT); }
__device__ __forceinline__ unsigned xb_xcc_id() { return (unsigned)__builtin_amdgcn_s_getreg((3 << 11) | 20) & 0xFu; }
#define XB_SPIN(cond, bar) do { unsigned _sp = 0; while (cond) { __builtin_amdgcn_s_sleep(1); \
    if ((++_sp & 255u) == 0u) { if (xb_ld(&(bar)[XB_TMO])) break; if (_sp > XB_SPIN_CAP) { atomicAdd(&(bar)[XB_TMO], 1u); break; } } } } while (0)

struct XcdBarrier { unsigned* bar; unsigned x; volatile LAS unsigned* st; };

__device__ __forceinline__ XcdBarrier xcd_barrier_post(unsigned* bar, volatile LAS unsigned* st) {
    XcdBarrier b; b.bar = bar; b.x = xb_xcc_id(); b.st = st;
    if (threadIdx.x == 0) st[2] = xb_add(&bar[XB_XCNT(b.x)], 1u);
    return b;
}
__device__ __forceinline__ void xcd_barrier_complete(unsigned* bar, unsigned x, unsigned& nloc, unsigned& nx) {
    const unsigned G = gridDim.x * gridDim.y * gridDim.z;
    unsigned sum, cnt, mine, sp = 0u;
    for (;;) {
        sum = 0u; cnt = 0u; mine = 0u;
#pragma unroll
        for (unsigned j = 0; j < 16; ++j) { const unsigned c = xb_ld(&bar[XB_XCNT(j)]); sum += c; cnt += (c > 0u) ? 1u : 0u; mine = (j == x) ? c : mine; }
        if (sum == G) break;
        __builtin_amdgcn_s_sleep(1);
        if ((++sp & 255u) == 0u) { if (xb_ld(&bar[XB_TMO])) break; if (sp > XB_SPIN_CAP) { atomicAdd(&bar[XB_TMO], 1u); break; } }
    }
    nloc = mine > 0u ? mine : 1u; nx = cnt > 0u ? cnt : 1u;
}
__device__ __forceinline__ void xcd_barrier(const XcdBarrier& b) {
    asm volatile("s_waitcnt vmcnt(0)" ::: "memory");
    __syncthreads();
    if (threadIdx.x == 0) {
        unsigned* bar = b.bar;
        __builtin_amdgcn_s_waitcnt(0);
        unsigned nloc = b.st[0], nx = b.st[1];
        if (nloc == 0u) { xcd_barrier_complete(bar, b.x, nloc, nx); b.st[0] = nloc; b.st[1] = nx; }
        const unsigned old = xb_add(&bar[XB_XSUB(b.x)], 1u);
        const unsigned gen = old / nloc;
        if (old + 1u == (gen + 1u) * nloc) {
            __builtin_amdgcn_fence(__ATOMIC_RELEASE, "agent");
            asm volatile("s_waitcnt vmcnt(0)" ::: "memory");
            const unsigned og = xb_add(&bar[XB_TOP], 1u);
            const unsigned tg = og / nx;
            if (og + 1u == (tg + 1u) * nx) xb_add(&bar[XB_TOPGEN], 1u);
            else XB_SPIN(xb_ld(&bar[XB_TOPGEN]) == tg, bar);
            __builtin_amdgcn_fence(__ATOMIC_ACQUIRE, "agent");
            xb_add(&bar[XB_XGEN(b.x)], 1u);
            asm volatile("s_waitcnt vmcnt(0)" ::: "memory");
        } else {
            XB_SPIN(xb_ld(&bar[XB_XGEN(b.x)]) == gen, bar);
            __builtin_amdgcn_fence(__ATOMIC_ACQUIRE, "agent");
            asm volatile("s_waitcnt vmcnt(0)" ::: "memory");
        }
    }
    __syncthreads();
}

namespace pg8 {
#define PG8_LAS __attribute__((address_space(3)))
typedef unsigned short bf16_t;
typedef short bf16x8 __attribute__((ext_vector_type(8)));
typedef float f32x4 __attribute__((ext_vector_type(4)));
typedef unsigned u32x4 __attribute__((ext_vector_type(4)));
constexpr int BM = 256, BK = 64, HALF = 128, HTB = HALF * BK * 2  , STAGE_BYTES = 8 * HTB, NXCD = 8, WGM = 8;

__host__ __device__ __forceinline__ int lds_byte(int r, int c) { const int st = (r >> 4) * 2 + (c >> 5), rr = r & 15, cc = c & 31, ob = rr * 64 + cc * 2; return st * 1024 + (ob ^ (((ob >> 9) & 1) << 5)); }
__host__ __device__ __forceinline__ void stage_rc(int b, int& R, int& C) { const int st = b / 1024, sb = b % 1024, swz = sb ^ (((sb >> 9) & 1) << 5); R = (st >> 1) * 16 + swz / 64; C = (st & 1) * 32 + (swz % 64) / 2; }
__host__ __device__ __forceinline__ int perm32(int rho) { const int n = rho >> 4, i = rho & 15; return 8 * (i >> 2) + 4 * n + (i & 3); }

struct Unit { int pm, pn; };
struct Gemm { const bf16_t* A; const bf16_t* Bt; int M, N, K; };

struct StaticOrder {
    int nM, nN, nwg, G, c;
    __host__ __device__ void init(int M, int N, int G_, int c_) { nM = M / BM; nN = N / BM; nwg = nM * nN; G = G_; c = c_; }
    __host__ __device__ bool next(int i, Unit& u) const {
        const long L = (long)i * G + c; if (L >= nwg) return false;
        int wgid = (int)L; { const int q = nwg / NXCD, r = nwg % NXCD, xcd = wgid % NXCD, off = wgid / NXCD; wgid = (xcd < r ? xcd * (q + 1) : r * (q + 1) + (xcd - r) * q) + off; }
        const int nig = WGM * nN, gid = wgid / nig, fm = gid * WGM, gsz = (nM - fm) < WGM ? (nM - fm) : WGM;
        u.pm = fm + ((wgid % nig) % gsz); u.pn = (wgid % nig) / gsz; return true;
    }
    __device__ __forceinline__ void a_ready(const Unit&) const {}
    __device__ __forceinline__ void done(const Unit&) const {}
};

__device__ __forceinline__ unsigned cvt_pk_bf16(float lo, float hi) { unsigned r; asm volatile("v_cvt_pk_bf16_f32 %0, %1, %2" : "=v"(r) : "v"(lo), "v"(hi)); return r; }
template <class Epi, class Sched, bool ALIGN_EPI = false, bool SP2 = false>
__device__ __forceinline__ void gemm_phase(PG8_LAS unsigned char* lds, const Gemm g, const Sched& S, const Epi& E) {
    const int tid = threadIdx.x, wid = __builtin_amdgcn_readfirstlane(tid >> 6), lane = tid & 63, wr = wid >> 2, wc = wid & 3, fr = lane & 15, fq = lane >> 4;
    const int K = g.K, nt = K / BK;
    unsigned voffA[2], voffB[2];
#pragma unroll
    for (int i = 0; i < 2; ++i) { int R, C; stage_rc(tid * 16 + i * 8192, R, C); const int Rb = Epi::PERM ? ((R & ~31) + perm32(R & 31)) : R;
        voffA[i] = (unsigned)(R * K + C) * 2u; voffB[i] = (unsigned)(Rb * K + C) * 2u; }
    const size_t kstep = (size_t)(BK * 2);
    const size_t hstep = (size_t)HALF * K * 2;
    const size_t tstep = 2 * hstep;
    const unsigned ldsw = (unsigned)wid * 1024u;
    const int aoff = lds_byte(wr * 64 + fr, fq * 8), boff = lds_byte(wc * 32 + fr, fq * 8);
#define PG8_SA(b, h) (((b) * 2 + (h)) * HTB)
#define PG8_SB(b, h) ((4 + (b) * 2 + (h)) * HTB)
#define PG8_STAGE(bufoff, gbase, voff) do { _Pragma("unroll") for (int _i = 0; _i < 2; ++_i) \
        __builtin_amdgcn_global_load_lds((const unsigned*)((const char*)(gbase) + (voff)[_i]), (PG8_LAS unsigned*)(lds + (bufoff) + ldsw + _i * 8192), 16, 0, 0); } while (0)
#define PG8_LDA(dst, b, h) do { _Pragma("unroll") for (int m = 0; m < 4; ++m) _Pragma("unroll") for (int k = 0; k < 2; ++k) dst[m][k] = *(const PG8_LAS bf16x8*)(lds + PG8_SA(b, h) + aoff + m * 2048 + k * 1024); } while (0)
#define PG8_LDB(dst, b, h) do { _Pragma("unroll") for (int n = 0; n < 2; ++n) _Pragma("unroll") for (int k = 0; k < 2; ++k) dst[n][k] = *(const PG8_LAS bf16x8*)(lds + PG8_SB(b, h) + boff + n * 2048 + k * 1024); } while (0)
#define PG8_MMA(ai, bj, At, Bt) do { __builtin_amdgcn_s_setprio(1); _Pragma("unroll") for (int m = 0; m < 4; ++m) _Pragma("unroll") for (int n = 0; n < 2; ++n) _Pragma("unroll") for (int k = 0; k < 2; ++k) \
        acc[ai][bj][m][n] = __builtin_amdgcn_mfma_f32_16x16x32_bf16(Bt[n][k], At[m][k], acc[ai][bj][m][n], 0, 0, 0); __builtin_amdgcn_s_setprio(0); } while (0)
#define PG8_WAIT_V(n) asm volatile("s_waitcnt vmcnt(" #n ")" ::: "memory")
#define PG8_WAIT_L(n) asm volatile("s_waitcnt lgkmcnt(" #n ")" ::: "memory")
#define PG8_BAR __builtin_amdgcn_s_barrier()
#define PG8_SCHED __builtin_amdgcn_sched_barrier(0)
    Unit cur, nxt; int ui = 0;
    if (!S.next(0, cur)) return;
    f32x4 acc[2][2][4][2];
#pragma unroll
    for (int a = 0; a < 2; ++a)
#pragma unroll
        for (int b = 0; b < 2; ++b)
#pragma unroll
            for (int m = 0; m < 4; ++m)
#pragma unroll
                for (int n = 0; n < 2; ++n) acc[a][b][m][n] = (f32x4){0.f, 0.f, 0.f, 0.f};
    bf16x8 At[4][2], B0[2][2], B1[2][2];
    const char* cA = (const char*)g.A + (size_t)cur.pm * tstep; const char* cB = (const char*)g.Bt + (size_t)cur.pn * tstep;
    S.a_ready(cur);
    if constexpr (SP2) {
        PG8_STAGE(PG8_SB(0, 0), cB, voffB); PG8_STAGE(PG8_SB(0, 1), cB + hstep, voffB); PG8_STAGE(PG8_SA(0, 0), cA, voffA); PG8_STAGE(PG8_SA(0, 1), cA + hstep, voffA);
        if (wr == 1) PG8_BAR;
        PG8_WAIT_V(2); PG8_BAR;
        PG8_STAGE(PG8_SB(1, 0), cB + kstep, voffB); PG8_STAGE(PG8_SA(1, 0), cA + kstep, voffA); PG8_STAGE(PG8_SB(1, 1), cB + hstep + kstep, voffB);
        PG8_WAIT_V(6); PG8_BAR;
    } else {
        PG8_STAGE(PG8_SB(0, 0), cB, voffB); PG8_STAGE(PG8_SA(0, 0), cA, voffA); PG8_STAGE(PG8_SB(0, 1), cB + hstep, voffB); PG8_STAGE(PG8_SA(0, 1), cA + hstep, voffA);
        if (wr == 1) PG8_BAR;
        PG8_WAIT_V(4); PG8_BAR;
        PG8_STAGE(PG8_SB(1, 0), cB + kstep, voffB); PG8_STAGE(PG8_SA(1, 0), cA + kstep, voffA); PG8_STAGE(PG8_SB(1, 1), cB + hstep + kstep, voffB);
        PG8_WAIT_V(6); PG8_BAR;
    }
    for (;;) {
        const bool has_next = S.next(ui + 1, nxt);
        const char* nA = has_next ? (const char*)g.A + (size_t)nxt.pm * tstep : cA; const char* nB = has_next ? (const char*)g.Bt + (size_t)nxt.pn * tstep : cB;
        for (int t = 0; t < nt; t += 2) {
            const bool last = (t == nt - 2);
            const char* a1 = cA + (size_t)(t + 1) * kstep;
            const char* a2 = last ? nA : cA + (size_t)(t + 2) * kstep; const char* b2 = last ? nB : cB + (size_t)(t + 2) * kstep;
            const char* a3 = a2 + kstep; const char* b3 = b2 + kstep;
            if (last && has_next) S.a_ready(nxt);
            if constexpr (SP2) {
            PG8_LDB(B0, 0, 0); PG8_LDB(B1, 0, 1); PG8_SCHED; PG8_LDA(At, 0, 0); PG8_STAGE(PG8_SA(1, 1), a1 + hstep, voffA);
            PG8_WAIT_V(8); PG8_WAIT_L(0); PG8_BAR; PG8_MMA(0, 0, At, B0); PG8_MMA(0, 1, At, B1); PG8_BAR; PG8_SCHED;
            PG8_LDA(At, 0, 1); PG8_STAGE(PG8_SB(0, 0), b2, voffB); PG8_STAGE(PG8_SB(0, 1), b2 + hstep, voffB); PG8_STAGE(PG8_SA(0, 0), a2, voffA);
            PG8_WAIT_V(8); PG8_WAIT_L(0); PG8_BAR; PG8_MMA(1, 0, At, B0); PG8_MMA(1, 1, At, B1); PG8_BAR; PG8_SCHED;
            PG8_LDB(B0, 1, 0); PG8_LDB(B1, 1, 1); PG8_SCHED; PG8_LDA(At, 1, 0); PG8_STAGE(PG8_SA(0, 1), a2 + hstep, voffA);
            PG8_WAIT_V(8); PG8_WAIT_L(0); PG8_BAR; PG8_MMA(0, 0, At, B0); PG8_MMA(0, 1, At, B1); PG8_BAR; PG8_SCHED;
            PG8_LDA(At, 1, 1); PG8_STAGE(PG8_SB(1, 0), b3, voffB); PG8_STAGE(PG8_SB(1, 1), b3 + hstep, voffB); PG8_STAGE(PG8_SA(1, 0), a3, voffA);
            PG8_WAIT_V(8); PG8_WAIT_L(0); PG8_BAR; PG8_MMA(1, 0, At, B0); PG8_MMA(1, 1, At, B1); PG8_BAR; PG8_SCHED;
            } else {
            PG8_LDB(B0, 0, 0); PG8_SCHED; PG8_LDA(At, 0, 0); PG8_STAGE(PG8_SA(1, 1), a1 + hstep, voffA);
            PG8_WAIT_L(8); PG8_BAR; PG8_WAIT_L(0); PG8_MMA(0, 0, At, B0); PG8_BAR; PG8_SCHED;
            PG8_LDB(B1, 0, 1); PG8_STAGE(PG8_SB(0, 0), b2, voffB);
            PG8_BAR; PG8_WAIT_L(0); PG8_MMA(0, 1, At, B1); PG8_BAR;
            PG8_LDA(At, 0, 1); PG8_STAGE(PG8_SA(0, 0), a2, voffA);
            PG8_BAR; PG8_WAIT_L(0); PG8_MMA(1, 0, At, B0); PG8_BAR; PG8_SCHED;
            PG8_STAGE(PG8_SB(0, 1), b2 + hstep, voffB);
            PG8_WAIT_V(6); PG8_BAR; PG8_MMA(1, 1, At, B1); PG8_BAR;
            PG8_LDB(B0, 1, 0); PG8_SCHED; PG8_LDA(At, 1, 0); PG8_STAGE(PG8_SA(0, 1), a2 + hstep, voffA);
            PG8_WAIT_L(8); PG8_BAR; PG8_WAIT_L(0); PG8_MMA(0, 0, At, B0); PG8_BAR; PG8_SCHED;
            PG8_LDB(B1, 1, 1); PG8_STAGE(PG8_SB(1, 0), b3, voffB);
            PG8_BAR; PG8_WAIT_L(0); PG8_MMA(0, 1, At, B1); PG8_BAR;
            PG8_LDA(At, 1, 1); PG8_STAGE(PG8_SA(1, 0), a3, voffA);
            PG8_BAR; PG8_WAIT_L(0); PG8_MMA(1, 0, At, B0); PG8_BAR; PG8_SCHED;
            PG8_STAGE(PG8_SB(1, 1), b3 + hstep, voffB);
            PG8_WAIT_V(6); PG8_BAR; PG8_MMA(1, 1, At, B1); PG8_BAR;
            }
        }
        if constexpr (ALIGN_EPI) { if (wr == 0) PG8_BAR; }
        if constexpr (!Epi::AFTER_DRAIN) { E(acc, cur, wr, wc, fr, fq); S.done(cur); }
        if (!has_next) break;
#pragma unroll
        for (int a = 0; a < 2; ++a)
#pragma unroll
            for (int b = 0; b < 2; ++b)
#pragma unroll
                for (int m = 0; m < 4; ++m)
#pragma unroll
                    for (int n = 0; n < 2; ++n) acc[a][b][m][n] = (f32x4){0.f, 0.f, 0.f, 0.f};
        cur = nxt; cA = nA; cB = nB; ++ui;
        if constexpr (ALIGN_EPI) { if (wr == 1) PG8_BAR; }
    }
    PG8_WAIT_V(0);
    if constexpr (!ALIGN_EPI) { if (wr == 0) PG8_BAR; }
    PG8_BAR;
    if constexpr (Epi::AFTER_DRAIN) { E.fused(acc, cur, wr, wc, fr, fq, lds, wid, lane); S.done(cur); }
#undef PG8_SA
#undef PG8_SB
#undef PG8_STAGE
#undef PG8_LDA
#undef PG8_LDB
#undef PG8_MMA
#undef PG8_WAIT_V
#undef PG8_WAIT_L
#undef PG8_BAR
#undef PG8_SCHED
}
}

constexpr int NB = 4, SEQ = 8192, NT = NB * SEQ, DM = 1024;
constexpr int ZW = 3328, NZ = 3336;
constexpr int C_RQ = 0, C_RK = 256, C_RV = 512, C_RG = 1024, C_AQ = 1536, C_AK = 1792, C_AV = 2048, C_MQ = 2304, C_MK = 2560, C_MV = 2816, C_MO = 3072;
constexpr float DN_ALPHA = 1.41421356237f;
constexpr float LN_EPS = 1e-5f;
constexpr int NTHR = 512, NWAVE = 8;
constexpr int LDS_BYTES = 160 * 1024;
constexpr int LDS_CTL_OFF = 159 * 1024;

constexpr size_t MiB = 1u << 20;
constexpr size_t WS_CTL = 0, CTL_ZERO_BYTES = 64 * 1024;
constexpr size_t WS_RCOS = 1 * MiB, WS_RSIN = 2 * MiB, WS_ACOS = 3 * MiB, WS_ASIN = 3 * MiB + 512 * 1024;
constexpr size_t WS_RST = 4 * MiB;
constexpr size_t WS_MC = 36 * MiB;
constexpr size_t WS_MN = 52 * MiB;
constexpr size_t WS_MA = 52 * MiB + 512 * 1024, WS_MML = WS_MA + 4096, WS_MMP = WS_MML + 4096;
constexpr size_t WS_GATES = 54 * MiB;
constexpr int NZP = 3584;
constexpr size_t WS_WIN = 56 * MiB;
constexpr size_t WS_WOUT = 70 * MiB;
constexpr size_t WS_WQG = 74 * MiB;
constexpr size_t WS_WP = 86 * MiB;
constexpr size_t WS_KEYS = 87 * MiB;
constexpr size_t WS_PB = 88 * MiB;
constexpr size_t WS_XB = 120 * MiB;
constexpr size_t WS_AO = 456 * MiB;
constexpr size_t WS_ALSE = 504 * MiB;
constexpr size_t WS_Z = 184 * MiB;
constexpr size_t WS_MIX = 392 * MiB;
constexpr size_t WS_U16 = 184 * MiB;
constexpr size_t WS_QRY = 184 * MiB;
constexpr size_t WS_E = 312 * MiB;
constexpr size_t WS_UQ = 376 * MiB, WS_VQ = 392 * MiB;
constexpr size_t WS_US = 408 * MiB, WS_VS = 408 * MiB + 65536;
constexpr size_t WS_X1Q = 4 * MiB;
constexpr size_t WS_X1S = 53 * MiB;
constexpr size_t WS_PC = 36 * MiB;
constexpr size_t WS_PCS = 53 * MiB + 256 * 1024;
constexpr size_t WS_PI = 184 * MiB;
constexpr size_t WS_Y = 184 * MiB;
constexpr int CW_PQ = 8192;
constexpr size_t WS_RI = 456 * MiB, WS_RG = 472 * MiB;
constexpr size_t WS_END = 506 * MiB;

struct Params {
    const float *x, *p, *w_in, *conv_w, *b_if, *ret_g, *mls_g, *w_out, *ln1_g, *ln1_b, *wq, *keys, *pu, *pv, *wg, *bg, *wp, *ln2_g, *ln2_b;
    float* out; unsigned char* ws; int ph_lo, ph_hi;
};

__device__ __forceinline__ float bf2f(bf16 h) { return __uint_as_float(((unsigned)h) << 16); }
__device__ __forceinline__ unsigned f2bf(float f) { unsigned u = __float_as_uint(f); return (u + 0x7fffu + ((u >> 16) & 1u)) >> 16; }
__device__ __forceinline__ unsigned pk2(float lo, float hi) { return f2bf(lo) | (f2bf(hi) << 16); }
__device__ __forceinline__ float wave_sum(float v) {
#pragma unroll
    for (int o = 1; o < 64; o <<= 1) v += __shfl_xor(v, o);
    return v;
}
__device__ __forceinline__ float wave_max(float v) {
#pragma unroll
    for (int o = 1; o < 64; o <<= 1) v = fmaxf(v, __shfl_xor(v, o));
    return v;
}
__device__ __forceinline__ float sigmoidf_(float x) { return __builtin_amdgcn_rcpf(1.f + __expf(-x)); }
__device__ __forceinline__ float siluf_(float x) { return x * __builtin_amdgcn_rcpf(1.f + __expf(-x)); }
__device__ __forceinline__ void unpack8(const uint4 v, float* o) {
    o[0] = __uint_as_float(v.x << 16); o[1] = __uint_as_float(v.x & 0xffff0000u);
    o[2] = __uint_as_float(v.y << 16); o[3] = __uint_as_float(v.y & 0xffff0000u);
    o[4] = __uint_as_float(v.z << 16); o[5] = __uint_as_float(v.z & 0xffff0000u);
    o[6] = __uint_as_float(v.w << 16); o[7] = __uint_as_float(v.w & 0xffff0000u);
}

template <class Epi>
__device__ __forceinline__ void gemm_tile_f32(const float* __restrict__ A, int lda, const float* __restrict__ W, int N, int K, int m0, int n0, float* lds, const Epi& epi) {
    float* As = lds; float* Bs = lds + 16 * 132;
    const int tid = threadIdx.x, ty = tid >> 4, tx = tid & 15;
    float acc[4][8];
#pragma unroll
    for (int i = 0; i < 4; ++i)
#pragma unroll
        for (int j = 0; j < 8; ++j) acc[i][j] = 0.f;
    const int arow = tid >> 2, akq = (tid & 3) * 4;
    const int bk = tid >> 5, bn = (tid & 31) * 4;
    const bool bvalid = (n0 + bn) < N;
    const float* ap = A + (size_t)(m0 + arow) * lda + akq;
    const float* bp = W + (size_t)bk * N + n0 + bn;
    for (int k0 = 0; k0 < K; k0 += 16) {
        const float4 av = *(const float4*)(ap + k0);
        float4 bv = make_float4(0.f, 0.f, 0.f, 0.f);
        if (bvalid) bv = *(const float4*)(bp + (size_t)k0 * N);
        __syncthreads();
        As[(akq + 0) * 132 + arow] = av.x; As[(akq + 1) * 132 + arow] = av.y; As[(akq + 2) * 132 + arow] = av.z; As[(akq + 3) * 132 + arow] = av.w;
        *(float4*)(Bs + bk * 128 + bn) = bv;
        __syncthreads();
#pragma unroll
        for (int k = 0; k < 16; ++k) {
            const float4 a = *(const float4*)(As + k * 132 + ty * 4);
            const float4 b0 = *(const float4*)(Bs + k * 128 + tx * 8);
            const float4 b1 = *(const float4*)(Bs + k * 128 + tx * 8 + 4);
            const float aa[4] = {a.x, a.y, a.z, a.w};
            const float bb[8] = {b0.x, b0.y, b0.z, b0.w, b1.x, b1.y, b1.z, b1.w};
#pragma unroll
            for (int i = 0; i < 4; ++i)
#pragma unroll
                for (int j = 0; j < 8; ++j) acc[i][j] = fmaf(aa[i], bb[j], acc[i][j]);
        }
    }
#pragma unroll
    for (int i = 0; i < 4; ++i) epi(m0 + ty * 4 + i, n0 + tx * 8, acc[i]);
    __syncthreads();
}

struct EpiZ {
    bf16* Z; float* gates;
    __device__ __forceinline__ void operator()(int row, int col0, const float (&v)[8]) const {
        if (col0 < ZW) { uint4 w; w.x = pk2(v[0], v[1]); w.y = pk2(v[2], v[3]); w.z = pk2(v[4], v[5]); w.w = pk2(v[6], v[7]); *(uint4*)(Z + (size_t)row * ZW + col0) = w; }
        else if (col0 == ZW) { float* g = gates + (size_t)row * 8; *(float4*)g = make_float4(v[0], v[1], v[2], v[3]); *(float4*)(g + 4) = make_float4(v[4], v[5], v[6], v[7]); }
    }
};
struct EpiRes {
    const float* xin; float* out;
    __device__ __forceinline__ void operator()(int row, int col0, const float (&v)[8]) const {
        const size_t o = (size_t)row * DM + col0;
        const float4 a = *(const float4*)(xin + o), b = *(const float4*)(xin + o + 4);
        *(float4*)(out + o) = make_float4(DN_ALPHA * a.x + v[0], DN_ALPHA * a.y + v[1], DN_ALPHA * a.z + v[2], DN_ALPHA * a.w + v[3]);
        *(float4*)(out + o + 4) = make_float4(DN_ALPHA * b.x + v[4], DN_ALPHA * b.y + v[5], DN_ALPHA * b.z + v[6], DN_ALPHA * b.w + v[7]);
    }
};
struct EpiStore {
    float* out; int ld;
    __device__ __forceinline__ void operator()(int row, int col0, const float (&v)[8]) const {
        const size_t o = (size_t)row * ld + col0;
        *(float4*)(out + o) = make_float4(v[0], v[1], v[2], v[3]); *(float4*)(out + o + 4) = make_float4(v[4], v[5], v[6], v[7]);
    }
};
struct EpiGate {
    float* E; const float* bg;
    __device__ __forceinline__ void operator()(int row, int col0, const float (&v)[8]) const {
        const size_t o = (size_t)row * DM + col0;
        float4 a = *(const float4*)(E + o), b = *(const float4*)(E + o + 4);
        a.x *= sigmoidf_(v[0] + bg[col0 + 0]); a.y *= sigmoidf_(v[1] + bg[col0 + 1]); a.z *= sigmoidf_(v[2] + bg[col0 + 2]); a.w *= sigmoidf_(v[3] + bg[col0 + 3]);
        b.x *= sigmoidf_(v[4] + bg[col0 + 4]); b.y *= sigmoidf_(v[5] + bg[col0 + 5]); b.z *= sigmoidf_(v[6] + bg[col0 + 6]); b.w *= sigmoidf_(v[7] + bg[col0 + 7]);
        *(float4*)(E + o) = a; *(float4*)(E + o + 4) = b;
    }
};

template <class Epi>
__device__ __forceinline__ void gemm_phase_f32(const float* A, int lda, const float* W, int N, int K, float* lds, const Epi& epi) {
    const int ntn = (N + 127) / 128, ntm = NT / 128, nit = ntn * ntm;
    for (int it = blockIdx.x; it < nit; it += gridDim.x) { const int mt = it / ntn, nt = it - mt * ntn; gemm_tile_f32(A, lda, W, N, K, mt * 128, nt * 128, lds, epi); }
}

typedef float f32x4 __attribute__((ext_vector_type(4)));
typedef unsigned u32x4 __attribute__((ext_vector_type(4)));
__device__ __forceinline__ void unpack8v(const u32x4 v, float* o) {
    o[0] = __uint_as_float(v.x << 16); o[1] = __uint_as_float(v.x & 0xffff0000u); o[2] = __uint_as_float(v.y << 16); o[3] = __uint_as_float(v.y & 0xffff0000u);
    o[4] = __uint_as_float(v.z << 16); o[5] = __uint_as_float(v.z & 0xffff0000u); o[6] = __uint_as_float(v.w << 16); o[7] = __uint_as_float(v.w & 0xffff0000u);
}
struct EpiZ16 {
    static constexpr bool PERM = true, AFTER_DRAIN = false;
    bf16* Z; float* gates; const float* acos_; const float* asin_;
    __device__ __forceinline__ void operator()(const f32x4 (&acc)[2][2][4][2], const pg8::Unit& u, int wr, int wc, int fr, int fq) const {
        const int row0 = u.pm * 256 + wr * 64 + fr;
        if (u.pn < 13) {
            const int col0 = u.pn * 256 + wc * 32 + 8 * fq;
            const bool rot = (u.pn == 6 || u.pn == 7) && ((wc & 1) == 0);
            const float qs = (u.pn == 6) ? 0.125f : 1.0f;
#pragma unroll
            for (int ai = 0; ai < 2; ++ai)
#pragma unroll
                for (int m = 0; m < 4; ++m) { const int row = row0 + ai * 128 + m * 16; bf16* rowp = Z + (size_t)row * ZW + col0;
#pragma unroll
                    for (int bj = 0; bj < 2; ++bj) { f32x4 v0 = acc[ai][bj][m][0], v1 = acc[ai][bj][m][1];
                        if (rot) {
                            f32x4 p0, p1;
#pragma unroll
                            for (int j = 0; j < 4; ++j) { p0[j] = __shfl_xor(v0[j], 16); p1[j] = __shfl_xor(v1[j], 16); }
                            if (fq < 2) {
                                const int pos = row & (SEQ - 1);
                                const f32x4 c0 = *(const f32x4*)(acos_ + pos * 8), c1 = *(const f32x4*)(acos_ + pos * 8 + 4), s0 = *(const f32x4*)(asin_ + pos * 8), s1 = *(const f32x4*)(asin_ + pos * 8 + 4);
                                const float sg = (fq == 0) ? -1.0f : 1.0f;
                                v0 = v0 * c0 + p0 * s0 * sg; v1 = v1 * c1 + p1 * s1 * sg;
                            }
                        }
                        v0 = v0 * qs; v1 = v1 * qs;
                        u32x4 w; w.x = pk2(v0[0], v0[1]); w.y = pk2(v0[2], v0[3]); w.z = pk2(v1[0], v1[1]); w.w = pk2(v1[2], v1[3]);
                        *(u32x4*)(rowp + bj * 128) = w; } }
        } else if (wc == 0 && fq == 0) {
#pragma unroll
            for (int ai = 0; ai < 2; ++ai)
#pragma unroll
                for (int m = 0; m < 4; ++m) { float* g = gates + (size_t)(row0 + ai * 128 + m * 16) * 8; *(f32x4*)g = acc[ai][0][m][0]; *(f32x4*)(g + 4) = acc[ai][0][m][1]; }
        }
    }
};
struct EpiBf16Store {
    static constexpr bool PERM = true, AFTER_DRAIN = false;
    bf16* O; int ldc;
    __device__ __forceinline__ void operator()(const f32x4 (&acc)[2][2][4][2], const pg8::Unit& u, int wr, int wc, int fr, int fq) const {
        const int row0 = u.pm * 256 + wr * 64 + fr, col0 = u.pn * 256 + wc * 32 + 8 * fq;
#pragma unroll
        for (int ai = 0; ai < 2; ++ai)
#pragma unroll
            for (int m = 0; m < 4; ++m) { bf16* rowp = O + (size_t)(row0 + ai * 128 + m * 16) * ldc + col0;
#pragma unroll
                for (int bj = 0; bj < 2; ++bj) { const f32x4 v0 = acc[ai][bj][m][0], v1 = acc[ai][bj][m][1];
                    u32x4 w; w.x = pk2(v0[0], v0[1]); w.y = pk2(v0[2], v0[3]); w.z = pk2(v1[0], v1[1]); w.w = pk2(v1[2], v1[3]);
                    *(u32x4*)(rowp + bj * 128) = w; } }
    }
};
struct EpiGate16 {
    static constexpr bool PERM = true, AFTER_DRAIN = false;
    bf16* E; const float* bg;
    __device__ __forceinline__ void operator()(const f32x4 (&acc)[2][2][4][2], const pg8::Unit& u, int wr, int wc, int fr, int fq) const {
        const int row0 = u.pm * 256 + wr * 64 + fr, col0 = u.pn * 256 + wc * 32 + 8 * fq;
#pragma unroll
        for (int bj = 0; bj < 2; ++bj) {
            const f32x4 b0 = *(const f32x4*)(bg + col0 + bj * 128), b1 = *(const f32x4*)(bg + col0 + bj * 128 + 4);
#pragma unroll
            for (int ai = 0; ai < 2; ++ai)
#pragma unroll
                for (int m = 0; m < 4; ++m) { bf16* ep = E + (size_t)(row0 + ai * 128 + m * 16) * DM + col0 + bj * 128;
                    float pp[8]; unpack8v(*(const u32x4*)ep, pp);
                    const f32x4 v0 = acc[ai][bj][m][0] + b0, v1 = acc[ai][bj][m][1] + b1;
                    u32x4 w; w.x = pk2(pp[0] * sigmoidf_(v0[0]), pp[1] * sigmoidf_(v0[1])); w.y = pk2(pp[2] * sigmoidf_(v0[2]), pp[3] * sigmoidf_(v0[3]));
                    w.z = pk2(pp[4] * sigmoidf_(v1[0]), pp[5] * sigmoidf_(v1[1])); w.w = pk2(pp[6] * sigmoidf_(v1[2]), pp[7] * sigmoidf_(v1[3]));
                    *(u32x4*)ep = w; }
        }
    }
};
struct EpiRes16 {
    static constexpr bool PERM = true, AFTER_DRAIN = false;
    const bf16* xinb; bf16* out;
    __device__ __forceinline__ void operator()(const f32x4 (&acc)[2][2][4][2], const pg8::Unit& u, int wr, int wc, int fr, int fq) const {
        const int row0 = u.pm * 256 + wr * 64 + fr, col0 = u.pn * 256 + wc * 32 + 8 * fq;
#pragma unroll
        for (int ai = 0; ai < 2; ++ai)
#pragma unroll
            for (int m = 0; m < 4; ++m) { const size_t ro = (size_t)(row0 + ai * 128 + m * 16) * DM + col0;
#pragma unroll
                for (int bj = 0; bj < 2; ++bj) { float xv[8]; unpack8v(*(const u32x4*)(xinb + ro + bj * 128), xv);
                    const f32x4 v0 = acc[ai][bj][m][0], v1 = acc[ai][bj][m][1];
                    u32x4 w; w.x = pk2(DN_ALPHA * xv[0] + v0[0], DN_ALPHA * xv[1] + v0[1]); w.y = pk2(DN_ALPHA * xv[2] + v0[2], DN_ALPHA * xv[3] + v0[3]);
                    w.z = pk2(DN_ALPHA * xv[4] + v1[0], DN_ALPHA * xv[5] + v1[1]); w.w = pk2(DN_ALPHA * xv[6] + v1[2], DN_ALPHA * xv[7] + v1[3]);
                    *(u32x4*)(out + ro + bj * 128) = w; } }
    }
};
template <class Epi>
__device__ __forceinline__ void gemm16(LAS unsigned char* lds, const bf16* A, const bf16* Bt, int N, int K, const Epi& e) {
    pg8::Gemm g{A, Bt, NT, N, K}; pg8::StaticOrder S; S.init(NT, N, (int)gridDim.x, (int)blockIdx.x);
    pg8::gemm_phase<Epi, pg8::StaticOrder, true, true>(lds, g, S, e);
}

__device__ __forceinline__ void tr_item(const float* W, int K, int N, bf16* WT, float* scr, int item, int nblk, int lane) {
    const int kb = item / nblk, nb = item - kb * nblk, k0 = 64 * kb, n0 = 64 * nb;
    const int col4 = (lane & 15) * 4; const bool ok = (n0 + col4) < N;
#pragma unroll 1
    for (int hf = 0; hf < 2; ++hf) {
        float4 v[8];
#pragma unroll
        for (int i = 0; i < 8; ++i) { const int row = (lane >> 4) + 4 * (i + 8 * hf); v[i] = ok ? *(const float4*)(W + (size_t)(k0 + row) * N + n0 + col4) : make_float4(0.f, 0.f, 0.f, 0.f); }
#pragma unroll
        for (int i = 0; i < 8; ++i) { const int row = (lane >> 4) + 4 * (i + 8 * hf); float* d = scr + row * 65 + col4; d[0] = v[i].x; d[1] = v[i].y; d[2] = v[i].z; d[3] = v[i].w; }
    }
    asm volatile("s_waitcnt lgkmcnt(0)" ::: "memory");
    const int c = lane & 7;
#pragma unroll
    for (int j = 0; j < 8; ++j) { const int nn = (lane >> 3) + 8 * j; const float* sp = scr + (8 * c) * 65 + nn;
        uint4 o; o.x = pk2(sp[0 * 65], sp[1 * 65]); o.y = pk2(sp[2 * 65], sp[3 * 65]); o.z = pk2(sp[4 * 65], sp[5 * 65]); o.w = pk2(sp[6 * 65], sp[7 * 65]);
        *(uint4*)(WT + (size_t)(n0 + nn) * K + k0 + 8 * c) = o; }
    asm volatile("s_waitcnt lgkmcnt(0)" ::: "memory");
}
__device__ __forceinline__ void cvt_f32_bf16(const float* src, bf16* dst, size_t n8) {
    const size_t gt = (size_t)blockIdx.x * NTHR + threadIdx.x, GT = (size_t)gridDim.x * NTHR;
    for (size_t i = gt; i < n8; i += GT) {
        const float4 a = *(const float4*)(src + i * 8), b = *(const float4*)(src + i * 8 + 4);
        uint4 o; o.x = pk2(a.x, a.y); o.y = pk2(a.z, a.w); o.z = pk2(b.x, b.y); o.w = pk2(b.z, b.w);
        *(uint4*)(dst + i * 8) = o;
    }
}
__device__ __forceinline__ void p0_weights(const Params& p, float* lds) {
    const int lane = threadIdx.x & 63, wave = __builtin_amdgcn_readfirstlane((int)threadIdx.x >> 6);
    float* scr = lds + wave * (64 * 65);
    const int gw = blockIdx.x * NWAVE + wave, NGW = gridDim.x * NWAVE;
    constexpr int I_IN = 16 * (NZP / 64), I_OUT = 16 * 16, I_Q = 16 * 32, I_G = 16 * 16, I_P = 4 * 16, I_L = I_IN + I_OUT + I_Q + I_G + I_P;
    for (int it = gw; it < 2 * I_L; it += NGW) {
        const int li = it / I_L; int r = it - li * I_L;
        if (r < I_IN) { tr_item(p.w_in + (size_t)li * DM * NZ, DM, NZ, (bf16*)(p.ws + WS_WIN) + (size_t)li * NZP * DM, scr, r, NZP / 64, lane); continue; } r -= I_IN;
        if (r < I_OUT) { tr_item(p.w_out + (size_t)li * DM * DM, DM, DM, (bf16*)(p.ws + WS_WOUT) + (size_t)li * DM * DM, scr, r, 16, lane); continue; } r -= I_OUT;
        if (r < I_Q) { tr_item(p.wq + (size_t)li * DM * 2048, DM, 2048, (bf16*)(p.ws + WS_WQG) + (size_t)li * 3072 * DM, scr, r, 32, lane); continue; } r -= I_Q;
        if (r < I_G) { tr_item(p.wg + (size_t)li * DM * DM, DM, DM, (bf16*)(p.ws + WS_WQG) + (size_t)li * 3072 * DM + (size_t)2048 * DM, scr, r, 16, lane); continue; } r -= I_G;
        tr_item(p.wp + (size_t)li * 256 * DM, 256, DM, (bf16*)(p.ws + WS_WP) + (size_t)li * DM * 256, scr, r, 16, lane);
    }
    cvt_f32_bf16(p.x, (bf16*)(p.ws + WS_XB), (size_t)NT * DM / 8);
    cvt_f32_bf16(p.p, (bf16*)(p.ws + WS_PB), (size_t)2 * NT * 256 / 8);
    cvt_f32_bf16(p.keys, (bf16*)(p.ws + WS_KEYS), (size_t)2 * 8 * 2 * 128 * 128 / 8);
}

__device__ __forceinline__ void p0_tables(const Params& p) {
    float* rcos = (float*)(p.ws + WS_RCOS); float* rsin = (float*)(p.ws + WS_RSIN); float* acos_ = (float*)(p.ws + WS_ACOS); float* asin_ = (float*)(p.ws + WS_ASIN);
    const int gt = blockIdx.x * NTHR + threadIdx.x, GT = gridDim.x * NTHR;
    for (int i = gt; i < SEQ * 32; i += GT) { const int pos = i >> 5, k = i & 31; const float inv = powf(10000.0f, -(float)k / 32.0f); const float ang = (float)pos * inv; rcos[i] = cosf(ang); rsin[i] = sinf(ang); }
    for (int i = gt; i < SEQ * 8; i += GT) { const int pos = i >> 3, k = i & 7; const float inv = powf(500000.0f, -(float)k / 8.0f); const float ang = (float)pos * inv; acos_[i] = cosf(ang); asin_[i] = sinf(ang); }
}

__device__ __forceinline__ float ret_lg(int h) { return logf(1.0f - exp2f(-5.0f - (float)h)); }

__device__ __forceinline__ void ret_state_item(const Params& p, int item, float* lds) {
    const int tid = threadIdx.x;
    const int c = item & 63, bh = item >> 6, h = bh & 3, b = bh >> 2;
    const int t0 = b * SEQ + c * 128, s0 = c * 128;
    const bf16* Z = (const bf16*)(p.ws + WS_Z);
    const float* rcos = (const float*)(p.ws + WS_RCOS); const float* rsin = (const float*)(p.ws + WS_RSIN);
    float* RST = (float*)(p.ws + WS_RST);
    float* Kz = lds; float* V = lds + 128 * 64;
    const float lg = ret_lg(h);
    for (int idx = tid; idx < 128 * 32; idx += NTHR) {
        const int row = idx >> 5, i = idx & 31;
        const bf16* zr = Z + (size_t)(t0 + row) * ZW + C_RK + h * 64;
        const float x1 = bf2f(zr[i]), x2 = bf2f(zr[i + 32]);
        const float cs = rcos[(s0 + row) * 32 + i], sn = rsin[(s0 + row) * 32 + i];
        const float sc = 0.125f * expf(lg * (float)(127 - row));
        Kz[row * 64 + i] = (x1 * cs - x2 * sn) * sc; Kz[row * 64 + i + 32] = (x2 * cs + x1 * sn) * sc;
    }
    for (int idx = tid; idx < 128 * 128; idx += NTHR) { const int row = idx >> 7, d = idx & 127; V[idx] = bf2f(Z[(size_t)(t0 + row) * ZW + C_RV + h * 128 + d]); }
    __syncthreads();
    const int k = tid >> 3, v0 = (tid & 7) * 16;
    float acc[16];
#pragma unroll
    for (int j = 0; j < 16; ++j) acc[j] = 0.f;
#pragma unroll 4
    for (int s = 0; s < 128; ++s) {
        const float kk = Kz[s * 64 + k];
#pragma unroll
        for (int j = 0; j < 16; ++j) acc[j] = fmaf(kk, V[s * 128 + v0 + j], acc[j]);
    }
    float* dst = RST + (size_t)item * 8192 + k * 128 + v0;
#pragma unroll
    for (int j = 0; j < 16; ++j) dst[j] = acc[j];
    __syncthreads();
}

__device__ __forceinline__ float logsigmoidf_(float f) { return fminf(f, 0.f) - log1pf(expf(-fabsf(f))); }

__device__ __forceinline__ void mls_state_item(const Params& p, int li, int item, float* lds) {
    const int tid = threadIdx.x;
    const int c = item & 63, bh = item >> 6, h = bh & 3, b = bh >> 2;
    const int t0 = b * SEQ + c * 128;
    const bf16* Z = (const bf16*)(p.ws + WS_Z);
    const float* gates = (const float*)(p.ws + WS_GATES);
    float* MC = (float*)(p.ws + WS_MC); float* MN = (float*)(p.ws + WS_MN); float* MA = (float*)(p.ws + WS_MA); float* MML = (float*)(p.ws + WS_MML);
    const float* cw = p.conv_w + (size_t)li * 4 * 512;
    float* Kc = lds; float* Vv = lds + 8192; float* ib = lds + 16384; float* bb = ib + 128; float* wk = bb + 128; float* scal = wk + 128;
    for (int idx = tid; idx < 128 * 64; idx += NTHR) {
        const int row = idx >> 6, d = idx & 63, ch = 256 + h * 64 + d;
        float a = 0.f;
#pragma unroll
        for (int j = 0; j < 4; ++j) { const int sp = c * 128 + row - 3 + j; if (sp >= 0) a = fmaf(cw[j * 512 + ch], bf2f(Z[(size_t)(t0 + row - 3 + j) * ZW + C_MK + h * 64 + d]), a); }
        Kc[idx] = siluf_(a) * 0.125f;
        Vv[idx] = bf2f(Z[(size_t)(t0 + row) * ZW + C_MV + h * 64 + d]);
    }
    if (tid < 128) {
        const int t = t0 + tid;
        const float ig = gates[(size_t)t * 8 + h] + p.b_if[li * 8 + h];
        const float fg = gates[(size_t)t * 8 + 4 + h] + p.b_if[li * 8 + 4 + h];
        ib[tid] = ig; bb[tid] = logsigmoidf_(fg);
    }
    __syncthreads();
    if (tid == 0) {
        float run = 0.f;
#pragma unroll 4
        for (int s = 0; s < 128; ++s) { run += bb[s]; bb[s] = run; }
        float ml = -INFINITY;
        for (int s = 0; s < 128; ++s) ml = fmaxf(ml, run - bb[s] + ib[s]);
        scal[0] = run; scal[1] = ml;
    }
    __syncthreads();
    const float a = scal[0], ml = scal[1];
    if (tid < 128) wk[tid] = expf(a - bb[tid] + ib[tid] - ml);
    __syncthreads();
    const int k = tid >> 3, v0 = (tid & 7) * 8;
    float acc[8], nacc = 0.f;
#pragma unroll
    for (int j = 0; j < 8; ++j) acc[j] = 0.f;
#pragma unroll 4
    for (int s = 0; s < 128; ++s) {
        const float kw = Kc[s * 64 + k] * wk[s];
        nacc += kw;
#pragma unroll
        for (int j = 0; j < 8; ++j) acc[j] = fmaf(kw, Vv[s * 64 + v0 + j], acc[j]);
    }
    float* dst = MC + (size_t)item * 4096 + k * 64 + v0;
#pragma unroll
    for (int j = 0; j < 8; ++j) dst[j] = acc[j];
    if ((tid & 7) == 0) MN[(size_t)item * 64 + k] = nacc;
    if (tid == 0) { MA[item] = a; MML[item] = ml; }
    __syncthreads();
}

typedef short bf16x8_t __attribute__((ext_vector_type(8)));
typedef short s16x4_t __attribute__((ext_vector_type(4)));
typedef float f32x16 __attribute__((ext_vector_type(16)));
typedef float f32x2_t __attribute__((ext_vector_type(2))); typedef __bf16 bf16x2_t __attribute__((ext_vector_type(2)));
__device__ __forceinline__ unsigned cvtpk(float lo, float hi) { f32x2_t v = {lo, hi}; bf16x2_t b = __builtin_convertvector(v, bf16x2_t); return __builtin_bit_cast(unsigned, b); }
__device__ __forceinline__ s16x4_t lds_tr(const LAS unsigned char* p) { return __builtin_bit_cast(s16x4_t, __builtin_amdgcn_ds_read_tr16_b64_v4i16((LAS s16x4_t*)p)); }

__device__ __forceinline__ void attn_unit(const Params& p, int unit, LAS unsigned char* lds) {
    RGN_T0(9)
    const int tid = threadIdx.x, lane = tid & 63, wave = __builtin_amdgcn_readfirstlane(tid >> 6);
    const int r32 = lane & 31, hh = lane >> 5;
    const bf16* Z = (const bf16*)(p.ws + WS_Z);
    const int bh = unit / 96, uu = unit - bh * 96, r = uu >> 5, v = uu & 31;
    const int dl = 1 << (2 * r), nb = 32 >> (2 * r);
    const int x = v / nb, blk = v - x * nb, q0 = blk * 256;
    const int b = bh >> 2, h = bh & 3;
    bf16* AO = (bf16*)(p.ws + WS_AO) + (size_t)r * NT * 256; float* ALSE = (float*)(p.ws + WS_ALSE) + (size_t)r * NT * 4;
    LAS unsigned char* Ks = lds; LAS unsigned char* Vs = lds + 384 * 128;
#pragma unroll 3
    for (int idx = tid; idx < 384 * 8; idx += NTHR) {
        const int i = idx >> 3, c = idx & 7, jk = q0 - 128 + i;
        const int jc = jk < 0 ? 0 : jk;
        const bf16* zr = Z + (size_t)(b * SEQ + jc * dl + x) * ZW + h * 64 + c * 8;
        u32x4 kv = *(const u32x4*)(zr + C_AK), vv = *(const u32x4*)(zr + C_AV);
        if (jk < 0) { kv = (u32x4){0u, 0u, 0u, 0u}; vv = (u32x4){0u, 0u, 0u, 0u}; }
        const int off = i * 128 + ((c ^ (i & 7)) << 4);
        *(LAS u32x4*)(Ks + off) = kv; *(LAS u32x4*)(Vs + off) = vv;
    }
    const int jq = q0 + 32 * wave + r32;
    const int tokq = b * SEQ + jq * dl + x;
    bf16x8_t qf[4];
#pragma unroll
    for (int ks = 0; ks < 4; ++ks) qf[ks] = *(const bf16x8_t*)(Z + (size_t)tokq * ZW + C_AQ + h * 64 + 16 * ks + 8 * hh);
    __syncthreads();
    f32x16 st[5];
#pragma unroll
    for (int tl = 0; tl < 5; ++tl) {
        f32x16 a16 = {0.f, 0.f, 0.f, 0.f, 0.f, 0.f, 0.f, 0.f, 0.f, 0.f, 0.f, 0.f, 0.f, 0.f, 0.f, 0.f};
        const int i = 32 * wave + 32 * tl + r32;
#pragma unroll
        for (int ks = 0; ks < 4; ++ks) {
            const int c = 2 * ks + hh;
            const bf16x8_t kf = *(const LAS bf16x8_t*)(Ks + i * 128 + ((c ^ (i & 7)) << 4));
            a16 = __builtin_amdgcn_mfma_f32_32x32x16_bf16(kf, qf[ks], a16, 0, 0, 0);
        }
        st[tl] = a16;
    }
    const int kb = q0 + 32 * wave - 128;
    float m = -INFINITY;
#pragma unroll
    for (int tl = 0; tl < 5; ++tl)
#pragma unroll
        for (int rg = 0; rg < 16; ++rg) {
            const int c = 32 * tl + (rg & 3) + 8 * (rg >> 2) + 4 * hh;
            const bool valid = (c >= r32) && (c <= r32 + 128) && (kb + c >= 0);
            const float sv = valid ? st[tl][rg] : -INFINITY;
            st[tl][rg] = sv; m = fmaxf(m, sv);
        }
    m = fmaxf(m, __shfl_xor(m, 32));
    float den = 0.f;
#pragma unroll
    for (int tl = 0; tl < 5; ++tl)
#pragma unroll
        for (int rg = 0; rg < 16; ++rg) { const float pe = __expf(st[tl][rg] - m); st[tl][rg] = pe; den += pe; }
    den += __shfl_xor(den, 32);
    f32x16 o[2];
#pragma unroll
    for (int dt = 0; dt < 2; ++dt) o[dt] = (f32x16){0.f, 0.f, 0.f, 0.f, 0.f, 0.f, 0.f, 0.f, 0.f, 0.f, 0.f, 0.f, 0.f, 0.f, 0.f, 0.f};
    const int tq = (lane & 15) >> 2, tp = lane & 3, tg = (lane >> 4) & 1;
#pragma unroll
    for (int tl = 0; tl < 5; ++tl)
#pragma unroll
        for (int s2 = 0; s2 < 2; ++s2) {
            u32x4 pw; pw.x = cvtpk(st[tl][8 * s2 + 0], st[tl][8 * s2 + 1]); pw.y = cvtpk(st[tl][8 * s2 + 2], st[tl][8 * s2 + 3]); pw.z = cvtpk(st[tl][8 * s2 + 4], st[tl][8 * s2 + 5]); pw.w = cvtpk(st[tl][8 * s2 + 6], st[tl][8 * s2 + 7]);
            const bf16x8_t pb = __builtin_bit_cast(bf16x8_t, pw);
            const int i0 = 32 * wave + 32 * tl + 16 * s2 + 4 * hh + tq;
#pragma unroll
            for (int dt = 0; dt < 2; ++dt) {
                const int c = 4 * dt + 2 * tg + (tp >> 1);
                const int i1 = i0 + 8;
                const s16x4_t lo = lds_tr(Vs + i0 * 128 + ((c ^ (i0 & 7)) << 4) + 8 * (tp & 1));
                const s16x4_t hi = lds_tr(Vs + i1 * 128 + ((c ^ (i1 & 7)) << 4) + 8 * (tp & 1));
                const bf16x8_t vf = (bf16x8_t){lo[0], lo[1], lo[2], lo[3], hi[0], hi[1], hi[2], hi[3]};
                o[dt] = __builtin_amdgcn_mfma_f32_32x32x16_bf16(vf, pb, o[dt], 0, 0, 0);
            }
        }
    const float rden = 1.0f / den;
    bf16* orow = AO + (size_t)tokq * 256 + h * 64;
#pragma unroll
    for (int dt = 0; dt < 2; ++dt)
#pragma unroll
        for (int g4 = 0; g4 < 4; ++g4) {
            const int d = 32 * dt + 8 * g4 + 4 * hh;
            *(uint2*)(orow + d) = make_uint2(cvtpk(o[dt][4 * g4] * rden, o[dt][4 * g4 + 1] * rden), cvtpk(o[dt][4 * g4 + 2] * rden, o[dt][4 * g4 + 3] * rden));
        }
    if (hh == 0) ALSE[(size_t)tokq * 4 + h] = m + __logf(den);
    __syncthreads();
    RGN_T1(9, lds)
}

__device__ __forceinline__ void attn_merge(const Params& p) {
    const bf16* AO = (const bf16*)(p.ws + WS_AO); const float* ALSE = (const float*)(p.ws + WS_ALSE);
    bf16* MIX = (bf16*)(p.ws + WS_MIX);
    const int gt = blockIdx.x * NTHR + threadIdx.x, GT = gridDim.x * NTHR;
    for (int e = gt; e < NT * 32; e += GT) {
        const int t = e >> 5, c8 = e & 31, h = c8 >> 3;
        const float l0 = ALSE[(size_t)t * 4 + h], l1 = ALSE[(size_t)NT * 4 + (size_t)t * 4 + h], l2 = ALSE[(size_t)2 * NT * 4 + (size_t)t * 4 + h];
        const float M = fmaxf(fmaxf(l0, l1), l2);
        float w0 = __expf(l0 - M), w1 = __expf(l1 - M), w2 = __expf(l2 - M);
        const float rs = 1.0f / (w0 + w1 + w2); w0 *= rs; w1 *= rs; w2 *= rs;
        float a0[8], a1[8], a2[8];
        unpack8(*(const uint4*)(AO + (size_t)t * 256 + c8 * 8), a0);
        unpack8(*(const uint4*)(AO + (size_t)NT * 256 + (size_t)t * 256 + c8 * 8), a1);
        unpack8(*(const uint4*)(AO + (size_t)2 * NT * 256 + (size_t)t * 256 + c8 * 8), a2);
        float y[8];
#pragma unroll
        for (int j = 0; j < 8; ++j) y[j] = w0 * a0[j] + w1 * a1[j] + w2 * a2[j];
        *(uint4*)(MIX + (size_t)t * DM + 512 + c8 * 8) = make_uint4(pk2(y[0], y[1]), pk2(y[2], y[3]), pk2(y[4], y[5]), pk2(y[6], y[7]));
    }
}

constexpr int UNIT_LDS = 79360;
__device__ __forceinline__ int swz16(int row, int chunk) { return (chunk ^ (row & 7)) << 4; }
template <bool ACCPERM>
__device__ __forceinline__ bf16x8_t frag_tr(const LAS unsigned char* img, int RB, int kbase, int cbase, int lane) {
    const int tq = (lane & 15) >> 2, tp = lane & 3, tg = (lane >> 4) & 1, hh = lane >> 5;
    const int r0 = kbase + (ACCPERM ? 4 : 8) * hh + tq, r1 = r0 + (ACCPERM ? 8 : 4);
    const int colb = (cbase + 16 * tg + 4 * tp) * 2, ch = colb >> 4, sub = colb & 15;
    const s16x4_t lo = lds_tr(img + r0 * RB + swz16(r0, ch) + sub);
    const s16x4_t hi = lds_tr(img + r1 * RB + swz16(r1, ch) + sub);
    return (bf16x8_t){lo[0], lo[1], lo[2], lo[3], hi[0], hi[1], hi[2], hi[3]};
}
__device__ __forceinline__ bf16x8_t frag_row(const LAS unsigned char* img, int RB, int row, int chunk) { return *(const LAS bf16x8_t*)(img + row * RB + swz16(row, chunk)); }
__device__ __forceinline__ u32x4 pack8(const float* v) { u32x4 w; w.x = pk2(v[0], v[1]); w.y = pk2(v[2], v[3]); w.z = pk2(v[4], v[5]); w.w = pk2(v[6], v[7]); return w; }
#define F16Z ((f32x16){0.f, 0.f, 0.f, 0.f, 0.f, 0.f, 0.f, 0.f, 0.f, 0.f, 0.f, 0.f, 0.f, 0.f, 0.f, 0.f})
__device__ __forceinline__ int acc_row(int rg, int hh) { return (rg & 3) + 8 * (rg >> 2) + 4 * hh; }

template <bool ZETA>
__device__ __forceinline__ void stage_ret_k(const Params& p, LAS unsigned char* Ks, int t0, int s0, int h, float lg, int tidU) {
    const bf16* Z = (const bf16*)(p.ws + WS_Z);
    const float* rcos = (const float*)(p.ws + WS_RCOS); const float* rsin = (const float*)(p.ws + WS_RSIN);
#pragma unroll
    for (int task = tidU; task < 512; task += 256) {
        const int row = task >> 2, pc = task & 3;
        const bf16* zr = Z + (size_t)(t0 + row) * ZW + C_RK + h * 64;
        float a[8], bq[8], o1[8], o2[8];
        unpack8v(*(const u32x4*)(zr + 8 * pc), a); unpack8v(*(const u32x4*)(zr + 32 + 8 * pc), bq);
        const f32x4 c0 = *(const f32x4*)(rcos + (s0 + row) * 32 + 8 * pc), c1 = *(const f32x4*)(rcos + (s0 + row) * 32 + 8 * pc + 4);
        const f32x4 n0 = *(const f32x4*)(rsin + (s0 + row) * 32 + 8 * pc), n1 = *(const f32x4*)(rsin + (s0 + row) * 32 + 8 * pc + 4);
        const float sc = ZETA ? 0.125f * __expf(lg * (float)(127 - row)) : 0.125f;
#pragma unroll
        for (int j = 0; j < 8; ++j) { const float cs = j < 4 ? c0[j & 3] : c1[j & 3], sn = j < 4 ? n0[j & 3] : n1[j & 3]; o1[j] = (a[j] * cs - bq[j] * sn) * sc; o2[j] = (bq[j] * cs + a[j] * sn) * sc; }
        *(LAS u32x4*)(Ks + row * 128 + swz16(row, pc)) = pack8(o1); *(LAS u32x4*)(Ks + row * 128 + swz16(row, pc + 4)) = pack8(o2);
    }
}
__device__ __forceinline__ void stage_copy(const bf16* src0, int ld, LAS unsigned char* img, int RB, int nrows, int nchunks, int tidU) {
#pragma unroll 4
    for (int task = tidU; task < nrows * nchunks; task += 256) {
        const int row = task / nchunks, c = task - row * nchunks;
        *(LAS u32x4*)(img + row * RB + swz16(row, c)) = *(const u32x4*)(src0 + (size_t)row * ld + 8 * c);
    }
}

__device__ __forceinline__ void ret_state_u(const Params& p, int unit, LAS unsigned char* ldsU, int wl, int tidU, int lane) {
    RGN_T0(7)
    const int c = unit & 63, bh = unit >> 6, h = bh & 3, b = bh >> 2, t0 = b * SEQ + c * 128, s0 = c * 128;
    const bf16* Z = (const bf16*)(p.ws + WS_Z); float* RST = (float*)(p.ws + WS_RST);
    LAS unsigned char* Ks = ldsU; LAS unsigned char* Vs = ldsU + 16384;
    stage_ret_k<true>(p, Ks, t0, s0, h, ret_lg(h), tidU);
    stage_copy(Z + (size_t)t0 * ZW + C_RV + h * 128, ZW, Vs, 256, 128, 16, tidU);
    __syncthreads();
    f32x16 a0 = F16Z, a1 = F16Z;
#pragma unroll 2
    for (int ks = 0; ks < 8; ++ks) {
        const bf16x8_t A = frag_tr<false>(Vs, 256, 16 * ks, 32 * wl, lane);
        const bf16x8_t B0 = frag_tr<false>(Ks, 128, 16 * ks, 0, lane), B1 = frag_tr<false>(Ks, 128, 16 * ks, 32, lane);
        a0 = __builtin_amdgcn_mfma_f32_32x32x16_bf16(A, B0, a0, 0, 0, 0); a1 = __builtin_amdgcn_mfma_f32_32x32x16_bf16(A, B1, a1, 0, 0, 0);
    }
    float* dst = RST + (size_t)unit * 8192; const int r32 = lane & 31, hh = lane >> 5;
#pragma unroll
    for (int rg = 0; rg < 16; ++rg) { const int dv = 32 * wl + acc_row(rg, hh); dst[dv * 64 + r32] = a0[rg]; dst[dv * 64 + 32 + r32] = a1[rg]; }
    __syncthreads();
    RGN_T1(7, ldsU)
}

__device__ __forceinline__ void mls_gates(const Params& p, int li, int t0, int h, int lane, float& b0, float& b1, float& g0, float& g1) {
    const float* gates = (const float*)(p.ws + WS_GATES);
    const float bi = p.b_if[li * 8 + h], bf = p.b_if[li * 8 + 4 + h];
    const int t = t0 + 2 * lane;
    const float i0 = gates[(size_t)t * 8 + h] + bi, i1 = gates[(size_t)(t + 1) * 8 + h] + bi;
    const float f0 = logsigmoidf_(gates[(size_t)t * 8 + 4 + h] + bf), f1 = logsigmoidf_(gates[(size_t)(t + 1) * 8 + 4 + h] + bf);
    const float tot = f0 + f1; float v = tot;
#pragma unroll
    for (int o = 1; o < 64; o <<= 1) { const float u = __shfl_up(v, o); if (lane >= o) v += u; }
    const float ex = v - tot;
    b0 = ex + f0; b1 = ex + tot; g0 = i0 - b0; g1 = i1 - b1;
}
__device__ __forceinline__ void conv8(const bf16* zq, const float* cw, int nprev, float scale, float* o) {
    float acc[8];
#pragma unroll
    for (int e = 0; e < 8; ++e) acc[e] = 0.f;
    u32x4 xr[4]; f32x4 w0[4], w1[4];
#pragma unroll
    for (int j = 0; j < 4; ++j) {
        const int back = (3 - j <= nprev) ? (3 - j) : 0;
        xr[j] = *(const u32x4*)(zq - (size_t)back * ZW);
        w0[j] = *(const f32x4*)(cw + j * 512); w1[j] = *(const f32x4*)(cw + j * 512 + 4);
    }
#pragma unroll
    for (int j = 0; j < 4; ++j) {
        const float ok = (3 - j <= nprev) ? 1.0f : 0.0f;
        float xv[8]; unpack8v(xr[j], xv);
#pragma unroll
        for (int e = 0; e < 8; ++e) acc[e] = fmaf((e < 4 ? w0[j][e & 3] : w1[j][e & 3]) * ok, xv[e], acc[e]);
    }
#pragma unroll
    for (int e = 0; e < 8; ++e) o[e] = siluf_(acc[e]) * scale;
}
__device__ __forceinline__ void stage_vext(const bf16* src0, LAS unsigned char* Vs, int tidU) {
#pragma unroll 3
    for (int task = tidU; task < 128 * 12; task += 256) {
        const int row = task / 12, c = task - row * 12;
        u32x4 v = *(const u32x4*)(src0 + (size_t)row * ZW + 8 * (c & 7));
        if (c >= 8) { v = (u32x4){0u, 0u, 0u, 0u}; if (c == 8) v.x = 0x3F80u; }
        *(LAS u32x4*)(Vs + row * 256 + swz16(row, c)) = v;
    }
}

__device__ __forceinline__ void mls_state_u(const Params& p, int li, int unit, LAS unsigned char* ldsU, int wl, int tidU, int lane) {
    RGN_T0(8)
    const int c = unit & 63, bh = unit >> 6, h = bh & 3, b = bh >> 2, t0 = b * SEQ + c * 128;
    const bf16* Z = (const bf16*)(p.ws + WS_Z);
    float* MC = (float*)(p.ws + WS_MC); float* MN = (float*)(p.ws + WS_MN); float* MA = (float*)(p.ws + WS_MA); float* MML = (float*)(p.ws + WS_MML);
    LAS unsigned char* Ks = ldsU; LAS unsigned char* Vs = ldsU + 16384; LAS float* wk = (LAS float*)(ldsU + 49152);
    if (wl == 0) {
        float b0, b1, g0, g1; mls_gates(p, li, t0, h, lane, b0, b1, g0, g1);
        const float gmax = wave_max(fmaxf(g0, g1));
        const float a = __shfl(b1, 63);
        wk[2 * lane] = __expf(g0 - gmax); wk[2 * lane + 1] = __expf(g1 - gmax);
        if (lane == 0) { MA[unit] = a; MML[unit] = a + gmax; }
    }
    stage_vext(Z + (size_t)t0 * ZW + C_MV + h * 64, Vs, tidU);
    __syncthreads();
    bf16* QKC = (bf16*)p.out;
#pragma unroll 2
    for (int task = tidU; task < 2048; task += 256) {
        const int isq = task >> 10, row = (task >> 3) & 127, cc = task & 7;
        float o[8]; conv8(Z + (size_t)(t0 + row) * ZW + (isq ? C_MQ : C_MK) + h * 64 + 8 * cc, p.conv_w + (size_t)li * 2048 + (isq ? 0 : 256) + h * 64 + 8 * cc, c * 128 + row, isq ? 1.0f : 0.125f, o);
        *(u32x4*)(QKC + (size_t)(t0 + row) * 512 + (isq ? 0 : 256) + h * 64 + 8 * cc) = pack8(o);
        if (!isq) { const float w = wk[row];
#pragma unroll
            for (int e = 0; e < 8; ++e) o[e] *= w;
            *(LAS u32x4*)(Ks + row * 128 + swz16(row, cc)) = pack8(o); }
    }
    __syncthreads();
    if (wl < 3) {
        f32x16 a0 = F16Z, a1 = F16Z;
#pragma unroll 2
        for (int ks = 0; ks < 8; ++ks) {
            const bf16x8_t A = frag_tr<false>(Vs, 256, 16 * ks, 32 * wl, lane);
            const bf16x8_t B0 = frag_tr<false>(Ks, 128, 16 * ks, 0, lane), B1 = frag_tr<false>(Ks, 128, 16 * ks, 32, lane);
            a0 = __builtin_amdgcn_mfma_f32_32x32x16_bf16(A, B0, a0, 0, 0, 0); a1 = __builtin_amdgcn_mfma_f32_32x32x16_bf16(A, B1, a1, 0, 0, 0);
        }
        const int r32 = lane & 31, hh = lane >> 5;
        if (wl < 2) {
            float* dst = MC + (size_t)unit * 4096;
#pragma unroll
            for (int rg = 0; rg < 16; ++rg) { const int v = 32 * wl + acc_row(rg, hh); dst[v * 64 + r32] = a0[rg]; dst[v * 64 + 32 + r32] = a1[rg]; }
        } else if (hh == 0) { MN[(size_t)unit * 64 + r32] = a0[0]; MN[(size_t)unit * 64 + 32 + r32] = a1[0]; }
    }
    __syncthreads();
    RGN_T1(8, ldsU)
}

__device__ __forceinline__ void epi_stage_put(LAS unsigned char* reg, int r32, int col, float a, float b, float c, float d) {
    typedef unsigned u32x2_ __attribute__((ext_vector_type(2)));
    *(LAS u32x2_*)(reg + r32 * 128 + swz16(r32, col >> 3) + ((col & 4) << 1)) = (u32x2_){pk2(a, b), pk2(c, d)};
}
__device__ __forceinline__ void ret_out_u(const Params& p, int li, int unit, LAS unsigned char* ldsU, int wl, int tidU, int lane) {
    const int c = unit & 63, bh = unit >> 6, h = bh & 3, b = bh >> 2, t0 = b * SEQ + c * 128, s0 = c * 128;
    const int r32 = lane & 31, hh = lane >> 5;
    const bf16* Z = (const bf16*)(p.ws + WS_Z); const float* RST = (const float*)(p.ws + WS_RST); bf16* MIX = (bf16*)(p.ws + WS_MIX);
    const float* rcos = (const float*)(p.ws + WS_RCOS); const float* rsin = (const float*)(p.ws + WS_RSIN);
    LAS unsigned char* Ks = ldsU; LAS unsigned char* Vs = ldsU + 16384; LAS unsigned char* Rs = ldsU + 49152;
    const float lg = ret_lg(h);
    RGN_T0(1)
    stage_ret_k<false>(p, Ks, t0, s0, h, lg, tidU);
    stage_copy(Z + (size_t)t0 * ZW + C_RV + h * 128, ZW, Vs, 256, 128, 16, tidU);
#pragma unroll
    for (int task = tidU; task < 1024; task += 256) {
        const int row = task >> 3, cc = task & 7;
        const float* src = RST + (size_t)unit * 8192 + row * 64 + 8 * cc;
        const f32x4 x0 = *(const f32x4*)src, x1 = *(const f32x4*)(src + 4);
        const float v[8] = {x0[0], x0[1], x0[2], x0[3], x1[0], x1[1], x1[2], x1[3]};
        *(LAS u32x4*)(Rs + row * 128 + swz16(row, cc)) = pack8(v);
    }
    const int t = 32 * wl + r32, tok = t0 + t, pos = s0 + t;
    bf16x8_t qf[4];
    {
        float f[4][8];
#pragma unroll
        for (int ks = 0; ks < 4; ++ks) unpack8v(*(const u32x4*)(Z + (size_t)tok * ZW + C_RQ + h * 64 + 16 * ks + 8 * hh), f[ks]);
#pragma unroll
        for (int ks = 0; ks < 2; ++ks) {
            const float* cp = rcos + pos * 32 + 16 * ks + 8 * hh; const float* sp = rsin + pos * 32 + 16 * ks + 8 * hh;
            const f32x4 c0 = *(const f32x4*)cp, c1 = *(const f32x4*)(cp + 4), n0 = *(const f32x4*)sp, n1 = *(const f32x4*)(sp + 4);
#pragma unroll
            for (int j = 0; j < 8; ++j) { const float cs = j < 4 ? c0[j & 3] : c1[j & 3], sn = j < 4 ? n0[j & 3] : n1[j & 3]; const float x1 = f[ks][j], x2 = f[ks + 2][j]; f[ks][j] = x1 * cs - x2 * sn; f[ks + 2][j] = x2 * cs + x1 * sn; }
        }
#pragma unroll
        for (int ks = 0; ks < 4; ++ks) qf[ks] = __builtin_bit_cast(bf16x8_t, pack8(f[ks]));
    }
    __syncthreads();
    RGN_T1(1, ldsU)
    RGN_T0(2)
    f32x16 o[4];
#pragma unroll
    for (int dt = 0; dt < 4; ++dt) {
        f32x16 a = F16Z;
#pragma unroll
        for (int ks = 0; ks < 4; ++ks) a = __builtin_amdgcn_mfma_f32_32x32x16_bf16(frag_row(Rs, 128, 32 * dt + r32, 2 * ks + hh), qf[ks], a, 0, 0, 0);
        o[dt] = a;
    }
    const float xi = __expf(lg * (float)(t + 1));
#pragma unroll
    for (int dt = 0; dt < 4; ++dt)
#pragma unroll
        for (int rg = 0; rg < 16; ++rg) o[dt][rg] *= xi;
#pragma unroll 1
    for (int tl = 0; tl <= wl; ++tl) {
        {
            f32x16 st = F16Z;
#pragma unroll
            for (int ks = 0; ks < 4; ++ks) st = __builtin_amdgcn_mfma_f32_32x32x16_bf16(frag_row(Ks, 128, 32 * tl + r32, 2 * ks + hh), qf[ks], st, 0, 0, 0);
#pragma unroll
            for (int rg = 0; rg < 16; ++rg) { const int s = 32 * tl + acc_row(rg, hh); st[rg] = (s <= t) ? st[rg] * __expf(lg * (float)(t - s)) : 0.f; }
#pragma unroll
            for (int s2 = 0; s2 < 2; ++s2) {
                u32x4 pw; pw.x = cvtpk(st[8 * s2 + 0], st[8 * s2 + 1]); pw.y = cvtpk(st[8 * s2 + 2], st[8 * s2 + 3]); pw.z = cvtpk(st[8 * s2 + 4], st[8 * s2 + 5]); pw.w = cvtpk(st[8 * s2 + 6], st[8 * s2 + 7]);
                const bf16x8_t pb = __builtin_bit_cast(bf16x8_t, pw);
#pragma unroll
                for (int dt = 0; dt < 4; ++dt) o[dt] = __builtin_amdgcn_mfma_f32_32x32x16_bf16(frag_tr<true>(Vs, 256, 32 * tl + 16 * s2, 32 * dt, lane), pb, o[dt], 0, 0, 0);
            }
        }
    }
    RGN_T1(2, ldsU)
    RGN_T0(3)
    float sum = 0.f, sq = 0.f;
#pragma unroll
    for (int dt = 0; dt < 4; ++dt)
#pragma unroll
        for (int rg = 0; rg < 16; ++rg) { sum += o[dt][rg]; sq += o[dt][rg] * o[dt][rg]; }
    sum += __shfl_xor(sum, 32); sq += __shfl_xor(sq, 32);
    const float mean = sum * (1.0f / 128.0f);
    const float rstd = 1.0f / sqrtf(fmaxf(sq * (1.0f / 128.0f) - mean * mean, 0.f) + LN_EPS);
    __syncthreads();
#pragma unroll
    for (int dt = 0; dt < 4; ++dt)
#pragma unroll
        for (int g4 = 0; g4 < 4; ++g4) {
            const int dv = 32 * dt + 8 * g4 + 4 * hh;
            const f32x4 gg = *(const f32x4*)(p.ret_g + li * 512 + h * 128 + dv);
            epi_stage_put(((dt < 2) ? Ks : Rs) + 4096 * wl, r32, dv & 63, (o[dt][4 * g4 + 0] - mean) * rstd * gg[0], (o[dt][4 * g4 + 1] - mean) * rstd * gg[1], (o[dt][4 * g4 + 2] - mean) * rstd * gg[2], (o[dt][4 * g4 + 3] - mean) * rstd * gg[3]);
        }
    asm volatile("s_waitcnt lgkmcnt(0)" ::: "memory");
#pragma unroll
    for (int j = 0; j < 8; ++j) {
        const int idx = (lane + 64 * j) & 255, half = j >> 2, row = idx >> 3, cc = idx & 7;
        const LAS unsigned char* reg = (half ? Rs : Ks) + 4096 * wl;
        float yv[8], gv[8]; unpack8v(*(const LAS u32x4*)(reg + row * 128 + swz16(row, cc)), yv);
        const size_t tk = (size_t)(t0 + 32 * wl + row);
        unpack8v(*(const u32x4*)(Z + tk * ZW + C_RG + h * 128 + 64 * half + 8 * cc), gv);
#pragma unroll
        for (int e = 0; e < 8; ++e) yv[e] *= siluf_(gv[e]);
        *(u32x4*)(MIX + tk * DM + h * 128 + 64 * half + 8 * cc) = pack8(yv);
    }
    __syncthreads();
    RGN_T1(3, ldsU)
}

__device__ __forceinline__ void mls_out_u(const Params& p, int li, int unit, LAS unsigned char* ldsU, int wl, int tidU, int lane) {
    const int c = unit & 63, bh = unit >> 6, h = bh & 3, b = bh >> 2, t0 = b * SEQ + c * 128;
    const int r32 = lane & 31, hh = lane >> 5;
    const bf16* Z = (const bf16*)(p.ws + WS_Z); bf16* MIX = (bf16*)(p.ws + WS_MIX);
    const float* MC = (const float*)(p.ws + WS_MC); const float* MN = (const float*)(p.ws + WS_MN); const float* MMP = (const float*)(p.ws + WS_MMP);
    LAS unsigned char* Ks = ldsU; LAS unsigned char* Qs = ldsU + 16384; LAS unsigned char* Vs = ldsU + 32768; LAS unsigned char* Cs = ldsU + 65536;
    LAS float* bb = (LAS float*)(ldsU + 77824); LAS float* gg = bb + 128; LAS float* pm = gg + 128;
    RGN_T0(4)
    if (wl == 0) {
        float b0, b1, g0, g1; mls_gates(p, li, t0, h, lane, b0, b1, g0, g1);
        const float p1 = fmaxf(g0, g1); float v = p1;
#pragma unroll
        for (int o = 1; o < 64; o <<= 1) { const float u = __shfl_up(v, o); if (lane >= o) v = fmaxf(v, u); }
        const float prev = __shfl_up(v, 1);
        const float ex = (lane == 0) ? -INFINITY : prev;
        bb[2 * lane] = b0; bb[2 * lane + 1] = b1; gg[2 * lane] = g0; gg[2 * lane + 1] = g1;
        pm[2 * lane] = fmaxf(ex, g0); pm[2 * lane + 1] = fmaxf(ex, p1);
    }
    stage_vext(Z + (size_t)t0 * ZW + C_MV + h * 64, Vs, tidU);
    stage_copy((const bf16*)p.out + (size_t)t0 * 512 + 256 + h * 64, 512, Ks, 128, 128, 8, tidU);
    stage_copy((const bf16*)p.out + (size_t)t0 * 512 + h * 64, 512, Qs, 128, 128, 8, tidU);
#pragma unroll
    for (int task = tidU; task < 96 * 8; task += 256) {
        const int row = task >> 3, cc = task & 7;
        const float* src = (row < 64) ? (MC + (size_t)unit * 4096 + row * 64 + 8 * cc) : (MN + (size_t)unit * 64 + 8 * cc);
        const f32x4 x0 = *(const f32x4*)src, x1 = *(const f32x4*)(src + 4);
        const float ok = (row <= 64) ? 1.0f : 0.0f;
        const float v[8] = {x0[0] * ok, x0[1] * ok, x0[2] * ok, x0[3] * ok, x1[0] * ok, x1[1] * ok, x1[2] * ok, x1[3] * ok};
        *(LAS u32x4*)(Cs + row * 128 + swz16(row, cc)) = pack8(v);
    }
    const float mprev = MMP[unit];
    __syncthreads();
    RGN_T1(4, ldsU)
    RGN_T0(5)
    const int t = 32 * wl + r32, tok = t0 + t;
    const float Mt = fmaxf(mprev, pm[t]), bt = bb[t];
    const float winter = __expf(mprev - Mt);
    bf16x8_t qf[4];
#pragma unroll
    for (int ks = 0; ks < 4; ++ks) qf[ks] = frag_row(Qs, 128, t, 2 * ks + hh);
    f32x16 o[3];
#pragma unroll
    for (int dt = 0; dt < 3; ++dt) {
        f32x16 a = F16Z;
#pragma unroll
        for (int ks = 0; ks < 4; ++ks) a = __builtin_amdgcn_mfma_f32_32x32x16_bf16(frag_row(Cs, 128, 32 * dt + r32, 2 * ks + hh), qf[ks], a, 0, 0, 0);
#pragma unroll
        for (int rg = 0; rg < 16; ++rg) a[rg] *= winter;
        o[dt] = a;
    }
#pragma unroll 1
    for (int tl = 0; tl <= wl; ++tl) {
        {
            f32x16 st = F16Z;
#pragma unroll
            for (int ks = 0; ks < 4; ++ks) st = __builtin_amdgcn_mfma_f32_32x32x16_bf16(frag_row(Ks, 128, 32 * tl + r32, 2 * ks + hh), qf[ks], st, 0, 0, 0);
#pragma unroll
            for (int g4 = 0; g4 < 4; ++g4) {
                const int sb = 32 * tl + 8 * g4 + 4 * hh;
                const f32x4 gv = *(const LAS f32x4*)(gg + sb);
#pragma unroll
                for (int j = 0; j < 4; ++j) st[4 * g4 + j] = (sb + j <= t) ? st[4 * g4 + j] * __expf(gv[j] - Mt) : 0.f;
            }
#pragma unroll
            for (int s2 = 0; s2 < 2; ++s2) {
                u32x4 pw; pw.x = cvtpk(st[8 * s2 + 0], st[8 * s2 + 1]); pw.y = cvtpk(st[8 * s2 + 2], st[8 * s2 + 3]); pw.z = cvtpk(st[8 * s2 + 4], st[8 * s2 + 5]); pw.w = cvtpk(st[8 * s2 + 6], st[8 * s2 + 7]);
                const bf16x8_t pb = __builtin_bit_cast(bf16x8_t, pw);
#pragma unroll
                for (int dt = 0; dt < 3; ++dt) o[dt] = __builtin_amdgcn_mfma_f32_32x32x16_bf16(frag_tr<true>(Vs, 256, 32 * tl + 16 * s2, 32 * dt, lane), pb, o[dt], 0, 0, 0);
            }
        }
    }
    RGN_T1(5, ldsU)
    RGN_T0(6)
    const float den = __shfl(o[2][0], r32);
    const float rden = 1.0f / fmaxf(fabsf(den), __expf(-(bt + Mt)));
    float sum = 0.f, sq = 0.f;
#pragma unroll
    for (int dt = 0; dt < 2; ++dt)
#pragma unroll
        for (int rg = 0; rg < 16; ++rg) { o[dt][rg] *= rden; sum += o[dt][rg]; sq += o[dt][rg] * o[dt][rg]; }
    sum += __shfl_xor(sum, 32); sq += __shfl_xor(sq, 32);
    const float mean = sum * (1.0f / 64.0f);
    const float rstd = 1.0f / sqrtf(fmaxf(sq * (1.0f / 64.0f) - mean * mean, 0.f) + LN_EPS);
    __syncthreads();
#pragma unroll
    for (int dt = 0; dt < 2; ++dt)
#pragma unroll
        for (int g4 = 0; g4 < 4; ++g4) {
            const int d = 32 * dt + 8 * g4 + 4 * hh;
            const f32x4 gn = *(const f32x4*)(p.mls_g + li * 256 + h * 64 + d);
            epi_stage_put(Ks + 4096 * wl, r32, d, (o[dt][4 * g4 + 0] - mean) * rstd * gn[0], (o[dt][4 * g4 + 1] - mean) * rstd * gn[1], (o[dt][4 * g4 + 2] - mean) * rstd * gn[2], (o[dt][4 * g4 + 3] - mean) * rstd * gn[3]);
        }
    asm volatile("s_waitcnt lgkmcnt(0)" ::: "memory");
#pragma unroll
    for (int j = 0; j < 4; ++j) {
        const int idx = lane + 64 * j, row = idx >> 3, cc = idx & 7;
        float yv[8], gv[8]; unpack8v(*(const LAS u32x4*)(Ks + 4096 * wl + row * 128 + swz16(row, cc)), yv);
        const size_t tk = (size_t)(t0 + 32 * wl + row);
        unpack8v(*(const u32x4*)(Z + tk * ZW + C_MO + h * 64 + 8 * cc), gv);
#pragma unroll
        for (int e = 0; e < 8; ++e) yv[e] *= sigmoidf_(gv[e]);
        *(u32x4*)(MIX + tk * DM + 768 + h * 64 + 8 * cc) = pack8(yv);
    }
    __syncthreads();
    RGN_T1(6, ldsU)
}

__device__ __forceinline__ void p3_scans(const Params& p) {
    float* RST = (float*)(p.ws + WS_RST);
    float* MC = (float*)(p.ws + WS_MC); float* MN = (float*)(p.ws + WS_MN); const float* MA = (const float*)(p.ws + WS_MA); const float* MML = (const float*)(p.ws + WS_MML); float* MMP = (float*)(p.ws + WS_MMP);
    const int gt = blockIdx.x * NTHR + threadIdx.x, GT = gridDim.x * NTHR;
    for (int e = gt; e < 16 * 8192; e += GT) {
        const int bh = e >> 13, el = e & 8191, h = bh & 3;
        const float gL = expf(ret_lg(h) * 128.0f);
        float R = 0.f;
        float* ptr = RST + (size_t)bh * 64 * 8192 + el;
        for (int c = 0; c < 64; ++c) { const float sv = ptr[(size_t)c * 8192]; ptr[(size_t)c * 8192] = R; R = fmaf(gL, R, sv); }
    }
    for (int e = gt; e < 16 * 4160; e += GT) {
        const int bh = e / 4160, el = e - bh * 4160;
        float* ptr; size_t stride;
        if (el < 4096) { ptr = MC + (size_t)bh * 64 * 4096 + el; stride = 4096; } else { ptr = MN + (size_t)bh * 64 * 64 + (el - 4096); stride = 64; }
        float m = 0.f, C = 0.f;
        for (int c = 0; c < 64; ++c) {
            const float a = MA[bh * 64 + c], ml = MML[bh * 64 + c];
            const float mn = fmaxf(a + m, ml);
            const float f1 = expf(a + m - mn), f2 = expf(ml - mn);
            const float sv = ptr[(size_t)c * stride]; ptr[(size_t)c * stride] = C; C = f1 * C + f2 * sv;
            if (el == 0) MMP[bh * 64 + c] = m;
            m = mn;
        }
    }
}

__device__ __forceinline__ void ret_out_item(const Params& p, int li, int item, float* lds) {
    const int tid = threadIdx.x;
    const int c = item & 63, bh = item >> 6, h = bh & 3, b = bh >> 2;
    const int t0 = b * SEQ + c * 128, s0 = c * 128;
    const bf16* Z = (const bf16*)(p.ws + WS_Z);
    const float* rcos = (const float*)(p.ws + WS_RCOS); const float* rsin = (const float*)(p.ws + WS_RSIN);
    const float* RST = (const float*)(p.ws + WS_RST);
    bf16* MIX = (bf16*)(p.ws + WS_MIX);
    float* Q = lds; float* K = Q + 8320; float* SC = K + 8320; float* V = SC + 8256; float* R = V + 8192;
    const float lg = ret_lg(h);
    for (int idx = tid; idx < 128 * 32; idx += NTHR) {
        const int row = idx >> 5, i = idx & 31;
        const bf16* zq = Z + (size_t)(t0 + row) * ZW + C_RQ + h * 64; const bf16* zk = Z + (size_t)(t0 + row) * ZW + C_RK + h * 64;
        const float cs = rcos[(s0 + row) * 32 + i], sn = rsin[(s0 + row) * 32 + i];
        const float q1 = bf2f(zq[i]), q2 = bf2f(zq[i + 32]), k1 = bf2f(zk[i]), k2 = bf2f(zk[i + 32]);
        Q[row * 65 + i] = q1 * cs - q2 * sn; Q[row * 65 + i + 32] = q2 * cs + q1 * sn;
        K[row * 65 + i] = (k1 * cs - k2 * sn) * 0.125f; K[row * 65 + i + 32] = (k2 * cs + k1 * sn) * 0.125f;
    }
    __syncthreads();
    const int r = tid >> 3, d0 = (tid & 7) * 8;
#pragma unroll 1
    for (int rh = 0; rh < 2; ++rh) {
        const int t = rh * 64 + r;
#pragma unroll 1
        for (int j = 0; j < 16; ++j) {
            const int s = (tid & 7) + 8 * j;
            float dot = 0.f;
#pragma unroll 16
            for (int d = 0; d < 64; ++d) dot = fmaf(Q[t * 65 + d], K[s * 65 + d], dot);
            SC[r * 129 + s] = (s <= t) ? dot * expf(lg * (float)(t - s)) : 0.f;
        }
        __syncthreads();
        float o[2][8];
#pragma unroll
        for (int dh = 0; dh < 2; ++dh) {
            for (int idx = tid; idx < 128 * 64; idx += NTHR) { const int row = idx >> 6, d = idx & 63; V[idx] = bf2f(Z[(size_t)(t0 + row) * ZW + C_RV + h * 128 + dh * 64 + d]); }
            for (int idx = tid; idx < 64 * 64; idx += NTHR) { const int k = idx >> 6, d = idx & 63; R[idx] = RST[(size_t)item * 8192 + k * 128 + dh * 64 + d]; }
            __syncthreads();
            float acc[8], cr[8];
#pragma unroll
            for (int j = 0; j < 8; ++j) { acc[j] = 0.f; cr[j] = 0.f; }
#pragma unroll 4
            for (int s = 0; s < 128; ++s) {
                const float w = SC[r * 129 + s];
#pragma unroll
                for (int j = 0; j < 8; ++j) acc[j] = fmaf(w, V[s * 64 + d0 + j], acc[j]);
            }
#pragma unroll 4
            for (int k = 0; k < 64; ++k) {
                const float qv = Q[t * 65 + k];
#pragma unroll
                for (int j = 0; j < 8; ++j) cr[j] = fmaf(qv, R[k * 64 + d0 + j], cr[j]);
            }
            const float xi = expf(lg * (float)(t + 1));
#pragma unroll
            for (int j = 0; j < 8; ++j) o[dh][j] = acc[j] + xi * cr[j];
            __syncthreads();
        }
        float sum = 0.f;
#pragma unroll
        for (int dh = 0; dh < 2; ++dh)
#pragma unroll
            for (int j = 0; j < 8; ++j) sum += o[dh][j];
        sum += __shfl_xor(sum, 1); sum += __shfl_xor(sum, 2); sum += __shfl_xor(sum, 4);
        const float mean = sum * (1.0f / 128.0f);
        float sq = 0.f;
#pragma unroll
        for (int dh = 0; dh < 2; ++dh)
#pragma unroll
            for (int j = 0; j < 8; ++j) { const float dd = o[dh][j] - mean; sq += dd * dd; }
        sq += __shfl_xor(sq, 1); sq += __shfl_xor(sq, 2); sq += __shfl_xor(sq, 4);
        const float rstd = 1.0f / sqrtf(sq * (1.0f / 128.0f) + LN_EPS);
#pragma unroll
        for (int dh = 0; dh < 2; ++dh) {
            float y[8];
#pragma unroll
            for (int j = 0; j < 8; ++j) {
                const int d = dh * 64 + d0 + j;
                const float g = p.ret_g[li * 512 + h * 128 + d];
                const float rg = bf2f(Z[(size_t)(t0 + t) * ZW + C_RG + h * 128 + d]);
                y[j] = (o[dh][j] - mean) * rstd * g * siluf_(rg);
            }
            uint4 w; w.x = pk2(y[0], y[1]); w.y = pk2(y[2], y[3]); w.z = pk2(y[4], y[5]); w.w = pk2(y[6], y[7]);
            *(uint4*)(MIX + (size_t)(t0 + t) * DM + h * 128 + dh * 64 + d0) = w;
        }
    }
    __syncthreads();
}

__device__ __forceinline__ void mls_out_item(const Params& p, int li, int item, float* lds) {
    const int tid = threadIdx.x;
    const int c = item & 63, bh = item >> 6, h = bh & 3, b = bh >> 2;
    const int t0 = b * SEQ + c * 128;
    const bf16* Z = (const bf16*)(p.ws + WS_Z);
    const float* gates = (const float*)(p.ws + WS_GATES);
    const float* MC = (const float*)(p.ws + WS_MC); const float* MN = (const float*)(p.ws + WS_MN); const float* MMP = (const float*)(p.ws + WS_MMP);
    bf16* MIX = (bf16*)(p.ws + WS_MIX);
    const float* cw = p.conv_w + (size_t)li * 4 * 512;
    float* Q = lds; float* K = Q + 8320; float* SM = K + 8320; float* V = SM + 8256; float* C = V + 8192; float* nv = C + 4096; float* ib = nv + 64; float* bb = ib + 128; float* pm = bb + 128;
    for (int idx = tid; idx < 128 * 64; idx += NTHR) {
        const int row = idx >> 6, d = idx & 63, chq = h * 64 + d, chk = 256 + h * 64 + d;
        float aq = 0.f, ak = 0.f;
#pragma unroll
        for (int j = 0; j < 4; ++j) {
            const int sp = c * 128 + row - 3 + j;
            if (sp >= 0) {
                const bf16* zr = Z + (size_t)(t0 + row - 3 + j) * ZW;
                aq = fmaf(cw[j * 512 + chq], bf2f(zr[C_MQ + h * 64 + d]), aq);
                ak = fmaf(cw[j * 512 + chk], bf2f(zr[C_MK + h * 64 + d]), ak);
            }
        }
        Q[row * 65 + d] = siluf_(aq); K[row * 65 + d] = siluf_(ak) * 0.125f;
        V[idx] = bf2f(Z[(size_t)(t0 + row) * ZW + C_MV + h * 64 + d]);
    }
    for (int idx = tid; idx < 4096; idx += NTHR) C[idx] = MC[(size_t)item * 4096 + idx];
    if (tid < 64) nv[tid] = MN[(size_t)item * 64 + tid];
    if (tid < 128) {
        const int t = t0 + tid;
        ib[tid] = gates[(size_t)t * 8 + h] + p.b_if[li * 8 + h];
        bb[tid] = logsigmoidf_(gates[(size_t)t * 8 + 4 + h] + p.b_if[li * 8 + 4 + h]);
    }
    const float mprev = MMP[item];
    __syncthreads();
    if (tid == 0) {
        float run = 0.f, pmx = -INFINITY;
#pragma unroll 4
        for (int s = 0; s < 128; ++s) { run += bb[s]; bb[s] = run; pmx = fmaxf(pmx, ib[s] - run); pm[s] = pmx; }
    }
    __syncthreads();
    const int r = tid >> 3, d0 = (tid & 7) * 8;
#pragma unroll 1
    for (int rh = 0; rh < 2; ++rh) {
        const int t = rh * 64 + r;
        const float mt = bb[t] + fmaxf(mprev, pm[t]);
#pragma unroll 1
        for (int j = 0; j < 16; ++j) {
            const int s = (tid & 7) + 8 * j;
            float dot = 0.f;
#pragma unroll 16
            for (int d = 0; d < 64; ++d) dot = fmaf(Q[t * 65 + d], K[s * 65 + d], dot);
            SM[r * 129 + s] = (s <= t) ? dot * expf(bb[t] - bb[s] + ib[s] - mt) : 0.f;
        }
        __syncthreads();
        float acc[8], qc[8], den = 0.f, qn = 0.f;
#pragma unroll
        for (int j = 0; j < 8; ++j) { acc[j] = 0.f; qc[j] = 0.f; }
#pragma unroll 4
        for (int s = 0; s < 128; ++s) {
            const float w = SM[r * 129 + s]; den += w;
#pragma unroll
            for (int j = 0; j < 8; ++j) acc[j] = fmaf(w, V[s * 64 + d0 + j], acc[j]);
        }
#pragma unroll 4
        for (int k = 0; k < 64; ++k) {
            const float qv = Q[t * 65 + k]; qn = fmaf(qv, nv[k], qn);
#pragma unroll
            for (int j = 0; j < 8; ++j) qc[j] = fmaf(qv, C[k * 64 + d0 + j], qc[j]);
        }
        const float winter = expf(bb[t] + mprev - mt);
        den += winter * qn;
        const float denom = fmaxf(fabsf(den), expf(-mt));
        float hv[8], sum = 0.f;
#pragma unroll
        for (int j = 0; j < 8; ++j) { hv[j] = (acc[j] + winter * qc[j]) / denom; sum += hv[j]; }
        sum += __shfl_xor(sum, 1); sum += __shfl_xor(sum, 2); sum += __shfl_xor(sum, 4);
        const float mean = sum * (1.0f / 64.0f);
        float sq = 0.f;
#pragma unroll
        for (int j = 0; j < 8; ++j) { const float dd = hv[j] - mean; sq += dd * dd; }
        sq += __shfl_xor(sq, 1); sq += __shfl_xor(sq, 2); sq += __shfl_xor(sq, 4);
        const float rstd = 1.0f / sqrtf(sq * (1.0f / 64.0f) + LN_EPS);
        float y[8];
#pragma unroll
        for (int j = 0; j < 8; ++j) {
            const int d = d0 + j;
            const float g = p.mls_g[li * 256 + h * 64 + d];
            const float mo = bf2f(Z[(size_t)(t0 + t) * ZW + C_MO + h * 64 + d]);
            y[j] = (hv[j] - mean) * rstd * g * sigmoidf_(mo);
        }
        { uint4 w; w.x = pk2(y[0], y[1]); w.y = pk2(y[2], y[3]); w.z = pk2(y[4], y[5]); w.w = pk2(y[6], y[7]);
          *(uint4*)(MIX + (size_t)(t0 + t) * DM + 768 + h * 64 + d0) = w; }
        __syncthreads();
    }
}

__device__ __forceinline__ void ln_row_inplace(const bf16* row, bf16* brow, signed char* qrow, float* qscale, const float* g, const float* bta, int lane) {
    float4 v[4]; float s = 0.f;
#pragma unroll
    for (int j = 0; j < 4; ++j) { const uint2 ub = *(const uint2*)(row + 256 * j + 4 * lane); v[j] = make_float4(__uint_as_float(ub.x << 16), __uint_as_float(ub.x & 0xffff0000u), __uint_as_float(ub.y << 16), __uint_as_float(ub.y & 0xffff0000u)); s += (v[j].x + v[j].y) + (v[j].z + v[j].w); }
    const float mean = wave_sum(s) * (1.0f / DM);
    float s2 = 0.f;
#pragma unroll
    for (int j = 0; j < 4; ++j) { v[j].x -= mean; v[j].y -= mean; v[j].z -= mean; v[j].w -= mean; s2 += (v[j].x * v[j].x + v[j].y * v[j].y) + (v[j].z * v[j].z + v[j].w * v[j].w); }
    const float rstd = 1.0f / sqrtf(wave_sum(s2) * (1.0f / DM) + LN_EPS);
#pragma unroll
    for (int j = 0; j < 4; ++j) {
        const float4 gg = *(const float4*)(g + 256 * j + 4 * lane), bv = *(const float4*)(bta + 256 * j + 4 * lane);
        const float4 o = make_float4(v[j].x * rstd * gg.x + bv.x, v[j].y * rstd * gg.y + bv.y, v[j].z * rstd * gg.z + bv.z, v[j].w * rstd * gg.w + bv.w);
        *(uint2*)(brow + 256 * j + 4 * lane) = make_uint2(pk2(o.x, o.y), pk2(o.z, o.w));
        v[j] = o;
    }
    float am = 0.f;
#pragma unroll
    for (int j = 0; j < 4; ++j) am = fmaxf(am, fmaxf(fmaxf(fabsf(v[j].x), fabsf(v[j].y)), fmaxf(fabsf(v[j].z), fabsf(v[j].w))));
    am = wave_max(am);
    const float inv = am > 0.f ? 127.0f / am : 0.f;
#pragma unroll
    for (int j = 0; j < 4; ++j) {
        const unsigned q0 = (unsigned)__float2int_rn(v[j].x * inv) & 0xffu, q1 = (unsigned)__float2int_rn(v[j].y * inv) & 0xffu, q2 = (unsigned)__float2int_rn(v[j].z * inv) & 0xffu, q3 = (unsigned)__float2int_rn(v[j].w * inv) & 0xffu;
        *(unsigned*)(qrow + 256 * j + 4 * lane) = q0 | (q1 << 8) | (q2 << 16) | (q3 << 24);
    }
    if (lane == 0) *qscale = am * (1.0f / 127.0f);
}

__device__ __forceinline__ void topk_item(const Params& p, int li, int item, float* lds) {
    const int tid = threadIdx.x, lane = tid & 63, wave = tid >> 6;
    const int tile = item >> 3, h = item & 7, tok0 = tile * 64;
    const bf16* QRY = (const bf16*)(p.ws + WS_QRY);
    int* RI = (int*)(p.ws + WS_RI); float* RG = (float*)(p.ws + WS_RG);
    float* Kk = lds; float* Qt = Kk + 128 * 129; float* SC = Qt + 64 * 129; float* TKV = SC + 64 * 128; int* TKI = (int*)(TKV + 2048);
#pragma unroll 1
    for (int pp = 0; pp < 2; ++pp) {
        const float* kb = p.keys + ((size_t)((li * 8 + h) * 2 + pp)) * 128 * 128;
        for (int idx = tid; idx < 128 * 128; idx += NTHR) { const int n = idx >> 7, c = idx & 127; Kk[n * 129 + c] = kb[idx]; }
        for (int idx = tid; idx < 64 * 128; idx += NTHR) { const int tok = idx >> 7, c = idx & 127; Qt[tok * 129 + c] = bf2f(QRY[(size_t)(tok0 + tok) * 2048 + h * 256 + pp * 128 + c]); }
        __syncthreads();
        {
            const int tok = tid >> 3;
#pragma unroll 1
            for (int j = 0; j < 16; ++j) {
                const int n = (tid & 7) + 8 * j;
                float dot = 0.f;
#pragma unroll 16
                for (int c = 0; c < 128; ++c) dot = fmaf(Qt[tok * 129 + c], Kk[n * 129 + c], dot);
                SC[tok * 128 + n] = dot;
            }
        }
        __syncthreads();
#pragma unroll 1
        for (int q = 0; q < 8; ++q) {
            const int tok = wave * 8 + q;
            float v0 = SC[tok * 128 + lane], v1 = SC[tok * 128 + 64 + lane];
#pragma unroll 1
            for (int k = 0; k < 16; ++k) {
                const float wm = wave_max(fmaxf(v0, v1));
                const unsigned long long b0 = __ballot(v0 == wm);
                int idx;
                if (b0) { const int sl = __ffsll((long long)b0) - 1; idx = sl; if (lane == sl) v0 = -INFINITY; }
                else { const unsigned long long b1 = __ballot(v1 == wm); const int sl = __ffsll((long long)b1) - 1; idx = 64 + sl; if (lane == sl) v1 = -INFINITY; }
                if (lane == 0) { TKV[(tok * 2 + pp) * 16 + k] = wm; TKI[(tok * 2 + pp) * 16 + k] = idx; }
            }
        }
        __syncthreads();
    }
#pragma unroll 1
    for (int q = 0; q < 8; ++q) {
        const int tok = wave * 8 + q;
        const float s1 = TKV[(tok * 2) * 16 + (lane >> 2)];
        float cnd[4];
#pragma unroll
        for (int j = 0; j < 4; ++j) cnd[j] = s1 + TKV[(tok * 2 + 1) * 16 + (lane & 3) * 4 + j];
        float myval = 0.f; int myflat = 0;
#pragma unroll 1
        for (int k = 0; k < 16; ++k) {
            const float wm = wave_max(fmaxf(fmaxf(cnd[0], cnd[1]), fmaxf(cnd[2], cnd[3])));
            const bool has = (cnd[0] == wm) | (cnd[1] == wm) | (cnd[2] == wm) | (cnd[3] == wm);
            const unsigned long long bl = __ballot(has);
            const int sl = __ffsll((long long)bl) - 1;
            int fl = 0;
            if (lane == sl) {
                int j = (cnd[0] == wm) ? 0 : ((cnd[1] == wm) ? 1 : ((cnd[2] == wm) ? 2 : 3));
                fl = lane * 4 + j;
                if (j == 0) cnd[0] = -INFINITY; else if (j == 1) cnd[1] = -INFINITY; else if (j == 2) cnd[2] = -INFINITY; else cnd[3] = -INFINITY;
            }
            fl = __shfl(fl, sl);
            if (lane == k) { myval = wm; myflat = fl; }
        }
        const float m0 = __shfl(myval, 0);
        const float e = (lane < 16) ? expf(myval - m0) : 0.f;
        const float ssum = wave_sum(e);
        if (lane < 16) {
            const int a = myflat >> 4, bq = myflat & 15;
            const int eidx = TKI[(tok * 2) * 16 + a] * 128 + TKI[(tok * 2 + 1) * 16 + bq];
            RI[(size_t)(tok0 + tok) * 128 + h * 16 + lane] = eidx;
            RG[(size_t)(tok0 + tok) * 128 + h * 16 + lane] = e / ssum;
        }
    }
    __syncthreads();
}

__device__ __forceinline__ float key_embed(float v, unsigned idx, unsigned keepmask) { return __uint_as_float((__float_as_uint(v) & keepmask) | idx); }

template <int N>
__device__ __forceinline__ void bitonic_desc(float (&a)[N]) {
#pragma unroll
    for (int k = 2; k <= N; k <<= 1)
#pragma unroll
        for (int j = k >> 1; j > 0; j >>= 1)
#pragma unroll
            for (int i = 0; i < N; ++i) {
                const int l = i ^ j;
                if (l > i) { const float hi = fmaxf(a[i], a[l]), lo = fminf(a[i], a[l]); if ((i & k) == 0) { a[i] = hi; a[l] = lo; } else { a[i] = lo; a[l] = hi; } }
            }
}
__device__ __forceinline__ void merge_top16(float (&a)[16], const float (&b)[16]) {
#pragma unroll
    for (int i = 0; i < 16; ++i) a[i] = fmaxf(a[i], b[15 - i]);
#pragma unroll
    for (int j = 8; j > 0; j >>= 1)
#pragma unroll
        for (int i = 0; i < 16; ++i) { const int l = i ^ j; if (l > i) { const float hi = fmaxf(a[i], a[l]), lo = fminf(a[i], a[l]); a[i] = hi; a[l] = lo; } }
}
__device__ __forceinline__ void topk_half(const bf16* qrow, const LAS unsigned char* kl, int r32, int hh, float (&out)[16]) {
    bf16x8_t qf[8];
#pragma unroll
    for (int ks = 0; ks < 8; ++ks) qf[ks] = *(const bf16x8_t*)(qrow + 16 * ks + 8 * hh);
    f32x16 st[4];
#pragma unroll
    for (int tl = 0; tl < 4; ++tl) {
        f32x16 a16 = {0.f, 0.f, 0.f, 0.f, 0.f, 0.f, 0.f, 0.f, 0.f, 0.f, 0.f, 0.f, 0.f, 0.f, 0.f, 0.f};
        const int n = 32 * tl + r32;
#pragma unroll
        for (int ks = 0; ks < 8; ++ks) {
            const int c = 2 * ks + hh;
            const bf16x8_t kf = *(const LAS bf16x8_t*)(kl + n * 256 + ((c ^ (n & 15)) << 4));
            a16 = __builtin_amdgcn_mfma_f32_32x32x16_bf16(kf, qf[ks], a16, 0, 0, 0);
        }
        st[tl] = a16;
    }
#pragma unroll
    for (int tl = 0; tl < 4; ++tl)
#pragma unroll
        for (int rg = 0; rg < 16; ++rg) st[tl][rg] = key_embed(st[tl][rg], (unsigned)(32 * tl + (rg & 3) + 8 * (rg >> 2)) | ((unsigned)hh << 2), 0xffffff80u);
    float g0[16], g1[16], g2[16], g3[16];
#pragma unroll
    for (int rg = 0; rg < 16; ++rg) { g0[rg] = st[0][rg]; g1[rg] = st[1][rg]; g2[rg] = st[2][rg]; g3[rg] = st[3][rg]; }
    bitonic_desc<16>(g0); bitonic_desc<16>(g1); bitonic_desc<16>(g2); bitonic_desc<16>(g3);
    merge_top16(g0, g1); merge_top16(g2, g3); merge_top16(g0, g2);
#pragma unroll
    for (int i = 0; i < 16; ++i) g1[i] = __shfl_xor(g0[i], 32);
    merge_top16(g0, g1);
#pragma unroll
    for (int i = 0; i < 16; ++i) out[i] = g0[i];
}

__device__ __forceinline__ void topk_unit(const Params& p, int li, int item, LAS unsigned char* lds) {
    const int tid = threadIdx.x, lane = tid & 63, wave = __builtin_amdgcn_readfirstlane(tid >> 6);
    const int r32 = lane & 31, hh = lane >> 5;
    const int tile = item >> 3, h = item & 7;
    const int t = tile * 256 + 32 * wave + r32;
    const bf16* QRY = (const bf16*)(p.ws + WS_QRY);
    const bf16* KB = (const bf16*)(p.ws + WS_KEYS) + (size_t)((li * 8 + h) * 2) * 128 * 128;
    int* RI = (int*)(p.ws + WS_RI); float* RG = (float*)(p.ws + WS_RG);
#pragma unroll 4
    for (int idx = tid; idx < 2 * 128 * 16; idx += NTHR) {
        const int pp = idx >> 11, n = (idx >> 4) & 127, c = idx & 15;
        const u32x4 v = *(const u32x4*)(KB + (size_t)(pp * 128 + n) * 128 + c * 8);
        *(LAS u32x4*)(lds + pp * 32768 + n * 256 + ((c ^ (n & 15)) << 4)) = v;
    }
    __syncthreads();
    float sk0[16], sk1[16];
    topk_half(QRY + (size_t)t * 2048 + h * 256, lds, r32, hh, sk0);
    topk_half(QRY + (size_t)t * 2048 + h * 256 + 128, lds + 32768, r32, hh, sk1);
    unsigned i1s[16], i2[16];
#pragma unroll
    for (int a = 0; a < 16; ++a) { i1s[a] = (__float_as_uint(sk0[a]) & 127u) << 7; i2[a] = __float_as_uint(sk1[a]) & 127u; }
    float cd[50];
    {
        constexpr int CA[50] = {0, 0, 0, 0, 0, 0, 0, 0, 0, 0, 0, 0, 0, 0, 0, 0, 1, 1, 1, 1, 1, 1, 1, 1, 2, 2, 2, 2, 2, 3, 3, 3, 3, 4, 4, 4, 5, 5, 6, 6, 7, 7, 8, 9, 10, 11, 12, 13, 14, 15};
        constexpr int CB[50] = {0, 1, 2, 3, 4, 5, 6, 7, 8, 9, 10, 11, 12, 13, 14, 15, 0, 1, 2, 3, 4, 5, 6, 7, 0, 1, 2, 3, 4, 0, 1, 2, 3, 0, 1, 2, 0, 1, 0, 1, 0, 1, 0, 0, 0, 0, 0, 0, 0, 0};
#pragma unroll
        for (int n = 0; n < 50; ++n) cd[n] = key_embed(sk0[CA[n]] + sk1[CB[n]], i1s[CA[n]] | i2[CB[n]], 0xffffc000u);
    }
    float sel[16], h1[16], h2[16], h3[16];
#pragma unroll
    for (int i = 0; i < 16; ++i) { sel[i] = cd[i]; h1[i] = cd[16 + i]; h2[i] = cd[32 + i]; h3[i] = -INFINITY; }
    h3[0] = fmaxf(cd[48], cd[49]); h3[1] = fminf(cd[48], cd[49]);
    bitonic_desc<16>(sel); bitonic_desc<16>(h1); bitonic_desc<16>(h2);
    merge_top16(sel, h1); merge_top16(h2, h3); merge_top16(sel, h2);
    float ev[16], es = 0.f;
    const float m0 = __uint_as_float((__float_as_uint(sel[0]) & 0xffffc000u) | 0x2000u);
#pragma unroll
    for (int k = 0; k < 16; ++k) { const float vk = __uint_as_float((__float_as_uint(sel[k]) & 0xffffc000u) | 0x2000u); ev[k] = __expf(vk - m0); es += ev[k]; }
    const float rs = 1.0f / es;
    int oi[8]; float og[8];
#pragma unroll
    for (int k = 0; k < 8; ++k) { float s_lo = sel[k], s_hi = sel[k + 8], g_lo = ev[k], g_hi = ev[k + 8]; asm volatile("" : "+v"(s_lo), "+v"(s_hi), "+v"(g_lo), "+v"(g_hi));
        const float sv = hh ? s_hi : s_lo; const float gv = hh ? g_hi : g_lo; oi[k] = (int)(__float_as_uint(sv) & 0x3fffu); og[k] = gv * rs; }
    int* rip = RI + (size_t)t * 128 + 2 * h + hh; float* rgp = RG + (size_t)t * 128 + 2 * h + hh;
#pragma unroll
    for (int j = 0; j < 8; ++j) { rip[16 * j] = oi[j]; rgp[16 * j] = og[j]; }
    __syncthreads();
}

template <bool SIGNED>
__device__ __forceinline__ void quant_rows(const float* src, unsigned char* dst, float* scl, int lane, int gw, int NGW) {
    for (int r = gw; r < 16384; r += NGW) {
        const float4* s4 = (const float4*)(src + (size_t)r * 1024 + 16 * lane);
        float4 a[4]; float am = 0.f;
#pragma unroll
        for (int j = 0; j < 4; ++j) { a[j] = s4[j]; am = fmaxf(am, fmaxf(fmaxf(fabsf(a[j].x), fabsf(a[j].y)), fmaxf(fabsf(a[j].z), fabsf(a[j].w)))); }
        am = wave_max(am);
        const float inv = am > 0.f ? 127.0f / am : 0.f;
        unsigned w[4];
#pragma unroll
        for (int j = 0; j < 4; ++j) {
            constexpr int OFS = SIGNED ? 0 : 128;
            const unsigned q0 = (unsigned)(__float2int_rn(a[j].x * inv) + OFS) & 0xffu, q1 = (unsigned)(__float2int_rn(a[j].y * inv) + OFS) & 0xffu, q2 = (unsigned)(__float2int_rn(a[j].z * inv) + OFS) & 0xffu, q3 = (unsigned)(__float2int_rn(a[j].w * inv) + OFS) & 0xffu;
            w[j] = q0 | (q1 << 8) | (q2 << 16) | (q3 << 24);
        }
        *(uint4*)(dst + (size_t)(lane >> 3) * (16384 * 128) + (size_t)r * 128 + 16 * (lane & 7)) = make_uint4(w[0], w[1], w[2], w[3]);
        if (lane == 0) scl[r] = am * (1.0f / 127.0f);
    }
}

__device__ __forceinline__ void ub4(unsigned w, float* o) { o[0] = (float)(w & 0xffu); o[1] = (float)((w >> 8) & 0xffu); o[2] = (float)((w >> 16) & 0xffu); o[3] = (float)(w >> 24); }

__device__ __forceinline__ void peer_token(const Params& p, int li, int t, int lane) {
    float* stream = p.out;
    const bf16* E = (const bf16*)(p.ws + WS_E); bf16* XB = (bf16*)(p.ws + WS_XB);
    const int* RI = (const int*)(p.ws + WS_RI); const float* RG = (const float*)(p.ws + WS_RG);
    const unsigned char* UQ = (const unsigned char*)(p.ws + WS_UQ); const unsigned char* VQ = (const unsigned char*)(p.ws + WS_VQ);
    const float* US = (const float*)(p.ws + WS_US); const float* VS = (const float*)(p.ws + WS_VS);
    float* row = stream + (size_t)t * DM + 16 * lane;
    float x[16], acc[16];
#pragma unroll
    for (int j = 0; j < 4; ++j) { const float4 v = *(const float4*)(row + 4 * j); x[4 * j] = v.x; x[4 * j + 1] = v.y; x[4 * j + 2] = v.z; x[4 * j + 3] = v.w; }
    float sx = 0.f;
#pragma unroll
    for (int j = 0; j < 16; ++j) { sx += x[j]; acc[j] = 0.f; }
    const float sumx128 = 128.0f * wave_sum(sx);
    const int e0 = RI[(size_t)t * 128 + lane], e1 = RI[(size_t)t * 128 + 64 + lane];
    const float g0 = RG[(size_t)t * 128 + lane], g1 = RG[(size_t)t * 128 + 64 + lane];
    const float su0 = US[e0], su1 = US[e1], sv0 = VS[e0], sv1 = VS[e1];
    float csum = 0.f;
    const int mi = (lane >> 3) & 7;
#pragma unroll 1
    for (int bt = 0; bt < 16; ++bt) {
        const bool lo = bt < 8;
        const int esel = lo ? e0 : e1;
        uint4 uq[8], vq[8];
#pragma unroll
        for (int i = 0; i < 8; ++i) {
            const int e = __builtin_amdgcn_readlane(esel, (bt * 8 + i) & 63);
            uq[i] = *(const uint4*)(UQ + (size_t)e * 1024 + 16 * lane);
            vq[i] = *(const uint4*)(VQ + (size_t)e * 1024 + 16 * lane);
        }
        float d[8];
#pragma unroll
        for (int i = 0; i < 8; ++i) {
            float f[16]; ub4(uq[i].x, f); ub4(uq[i].y, f + 4); ub4(uq[i].z, f + 8); ub4(uq[i].w, f + 12);
            float s = 0.f;
#pragma unroll
            for (int j = 0; j < 16; ++j) s = fmaf(x[j], f[j], s);
            d[i] = s;
        }
#pragma unroll
        for (int i = 0; i < 4; ++i) { const bool up = (lane & 32) != 0; const float send = up ? d[i] : d[i + 4]; const float keep = up ? d[i + 4] : d[i]; d[i] = keep + __shfl_xor(send, 32); }
#pragma unroll
        for (int i = 0; i < 2; ++i) { const bool up = (lane & 16) != 0; const float send = up ? d[i] : d[i + 2]; const float keep = up ? d[i + 2] : d[i]; d[i] = keep + __shfl_xor(send, 16); }
        { const bool up = (lane & 8) != 0; const float send = up ? d[0] : d[1]; const float keep = up ? d[1] : d[0]; d[0] = keep + __shfl_xor(send, 8); }
        float dq = d[0]; dq += __shfl_xor(dq, 4); dq += __shfl_xor(dq, 2); dq += __shfl_xor(dq, 1);
        const int src = (bt * 8 + mi) & 63;
        const float su = __shfl(lo ? su0 : su1, src), sv = __shfl(lo ? sv0 : sv1, src), gg = __shfl(lo ? g0 : g1, src);
        const float dot = su * (dq - sumx128);
        const float cf = 0.5f * dot * (1.0f + erff(dot * 0.70710678118f)) * gg * sv;
#pragma unroll
        for (int i = 0; i < 8; ++i) {
            const float c = __int_as_float(__builtin_amdgcn_readlane(__float_as_int(cf), 8 * i));
            csum += c;
            float f[16]; ub4(vq[i].x, f); ub4(vq[i].y, f + 4); ub4(vq[i].z, f + 8); ub4(vq[i].w, f + 12);
#pragma unroll
            for (int j = 0; j < 16; ++j) acc[j] = fmaf(c, f[j], acc[j]);
        }
    }
    const float off = 128.0f * csum;
    float s = 0.f;
    {
        const uint4 ea = *(const uint4*)(E + (size_t)t * DM + 16 * lane), eb = *(const uint4*)(E + (size_t)t * DM + 16 * lane + 8);
        float ev[16]; unpack8(ea, ev); unpack8(eb, ev + 8);
#pragma unroll
        for (int j = 0; j < 16; ++j) { acc[j] = (acc[j] - off) + DN_ALPHA * x[j] + ev[j]; s += acc[j]; }
    }
    const float mean = wave_sum(s) * (1.0f / DM);
    float s2 = 0.f;
#pragma unroll
    for (int j = 0; j < 16; ++j) { acc[j] -= mean; s2 += acc[j] * acc[j]; }
    const float rstd = 1.0f / sqrtf(wave_sum(s2) * (1.0f / DM) + LN_EPS);
    const float* g2 = p.ln2_g + li * DM + 16 * lane; const float* b2 = p.ln2_b + li * DM + 16 * lane;
    float o[16];
#pragma unroll
    for (int j = 0; j < 4; ++j) {
        const float4 gg = *(const float4*)(g2 + 4 * j), bv = *(const float4*)(b2 + 4 * j);
        o[4 * j] = acc[4 * j] * rstd * gg.x + bv.x; o[4 * j + 1] = acc[4 * j + 1] * rstd * gg.y + bv.y; o[4 * j + 2] = acc[4 * j + 2] * rstd * gg.z + bv.z; o[4 * j + 3] = acc[4 * j + 3] * rstd * gg.w + bv.w;
        *(float4*)(row + 4 * j) = make_float4(o[4 * j], o[4 * j + 1], o[4 * j + 2], o[4 * j + 3]);
    }
    if (li == 0) {
        bf16* xb = XB + (size_t)t * DM + 16 * lane;
        *(uint4*)xb = make_uint4(pk2(o[0], o[1]), pk2(o[2], o[3]), pk2(o[4], o[5]), pk2(o[6], o[7]));
        *(uint4*)(xb + 8) = make_uint4(pk2(o[8], o[9]), pk2(o[10], o[11]), pk2(o[12], o[13]), pk2(o[14], o[15]));
    }
}

struct SlicePlan { int m, mi, wid, wstride; };
__device__ __forceinline__ SlicePlan slice_plan(const Params& p, unsigned rank, int wave) {
    unsigned* bar = (unsigned*)(p.ws + WS_CTL) + 1024;
    const unsigned x = xb_xcc_id();
    SlicePlan sp; sp.m = 0; sp.mi = 0; int nloc = 1;
#pragma unroll
    for (unsigned j = 0; j < 16; ++j) { const unsigned c = xb_ld(&bar[XB_XCNT(j)]); if (j == x) { sp.mi = sp.m; nloc = (int)c; } if (c > 0u) ++sp.m; }
    sp.wid = (int)rank * NWAVE + wave; sp.wstride = nloc * NWAVE;
    return sp;
}
#define PEER_TPW 16
__device__ __forceinline__ int peer_tok(int n, int wid, int wstride) { return ((n >> 4) * wstride + wid) * PEER_TPW + (n & 15); }
__device__ __forceinline__ void peer_u_slice(const Params& p, int xs, int wid, int wstride, int lane) {
    const int* RI = (const int*)(p.ws + WS_RI);
    const signed char* X1Q = (const signed char*)(p.ws + WS_X1Q); const signed char* UQ = (const signed char*)(p.ws + WS_UQ);
    int* PI = (int*)(p.ws + WS_PI) + (size_t)xs * NT * 128;
    const int g = lane >> 3, q = lane & 7, loff = 128 * xs + 16 * q;
    const signed char* UQs = UQ + (size_t)xs * (16384 * 128) + 16 * q;
    const int ngrp = (NT / PEER_TPW - wid + wstride - 1) / wstride, N = ngrp * PEER_TPW;
    if (N <= 0) return;
    int ee[16]; int4 uA[16], uB[16]; int4 xA, xB;
#define PU_E(E, t) do { const int4* rp_ = (const int4*)(RI + (size_t)(t) * 128 + 16 * g); _Pragma("unroll") for (int b4 = 0; b4 < 4; ++b4) { const int4 r_ = rp_[b4]; E[4 * b4] = r_.x; E[4 * b4 + 1] = r_.y; E[4 * b4 + 2] = r_.z; E[4 * b4 + 3] = r_.w; } } while (0)
#define PU_U(U, X, E, t) do { X = *(const int4*)(X1Q + (size_t)(t) * DM + loff); _Pragma("unroll") for (int bt = 0; bt < 16; ++bt) U[bt] = *(const int4*)(UQs + (size_t)E[bt] * 128); } while (0)
#define PU_C(U, X, t) do { int dd_[16]; _Pragma("unroll") for (int bt = 0; bt < 16; ++bt) { \
        int d = __builtin_amdgcn_sdot4(X.x, U[bt].x, 0, false); d = __builtin_amdgcn_sdot4(X.y, U[bt].y, d, false); d = __builtin_amdgcn_sdot4(X.z, U[bt].z, d, false); d = __builtin_amdgcn_sdot4(X.w, U[bt].w, d, false); \
        d += __shfl_xor(d, 1); d += __shfl_xor(d, 2); d += __shfl_xor(d, 4); dd_[bt] = d; } \
        if (q == 0) { int4* pp_ = (int4*)(PI + (size_t)(t) * 128 + 16 * g); _Pragma("unroll") for (int b4 = 0; b4 < 4; ++b4) pp_[b4] = make_int4(dd_[4 * b4], dd_[4 * b4 + 1], dd_[4 * b4 + 2], dd_[4 * b4 + 3]); } } while (0)
#define TK(n) peer_tok((n), wid, wstride)
    PU_E(ee, TK(0)); PU_U(uA, xA, ee, TK(0)); PU_E(ee, TK(1));
#pragma unroll 1
    for (int i = 0; i < N; i += 2) {
        PU_U(uB, xB, ee, TK(i + 1));
        if (i + 2 < N) PU_E(ee, TK(i + 2));
        asm volatile("" ::: "memory");
        PU_C(uA, xA, TK(i));
        if (i + 2 < N) PU_U(uA, xA, ee, TK(i + 2));
        if (i + 3 < N) PU_E(ee, TK(i + 3));
        asm volatile("" ::: "memory");
        PU_C(uB, xB, TK(i + 1));
    }
#undef PU_E
#undef PU_U
#undef PU_C
}
__device__ __forceinline__ void peer_coef_token(const Params& p, int t, int lane) {
    const int* RI = (const int*)(p.ws + WS_RI); const float* RG = (const float*)(p.ws + WS_RG);
    const float* US = (const float*)(p.ws + WS_US); const float* VS = (const float*)(p.ws + WS_VS);
    const int* PI = (const int*)(p.ws + WS_PI);
    signed char* PC = (signed char*)(p.ws + WS_PC); float* PCS = (float*)(p.ws + WS_PCS);
    const float sx = ((const float*)(p.ws + WS_X1S))[t];
    float c[2];
#pragma unroll
    for (int hf = 0; hf < 2; ++hf) {
        const int k = lane + 64 * hf;
        const int e = RI[(size_t)t * 128 + k];
        int acc = 0;
#pragma unroll
        for (int x = 0; x < 8; ++x) acc += PI[((size_t)x * NT + t) * 128 + k];
        const float dot = US[e] * sx * (float)acc;
        c[hf] = 0.5f * dot * (1.0f + erff(dot * 0.70710678118f)) * RG[(size_t)t * 128 + k] * VS[e];
    }
    const float cm = wave_max(fmaxf(fabsf(c[0]), fabsf(c[1])));
    const float inv = cm > 0.f ? 127.0f / cm : 0.f;
    PC[(size_t)t * 128 + lane] = (signed char)__float2int_rn(c[0] * inv);
    PC[(size_t)t * 128 + 64 + lane] = (signed char)__float2int_rn(c[1] * inv);
    if (lane == 0) PCS[t] = cm * (1.0f / 127.0f);
}
__device__ __forceinline__ void peer_v_token(const uint4 (&vq)[16], const int4 cq, float cscale, bf16* yrow, int lane) {
    int acc[16];
#pragma unroll
    for (int j = 0; j < 16; ++j) acc[j] = 0;
    const int c4[4] = {cq.x, cq.y, cq.z, cq.w};
#pragma unroll
    for (int b4 = 0; b4 < 4; ++b4) {
#pragma unroll
        for (int dc = 0; dc < 4; ++dc) {
            const unsigned w0 = dc == 0 ? vq[4 * b4].x : dc == 1 ? vq[4 * b4].y : dc == 2 ? vq[4 * b4].z : vq[4 * b4].w;
            const unsigned w1 = dc == 0 ? vq[4 * b4 + 1].x : dc == 1 ? vq[4 * b4 + 1].y : dc == 2 ? vq[4 * b4 + 1].z : vq[4 * b4 + 1].w;
            const unsigned w2 = dc == 0 ? vq[4 * b4 + 2].x : dc == 1 ? vq[4 * b4 + 2].y : dc == 2 ? vq[4 * b4 + 2].z : vq[4 * b4 + 2].w;
            const unsigned w3 = dc == 0 ? vq[4 * b4 + 3].x : dc == 1 ? vq[4 * b4 + 3].y : dc == 2 ? vq[4 * b4 + 3].z : vq[4 * b4 + 3].w;
            const unsigned t0 = __builtin_amdgcn_perm(w1, w0, 0x05010400u), t1 = __builtin_amdgcn_perm(w1, w0, 0x07030602u);
            const unsigned t2 = __builtin_amdgcn_perm(w3, w2, 0x05010400u), t3 = __builtin_amdgcn_perm(w3, w2, 0x07030602u);
            const unsigned f0 = __builtin_amdgcn_perm(t2, t0, 0x05040100u), f1 = __builtin_amdgcn_perm(t2, t0, 0x07060302u);
            const unsigned f2 = __builtin_amdgcn_perm(t3, t1, 0x05040100u), f3 = __builtin_amdgcn_perm(t3, t1, 0x07060302u);
            acc[4 * dc + 0] = __builtin_amdgcn_sdot4((int)f0, c4[b4], acc[4 * dc + 0], false);
            acc[4 * dc + 1] = __builtin_amdgcn_sdot4((int)f1, c4[b4], acc[4 * dc + 1], false);
            acc[4 * dc + 2] = __builtin_amdgcn_sdot4((int)f2, c4[b4], acc[4 * dc + 2], false);
            acc[4 * dc + 3] = __builtin_amdgcn_sdot4((int)f3, c4[b4], acc[4 * dc + 3], false);
        }
    }
#pragma unroll
    for (int j = 0; j < 8; ++j) { const bool up = (lane & 32) != 0; const int send = up ? acc[j] : acc[j + 8]; const int keep = up ? acc[j + 8] : acc[j]; acc[j] = keep + __shfl_xor(send, 32); }
#pragma unroll
    for (int j = 0; j < 4; ++j) { const bool up = (lane & 16) != 0; const int send = up ? acc[j] : acc[j + 4]; const int keep = up ? acc[j + 4] : acc[j]; acc[j] = keep + __shfl_xor(send, 16); }
#pragma unroll
    for (int j = 0; j < 2; ++j) { const bool up = (lane & 8) != 0; const int send = up ? acc[j] : acc[j + 2]; const int keep = up ? acc[j + 2] : acc[j]; acc[j] = keep + __shfl_xor(send, 8); }
    const int j0 = 2 * ((lane >> 3) & 1) + 4 * ((lane >> 4) & 1) + 8 * ((lane >> 5) & 1);
    *(unsigned*)(yrow + j0) = pk2((float)acc[0] * cscale, (float)acc[1] * cscale);
}
__device__ __forceinline__ void peer_v_slice(const Params& p, int xs, int wid, int wstride, int lane) {
    const int* RI = (const int*)(p.ws + WS_RI);
    const unsigned char* VQ = (const unsigned char*)(p.ws + WS_VQ);
    const signed char* PC = (const signed char*)(p.ws + WS_PC); const float* PCS = (const float*)(p.ws + WS_PCS);
    bf16* Y = (bf16*)(p.ws + WS_Y);
    const int g = lane >> 3, q = lane & 7, loff = 128 * xs + 16 * q;
    const unsigned char* VQs = VQ + (size_t)xs * (16384 * 128) + 16 * q;
    const int ngrp = (NT / PEER_TPW - wid + wstride - 1) / wstride, N = ngrp * PEER_TPW;
    if (N <= 0) return;
    int ee[16]; uint4 vA[16], vB[16]; int4 cA, cB; float oA, oB;
#define PV_E(E, t) do { const int4* rp_ = (const int4*)(RI + (size_t)(t) * 128 + 16 * g); _Pragma("unroll") for (int b4 = 0; b4 < 4; ++b4) { const int4 r_ = rp_[b4]; E[4 * b4] = r_.x; E[4 * b4 + 1] = r_.y; E[4 * b4 + 2] = r_.z; E[4 * b4 + 3] = r_.w; } } while (0)
#define PV_U(V, C, O, E, t) do { O = PCS[(t)]; C = *(const int4*)(PC + (size_t)(t) * 128 + 16 * g); _Pragma("unroll") for (int bt = 0; bt < 16; ++bt) V[bt] = *(const uint4*)(VQs + (size_t)E[bt] * 128); } while (0)
    PV_E(ee, TK(0)); PV_U(vA, cA, oA, ee, TK(0)); PV_E(ee, TK(1));
#pragma unroll 1
    for (int i = 0; i < N; i += 2) {
        PV_U(vB, cB, oB, ee, TK(i + 1));
        if (i + 2 < N) PV_E(ee, TK(i + 2));
        asm volatile("" ::: "memory");
        peer_v_token(vA, cA, oA, Y + (size_t)TK(i) * DM + loff, lane);
        if (i + 2 < N) PV_U(vA, cA, oA, ee, TK(i + 2));
        if (i + 3 < N) PV_E(ee, TK(i + 3));
        asm volatile("" ::: "memory");
        peer_v_token(vB, cB, oB, Y + (size_t)TK(i + 1) * DM + loff, lane);
    }
#undef PV_E
#undef PV_U
#undef TK
}
__device__ __forceinline__ void up4(const uint2 w, float* o) { o[0] = __uint_as_float(w.x << 16); o[1] = __uint_as_float(w.x & 0xffff0000u); o[2] = __uint_as_float(w.y << 16); o[3] = __uint_as_float(w.y & 0xffff0000u); }
__device__ __forceinline__ void peer_ln_token(const Params& p, int li, int t, int lane) {
    const bf16* E = (const bf16*)(p.ws + WS_E); bf16* XB = (bf16*)(p.ws + WS_XB); const bf16* Y = (const bf16*)(p.ws + WS_Y);
    float4 v[4]; float s = 0.f;
#pragma unroll
    for (int j = 0; j < 4; ++j) {
        const size_t o = (size_t)t * DM + 256 * j + 4 * lane;
        float x[4], y[4], e[4]; up4(*(const uint2*)(XB + o), x); up4(*(const uint2*)(Y + o), y); up4(*(const uint2*)(E + o), e);
        v[j].x = DN_ALPHA * x[0] + y[0] + e[0]; v[j].y = DN_ALPHA * x[1] + y[1] + e[1]; v[j].z = DN_ALPHA * x[2] + y[2] + e[2]; v[j].w = DN_ALPHA * x[3] + y[3] + e[3];
        s += (v[j].x + v[j].y) + (v[j].z + v[j].w);
    }
    const float mean = wave_sum(s) * (1.0f / DM);
    float s2 = 0.f;
#pragma unroll
    for (int j = 0; j < 4; ++j) { v[j].x -= mean; v[j].y -= mean; v[j].z -= mean; v[j].w -= mean; s2 += (v[j].x * v[j].x + v[j].y * v[j].y) + (v[j].z * v[j].z + v[j].w * v[j].w); }
    const float rstd = 1.0f / sqrtf(wave_sum(s2) * (1.0f / DM) + LN_EPS);
    const float* g2 = p.ln2_g + li * DM; const float* b2 = p.ln2_b + li * DM;
#pragma unroll
    for (int j = 0; j < 4; ++j) {
        const float4 gg = *(const float4*)(g2 + 256 * j + 4 * lane), bv = *(const float4*)(b2 + 256 * j + 4 * lane);
        const float4 o = make_float4(v[j].x * rstd * gg.x + bv.x, v[j].y * rstd * gg.y + bv.y, v[j].z * rstd * gg.z + bv.z, v[j].w * rstd * gg.w + bv.w);
        if (li == 0) *(uint2*)(XB + (size_t)t * DM + 256 * j + 4 * lane) = make_uint2(pk2(o.x, o.y), pk2(o.z, o.w));
        else *(float4*)(p.out + (size_t)t * DM + 256 * j + 4 * lane) = o;
    }
}

constexpr int PH_PER_LAYER = 12, NPHASE = 1 + 2 * PH_PER_LAYER;

#ifndef PROBE_DUP
#define PROBE_DUP 0
#endif
#define PH_BEGIN(k) if (lo <= (k) && (k) < hi && ((k) == 0 || PHON(((k) - 1) % PH_PER_LAYER))) for (int rep_ = 0; rep_ < (((k) > 0 && ((PROBE_DUP >> (((k) - 1) % PH_PER_LAYER)) & 1)) ? 2 : 1); ++rep_) { unsigned long long probe_t0 = 0; if ((PROBE_T >> PH_BIT(k)) & 1) probe_t0 = __builtin_amdgcn_s_memrealtime();
#define PH_SYNC_DUP() do { if (rep_ == 0) { asm volatile("s_waitcnt vmcnt(0)" ::: "memory"); __syncthreads(); } } while (0)
#ifndef PROBE_T
#define PROBE_T 0
#endif
#define PH_BIT(k) ((k) == 0 ? 15 : (((k) - 1) % PH_PER_LAYER))
#define PH_END(k) if ((k) + 1 < hi) xcd_barrier(bar); if ((PROBE_T >> PH_BIT(k)) & 1) { const unsigned long long tn_ = __builtin_amdgcn_s_memrealtime(); probe_ticks += tn_ - probe_t0; } }

template <int LI>
__device__ __forceinline__ void run_layer(const Params& p, float* lds, const XcdBarrier& bar, int lo, int hi, unsigned long long& probe_ticks, unsigned rank) {
    constexpr int li = LI, base = 1 + LI * PH_PER_LAYER;
    const int tid = threadIdx.x, lane = tid & 63, wave = __builtin_amdgcn_readfirstlane(tid >> 6);
    const int G = gridDim.x;
    float* stream = p.out;
    LAS unsigned char* ldsb = (LAS unsigned char*)lds;
    PH_BEGIN(base + 0)
        EpiZ16 e{(bf16*)(p.ws + WS_Z), (float*)(p.ws + WS_GATES), (const float*)(p.ws + WS_ACOS), (const float*)(p.ws + WS_ASIN)};
        gemm16(ldsb, (const bf16*)(p.ws + WS_XB), (const bf16*)(p.ws + WS_WIN) + (size_t)li * NZP * DM, NZP, DM, e);
    PH_END(base + 0)
    PH_BEGIN(base + 1)
        for (int it = blockIdx.x; it < 1024 + 1536; it += G) {
            if (it < 512) ret_state_u(p, 2 * it + (wave >> 2), ldsb + (wave >> 2) * UNIT_LDS, wave & 3, tid & 255, lane);
            else if (it < 1024) mls_state_u(p, li, 2 * (it - 512) + (wave >> 2), ldsb + (wave >> 2) * UNIT_LDS, wave & 3, tid & 255, lane);
            else attn_unit(p, it - 1024, ldsb);
        }
    PH_END(base + 1)
    PH_BEGIN(base + 2)
        p3_scans(p);
        attn_merge(p);
    PH_END(base + 2)
    PH_BEGIN(base + 3)
        for (int it = blockIdx.x; it < 1024; it += G) {
            if (it < 512) ret_out_u(p, li, 2 * it + (wave >> 2), ldsb + (wave >> 2) * UNIT_LDS, wave & 3, tid & 255, lane);
            else mls_out_u(p, li, 2 * (it - 512) + (wave >> 2), ldsb + (wave >> 2) * UNIT_LDS, wave & 3, tid & 255, lane);
        }
    PH_END(base + 3)
    PH_BEGIN(base + 4)
        EpiRes16 e{(const bf16*)(p.ws + WS_XB), (bf16*)(p.ws + WS_U16)};
        gemm16(ldsb, (const bf16*)(p.ws + WS_MIX), (const bf16*)(p.ws + WS_WOUT) + (size_t)li * DM * DM, DM, DM, e);
    PH_END(base + 4)
    PH_BEGIN(base + 5)
        for (int r = blockIdx.x * NWAVE + wave; r < NT; r += G * NWAVE) ln_row_inplace((const bf16*)(p.ws + WS_U16) + (size_t)r * DM, (bf16*)(p.ws + WS_XB) + (size_t)r * DM, (signed char*)(p.ws + WS_X1Q) + (size_t)r * DM, (float*)(p.ws + WS_X1S) + r, p.ln1_g + li * DM, p.ln1_b + li * DM, lane);
        quant_rows<true>(p.pu + (size_t)li * 16384 * 1024, (unsigned char*)(p.ws + WS_UQ), (float*)(p.ws + WS_US), lane, blockIdx.x * NWAVE + wave, G * NWAVE);
        quant_rows<true>(p.pv + (size_t)li * 16384 * 1024, (unsigned char*)(p.ws + WS_VQ), (float*)(p.ws + WS_VS), lane, blockIdx.x * NWAVE + wave, G * NWAVE);
        EpiBf16Store e{(bf16*)(p.ws + WS_E), DM};
        gemm16(ldsb, (const bf16*)(p.ws + WS_PB) + (size_t)li * NT * 256, (const bf16*)(p.ws + WS_WP) + (size_t)li * DM * 256, DM, 256, e);
    PH_END(base + 5)
    PH_BEGIN(base + 6)
        EpiBf16Store eq{(bf16*)(p.ws + WS_QRY), 2048};
        gemm16(ldsb, (const bf16*)(p.ws + WS_XB), (const bf16*)(p.ws + WS_WQG) + (size_t)li * 3072 * DM, 2048, DM, eq);
        EpiGate16 eg{(bf16*)(p.ws + WS_E), p.bg + li * DM};
        gemm16(ldsb, (const bf16*)(p.ws + WS_XB), (const bf16*)(p.ws + WS_WQG) + (size_t)li * 3072 * DM + (size_t)2048 * DM, DM, DM, eg);
    PH_END(base + 6)
    PH_BEGIN(base + 7)
        for (int it = blockIdx.x; it < (NT / 256) * 8; it += G) topk_unit(p, li, it, ldsb);
    PH_END(base + 7)
    PH_BEGIN(base + 8)
        const SlicePlan sp = slice_plan(p, rank, wave);
        for (int xs = 0; xs < 8; ++xs) if ((xs % sp.m) == sp.mi) peer_u_slice(p, xs, sp.wid, sp.wstride, lane);
    PH_END(base + 8)
    PH_BEGIN(base + 9)
        for (int t = blockIdx.x * NWAVE + wave; t < NT; t += G * NWAVE) peer_coef_token(p, t, lane);
    PH_END(base + 9)
    PH_BEGIN(base + 10)
        const SlicePlan sp = slice_plan(p, rank, wave);
        for (int xs = 0; xs < 8; ++xs) if ((xs % sp.m) == sp.mi) peer_v_slice(p, xs, sp.wid, sp.wstride, lane);
    PH_END(base + 10)
    PH_BEGIN(base + 11)
        for (int t = blockIdx.x * NWAVE + wave; t < NT; t += G * NWAVE) peer_ln_token(p, li, t, lane);
    PH_END(base + 11)
}

__global__ void __launch_bounds__(NTHR, 2) mk_fwd(Params p) {
    extern __shared__ __attribute__((aligned(16))) unsigned char lds_raw[];
    float* lds = (float*)lds_raw;
    const int tid = threadIdx.x;
    volatile LAS unsigned* MISC = (volatile LAS unsigned*)((LAS unsigned char*)lds_raw + LDS_CTL_OFF);
    if (tid < 64) MISC[tid] = 0u;
    __syncthreads();
    const int lo = p.ph_lo, hi = p.ph_hi;
    XcdBarrier bar; bar.bar = (unsigned*)(p.ws + WS_CTL) + 1024; bar.x = 0; bar.st = nullptr;
    if (hi - lo > 1) bar = xcd_barrier_post((unsigned*)(p.ws + WS_CTL) + 1024, MISC + 8);
    __syncthreads();
    const unsigned rank = MISC[10];
    unsigned long long probe_ticks = 0;
    PH_BEGIN(0)
        p0_tables(p);
        p0_weights(p, lds);
    PH_END(0)
    run_layer<0>(p, lds, bar, lo, hi, probe_ticks, rank);
    run_layer<1>(p, lds, bar, lo, hi, probe_ticks, rank);
    if (PROBE_R) { __syncthreads(); probe_ticks += ((volatile LAS unsigned*)((LAS unsigned char*)lds_raw + 159 * 1024 + 128))[0]; }
    if (PROBE_T || PROBE_R) { const unsigned long long te_ = __builtin_amdgcn_s_memrealtime(); while (__builtin_amdgcn_s_memrealtime() - te_ < probe_ticks) __builtin_amdgcn_s_sleep(8); }
}

extern "C" void kernel_launch(void* const* d_in, const int* in_sizes, int n_in, void* d_out, int out_size, void* d_ws, size_t ws_size, hipStream_t stream) {
    static int grid = 0;
    if (grid == 0) {
        if (n_in != 19 || in_sizes[0] != NT * DM || out_size != NT * DM || ws_size < WS_END) { fprintf(stderr, "kernel_launch: unexpected shapes (n_in %d in0 %d out %d ws %zu)\n", n_in, n_in > 0 ? in_sizes[0] : -1, out_size, ws_size); grid = -1; return; }
        int dev = 0, cus = 0;
        if (hipGetDevice(&dev) != hipSuccess || hipDeviceGetAttribute(&cus, hipDeviceAttributeMultiprocessorCount, dev) != hipSuccess) { grid = -1; return; }
        if (hipFuncSetAttribute((const void*)mk_fwd, hipFuncAttributeMaxDynamicSharedMemorySize, LDS_BYTES) != hipSuccess) { fprintf(stderr, "kernel_launch: hipFuncSetAttribute failed\n"); grid = -1; return; }
        int per_cu = 0;
        if (hipOccupancyMaxActiveBlocksPerMultiprocessor(&per_cu, (const void*)mk_fwd, NTHR, LDS_BYTES) != hipSuccess || per_cu < 1) fprintf(stderr, "kernel_launch: occupancy query says %d\n", per_cu);
        (void)hipGetLastError();
        grid = cus;
    }
    if (grid < 0) return;
    if (hipMemsetAsync((char*)d_ws + WS_CTL, 0, CTL_ZERO_BYTES, stream) != hipSuccess) return;
    Params a{};
    a.x = (const float*)d_in[0]; a.p = (const float*)d_in[1]; a.w_in = (const float*)d_in[2]; a.conv_w = (const float*)d_in[3]; a.b_if = (const float*)d_in[4];
    a.ret_g = (const float*)d_in[5]; a.mls_g = (const float*)d_in[6]; a.w_out = (const float*)d_in[7]; a.ln1_g = (const float*)d_in[8]; a.ln1_b = (const float*)d_in[9];
    a.wq = (const float*)d_in[10]; a.keys = (const float*)d_in[11]; a.pu = (const float*)d_in[12]; a.pv = (const float*)d_in[13]; a.wg = (const float*)d_in[14];
    a.bg = (const float*)d_in[15]; a.wp = (const float*)d_in[16]; a.ln2_g = (const float*)d_in[17]; a.ln2_b = (const float*)d_in[18];
    a.out = (float*)d_out; a.ws = (unsigned char*)d_ws;
#if MK_SPLIT
    for (int ph = 0; ph < NPHASE; ++ph) { a.ph_lo = ph; a.ph_hi = ph + 1; hipLaunchKernelGGL(mk_fwd, dim3(grid), dim3(NTHR), LDS_BYTES, stream, a); }
#else
    a.ph_lo = 0; a.ph_hi = NPHASE;
    hipLaunchKernelGGL(mk_fwd, dim3(grid), dim3(NTHR), LDS_BYTES, stream, a);
#endif
}
```

```cpp
#include <hip/hip_runtime.h>
#include <cstdio>
#include <cstdint>
#include <cmath>

#ifndef MK_SPLIT
#define MK_SPLIT 0
#endif

#ifndef ONLY
#define ONLY -1
#endif
#ifndef PMASK
#define PMASK 0xfff
#endif
#define PHON(k) ((ONLY < 0 || ONLY == (k)) && ((PMASK >> (k)) & 1))
#define LAS __attribute__((address_space(3)))
typedef unsigned short bf16;
#ifndef PROBE_R
#define PROBE_R 0
#endif
#define RGN_T0(id) unsigned long long rgn_t0_##id = 0; if (PROBE_R == (id) && threadIdx.x == 0) rgn_t0_##id = __builtin_amdgcn_s_memrealtime();
#define RGN_T1(id, ldsbase) if (PROBE_R == (id) && threadIdx.x == 0) { volatile LAS unsigned* w_ = (volatile LAS unsigned*)((LAS unsigned char*)(ldsbase) + 159 * 1024 + 128); w_[0] = w_[0] + (unsigned)(__builtin_amdgcn_s_memrealtime() - rgn_t0_##id); }

#define XB_TMO      128
#define XB_XCNT(j)  (256  + 64 * (j))
#define XB_XSUB(j)  (1280 + 64 * (j))
#define XB_XGEN(j)  (2304 + 64 * (j))
#define XB_TOP      3328
#define XB_TOPGEN   3392
#define XCD_BAR_WORDS 3456
#define XB_SPIN_CAP (1u << 22)

__device__ __forceinline__ unsigned xb_ld(unsigned* p)              { return __hip_atomic_load(p, __ATOMIC_RELAXED, __HIP_MEMORY_SCOPE_AGENT); }
__device__ __forceinline__ unsigned xb_add(unsigned* p, unsigned v) { return __hip_atomic_fetch_add(p, v, __ATOMIC_RELAXED, __HIP_MEMORY_SCOPE_AGENT); }
__device__ __forceinline__ unsigned xb_xcc_id() { return (unsigned)__builtin_amdgcn_s_getreg((3 << 11) | 20) & 0xFu; }
#define XB_SPIN(cond, bar) do { unsigned _sp = 0; while (cond) { __builtin_amdgcn_s_sleep(1); \
    if ((++_sp & 255u) == 0u) { if (xb_ld(&(bar)[XB_TMO])) break; if (_sp > XB_SPIN_CAP) { atomicAdd(&(bar)[XB_TMO], 1u); break; } } } } while (0)

struct XcdBarrier { unsigned* bar; unsigned x; volatile LAS unsigned* st; };

__device__ __forceinline__ XcdBarrier xcd_barrier_post(unsigned* bar, volatile LAS unsigned* st) {
    XcdBarrier b; b.bar = bar; b.x = xb_xcc_id(); b.st = st;
    if (threadIdx.x == 0) st[2] = xb_add(&bar[XB_XCNT(b.x)], 1u);
    return b;
}
__device__ __forceinline__ void xcd_barrier_complete(unsigned* bar, unsigned x, unsigned& nloc, unsigned& nx) {
    const unsigned G = gridDim.x * gridDim.y * gridDim.z;
    unsigned sum, cnt, mine, sp = 0u;
    for (;;) {
        sum = 0u; cnt = 0u; mine = 0u;
#pragma unroll
        for (unsigned j = 0; j < 16; ++j) { const unsigned c = xb_ld(&bar[XB_XCNT(j)]); sum += c; cnt += (c > 0u) ? 1u : 0u; mine = (j == x) ? c : mine; }
        if (sum == G) break;
        __builtin_amdgcn_s_sleep(1);
        if ((++sp & 255u) == 0u) { if (xb_ld(&bar[XB_TMO])) break; if (sp > XB_SPIN_CAP) { atomicAdd(&bar[XB_TMO], 1u); break; } }
    }
    nloc = mine > 0u ? mine : 1u; nx = cnt > 0u ? cnt : 1u;
}
__device__ __forceinline__ void xcd_barrier(const XcdBarrier& b) {
    asm volatile("s_waitcnt vmcnt(0)" ::: "memory");
    __syncthreads();
    if (threadIdx.x == 0) {
        unsigned* bar = b.bar;
        __builtin_amdgcn_s_waitcnt(0);
        unsigned nloc = b.st[0], nx = b.st[1];
        if (nloc == 0u) { xcd_barrier_complete(bar, b.x, nloc, nx); b.st[0] = nloc; b.st[1] = nx; }
        const unsigned old = xb_add(&bar[XB_XSUB(b.x)], 1u);
        const unsigned gen = old / nloc;
        if (old + 1u == (gen + 1u) * nloc) {
            __builtin_amdgcn_fence(__ATOMIC_RELEASE, "agent");
            asm volatile("s_waitcnt vmcnt(0)" ::: "memory");
            const unsigned og = xb_add(&bar[XB_TOP], 1u);
            const unsigned tg = og / nx;
            if (og + 1u == (tg + 1u) * nx) xb_add(&bar[XB_TOPGEN], 1u);
            else XB_SPIN(xb_ld(&bar[XB_TOPGEN]) == tg, bar);
            __builtin_amdgcn_fence(__ATOMIC_ACQUIRE, "agent");
            xb_add(&bar[XB_XGEN(b.x)], 1u);
            asm volatile("s_waitcnt vmcnt(0)" ::: "memory");
        } else {
            XB_SPIN(xb_ld(&bar[XB_XGEN(b.x)]) == gen, bar);
            __builtin_amdgcn_fence(__ATOMIC_ACQUIRE, "agent");
            asm volatile("s_waitcnt vmcnt(0)" ::: "memory");
        }
    }
    __syncthreads();
}

namespace pg8 {
#define PG8_LAS __attribute__((address_space(3)))
typedef unsigned short bf16_t;
typedef short bf16x8 __attribute__((ext_vector_type(8)));
typedef float f32x4 __attribute__((ext_vector_type(4)));
typedef unsigned u32x4 __attribute__((ext_vector_type(4)));
constexpr int BM = 256, BK = 64, HALF = 128, HTB = HALF * BK * 2  , STAGE_BYTES = 8 * HTB, NXCD = 8, WGM = 8;

__host__ __device__ __forceinline__ int lds_byte(int r, int c) { const int st = (r >> 4) * 2 + (c >> 5), rr = r & 15, cc = c & 31, ob = rr * 64 + cc * 2; return st * 1024 + (ob ^ (((ob >> 9) & 1) << 5)); }
__host__ __device__ __forceinline__ void stage_rc(int b, int& R, int& C) { const int st = b / 1024, sb = b % 1024, swz = sb ^ (((sb >> 9) & 1) << 5); R = (st >> 1) * 16 + swz / 64; C = (st & 1) * 32 + (swz % 64) / 2; }
__host__ __device__ __forceinline__ int perm32(int rho) { const int n = rho >> 4, i = rho & 15; return 8 * (i >> 2) + 4 * n + (i & 3); }

struct Unit { int pm, pn; };
struct Gemm { const bf16_t* A; const bf16_t* Bt; int M, N, K; };

struct StaticOrder {
    int nM, nN, nwg, G, c;
    __host__ __device__ void init(int M, int N, int G_, int c_) { nM = M / BM; nN = N / BM; nwg = nM * nN; G = G_; c = c_; }
    __host__ __device__ bool next(int i, Unit& u) const {
        const long L = (long)i * G + c; if (L >= nwg) return false;
        int wgid = (int)L; { const int q = nwg / NXCD, r = nwg % NXCD, xcd = wgid % NXCD, off = wgid / NXCD; wgid = (xcd < r ? xcd * (q + 1) : r * (q + 1) + (xcd - r) * q) + off; }
        const int nig = WGM * nN, gid = wgid / nig, fm = gid * WGM, gsz = (nM - fm) < WGM ? (nM - fm) : WGM;
        u.pm = fm + ((wgid % nig) % gsz); u.pn = (wgid % nig) / gsz; return true;
    }
    __device__ __forceinline__ void a_ready(const Unit&) const {}
    __device__ __forceinline__ void done(const Unit&) const {}
};

__device__ __forceinline__ unsigned cvt_pk_bf16(float lo, float hi) { unsigned r; asm volatile("v_cvt_pk_bf16_f32 %0, %1, %2" : "=v"(r) : "v"(lo), "v"(hi)); return r; }
template <class Epi, class Sched, bool ALIGN_EPI = false, bool SP2 = false>
__device__ __forceinline__ void gemm_phase(PG8_LAS unsigned char* lds, const Gemm g, const Sched& S, const Epi& E) {
    const int tid = threadIdx.x, wid = __builtin_amdgcn_readfirstlane(tid >> 6), lane = tid & 63, wr = wid >> 2, wc = wid & 3, fr = lane & 15, fq = lane >> 4;
    const int K = g.K, nt = K / BK;
    unsigned voffA[2], voffB[2];
#pragma unroll
    for (int i = 0; i < 2; ++i) { int R, C; stage_rc(tid * 16 + i * 8192, R, C); const int Rb = Epi::PERM ? ((R & ~31) + perm32(R & 31)) : R;
        voffA[i] = (unsigned)(R * K + C) * 2u; voffB[i] = (unsigned)(Rb * K + C) * 2u; }
    const size_t kstep = (size_t)(BK * 2);
    const size_t hstep = (size_t)HALF * K * 2;
    const size_t tstep = 2 * hstep;
    const unsigned ldsw = (unsigned)wid * 1024u;
    const int aoff = lds_byte(wr * 64 + fr, fq * 8), boff = lds_byte(wc * 32 + fr, fq * 8);
#define PG8_SA(b, h) (((b) * 2 + (h)) * HTB)
#define PG8_SB(b, h) ((4 + (b) * 2 + (h)) * HTB)
#define PG8_STAGE(bufoff, gbase, voff) do { _Pragma("unroll") for (int _i = 0; _i < 2; ++_i) \
        __builtin_amdgcn_global_load_lds((const unsigned*)((const char*)(gbase) + (voff)[_i]), (PG8_LAS unsigned*)(lds + (bufoff) + ldsw + _i * 8192), 16, 0, 0); } while (0)
#define PG8_LDA(dst, b, h) do { _Pragma("unroll") for (int m = 0; m < 4; ++m) _Pragma("unroll") for (int k = 0; k < 2; ++k) dst[m][k] = *(const PG8_LAS bf16x8*)(lds + PG8_SA(b, h) + aoff + m * 2048 + k * 1024); } while (0)
#define PG8_LDB(dst, b, h) do { _Pragma("unroll") for (int n = 0; n < 2; ++n) _Pragma("unroll") for (int k = 0; k < 2; ++k) dst[n][k] = *(const PG8_LAS bf16x8*)(lds + PG8_SB(b, h) + boff + n * 2048 + k * 1024); } while (0)
#define PG8_MMA(ai, bj, At, Bt) do { __builtin_amdgcn_s_setprio(1); _Pragma("unroll") for (int m = 0; m < 4; ++m) _Pragma("unroll") for (int n = 0; n < 2; ++n) _Pragma("unroll") for (int k = 0; k < 2; ++k) \
        acc[ai][bj][m][n] = __builtin_amdgcn_mfma_f32_16x16x32_bf16(Bt[n][k], At[m][k], acc[ai][bj][m][n], 0, 0, 0); __builtin_amdgcn_s_setprio(0); } while (0)
#define PG8_WAIT_V(n) asm volatile("s_waitcnt vmcnt(" #n ")" ::: "memory")
#define PG8_WAIT_L(n) asm volatile("s_waitcnt lgkmcnt(" #n ")" ::: "memory")
#define PG8_BAR __builtin_amdgcn_s_barrier()
#define PG8_SCHED __builtin_amdgcn_sched_barrier(0)
    Unit cur, nxt; int ui = 0;
    if (!S.next(0, cur)) return;
    f32x4 acc[2][2][4][2];
#pragma unroll
    for (int a = 0; a < 2; ++a)
#pragma unroll
        for (int b = 0; b < 2; ++b)
#pragma unroll
            for (int m = 0; m < 4; ++m)
#pragma unroll
                for (int n = 0; n < 2; ++n) acc[a][b][m][n] = (f32x4){0.f, 0.f, 0.f, 0.f};
    bf16x8 At[4][2], B0[2][2], B1[2][2];
    const char* cA = (const char*)g.A + (size_t)cur.pm * tstep; const char* cB = (const char*)g.Bt + (size_t)cur.pn * tstep;
    S.a_ready(cur);
    if constexpr (SP2) {
        PG8_STAGE(PG8_SB(0, 0), cB, voffB); PG8_STAGE(PG8_SB(0, 1), cB + hstep, voffB); PG8_STAGE(PG8_SA(0, 0), cA, voffA); PG8_STAGE(PG8_SA(0, 1), cA + hstep, voffA);
        if (wr == 1) PG8_BAR;
        PG8_WAIT_V(2); PG8_BAR;
        PG8_STAGE(PG8_SB(1, 0), cB + kstep, voffB); PG8_STAGE(PG8_SA(1, 0), cA + kstep, voffA); PG8_STAGE(PG8_SB(1, 1), cB + hstep + kstep, voffB);
        PG8_WAIT_V(6); PG8_BAR;
    } else {
        PG8_STAGE(PG8_SB(0, 0), cB, voffB); PG8_STAGE(PG8_SA(0, 0), cA, voffA); PG8_STAGE(PG8_SB(0, 1), cB + hstep, voffB); PG8_STAGE(PG8_SA(0, 1), cA + hstep, voffA);
        if (wr == 1) PG8_BAR;
        PG8_WAIT_V(4); PG8_BAR;
        PG8_STAGE(PG8_SB(1, 0), cB + kstep, voffB); PG8_STAGE(PG8_SA(1, 0), cA + kstep, voffA); PG8_STAGE(PG8_SB(1, 1), cB + hstep + kstep, voffB);
        PG8_WAIT_V(6); PG8_BAR;
    }
    for (;;) {
        const bool has_next = S.next(ui + 1, nxt);
        const char* nA = has_next ? (const char*)g.A + (size_t)nxt.pm * tstep : cA; const char* nB = has_next ? (const char*)g.Bt + (size_t)nxt.pn * tstep : cB;
        for (int t = 0; t < nt; t += 2) {
            const bool last = (t == nt - 2);
            const char* a1 = cA + (size_t)(t + 1) * kstep;
            const char* a2 = last ? nA : cA + (size_t)(t + 2) * kstep; const char* b2 = last ? nB : cB + (size_t)(t + 2) * kstep;
            const char* a3 = a2 + kstep; const char* b3 = b2 + kstep;
            if (last && has_next) S.a_ready(nxt);
            if constexpr (SP2) {
            PG8_LDB(B0, 0, 0); PG8_LDB(B1, 0, 1); PG8_SCHED; PG8_LDA(At, 0, 0); PG8_STAGE(PG8_SA(1, 1), a1 + hstep, voffA);
            PG8_WAIT_V(8); PG8_WAIT_L(0); PG8_BAR; PG8_MMA(0, 0, At, B0); PG8_MMA(0, 1, At, B1); PG8_BAR; PG8_SCHED;
            PG8_LDA(At, 0, 1); PG8_STAGE(PG8_SB(0, 0), b2, voffB); PG8_STAGE(PG8_SB(0, 1), b2 + hstep, voffB); PG8_STAGE(PG8_SA(0, 0), a2, voffA);
            PG8_WAIT_V(8); PG8_WAIT_L(0); PG8_BAR; PG8_MMA(1, 0, At, B0); PG8_MMA(1, 1, At, B1); PG8_BAR; PG8_SCHED;
            PG8_LDB(B0, 1, 0); PG8_LDB(B1, 1, 1); PG8_SCHED; PG8_LDA(At, 1, 0); PG8_STAGE(PG8_SA(0, 1), a2 + hstep, voffA);
            PG8_WAIT_V(8); PG8_WAIT_L(0); PG8_BAR; PG8_MMA(0, 0, At, B0); PG8_MMA(0, 1, At, B1); PG8_BAR; PG8_SCHED;
            PG8_LDA(At, 1, 1); PG8_STAGE(PG8_SB(1, 0), b3, voffB); PG8_STAGE(PG8_SB(1, 1), b3 + hstep, voffB); PG8_STAGE(PG8_SA(1, 0), a3, voffA);
            PG8_WAIT_V(8); PG8_WAIT_L(0); PG8_BAR; PG8_MMA(1, 0, At, B0); PG8_MMA(1, 1, At, B1); PG8_BAR; PG8_SCHED;
            } else {
            PG8_LDB(B0, 0, 0); PG8_SCHED; PG8_LDA(At, 0, 0); PG8_STAGE(PG8_SA(1, 1), a1 + hstep, voffA);
            PG8_WAIT_L(8); PG8_BAR; PG8_WAIT_L(0); PG8_MMA(0, 0, At, B0); PG8_BAR; PG8_SCHED;
            PG8_LDB(B1, 0, 1); PG8_STAGE(PG8_SB(0, 0), b2, voffB);
            PG8_BAR; PG8_WAIT_L(0); PG8_MMA(0, 1, At, B1); PG8_BAR;
            PG8_LDA(At, 0, 1); PG8_STAGE(PG8_SA(0, 0), a2, voffA);
            PG8_BAR; PG8_WAIT_L(0); PG8_MMA(1, 0, At, B0); PG8_BAR; PG8_SCHED;
            PG8_STAGE(PG8_SB(0, 1), b2 + hstep, voffB);
            PG8_WAIT_V(6); PG8_BAR; PG8_MMA(1, 1, At, B1); PG8_BAR;
            PG8_LDB(B0, 1, 0); PG8_SCHED; PG8_LDA(At, 1, 0); PG8_STAGE(PG8_SA(0, 1), a2 + hstep, voffA);
            PG8_WAIT_L(8); PG8_BAR; PG8_WAIT_L(0); PG8_MMA(0, 0, At, B0); PG8_BAR; PG8_SCHED;
            PG8_LDB(B1, 1, 1); PG8_STAGE(PG8_SB(1, 0), b3, voffB);
            PG8_BAR; PG8_WAIT_L(0); PG8_MMA(0, 1, At, B1); PG8_BAR;
            PG8_LDA(At, 1, 1); PG8_STAGE(PG8_SA(1, 0), a3, voffA);
            PG8_BAR; PG8_WAIT_L(0); PG8_MMA(1, 0, At, B0); PG8_BAR; PG8_SCHED;
            PG8_STAGE(PG8_SB(1, 1), b3 + hstep, voffB);
            PG8_WAIT_V(6); PG8_BAR; PG8_MMA(1, 1, At, B1); PG8_BAR;
            }
        }
        if constexpr (ALIGN_EPI) { if (wr == 0) PG8_BAR; }
        if constexpr (!Epi::AFTER_DRAIN) { E(acc, cur, wr, wc, fr, fq); S.done(cur); }
        if (!has_next) break;
#pragma unroll
        for (int a = 0; a < 2; ++a)
#pragma unroll
            for (int b = 0; b < 2; ++b)
#pragma unroll
                for (int m = 0; m < 4; ++m)
#pragma unroll
                    for (int n = 0; n < 2; ++n) acc[a][b][m][n] = (f32x4){0.f, 0.f, 0.f, 0.f};
        cur = nxt; cA = nA; cB = nB; ++ui;
        if constexpr (ALIGN_EPI) { if (wr == 1) PG8_BAR; }
    }
    PG8_WAIT_V(0);
    if constexpr (!ALIGN_EPI) { if (wr == 0) PG8_BAR; }
    PG8_BAR;
    if constexpr (Epi::AFTER_DRAIN) { E.fused(acc, cur, wr, wc, fr, fq, lds, wid, lane); S.done(cur); }
#undef PG8_SA
#undef PG8_SB
#undef PG8_STAGE
#undef PG8_LDA
#undef PG8_LDB
#undef PG8_MMA
#undef PG8_WAIT_V
#undef PG8_WAIT_L
#undef PG8_BAR
#undef PG8_SCHED
}
}

constexpr int NB = 4, SEQ = 8192, NT = NB * SEQ, DM = 1024;
constexpr int ZW = 3328, NZ = 3336;
constexpr int C_RQ = 0, C_RK = 256, C_RV = 512, C_RG = 1024, C_AQ = 1536, C_AK = 1792, C_AV = 2048, C_MQ = 2304, C_MK = 2560, C_MV = 2816, C_MO = 3072;
constexpr float DN_ALPHA = 1.41421356237f;
constexpr float LN_EPS = 1e-5f;
constexpr int NTHR = 512, NWAVE = 8;
constexpr int LDS_BYTES = 160 * 1024;
constexpr int LDS_CTL_OFF = 159 * 1024;

constexpr size_t MiB = 1u << 20;
constexpr size_t WS_CTL = 0, CTL_ZERO_BYTES = 64 * 1024;
constexpr size_t WS_RCOS = 1 * MiB, WS_RSIN = 2 * MiB, WS_ACOS = 3 * MiB, WS_ASIN = 3 * MiB + 512 * 1024;
constexpr size_t WS_RST = 4 * MiB;
constexpr size_t WS_MC = 36 * MiB;
constexpr size_t WS_MN = 52 * MiB;
constexpr size_t WS_MA = 52 * MiB + 512 * 1024, WS_MML = WS_MA + 4096, WS_MMP = WS_MML + 4096;
constexpr size_t WS_GATES = 54 * MiB;
constexpr int NZP = 3584;
constexpr size_t WS_WIN = 56 * MiB;
constexpr size_t WS_WOUT = 70 * MiB;
constexpr size_t WS_WQG = 74 * MiB;
constexpr size_t WS_WP = 86 * MiB;
constexpr size_t WS_KEYS = 87 * MiB;
constexpr size_t WS_PB = 88 * MiB;
constexpr size_t WS_XB = 120 * MiB;
constexpr size_t WS_AO = 456 * MiB;
constexpr size_t WS_ALSE = 504 * MiB;
constexpr size_t WS_Z = 184 * MiB;
constexpr size_t WS_MIX = 392 * MiB;
constexpr size_t WS_U16 = 184 * MiB;
constexpr size_t WS_QRY = 184 * MiB;
constexpr size_t WS_E = 312 * MiB;
constexpr size_t WS_UQ = 376 * MiB, WS_VQ = 392 * MiB;
constexpr size_t WS_US = 408 * MiB, WS_VS = 408 * MiB + 65536;
constexpr size_t WS_X1Q = 4 * MiB;
constexpr size_t WS_X1S = 53 * MiB;
constexpr size_t WS_PC = 36 * MiB;
constexpr size_t WS_PCS = 53 * MiB + 256 * 1024;
constexpr size_t WS_PI = 184 * MiB;
constexpr size_t WS_Y = 184 * MiB;
constexpr int CW_PQ = 8192;
constexpr size_t WS_RI = 456 * MiB, WS_RG = 472 * MiB;
constexpr size_t WS_END = 506 * MiB;

struct Params {
    const float *x, *p, *w_in, *conv_w, *b_if, *ret_g, *mls_g, *w_out, *ln1_g, *ln1_b, *wq, *keys, *pu, *pv, *wg, *bg, *wp, *ln2_g, *ln2_b;
    float* out; unsigned char* ws; int ph_lo, ph_hi;
};

__device__ __forceinline__ float bf2f(bf16 h) { return __uint_as_float(((unsigned)h) << 16); }
__device__ __forceinline__ unsigned f2bf(float f) { unsigned u = __float_as_uint(f); return (u + 0x7fffu + ((u >> 16) & 1u)) >> 16; }
typedef float f32x2_t __attribute__((ext_vector_type(2))); typedef __bf16 bf16x2_t __attribute__((ext_vector_type(2)));
__device__ __forceinline__ unsigned cvtpk(float lo, float hi) { f32x2_t v = {lo, hi}; bf16x2_t b = __builtin_convertvector(v, bf16x2_t); return __builtin_bit_cast(unsigned, b); }
__device__ __forceinline__ unsigned pk2(float lo, float hi) { return cvtpk(lo, hi); }
__device__ __forceinline__ float wave_sum(float v) {
#pragma unroll
    for (int o = 1; o < 64; o <<= 1) v += __shfl_xor(v, o);
    return v;
}
__device__ __forceinline__ float wave_max(float v) {
#pragma unroll
    for (int o = 1; o < 64; o <<= 1) v = fmaxf(v, __shfl_xor(v, o));
    return v;
}
__device__ __forceinline__ float sigmoidf_(float x) { return __builtin_amdgcn_rcpf(1.f + __expf(-x)); }
__device__ __forceinline__ float siluf_(float x) { return x * __builtin_amdgcn_rcpf(1.f + __expf(-x)); }
__device__ __forceinline__ void unpack8(const uint4 v, float* o) {
    o[0] = __uint_as_float(v.x << 16); o[1] = __uint_as_float(v.x & 0xffff0000u);
    o[2] = __uint_as_float(v.y << 16); o[3] = __uint_as_float(v.y & 0xffff0000u);
    o[4] = __uint_as_float(v.z << 16); o[5] = __uint_as_float(v.z & 0xffff0000u);
    o[6] = __uint_as_float(v.w << 16); o[7] = __uint_as_float(v.w & 0xffff0000u);
}

template <class Epi>
__device__ __forceinline__ void gemm_tile_f32(const float* __restrict__ A, int lda, const float* __restrict__ W, int N, int K, int m0, int n0, float* lds, const Epi& epi) {
    float* As = lds; float* Bs = lds + 16 * 132;
    const int tid = threadIdx.x, ty = tid >> 4, tx = tid & 15;
    float acc[4][8];
#pragma unroll
    for (int i = 0; i < 4; ++i)
#pragma unroll
        for (int j = 0; j < 8; ++j) acc[i][j] = 0.f;
    const int arow = tid >> 2, akq = (tid & 3) * 4;
    const int bk = tid >> 5, bn = (tid & 31) * 4;
    const bool bvalid = (n0 + bn) < N;
    const float* ap = A + (size_t)(m0 + arow) * lda + akq;
    const float* bp = W + (size_t)bk * N + n0 + bn;
    for (int k0 = 0; k0 < K; k0 += 16) {
        const float4 av = *(const float4*)(ap + k0);
        float4 bv = make_float4(0.f, 0.f, 0.f, 0.f);
        if (bvalid) bv = *(const float4*)(bp + (size_t)k0 * N);
        __syncthreads();
        As[(akq + 0) * 132 + arow] = av.x; As[(akq + 1) * 132 + arow] = av.y; As[(akq + 2) * 132 + arow] = av.z; As[(akq + 3) * 132 + arow] = av.w;
        *(float4*)(Bs + bk * 128 + bn) = bv;
        __syncthreads();
#pragma unroll
        for (int k = 0; k < 16; ++k) {
            const float4 a = *(const float4*)(As + k * 132 + ty * 4);
            const float4 b0 = *(const float4*)(Bs + k * 128 + tx * 8);
            const float4 b1 = *(const float4*)(Bs + k * 128 + tx * 8 + 4);
            const float aa[4] = {a.x, a.y, a.z, a.w};
            const float bb[8] = {b0.x, b0.y, b0.z, b0.w, b1.x, b1.y, b1.z, b1.w};
#pragma unroll
            for (int i = 0; i < 4; ++i)
#pragma unroll
                for (int j = 0; j < 8; ++j) acc[i][j] = fmaf(aa[i], bb[j], acc[i][j]);
        }
    }
#pragma unroll
    for (int i = 0; i < 4; ++i) epi(m0 + ty * 4 + i, n0 + tx * 8, acc[i]);
    __syncthreads();
}

struct EpiZ {
    bf16* Z; float* gates;
    __device__ __forceinline__ void operator()(int row, int col0, const float (&v)[8]) const {
        if (col0 < ZW) { uint4 w; w.x = pk2(v[0], v[1]); w.y = pk2(v[2], v[3]); w.z = pk2(v[4], v[5]); w.w = pk2(v[6], v[7]); *(uint4*)(Z + (size_t)row * ZW + col0) = w; }
        else if (col0 == ZW) { float* g = gates + (size_t)row * 8; *(float4*)g = make_float4(v[0], v[1], v[2], v[3]); *(float4*)(g + 4) = make_float4(v[4], v[5], v[6], v[7]); }
    }
};
struct EpiRes {
    const float* xin; float* out;
    __device__ __forceinline__ void operator()(int row, int col0, const float (&v)[8]) const {
        const size_t o = (size_t)row * DM + col0;
        const float4 a = *(const float4*)(xin + o), b = *(const float4*)(xin + o + 4);
        *(float4*)(out + o) = make_float4(DN_ALPHA * a.x + v[0], DN_ALPHA * a.y + v[1], DN_ALPHA * a.z + v[2], DN_ALPHA * a.w + v[3]);
        *(float4*)(out + o + 4) = make_float4(DN_ALPHA * b.x + v[4], DN_ALPHA * b.y + v[5], DN_ALPHA * b.z + v[6], DN_ALPHA * b.w + v[7]);
    }
};
struct EpiStore {
    float* out; int ld;
    __device__ __forceinline__ void operator()(int row, int col0, const float (&v)[8]) const {
        const size_t o = (size_t)row * ld + col0;
        *(float4*)(out + o) = make_float4(v[0], v[1], v[2], v[3]); *(float4*)(out + o + 4) = make_float4(v[4], v[5], v[6], v[7]);
    }
};
struct EpiGate {
    float* E; const float* bg;
    __device__ __forceinline__ void operator()(int row, int col0, const float (&v)[8]) const {
        const size_t o = (size_t)row * DM + col0;
        float4 a = *(const float4*)(E + o), b = *(const float4*)(E + o + 4);
        a.x *= sigmoidf_(v[0] + bg[col0 + 0]); a.y *= sigmoidf_(v[1] + bg[col0 + 1]); a.z *= sigmoidf_(v[2] + bg[col0 + 2]); a.w *= sigmoidf_(v[3] + bg[col0 + 3]);
        b.x *= sigmoidf_(v[4] + bg[col0 + 4]); b.y *= sigmoidf_(v[5] + bg[col0 + 5]); b.z *= sigmoidf_(v[6] + bg[col0 + 6]); b.w *= sigmoidf_(v[7] + bg[col0 + 7]);
        *(float4*)(E + o) = a; *(float4*)(E + o + 4) = b;
    }
};

template <class Epi>
__device__ __forceinline__ void gemm_phase_f32(const float* A, int lda, const float* W, int N, int K, float* lds, const Epi& epi) {
    const int ntn = (N + 127) / 128, ntm = NT / 128, nit = ntn * ntm;
    for (int it = blockIdx.x; it < nit; it += gridDim.x) { const int mt = it / ntn, nt = it - mt * ntn; gemm_tile_f32(A, lda, W, N, K, mt * 128, nt * 128, lds, epi); }
}

typedef float f32x4 __attribute__((ext_vector_type(4)));
typedef unsigned u32x4 __attribute__((ext_vector_type(4)));
__device__ __forceinline__ void unpack8v(const u32x4 v, float* o) {
    o[0] = __uint_as_float(v.x << 16); o[1] = __uint_as_float(v.x & 0xffff0000u); o[2] = __uint_as_float(v.y << 16); o[3] = __uint_as_float(v.y & 0xffff0000u);
    o[4] = __uint_as_float(v.z << 16); o[5] = __uint_as_float(v.z & 0xffff0000u); o[6] = __uint_as_float(v.w << 16); o[7] = __uint_as_float(v.w & 0xffff0000u);
}
struct EpiZ16 {
    static constexpr bool PERM = true, AFTER_DRAIN = false;
    bf16* Z; float* gates; const float* acos_; const float* asin_;
    __device__ __forceinline__ void operator()(const f32x4 (&acc)[2][2][4][2], const pg8::Unit& u, int wr, int wc, int fr, int fq) const {
        const int row0 = u.pm * 256 + wr * 64 + fr;
        if (u.pn < 13) {
            const int col0 = u.pn * 256 + wc * 32 + 8 * fq;
            const bool rot = (u.pn == 6 || u.pn == 7) && ((wc & 1) == 0);
            const float qs = (u.pn == 6) ? 0.125f : 1.0f;
#pragma unroll
            for (int ai = 0; ai < 2; ++ai)
#pragma unroll
                for (int m = 0; m < 4; ++m) { const int row = row0 + ai * 128 + m * 16; bf16* rowp = Z + (size_t)row * ZW + col0;
#pragma unroll
                    for (int bj = 0; bj < 2; ++bj) { f32x4 v0 = acc[ai][bj][m][0], v1 = acc[ai][bj][m][1];
                        if (rot) {
                            f32x4 p0, p1;
#pragma unroll
                            for (int j = 0; j < 4; ++j) { p0[j] = __shfl_xor(v0[j], 16); p1[j] = __shfl_xor(v1[j], 16); }
                            if (fq < 2) {
                                const int pos = row & (SEQ - 1);
                                const f32x4 c0 = *(const f32x4*)(acos_ + pos * 8), c1 = *(const f32x4*)(acos_ + pos * 8 + 4), s0 = *(const f32x4*)(asin_ + pos * 8), s1 = *(const f32x4*)(asin_ + pos * 8 + 4);
                                const float sg = (fq == 0) ? -1.0f : 1.0f;
                                v0 = v0 * c0 + p0 * s0 * sg; v1 = v1 * c1 + p1 * s1 * sg;
                            }
                        }
                        v0 = v0 * qs; v1 = v1 * qs;
                        u32x4 w; w.x = pk2(v0[0], v0[1]); w.y = pk2(v0[2], v0[3]); w.z = pk2(v1[0], v1[1]); w.w = pk2(v1[2], v1[3]);
                        *(u32x4*)(rowp + bj * 128) = w; } }
        } else if (wc == 0 && fq == 0) {
#pragma unroll
            for (int ai = 0; ai < 2; ++ai)
#pragma unroll
                for (int m = 0; m < 4; ++m) { float* g = gates + (size_t)(row0 + ai * 128 + m * 16) * 8; *(f32x4*)g = acc[ai][0][m][0]; *(f32x4*)(g + 4) = acc[ai][0][m][1]; }
        }
    }
};
struct EpiBf16Store {
    static constexpr bool PERM = true, AFTER_DRAIN = false;
    bf16* O; int ldc;
    __device__ __forceinline__ void operator()(const f32x4 (&acc)[2][2][4][2], const pg8::Unit& u, int wr, int wc, int fr, int fq) const {
        const int row0 = u.pm * 256 + wr * 64 + fr, col0 = u.pn * 256 + wc * 32 + 8 * fq;
#pragma unroll
        for (int ai = 0; ai < 2; ++ai)
#pragma unroll
            for (int m = 0; m < 4; ++m) { bf16* rowp = O + (size_t)(row0 + ai * 128 + m * 16) * ldc + col0;
#pragma unroll
                for (int bj = 0; bj < 2; ++bj) { const f32x4 v0 = acc[ai][bj][m][0], v1 = acc[ai][bj][m][1];
                    u32x4 w; w.x = pk2(v0[0], v0[1]); w.y = pk2(v0[2], v0[3]); w.z = pk2(v1[0], v1[1]); w.w = pk2(v1[2], v1[3]);
                    *(u32x4*)(rowp + bj * 128) = w; } }
    }
};
struct EpiGate16 {
    static constexpr bool PERM = true, AFTER_DRAIN = false;
    bf16* E; const float* bg;
    __device__ __forceinline__ void operator()(const f32x4 (&acc)[2][2][4][2], const pg8::Unit& u, int wr, int wc, int fr, int fq) const {
        const int row0 = u.pm * 256 + wr * 64 + fr, col0 = u.pn * 256 + wc * 32 + 8 * fq;
#pragma unroll
        for (int bj = 0; bj < 2; ++bj) {
            const f32x4 b0 = *(const f32x4*)(bg + col0 + bj * 128), b1 = *(const f32x4*)(bg + col0 + bj * 128 + 4);
#pragma unroll
            for (int ai = 0; ai < 2; ++ai)
#pragma unroll
                for (int m = 0; m < 4; ++m) { bf16* ep = E + (size_t)(row0 + ai * 128 + m * 16) * DM + col0 + bj * 128;
                    float pp[8]; unpack8v(*(const u32x4*)ep, pp);
                    const f32x4 v0 = acc[ai][bj][m][0] + b0, v1 = acc[ai][bj][m][1] + b1;
                    u32x4 w; w.x = pk2(pp[0] * sigmoidf_(v0[0]), pp[1] * sigmoidf_(v0[1])); w.y = pk2(pp[2] * sigmoidf_(v0[2]), pp[3] * sigmoidf_(v0[3]));
                    w.z = pk2(pp[4] * sigmoidf_(v1[0]), pp[5] * sigmoidf_(v1[1])); w.w = pk2(pp[6] * sigmoidf_(v1[2]), pp[7] * sigmoidf_(v1[3]));
                    *(u32x4*)ep = w; }
        }
    }
};
struct EpiRes16 {
    static constexpr bool PERM = true, AFTER_DRAIN = false;
    const bf16* xinb; bf16* out;
    __device__ __forceinline__ void operator()(const f32x4 (&acc)[2][2][4][2], const pg8::Unit& u, int wr, int wc, int fr, int fq) const {
        const int row0 = u.pm * 256 + wr * 64 + fr, col0 = u.pn * 256 + wc * 32 + 8 * fq;
#pragma unroll
        for (int ai = 0; ai < 2; ++ai)
#pragma unroll
            for (int m = 0; m < 4; ++m) { const size_t ro = (size_t)(row0 + ai * 128 + m * 16) * DM + col0;
#pragma unroll
                for (int bj = 0; bj < 2; ++bj) { float xv[8]; unpack8v(*(const u32x4*)(xinb + ro + bj * 128), xv);
                    const f32x4 v0 = acc[ai][bj][m][0], v1 = acc[ai][bj][m][1];
                    u32x4 w; w.x = pk2(DN_ALPHA * xv[0] + v0[0], DN_ALPHA * xv[1] + v0[1]); w.y = pk2(DN_ALPHA * xv[2] + v0[2], DN_ALPHA * xv[3] + v0[3]);
                    w.z = pk2(DN_ALPHA * xv[4] + v1[0], DN_ALPHA * xv[5] + v1[1]); w.w = pk2(DN_ALPHA * xv[6] + v1[2], DN_ALPHA * xv[7] + v1[3]);
                    *(u32x4*)(out + ro + bj * 128) = w; } }
    }
};
template <class Epi>
__device__ __forceinline__ void gemm16(LAS unsigned char* lds, const bf16* A, const bf16* Bt, int N, int K, const Epi& e) {
    pg8::Gemm g{A, Bt, NT, N, K}; pg8::StaticOrder S; S.init(NT, N, (int)gridDim.x, (int)blockIdx.x);
    pg8::gemm_phase<Epi, pg8::StaticOrder, true, true>(lds, g, S, e);
}

__device__ __forceinline__ void tr_item(const float* W, int K, int N, bf16* WT, float* scr, int item, int nblk, int lane) {
    const int kb = item / nblk, nb = item - kb * nblk, k0 = 64 * kb, n0 = 64 * nb;
    const int col4 = (lane & 15) * 4; const bool ok = (n0 + col4) < N;
#pragma unroll 1
    for (int hf = 0; hf < 2; ++hf) {
        float4 v[8];
#pragma unroll
        for (int i = 0; i < 8; ++i) { const int row = (lane >> 4) + 4 * (i + 8 * hf); v[i] = ok ? *(const float4*)(W + (size_t)(k0 + row) * N + n0 + col4) : make_float4(0.f, 0.f, 0.f, 0.f); }
#pragma unroll
        for (int i = 0; i < 8; ++i) { const int row = (lane >> 4) + 4 * (i + 8 * hf); float* d = scr + row * 65 + col4; d[0] = v[i].x; d[1] = v[i].y; d[2] = v[i].z; d[3] = v[i].w; }
    }
    asm volatile("s_waitcnt lgkmcnt(0)" ::: "memory");
    const int c = lane & 7;
#pragma unroll
    for (int j = 0; j < 8; ++j) { const int nn = (lane >> 3) + 8 * j; const float* sp = scr + (8 * c) * 65 + nn;
        uint4 o; o.x = pk2(sp[0 * 65], sp[1 * 65]); o.y = pk2(sp[2 * 65], sp[3 * 65]); o.z = pk2(sp[4 * 65], sp[5 * 65]); o.w = pk2(sp[6 * 65], sp[7 * 65]);
        *(uint4*)(WT + (size_t)(n0 + nn) * K + k0 + 8 * c) = o; }
    asm volatile("s_waitcnt lgkmcnt(0)" ::: "memory");
}
__device__ __forceinline__ void cvt_f32_bf16(const float* src, bf16* dst, size_t n8) {
    const size_t gt = (size_t)blockIdx.x * NTHR + threadIdx.x, GT = (size_t)gridDim.x * NTHR;
    for (size_t i0 = gt; i0 < n8; i0 += 4 * GT) {
        float4 a[4], b[4];
#pragma unroll
        for (int u = 0; u < 4; ++u) { const size_t i = i0 + u * GT; if (i < n8) { a[u] = *(const float4*)(src + i * 8); b[u] = *(const float4*)(src + i * 8 + 4); } }
#pragma unroll
        for (int u = 0; u < 4; ++u) { const size_t i = i0 + u * GT; if (i < n8) { uint4 o; o.x = pk2(a[u].x, a[u].y); o.y = pk2(a[u].z, a[u].w); o.z = pk2(b[u].x, b[u].y); o.w = pk2(b[u].z, b[u].w); *(uint4*)(dst + i * 8) = o; } }
    }
}
__device__ __forceinline__ void p0_weights(const Params& p, float* lds) {
    const int lane = threadIdx.x & 63, wave = __builtin_amdgcn_readfirstlane((int)threadIdx.x >> 6);
    float* scr = lds + wave * (64 * 65);
    const int gw = blockIdx.x * NWAVE + wave, NGW = gridDim.x * NWAVE;
    constexpr int I_IN = 16 * (NZP / 64), I_OUT = 16 * 16, I_Q = 16 * 32, I_G = 16 * 16, I_P = 4 * 16, I_L = I_IN + I_OUT + I_Q + I_G + I_P;
    for (int it = gw; it < 2 * I_L; it += NGW) {
        const int li = it / I_L; int r = it - li * I_L;
        if (r < I_IN) { tr_item(p.w_in + (size_t)li * DM * NZ, DM, NZ, (bf16*)(p.ws + WS_WIN) + (size_t)li * NZP * DM, scr, r, NZP / 64, lane); continue; } r -= I_IN;
        if (r < I_OUT) { tr_item(p.w_out + (size_t)li * DM * DM, DM, DM, (bf16*)(p.ws + WS_WOUT) + (size_t)li * DM * DM, scr, r, 16, lane); continue; } r -= I_OUT;
        if (r < I_Q) { tr_item(p.wq + (size_t)li * DM * 2048, DM, 2048, (bf16*)(p.ws + WS_WQG) + (size_t)li * 3072 * DM, scr, r, 32, lane); continue; } r -= I_Q;
        if (r < I_G) { tr_item(p.wg + (size_t)li * DM * DM, DM, DM, (bf16*)(p.ws + WS_WQG) + (size_t)li * 3072 * DM + (size_t)2048 * DM, scr, r, 16, lane); continue; } r -= I_G;
        tr_item(p.wp + (size_t)li * 256 * DM, 256, DM, (bf16*)(p.ws + WS_WP) + (size_t)li * DM * 256, scr, r, 16, lane);
    }
    cvt_f32_bf16(p.x, (bf16*)(p.ws + WS_XB), (size_t)NT * DM / 8);
    cvt_f32_bf16(p.p, (bf16*)(p.ws + WS_PB), (size_t)2 * NT * 256 / 8);
    cvt_f32_bf16(p.keys, (bf16*)(p.ws + WS_KEYS), (size_t)2 * 8 * 2 * 128 * 128 / 8);
}

__device__ __forceinline__ void p0_tables(const Params& p) {
    float* rcos = (float*)(p.ws + WS_RCOS); float* rsin = (float*)(p.ws + WS_RSIN); float* acos_ = (float*)(p.ws + WS_ACOS); float* asin_ = (float*)(p.ws + WS_ASIN);
    const int gt = blockIdx.x * NTHR + threadIdx.x, GT = gridDim.x * NTHR;
    for (int i = gt; i < SEQ * 32; i += GT) { const int pos = i >> 5, k = i & 31; const float inv = powf(10000.0f, -(float)k / 32.0f); const float ang = (float)pos * inv; rcos[i] = cosf(ang); rsin[i] = sinf(ang); }
    for (int i = gt; i < SEQ * 8; i += GT) { const int pos = i >> 3, k = i & 7; const float inv = powf(500000.0f, -(float)k / 8.0f); const float ang = (float)pos * inv; acos_[i] = cosf(ang); asin_[i] = sinf(ang); }
}

__device__ __forceinline__ float ret_lg(int h) { return logf(1.0f - exp2f(-5.0f - (float)h)); }

__device__ __forceinline__ void ret_state_item(const Params& p, int item, float* lds) {
    const int tid = threadIdx.x;
    const int c = item & 63, bh = item >> 6, h = bh & 3, b = bh >> 2;
    const int t0 = b * SEQ + c * 128, s0 = c * 128;
    const bf16* Z = (const bf16*)(p.ws + WS_Z);
    const float* rcos = (const float*)(p.ws + WS_RCOS); const float* rsin = (const float*)(p.ws + WS_RSIN);
    float* RST = (float*)(p.ws + WS_RST);
    float* Kz = lds; float* V = lds + 128 * 64;
    const float lg = ret_lg(h);
    for (int idx = tid; idx < 128 * 32; idx += NTHR) {
        const int row = idx >> 5, i = idx & 31;
        const bf16* zr = Z + (size_t)(t0 + row) * ZW + C_RK + h * 64;
        const float x1 = bf2f(zr[i]), x2 = bf2f(zr[i + 32]);
        const float cs = rcos[(s0 + row) * 32 + i], sn = rsin[(s0 + row) * 32 + i];
        const float sc = 0.125f * expf(lg * (float)(127 - row));
        Kz[row * 64 + i] = (x1 * cs - x2 * sn) * sc; Kz[row * 64 + i + 32] = (x2 * cs + x1 * sn) * sc;
    }
    for (int idx = tid; idx < 128 * 128; idx += NTHR) { const int row = idx >> 7, d = idx & 127; V[idx] = bf2f(Z[(size_t)(t0 + row) * ZW + C_RV + h * 128 + d]); }
    __syncthreads();
    const int k = tid >> 3, v0 = (tid & 7) * 16;
    float acc[16];
#pragma unroll
    for (int j = 0; j < 16; ++j) acc[j] = 0.f;
#pragma unroll 4
    for (int s = 0; s < 128; ++s) {
        const float kk = Kz[s * 64 + k];
#pragma unroll
        for (int j = 0; j < 16; ++j) acc[j] = fmaf(kk, V[s * 128 + v0 + j], acc[j]);
    }
    float* dst = RST + (size_t)item * 8192 + k * 128 + v0;
#pragma unroll
    for (int j = 0; j < 16; ++j) dst[j] = acc[j];
    __syncthreads();
}

__device__ __forceinline__ float logsigmoidf_(float f) { return fminf(f, 0.f) - log1pf(expf(-fabsf(f))); }

__device__ __forceinline__ void mls_state_item(const Params& p, int li, int item, float* lds) {
    const int tid = threadIdx.x;
    const int c = item & 63, bh = item >> 6, h = bh & 3, b = bh >> 2;
    const int t0 = b * SEQ + c * 128;
    const bf16* Z = (const bf16*)(p.ws + WS_Z);
    const float* gates = (const float*)(p.ws + WS_GATES);
    float* MC = (float*)(p.ws + WS_MC); float* MN = (float*)(p.ws + WS_MN); float* MA = (float*)(p.ws + WS_MA); float* MML = (float*)(p.ws + WS_MML);
    const float* cw = p.conv_w + (size_t)li * 4 * 512;
    float* Kc = lds; float* Vv = lds + 8192; float* ib = lds + 16384; float* bb = ib + 128; float* wk = bb + 128; float* scal = wk + 128;
    for (int idx = tid; idx < 128 * 64; idx += NTHR) {
        const int row = idx >> 6, d = idx & 63, ch = 256 + h * 64 + d;
        float a = 0.f;
#pragma unroll
        for (int j = 0; j < 4; ++j) { const int sp = c * 128 + row - 3 + j; if (sp >= 0) a = fmaf(cw[j * 512 + ch], bf2f(Z[(size_t)(t0 + row - 3 + j) * ZW + C_MK + h * 64 + d]), a); }
        Kc[idx] = siluf_(a) * 0.125f;
        Vv[idx] = bf2f(Z[(size_t)(t0 + row) * ZW + C_MV + h * 64 + d]);
    }
    if (tid < 128) {
        const int t = t0 + tid;
        const float ig = gates[(size_t)t * 8 + h] + p.b_if[li * 8 + h];
        const float fg = gates[(size_t)t * 8 + 4 + h] + p.b_if[li * 8 + 4 + h];
        ib[tid] = ig; bb[tid] = logsigmoidf_(fg);
    }
    __syncthreads();
    if (tid == 0) {
        float run = 0.f;
#pragma unroll 4
        for (int s = 0; s < 128; ++s) { run += bb[s]; bb[s] = run; }
        float ml = -INFINITY;
        for (int s = 0; s < 128; ++s) ml = fmaxf(ml, run - bb[s] + ib[s]);
        scal[0] = run; scal[1] = ml;
    }
    __syncthreads();
    const float a = scal[0], ml = scal[1];
    if (tid < 128) wk[tid] = expf(a - bb[tid] + ib[tid] - ml);
    __syncthreads();
    const int k = tid >> 3, v0 = (tid & 7) * 8;
    float acc[8], nacc = 0.f;
#pragma unroll
    for (int j = 0; j < 8; ++j) acc[j] = 0.f;
#pragma unroll 4
    for (int s = 0; s < 128; ++s) {
        const float kw = Kc[s * 64 + k] * wk[s];
        nacc += kw;
#pragma unroll
        for (int j = 0; j < 8; ++j) acc[j] = fmaf(kw, Vv[s * 64 + v0 + j], acc[j]);
    }
    float* dst = MC + (size_t)item * 4096 + k * 64 + v0;
#pragma unroll
    for (int j = 0; j < 8; ++j) dst[j] = acc[j];
    if ((tid & 7) == 0) MN[(size_t)item * 64 + k] = nacc;
    if (tid == 0) { MA[item] = a; MML[item] = ml; }
    __syncthreads();
}

typedef short bf16x8_t __attribute__((ext_vector_type(8)));
typedef short s16x4_t __attribute__((ext_vector_type(4)));
typedef float f32x16 __attribute__((ext_vector_type(16)));
__device__ __forceinline__ s16x4_t lds_tr(const LAS unsigned char* p) { return __builtin_bit_cast(s16x4_t, __builtin_amdgcn_ds_read_tr16_b64_v4i16((LAS s16x4_t*)p)); }

__device__ __forceinline__ void attn_unit(const Params& p, int unit, LAS unsigned char* lds) {
    RGN_T0(9)
    const int tid = threadIdx.x, lane = tid & 63, wave = __builtin_amdgcn_readfirstlane(tid >> 6);
    const int r32 = lane & 31, hh = lane >> 5;
    const bf16* Z = (const bf16*)(p.ws + WS_Z);
    const int bh = unit / 96, uu = unit - bh * 96, r = uu >> 5, v = uu & 31;
    const int dl = 1 << (2 * r), nb = 32 >> (2 * r);
    const int x = v / nb, blk = v - x * nb, q0 = blk * 256;
    const int b = bh >> 2, h = bh & 3;
    bf16* AO = (bf16*)(p.ws + WS_AO) + (size_t)r * NT * 256; float* ALSE = (float*)(p.ws + WS_ALSE) + (size_t)r * NT * 4;
    LAS unsigned char* Ks = lds; LAS unsigned char* Vs = lds + 384 * 128;
#pragma unroll 3
    for (int idx = tid; idx < 384 * 8; idx += NTHR) {
        const int i = idx >> 3, c = idx & 7, jk = q0 - 128 + i;
        const int jc = jk < 0 ? 0 : jk;
        const bf16* zr = Z + (size_t)(b * SEQ + jc * dl + x) * ZW + h * 64 + c * 8;
        u32x4 kv = *(const u32x4*)(zr + C_AK), vv = *(const u32x4*)(zr + C_AV);
        if (jk < 0) { kv = (u32x4){0u, 0u, 0u, 0u}; vv = (u32x4){0u, 0u, 0u, 0u}; }
        const int off = i * 128 + ((c ^ (i & 7)) << 4);
        *(LAS u32x4*)(Ks + off) = kv; *(LAS u32x4*)(Vs + off) = vv;
    }
    const int jq = q0 + 32 * wave + r32;
    const int tokq = b * SEQ + jq * dl + x;
    bf16x8_t qf[4];
#pragma unroll
    for (int ks = 0; ks < 4; ++ks) qf[ks] = *(const bf16x8_t*)(Z + (size_t)tokq * ZW + C_AQ + h * 64 + 16 * ks + 8 * hh);
    __syncthreads();
    f32x16 st[5];
#pragma unroll
    for (int tl = 0; tl < 5; ++tl) {
        f32x16 a16 = {0.f, 0.f, 0.f, 0.f, 0.f, 0.f, 0.f, 0.f, 0.f, 0.f, 0.f, 0.f, 0.f, 0.f, 0.f, 0.f};
        const int i = 32 * wave + 32 * tl + r32;
#pragma unroll
        for (int ks = 0; ks < 4; ++ks) {
            const int c = 2 * ks + hh;
            const bf16x8_t kf = *(const LAS bf16x8_t*)(Ks + i * 128 + ((c ^ (i & 7)) << 4));
            a16 = __builtin_amdgcn_mfma_f32_32x32x16_bf16(kf, qf[ks], a16, 0, 0, 0);
        }
        st[tl] = a16;
    }
    const int kb = q0 + 32 * wave - 128;
    float m = -INFINITY;
#pragma unroll
    for (int tl = 0; tl < 5; ++tl)
#pragma unroll
        for (int rg = 0; rg < 16; ++rg) {
            const int c = 32 * tl + (rg & 3) + 8 * (rg >> 2) + 4 * hh;
            const bool valid = (c >= r32) && (c <= r32 + 128) && (kb + c >= 0);
            const float sv = valid ? st[tl][rg] : -INFINITY;
            st[tl][rg] = sv; m = fmaxf(m, sv);
        }
    m = fmaxf(m, __shfl_xor(m, 32));
    float den = 0.f;
#pragma unroll
    for (int tl = 0; tl < 5; ++tl)
#pragma unroll
        for (int rg = 0; rg < 16; ++rg) { const float pe = __expf(st[tl][rg] - m); st[tl][rg] = pe; den += pe; }
    den += __shfl_xor(den, 32);
    f32x16 o[2];
#pragma unroll
    for (int dt = 0; dt < 2; ++dt) o[dt] = (f32x16){0.f, 0.f, 0.f, 0.f, 0.f, 0.f, 0.f, 0.f, 0.f, 0.f, 0.f, 0.f, 0.f, 0.f, 0.f, 0.f};
    const int tq = (lane & 15) >> 2, tp = lane & 3, tg = (lane >> 4) & 1;
#pragma unroll
    for (int tl = 0; tl < 5; ++tl)
#pragma unroll
        for (int s2 = 0; s2 < 2; ++s2) {
            u32x4 pw; pw.x = cvtpk(st[tl][8 * s2 + 0], st[tl][8 * s2 + 1]); pw.y = cvtpk(st[tl][8 * s2 + 2], st[tl][8 * s2 + 3]); pw.z = cvtpk(st[tl][8 * s2 + 4], st[tl][8 * s2 + 5]); pw.w = cvtpk(st[tl][8 * s2 + 6], st[tl][8 * s2 + 7]);
            const bf16x8_t pb = __builtin_bit_cast(bf16x8_t, pw);
            const int i0 = 32 * wave + 32 * tl + 16 * s2 + 4 * hh + tq;
#pragma unroll
            for (int dt = 0; dt < 2; ++dt) {
                const int c = 4 * dt + 2 * tg + (tp >> 1);
                const int i1 = i0 + 8;
                const s16x4_t lo = lds_tr(Vs + i0 * 128 + ((c ^ (i0 & 7)) << 4) + 8 * (tp & 1));
                const s16x4_t hi = lds_tr(Vs + i1 * 128 + ((c ^ (i1 & 7)) << 4) + 8 * (tp & 1));
                const bf16x8_t vf = (bf16x8_t){lo[0], lo[1], lo[2], lo[3], hi[0], hi[1], hi[2], hi[3]};
                o[dt] = __builtin_amdgcn_mfma_f32_32x32x16_bf16(vf, pb, o[dt], 0, 0, 0);
            }
        }
    const float rden = 1.0f / den;
    bf16* orow = AO + (size_t)tokq * 256 + h * 64;
#pragma unroll
    for (int dt = 0; dt < 2; ++dt)
#pragma unroll
        for (int g4 = 0; g4 < 4; ++g4) {
            const int d = 32 * dt + 8 * g4 + 4 * hh;
            *(uint2*)(orow + d) = make_uint2(cvtpk(o[dt][4 * g4] * rden, o[dt][4 * g4 + 1] * rden), cvtpk(o[dt][4 * g4 + 2] * rden, o[dt][4 * g4 + 3] * rden));
        }
    if (hh == 0) ALSE[(size_t)tokq * 4 + h] = m + __logf(den);
    __syncthreads();
    RGN_T1(9, lds)
}

__device__ __forceinline__ void attn_merge(const Params& p) {
    const bf16* AO = (const bf16*)(p.ws + WS_AO); const float* ALSE = (const float*)(p.ws + WS_ALSE);
    bf16* MIX = (bf16*)(p.ws + WS_MIX);
    const int gt = blockIdx.x * NTHR + threadIdx.x, GT = gridDim.x * NTHR;
    for (int e0 = gt; e0 < NT * 32; e0 += 2 * GT) {
        float l[2][3]; uint4 a[2][3];
#pragma unroll
        for (int u = 0; u < 2; ++u) { const int e = (e0 + u * GT < NT * 32) ? e0 + u * GT : e0; const int t = e >> 5, c8 = e & 31, h = c8 >> 3;
#pragma unroll
            for (int r = 0; r < 3; ++r) { l[u][r] = ALSE[(size_t)r * NT * 4 + (size_t)t * 4 + h]; a[u][r] = *(const uint4*)(AO + (size_t)r * NT * 256 + (size_t)t * 256 + c8 * 8); } }
#pragma unroll
        for (int u = 0; u < 2; ++u) {
            const int e = e0 + u * GT;
            if (e < NT * 32) {
                const int t = e >> 5, c8 = e & 31;
                const float M = fmaxf(fmaxf(l[u][0], l[u][1]), l[u][2]);
                float w0 = __expf(l[u][0] - M), w1 = __expf(l[u][1] - M), w2 = __expf(l[u][2] - M);
                const float rs = 1.0f / (w0 + w1 + w2); w0 *= rs; w1 *= rs; w2 *= rs;
                float a0[8], a1[8], a2[8]; unpack8(a[u][0], a0); unpack8(a[u][1], a1); unpack8(a[u][2], a2);
                float y[8];
#pragma unroll
                for (int j = 0; j < 8; ++j) y[j] = w0 * a0[j] + w1 * a1[j] + w2 * a2[j];
                *(uint4*)(MIX + (size_t)t * DM + 512 + c8 * 8) = make_uint4(pk2(y[0], y[1]), pk2(y[2], y[3]), pk2(y[4], y[5]), pk2(y[6], y[7]));
            }
        }
    }
}

constexpr int UNIT_LDS = 79360;
__device__ __forceinline__ int swz16(int row, int chunk) { return (chunk ^ (row & 7)) << 4; }
template <bool ACCPERM>
__device__ __forceinline__ bf16x8_t frag_tr(const LAS unsigned char* img, int RB, int kbase, int cbase, int lane) {
    const int tq = (lane & 15) >> 2, tp = lane & 3, tg = (lane >> 4) & 1, hh = lane >> 5;
    const int r0 = kbase + (ACCPERM ? 4 : 8) * hh + tq, r1 = r0 + (ACCPERM ? 8 : 4);
    const int colb = (cbase + 16 * tg + 4 * tp) * 2, ch = colb >> 4, sub = colb & 15;
    const s16x4_t lo = lds_tr(img + r0 * RB + swz16(r0, ch) + sub);
    const s16x4_t hi = lds_tr(img + r1 * RB + swz16(r1, ch) + sub);
    return (bf16x8_t){lo[0], lo[1], lo[2], lo[3], hi[0], hi[1], hi[2], hi[3]};
}
__device__ __forceinline__ bf16x8_t frag_row(const LAS unsigned char* img, int RB, int row, int chunk) { return *(const LAS bf16x8_t*)(img + row * RB + swz16(row, chunk)); }
__device__ __forceinline__ u32x4 pack8(const float* v) { u32x4 w; w.x = pk2(v[0], v[1]); w.y = pk2(v[2], v[3]); w.z = pk2(v[4], v[5]); w.w = pk2(v[6], v[7]); return w; }
#define F16Z ((f32x16){0.f, 0.f, 0.f, 0.f, 0.f, 0.f, 0.f, 0.f, 0.f, 0.f, 0.f, 0.f, 0.f, 0.f, 0.f, 0.f})
__device__ __forceinline__ int acc_row(int rg, int hh) { return (rg & 3) + 8 * (rg >> 2) + 4 * hh; }

template <bool ZETA>
__device__ __forceinline__ void stage_ret_k(const Params& p, LAS unsigned char* Ks, int t0, int s0, int h, float lg, int tidU) {
    const bf16* Z = (const bf16*)(p.ws + WS_Z);
    const float* rcos = (const float*)(p.ws + WS_RCOS); const float* rsin = (const float*)(p.ws + WS_RSIN);
#pragma unroll
    for (int task = tidU; task < 512; task += 256) {
        const int row = task >> 2, pc = task & 3;
        const bf16* zr = Z + (size_t)(t0 + row) * ZW + C_RK + h * 64;
        float a[8], bq[8], o1[8], o2[8];
        unpack8v(*(const u32x4*)(zr + 8 * pc), a); unpack8v(*(const u32x4*)(zr + 32 + 8 * pc), bq);
        const f32x4 c0 = *(const f32x4*)(rcos + (s0 + row) * 32 + 8 * pc), c1 = *(const f32x4*)(rcos + (s0 + row) * 32 + 8 * pc + 4);
        const f32x4 n0 = *(const f32x4*)(rsin + (s0 + row) * 32 + 8 * pc), n1 = *(const f32x4*)(rsin + (s0 + row) * 32 + 8 * pc + 4);
        const float sc = ZETA ? 0.125f * __expf(lg * (float)(127 - row)) : 0.125f;
#pragma unroll
        for (int j = 0; j < 8; ++j) { const float cs = j < 4 ? c0[j & 3] : c1[j & 3], sn = j < 4 ? n0[j & 3] : n1[j & 3]; o1[j] = (a[j] * cs - bq[j] * sn) * sc; o2[j] = (bq[j] * cs + a[j] * sn) * sc; }
        *(LAS u32x4*)(Ks + row * 128 + swz16(row, pc)) = pack8(o1); *(LAS u32x4*)(Ks + row * 128 + swz16(row, pc + 4)) = pack8(o2);
    }
}
__device__ __forceinline__ void stage_copy(const bf16* src0, int ld, LAS unsigned char* img, int RB, int nrows, int nchunks, int tidU) {
#pragma unroll 4
    for (int task = tidU; task < nrows * nchunks; task += 256) {
        const int row = task / nchunks, c = task - row * nchunks;
        *(LAS u32x4*)(img + row * RB + swz16(row, c)) = *(const u32x4*)(src0 + (size_t)row * ld + 8 * c);
    }
}

__device__ __forceinline__ void ret_state_u(const Params& p, int unit, LAS unsigned char* ldsU, int wl, int tidU, int lane) {
    RGN_T0(7)
    const int c = unit & 63, bh = unit >> 6, h = bh & 3, b = bh >> 2, t0 = b * SEQ + c * 128, s0 = c * 128;
    const bf16* Z = (const bf16*)(p.ws + WS_Z); float* RST = (float*)(p.ws + WS_RST);
    LAS unsigned char* Ks = ldsU; LAS unsigned char* Vs = ldsU + 16384;
    stage_ret_k<true>(p, Ks, t0, s0, h, ret_lg(h), tidU);
    stage_copy(Z + (size_t)t0 * ZW + C_RV + h * 128, ZW, Vs, 256, 128, 16, tidU);
    __syncthreads();
    f32x16 a0 = F16Z, a1 = F16Z;
#pragma unroll 2
    for (int ks = 0; ks < 8; ++ks) {
        const bf16x8_t A = frag_tr<false>(Vs, 256, 16 * ks, 32 * wl, lane);
        const bf16x8_t B0 = frag_tr<false>(Ks, 128, 16 * ks, 0, lane), B1 = frag_tr<false>(Ks, 128, 16 * ks, 32, lane);
        a0 = __builtin_amdgcn_mfma_f32_32x32x16_bf16(A, B0, a0, 0, 0, 0); a1 = __builtin_amdgcn_mfma_f32_32x32x16_bf16(A, B1, a1, 0, 0, 0);
    }
    float* dst = RST + (size_t)unit * 8192; const int r32 = lane & 31, hh = lane >> 5;
#pragma unroll
    for (int rg = 0; rg < 16; ++rg) { const int dv = 32 * wl + acc_row(rg, hh); dst[dv * 64 + r32] = a0[rg]; dst[dv * 64 + 32 + r32] = a1[rg]; }
    __syncthreads();
    RGN_T1(7, ldsU)
}

__device__ __forceinline__ void mls_gates(const Params& p, int li, int t0, int h, int lane, float& b0, float& b1, float& g0, float& g1) {
    const float* gates = (const float*)(p.ws + WS_GATES);
    const float bi = p.b_if[li * 8 + h], bf = p.b_if[li * 8 + 4 + h];
    const int t = t0 + 2 * lane;
    const float i0 = gates[(size_t)t * 8 + h] + bi, i1 = gates[(size_t)(t + 1) * 8 + h] + bi;
    const float f0 = logsigmoidf_(gates[(size_t)t * 8 + 4 + h] + bf), f1 = logsigmoidf_(gates[(size_t)(t + 1) * 8 + 4 + h] + bf);
    const float tot = f0 + f1; float v = tot;
#pragma unroll
    for (int o = 1; o < 64; o <<= 1) { const float u = __shfl_up(v, o); if (lane >= o) v += u; }
    const float ex = v - tot;
    b0 = ex + f0; b1 = ex + tot; g0 = i0 - b0; g1 = i1 - b1;
}
__device__ __forceinline__ void conv8(const bf16* zq, const float* cw, int nprev, float scale, float* o) {
    float acc[8];
#pragma unroll
    for (int e = 0; e < 8; ++e) acc[e] = 0.f;
    u32x4 xr[4]; f32x4 w0[4], w1[4];
#pragma unroll
    for (int j = 0; j < 4; ++j) {
        const int back = (3 - j <= nprev) ? (3 - j) : 0;
        xr[j] = *(const u32x4*)(zq - (size_t)back * ZW);
        w0[j] = *(const f32x4*)(cw + j * 512); w1[j] = *(const f32x4*)(cw + j * 512 + 4);
    }
#pragma unroll
    for (int j = 0; j < 4; ++j) {
        const float ok = (3 - j <= nprev) ? 1.0f : 0.0f;
        float xv[8]; unpack8v(xr[j], xv);
#pragma unroll
        for (int e = 0; e < 8; ++e) acc[e] = fmaf((e < 4 ? w0[j][e & 3] : w1[j][e & 3]) * ok, xv[e], acc[e]);
    }
#pragma unroll
    for (int e = 0; e < 8; ++e) o[e] = siluf_(acc[e]) * scale;
}
__device__ __forceinline__ void stage_vext(const bf16* src0, LAS unsigned char* Vs, int tidU) {
#pragma unroll 3
    for (int task = tidU; task < 128 * 12; task += 256) {
        const int row = task / 12, c = task - row * 12;
        u32x4 v = *(const u32x4*)(src0 + (size_t)row * ZW + 8 * (c & 7));
        if (c >= 8) { v = (u32x4){0u, 0u, 0u, 0u}; if (c == 8) v.x = 0x3F80u; }
        *(LAS u32x4*)(Vs + row * 256 + swz16(row, c)) = v;
    }
}

__device__ __forceinline__ void mls_state_u(const Params& p, int li, int unit, LAS unsigned char* ldsU, int wl, int tidU, int lane) {
    RGN_T0(8)
    const int c = unit & 63, bh = unit >> 6, h = bh & 3, b = bh >> 2, t0 = b * SEQ + c * 128;
    const bf16* Z = (const bf16*)(p.ws + WS_Z);
    float* MC = (float*)(p.ws + WS_MC); float* MN = (float*)(p.ws + WS_MN); float* MA = (float*)(p.ws + WS_MA); float* MML = (float*)(p.ws + WS_MML);
    LAS unsigned char* Ks = ldsU; LAS unsigned char* Vs = ldsU + 16384; LAS float* wk = (LAS float*)(ldsU + 49152);
    if (wl == 0) {
        float b0, b1, g0, g1; mls_gates(p, li, t0, h, lane, b0, b1, g0, g1);
        const float gmax = wave_max(fmaxf(g0, g1));
        const float a = __shfl(b1, 63);
        wk[2 * lane] = __expf(g0 - gmax); wk[2 * lane + 1] = __expf(g1 - gmax);
        if (lane == 0) { MA[unit] = a; MML[unit] = a + gmax; }
    }
    stage_vext(Z + (size_t)t0 * ZW + C_MV + h * 64, Vs, tidU);
    __syncthreads();
    bf16* QKC = (bf16*)p.out;
#pragma unroll 2
    for (int task = tidU; task < 2048; task += 256) {
        const int isq = task >> 10, row = (task >> 3) & 127, cc = task & 7;
        float o[8]; conv8(Z + (size_t)(t0 + row) * ZW + (isq ? C_MQ : C_MK) + h * 64 + 8 * cc, p.conv_w + (size_t)li * 2048 + (isq ? 0 : 256) + h * 64 + 8 * cc, c * 128 + row, isq ? 1.0f : 0.125f, o);
        *(u32x4*)(QKC + (size_t)(t0 + row) * 512 + (isq ? 0 : 256) + h * 64 + 8 * cc) = pack8(o);
        if (!isq) { const float w = wk[row];
#pragma unroll
            for (int e = 0; e < 8; ++e) o[e] *= w;
            *(LAS u32x4*)(Ks + row * 128 + swz16(row, cc)) = pack8(o); }
    }
    __syncthreads();
    if (wl < 3) {
        f32x16 a0 = F16Z, a1 = F16Z;
#pragma unroll 2
        for (int ks = 0; ks < 8; ++ks) {
            const bf16x8_t A = frag_tr<false>(Vs, 256, 16 * ks, 32 * wl, lane);
            const bf16x8_t B0 = frag_tr<false>(Ks, 128, 16 * ks, 0, lane), B1 = frag_tr<false>(Ks, 128, 16 * ks, 32, lane);
            a0 = __builtin_amdgcn_mfma_f32_32x32x16_bf16(A, B0, a0, 0, 0, 0); a1 = __builtin_amdgcn_mfma_f32_32x32x16_bf16(A, B1, a1, 0, 0, 0);
        }
        const int r32 = lane & 31, hh = lane >> 5;
        if (wl < 2) {
            float* dst = MC + (size_t)unit * 4096;
#pragma unroll
            for (int rg = 0; rg < 16; ++rg) { const int v = 32 * wl + acc_row(rg, hh); dst[v * 64 + r32] = a0[rg]; dst[v * 64 + 32 + r32] = a1[rg]; }
        } else if (hh == 0) { MN[(size_t)unit * 64 + r32] = a0[0]; MN[(size_t)unit * 64 + 32 + r32] = a1[0]; }
    }
    __syncthreads();
    RGN_T1(8, ldsU)
}

__device__ __forceinline__ void epi_stage_put(LAS unsigned char* reg, int r32, int col, float a, float b, float c, float d) {
    typedef unsigned u32x2_ __attribute__((ext_vector_type(2)));
    *(LAS u32x2_*)(reg + r32 * 128 + swz16(r32, col >> 3) + ((col & 4) << 1)) = (u32x2_){pk2(a, b), pk2(c, d)};
}
__device__ __forceinline__ void ret_out_u(const Params& p, int li, int unit, LAS unsigned char* ldsU, int wl, int tidU, int lane) {
    const int c = unit & 63, bh = unit >> 6, h = bh & 3, b = bh >> 2, t0 = b * SEQ + c * 128, s0 = c * 128;
    const int r32 = lane & 31, hh = lane >> 5;
    const bf16* Z = (const bf16*)(p.ws + WS_Z); const float* RST = (const float*)(p.ws + WS_RST); bf16* MIX = (bf16*)(p.ws + WS_MIX);
    const float* rcos = (const float*)(p.ws + WS_RCOS); const float* rsin = (const float*)(p.ws + WS_RSIN);
    LAS unsigned char* Ks = ldsU; LAS unsigned char* Vs = ldsU + 16384; LAS unsigned char* Rs = ldsU + 49152;
    const float lg = ret_lg(h);
    RGN_T0(1)
    stage_ret_k<false>(p, Ks, t0, s0, h, lg, tidU);
    stage_copy(Z + (size_t)t0 * ZW + C_RV + h * 128, ZW, Vs, 256, 128, 16, tidU);
#pragma unroll
    for (int task = tidU; task < 1024; task += 256) {
        const int row = task >> 3, cc = task & 7;
        const float* src = RST + (size_t)unit * 8192 + row * 64 + 8 * cc;
        const f32x4 x0 = *(const f32x4*)src, x1 = *(const f32x4*)(src + 4);
        const float v[8] = {x0[0], x0[1], x0[2], x0[3], x1[0], x1[1], x1[2], x1[3]};
        *(LAS u32x4*)(Rs + row * 128 + swz16(row, cc)) = pack8(v);
    }
    const int t = 32 * wl + r32, tok = t0 + t, pos = s0 + t;
    bf16x8_t qf[4];
    {
        float f[4][8];
#pragma unroll
        for (int ks = 0; ks < 4; ++ks) unpack8v(*(const u32x4*)(Z + (size_t)tok * ZW + C_RQ + h * 64 + 16 * ks + 8 * hh), f[ks]);
#pragma unroll
        for (int ks = 0; ks < 2; ++ks) {
            const float* cp = rcos + pos * 32 + 16 * ks + 8 * hh; const float* sp = rsin + pos * 32 + 16 * ks + 8 * hh;
            const f32x4 c0 = *(const f32x4*)cp, c1 = *(const f32x4*)(cp + 4), n0 = *(const f32x4*)sp, n1 = *(const f32x4*)(sp + 4);
#pragma unroll
            for (int j = 0; j < 8; ++j) { const float cs = j < 4 ? c0[j & 3] : c1[j & 3], sn = j < 4 ? n0[j & 3] : n1[j & 3]; const float x1 = f[ks][j], x2 = f[ks + 2][j]; f[ks][j] = x1 * cs - x2 * sn; f[ks + 2][j] = x2 * cs + x1 * sn; }
        }
#pragma unroll
        for (int ks = 0; ks < 4; ++ks) qf[ks] = __builtin_bit_cast(bf16x8_t, pack8(f[ks]));
    }
    __syncthreads();
    RGN_T1(1, ldsU)
    RGN_T0(2)
    f32x16 o[4];
#pragma unroll
    for (int dt = 0; dt < 4; ++dt) {
        f32x16 a = F16Z;
#pragma unroll
        for (int ks = 0; ks < 4; ++ks) a = __builtin_amdgcn_mfma_f32_32x32x16_bf16(frag_row(Rs, 128, 32 * dt + r32, 2 * ks + hh), qf[ks], a, 0, 0, 0);
        o[dt] = a;
    }
    const float xi = __expf(lg * (float)(t + 1));
#pragma unroll
    for (int dt = 0; dt < 4; ++dt)
#pragma unroll
        for (int rg = 0; rg < 16; ++rg) o[dt][rg] *= xi;
#pragma unroll 1
    for (int tl = 0; tl <= wl; ++tl) {
        {
            f32x16 st = F16Z;
#pragma unroll
            for (int ks = 0; ks < 4; ++ks) st = __builtin_amdgcn_mfma_f32_32x32x16_bf16(frag_row(Ks, 128, 32 * tl + r32, 2 * ks + hh), qf[ks], st, 0, 0, 0);
#pragma unroll
            for (int rg = 0; rg < 16; ++rg) { const int s = 32 * tl + acc_row(rg, hh); st[rg] = (s <= t) ? st[rg] * __expf(lg * (float)(t - s)) : 0.f; }
#pragma unroll
            for (int s2 = 0; s2 < 2; ++s2) {
                u32x4 pw; pw.x = cvtpk(st[8 * s2 + 0], st[8 * s2 + 1]); pw.y = cvtpk(st[8 * s2 + 2], st[8 * s2 + 3]); pw.z = cvtpk(st[8 * s2 + 4], st[8 * s2 + 5]); pw.w = cvtpk(st[8 * s2 + 6], st[8 * s2 + 7]);
                const bf16x8_t pb = __builtin_bit_cast(bf16x8_t, pw);
#pragma unroll
                for (int dt = 0; dt < 4; ++dt) o[dt] = __builtin_amdgcn_mfma_f32_32x32x16_bf16(frag_tr<true>(Vs, 256, 32 * tl + 16 * s2, 32 * dt, lane), pb, o[dt], 0, 0, 0);
            }
        }
    }
    RGN_T1(2, ldsU)
    RGN_T0(3)
    float sum = 0.f, sq = 0.f;
#pragma unroll
    for (int dt = 0; dt < 4; ++dt)
#pragma unroll
        for (int rg = 0; rg < 16; ++rg) { sum += o[dt][rg]; sq += o[dt][rg] * o[dt][rg]; }
    sum += __shfl_xor(sum, 32); sq += __shfl_xor(sq, 32);
    const float mean = sum * (1.0f / 128.0f);
    const float rstd = 1.0f / sqrtf(fmaxf(sq * (1.0f / 128.0f) - mean * mean, 0.f) + LN_EPS);
    __syncthreads();
#pragma unroll
    for (int dt = 0; dt < 4; ++dt)
#pragma unroll
        for (int g4 = 0; g4 < 4; ++g4) {
            const int dv = 32 * dt + 8 * g4 + 4 * hh;
            const f32x4 gg = *(const f32x4*)(p.ret_g + li * 512 + h * 128 + dv);
            epi_stage_put(((dt < 2) ? Ks : Rs) + 4096 * wl, r32, dv & 63, (o[dt][4 * g4 + 0] - mean) * rstd * gg[0], (o[dt][4 * g4 + 1] - mean) * rstd * gg[1], (o[dt][4 * g4 + 2] - mean) * rstd * gg[2], (o[dt][4 * g4 + 3] - mean) * rstd * gg[3]);
        }
    asm volatile("s_waitcnt lgkmcnt(0)" ::: "memory");
#pragma unroll
    for (int j = 0; j < 8; ++j) {
        const int idx = (lane + 64 * j) & 255, half = j >> 2, row = idx >> 3, cc = idx & 7;
        const LAS unsigned char* reg = (half ? Rs : Ks) + 4096 * wl;
        float yv[8], gv[8]; unpack8v(*(const LAS u32x4*)(reg + row * 128 + swz16(row, cc)), yv);
        const size_t tk = (size_t)(t0 + 32 * wl + row);
        unpack8v(*(const u32x4*)(Z + tk * ZW + C_RG + h * 128 + 64 * half + 8 * cc), gv);
#pragma unroll
        for (int e = 0; e < 8; ++e) yv[e] *= siluf_(gv[e]);
        *(u32x4*)(MIX + tk * DM + h * 128 + 64 * half + 8 * cc) = pack8(yv);
    }
    __syncthreads();
    RGN_T1(3, ldsU)
}

__device__ __forceinline__ void mls_out_u(const Params& p, int li, int unit, LAS unsigned char* ldsU, int wl, int tidU, int lane) {
    const int c = unit & 63, bh = unit >> 6, h = bh & 3, b = bh >> 2, t0 = b * SEQ + c * 128;
    const int r32 = lane & 31, hh = lane >> 5;
    const bf16* Z = (const bf16*)(p.ws + WS_Z); bf16* MIX = (bf16*)(p.ws + WS_MIX);
    const float* MC = (const float*)(p.ws + WS_MC); const float* MN = (const float*)(p.ws + WS_MN); const float* MMP = (const float*)(p.ws + WS_MMP);
    LAS unsigned char* Ks = ldsU; LAS unsigned char* Qs = ldsU + 16384; LAS unsigned char* Vs = ldsU + 32768; LAS unsigned char* Cs = ldsU + 65536;
    LAS float* bb = (LAS float*)(ldsU + 77824); LAS float* gg = bb + 128; LAS float* pm = gg + 128;
    RGN_T0(4)
    if (wl == 0) {
        float b0, b1, g0, g1; mls_gates(p, li, t0, h, lane, b0, b1, g0, g1);
        const float p1 = fmaxf(g0, g1); float v = p1;
#pragma unroll
        for (int o = 1; o < 64; o <<= 1) { const float u = __shfl_up(v, o); if (lane >= o) v = fmaxf(v, u); }
        const float prev = __shfl_up(v, 1);
        const float ex = (lane == 0) ? -INFINITY : prev;
        bb[2 * lane] = b0; bb[2 * lane + 1] = b1; gg[2 * lane] = g0; gg[2 * lane + 1] = g1;
        pm[2 * lane] = fmaxf(ex, g0); pm[2 * lane + 1] = fmaxf(ex, p1);
    }
    stage_vext(Z + (size_t)t0 * ZW + C_MV + h * 64, Vs, tidU);
    stage_copy((const bf16*)p.out + (size_t)t0 * 512 + 256 + h * 64, 512, Ks, 128, 128, 8, tidU);
    stage_copy((const bf16*)p.out + (size_t)t0 * 512 + h * 64, 512, Qs, 128, 128, 8, tidU);
#pragma unroll
    for (int task = tidU; task < 96 * 8; task += 256) {
        const int row = task >> 3, cc = task & 7;
        const float* src = (row < 64) ? (MC + (size_t)unit * 4096 + row * 64 + 8 * cc) : (MN + (size_t)unit * 64 + 8 * cc);
        const f32x4 x0 = *(const f32x4*)src, x1 = *(const f32x4*)(src + 4);
        const float ok = (row <= 64) ? 1.0f : 0.0f;
        const float v[8] = {x0[0] * ok, x0[1] * ok, x0[2] * ok, x0[3] * ok, x1[0] * ok, x1[1] * ok, x1[2] * ok, x1[3] * ok};
        *(LAS u32x4*)(Cs + row * 128 + swz16(row, cc)) = pack8(v);
    }
    const float mprev = MMP[unit];
    __syncthreads();
    RGN_T1(4, ldsU)
    RGN_T0(5)
    const int t = 32 * wl + r32, tok = t0 + t;
    const float Mt = fmaxf(mprev, pm[t]), bt = bb[t];
    const float winter = __expf(mprev - Mt);
    bf16x8_t qf[4];
#pragma unroll
    for (int ks = 0; ks < 4; ++ks) qf[ks] = frag_row(Qs, 128, t, 2 * ks + hh);
    f32x16 o[3];
#pragma unroll
    for (int dt = 0; dt < 3; ++dt) {
        f32x16 a = F16Z;
#pragma unroll
        for (int ks = 0; ks < 4; ++ks) a = __builtin_amdgcn_mfma_f32_32x32x16_bf16(frag_row(Cs, 128, 32 * dt + r32, 2 * ks + hh), qf[ks], a, 0, 0, 0);
#pragma unroll
        for (int rg = 0; rg < 16; ++rg) a[rg] *= winter;
        o[dt] = a;
    }
#pragma unroll 1
    for (int tl = 0; tl <= wl; ++tl) {
        {
            f32x16 st = F16Z;
#pragma unroll
            for (int ks = 0; ks < 4; ++ks) st = __builtin_amdgcn_mfma_f32_32x32x16_bf16(frag_row(Ks, 128, 32 * tl + r32, 2 * ks + hh), qf[ks], st, 0, 0, 0);
#pragma unroll
            for (int g4 = 0; g4 < 4; ++g4) {
                const int sb = 32 * tl + 8 * g4 + 4 * hh;
                const f32x4 gv = *(const LAS f32x4*)(gg + sb);
#pragma unroll
                for (int j = 0; j < 4; ++j) st[4 * g4 + j] = (sb + j <= t) ? st[4 * g4 + j] * __expf(gv[j] - Mt) : 0.f;
            }
#pragma unroll
            for (int s2 = 0; s2 < 2; ++s2) {
                u32x4 pw; pw.x = cvtpk(st[8 * s2 + 0], st[8 * s2 + 1]); pw.y = cvtpk(st[8 * s2 + 2], st[8 * s2 + 3]); pw.z = cvtpk(st[8 * s2 + 4], st[8 * s2 + 5]); pw.w = cvtpk(st[8 * s2 + 6], st[8 * s2 + 7]);
                const bf16x8_t pb = __builtin_bit_cast(bf16x8_t, pw);
#pragma unroll
                for (int dt = 0; dt < 3; ++dt) o[dt] = __builtin_amdgcn_mfma_f32_32x32x16_bf16(frag_tr<true>(Vs, 256, 32 * tl + 16 * s2, 32 * dt, lane), pb, o[dt], 0, 0, 0);
            }
        }
    }
    RGN_T1(5, ldsU)
    RGN_T0(6)
    const float den = __shfl(o[2][0], r32);
    const float rden = 1.0f / fmaxf(fabsf(den), __expf(-(bt + Mt)));
    float sum = 0.f, sq = 0.f;
#pragma unroll
    for (int dt = 0; dt < 2; ++dt)
#pragma unroll
        for (int rg = 0; rg < 16; ++rg) { o[dt][rg] *= rden; sum += o[dt][rg]; sq += o[dt][rg] * o[dt][rg]; }
    sum += __shfl_xor(sum, 32); sq += __shfl_xor(sq, 32);
    const float mean = sum * (1.0f / 64.0f);
    const float rstd = 1.0f / sqrtf(fmaxf(sq * (1.0f / 64.0f) - mean * mean, 0.f) + LN_EPS);
    __syncthreads();
#pragma unroll
    for (int dt = 0; dt < 2; ++dt)
#pragma unroll
        for (int g4 = 0; g4 < 4; ++g4) {
            const int d = 32 * dt + 8 * g4 + 4 * hh;
            const f32x4 gn = *(const f32x4*)(p.mls_g + li * 256 + h * 64 + d);
            epi_stage_put(Ks + 4096 * wl, r32, d, (o[dt][4 * g4 + 0] - mean) * rstd * gn[0], (o[dt][4 * g4 + 1] - mean) * rstd * gn[1], (o[dt][4 * g4 + 2] - mean) * rstd * gn[2], (o[dt][4 * g4 + 3] - mean) * rstd * gn[3]);
        }
    asm volatile("s_waitcnt lgkmcnt(0)" ::: "memory");
#pragma unroll
    for (int j = 0; j < 4; ++j) {
        const int idx = lane + 64 * j, row = idx >> 3, cc = idx & 7;
        float yv[8], gv[8]; unpack8v(*(const LAS u32x4*)(Ks + 4096 * wl + row * 128 + swz16(row, cc)), yv);
        const size_t tk = (size_t)(t0 + 32 * wl + row);
        unpack8v(*(const u32x4*)(Z + tk * ZW + C_MO + h * 64 + 8 * cc), gv);
#pragma unroll
        for (int e = 0; e < 8; ++e) yv[e] *= sigmoidf_(gv[e]);
        *(u32x4*)(MIX + tk * DM + 768 + h * 64 + 8 * cc) = pack8(yv);
    }
    __syncthreads();
    RGN_T1(6, ldsU)
}

__device__ __forceinline__ void p3_scans(const Params& p) {
    float* RST = (float*)(p.ws + WS_RST);
    float* MC = (float*)(p.ws + WS_MC); float* MN = (float*)(p.ws + WS_MN); const float* MA = (const float*)(p.ws + WS_MA); const float* MML = (const float*)(p.ws + WS_MML); float* MMP = (float*)(p.ws + WS_MMP);
    const int gt = blockIdx.x * NTHR + threadIdx.x, GT = gridDim.x * NTHR;
    for (int e = gt; e < 16 * 8192; e += GT) {
        const int bh = e >> 13, el = e & 8191, h = bh & 3;
        const float gL = expf(ret_lg(h) * 128.0f);
        float R = 0.f;
        float* ptr = RST + (size_t)bh * 64 * 8192 + el;
#pragma unroll 1
        for (int cb = 0; cb < 64; cb += 16) {
            float sv[16];
#pragma unroll
            for (int j = 0; j < 16; ++j) sv[j] = ptr[(size_t)(cb + j) * 8192];
#pragma unroll
            for (int j = 0; j < 16; ++j) { ptr[(size_t)(cb + j) * 8192] = R; R = fmaf(gL, R, sv[j]); }
        }
    }
    for (int e = gt; e < 16 * 4160; e += GT) {
        const int bh = e / 4160, el = e - bh * 4160;
        float* ptr; size_t stride;
        if (el < 4096) { ptr = MC + (size_t)bh * 64 * 4096 + el; stride = 4096; } else { ptr = MN + (size_t)bh * 64 * 64 + (el - 4096); stride = 64; }
        float m = 0.f, C = 0.f;
#pragma unroll 1
        for (int cb = 0; cb < 64; cb += 16) {
            float sv[16], av[16], mlv[16];
#pragma unroll
            for (int j = 0; j < 16; ++j) { sv[j] = ptr[(size_t)(cb + j) * stride]; av[j] = MA[bh * 64 + cb + j]; mlv[j] = MML[bh * 64 + cb + j]; }
#pragma unroll
            for (int j = 0; j < 16; ++j) {
                const float mn = fmaxf(av[j] + m, mlv[j]);
                const float f1 = __expf(av[j] + m - mn), f2 = __expf(mlv[j] - mn);
                ptr[(size_t)(cb + j) * stride] = C; C = f1 * C + f2 * sv[j];
                if (el == 0) MMP[bh * 64 + cb + j] = m;
                m = mn;
            }
        }
    }
}

__device__ __forceinline__ void ret_out_item(const Params& p, int li, int item, float* lds) {
    const int tid = threadIdx.x;
    const int c = item & 63, bh = item >> 6, h = bh & 3, b = bh >> 2;
    const int t0 = b * SEQ + c * 128, s0 = c * 128;
    const bf16* Z = (const bf16*)(p.ws + WS_Z);
    const float* rcos = (const float*)(p.ws + WS_RCOS); const float* rsin = (const float*)(p.ws + WS_RSIN);
    const float* RST = (const float*)(p.ws + WS_RST);
    bf16* MIX = (bf16*)(p.ws + WS_MIX);
    float* Q = lds; float* K = Q + 8320; float* SC = K + 8320; float* V = SC + 8256; float* R = V + 8192;
    const float lg = ret_lg(h);
    for (int idx = tid; idx < 128 * 32; idx += NTHR) {
        const int row = idx >> 5, i = idx & 31;
        const bf16* zq = Z + (size_t)(t0 + row) * ZW + C_RQ + h * 64; const bf16* zk = Z + (size_t)(t0 + row) * ZW + C_RK + h * 64;
        const float cs = rcos[(s0 + row) * 32 + i], sn = rsin[(s0 + row) * 32 + i];
        const float q1 = bf2f(zq[i]), q2 = bf2f(zq[i + 32]), k1 = bf2f(zk[i]), k2 = bf2f(zk[i + 32]);
        Q[row * 65 + i] = q1 * cs - q2 * sn; Q[row * 65 + i + 32] = q2 * cs + q1 * sn;
        K[row * 65 + i] = (k1 * cs - k2 * sn) * 0.125f; K[row * 65 + i + 32] = (k2 * cs + k1 * sn) * 0.125f;
    }
    __syncthreads();
    const int r = tid >> 3, d0 = (tid & 7) * 8;
#pragma unroll 1
    for (int rh = 0; rh < 2; ++rh) {
        const int t = rh * 64 + r;
#pragma unroll 1
        for (int j = 0; j < 16; ++j) {
            const int s = (tid & 7) + 8 * j;
            float dot = 0.f;
#pragma unroll 16
            for (int d = 0; d < 64; ++d) dot = fmaf(Q[t * 65 + d], K[s * 65 + d], dot);
            SC[r * 129 + s] = (s <= t) ? dot * expf(lg * (float)(t - s)) : 0.f;
        }
        __syncthreads();
        float o[2][8];
#pragma unroll
        for (int dh = 0; dh < 2; ++dh) {
            for (int idx = tid; idx < 128 * 64; idx += NTHR) { const int row = idx >> 6, d = idx & 63; V[idx] = bf2f(Z[(size_t)(t0 + row) * ZW + C_RV + h * 128 + dh * 64 + d]); }
            for (int idx = tid; idx < 64 * 64; idx += NTHR) { const int k = idx >> 6, d = idx & 63; R[idx] = RST[(size_t)item * 8192 + k * 128 + dh * 64 + d]; }
            __syncthreads();
            float acc[8], cr[8];
#pragma unroll
            for (int j = 0; j < 8; ++j) { acc[j] = 0.f; cr[j] = 0.f; }
#pragma unroll 4
            for (int s = 0; s < 128; ++s) {
                const float w = SC[r * 129 + s];
#pragma unroll
                for (int j = 0; j < 8; ++j) acc[j] = fmaf(w, V[s * 64 + d0 + j], acc[j]);
            }
#pragma unroll 4
            for (int k = 0; k < 64; ++k) {
                const float qv = Q[t * 65 + k];
#pragma unroll
                for (int j = 0; j < 8; ++j) cr[j] = fmaf(qv, R[k * 64 + d0 + j], cr[j]);
            }
            const float xi = expf(lg * (float)(t + 1));
#pragma unroll
            for (int j = 0; j < 8; ++j) o[dh][j] = acc[j] + xi * cr[j];
            __syncthreads();
        }
        float sum = 0.f;
#pragma unroll
        for (int dh = 0; dh < 2; ++dh)
#pragma unroll
            for (int j = 0; j < 8; ++j) sum += o[dh][j];
        sum += __shfl_xor(sum, 1); sum += __shfl_xor(sum, 2); sum += __shfl_xor(sum, 4);
        const float mean = sum * (1.0f / 128.0f);
        float sq = 0.f;
#pragma unroll
        for (int dh = 0; dh < 2; ++dh)
#pragma unroll
            for (int j = 0; j < 8; ++j) { const float dd = o[dh][j] - mean; sq += dd * dd; }
        sq += __shfl_xor(sq, 1); sq += __shfl_xor(sq, 2); sq += __shfl_xor(sq, 4);
        const float rstd = 1.0f / sqrtf(sq * (1.0f / 128.0f) + LN_EPS);
#pragma unroll
        for (int dh = 0; dh < 2; ++dh) {
            float y[8];
#pragma unroll
            for (int j = 0; j < 8; ++j) {
                const int d = dh * 64 + d0 + j;
                const float g = p.ret_g[li * 512 + h * 128 + d];
                const float rg = bf2f(Z[(size_t)(t0 + t) * ZW + C_RG + h * 128 + d]);
                y[j] = (o[dh][j] - mean) * rstd * g * siluf_(rg);
            }
            uint4 w; w.x = pk2(y[0], y[1]); w.y = pk2(y[2], y[3]); w.z = pk2(y[4], y[5]); w.w = pk2(y[6], y[7]);
            *(uint4*)(MIX + (size_t)(t0 + t) * DM + h * 128 + dh * 64 + d0) = w;
        }
    }
    __syncthreads();
}

__device__ __forceinline__ void mls_out_item(const Params& p, int li, int item, float* lds) {
    const int tid = threadIdx.x;
    const int c = item & 63, bh = item >> 6, h = bh & 3, b = bh >> 2;
    const int t0 = b * SEQ + c * 128;
    const bf16* Z = (const bf16*)(p.ws + WS_Z);
    const float* gates = (const float*)(p.ws + WS_GATES);
    const float* MC = (const float*)(p.ws + WS_MC); const float* MN = (const float*)(p.ws + WS_MN); const float* MMP = (const float*)(p.ws + WS_MMP);
    bf16* MIX = (bf16*)(p.ws + WS_MIX);
    const float* cw = p.conv_w + (size_t)li * 4 * 512;
    float* Q = lds; float* K = Q + 8320; float* SM = K + 8320; float* V = SM + 8256; float* C = V + 8192; float* nv = C + 4096; float* ib = nv + 64; float* bb = ib + 128; float* pm = bb + 128;
    for (int idx = tid; idx < 128 * 64; idx += NTHR) {
        const int row = idx >> 6, d = idx & 63, chq = h * 64 + d, chk = 256 + h * 64 + d;
        float aq = 0.f, ak = 0.f;
#pragma unroll
        for (int j = 0; j < 4; ++j) {
            const int sp = c * 128 + row - 3 + j;
            if (sp >= 0) {
                const bf16* zr = Z + (size_t)(t0 + row - 3 + j) * ZW;
                aq = fmaf(cw[j * 512 + chq], bf2f(zr[C_MQ + h * 64 + d]), aq);
                ak = fmaf(cw[j * 512 + chk], bf2f(zr[C_MK + h * 64 + d]), ak);
            }
        }
        Q[row * 65 + d] = siluf_(aq); K[row * 65 + d] = siluf_(ak) * 0.125f;
        V[idx] = bf2f(Z[(size_t)(t0 + row) * ZW + C_MV + h * 64 + d]);
    }
    for (int idx = tid; idx < 4096; idx += NTHR) C[idx] = MC[(size_t)item * 4096 + idx];
    if (tid < 64) nv[tid] = MN[(size_t)item * 64 + tid];
    if (tid < 128) {
        const int t = t0 + tid;
        ib[tid] = gates[(size_t)t * 8 + h] + p.b_if[li * 8 + h];
        bb[tid] = logsigmoidf_(gates[(size_t)t * 8 + 4 + h] + p.b_if[li * 8 + 4 + h]);
    }
    const float mprev = MMP[item];
    __syncthreads();
    if (tid == 0) {
        float run = 0.f, pmx = -INFINITY;
#pragma unroll 4
        for (int s = 0; s < 128; ++s) { run += bb[s]; bb[s] = run; pmx = fmaxf(pmx, ib[s] - run); pm[s] = pmx; }
    }
    __syncthreads();
    const int r = tid >> 3, d0 = (tid & 7) * 8;
#pragma unroll 1
    for (int rh = 0; rh < 2; ++rh) {
        const int t = rh * 64 + r;
        const float mt = bb[t] + fmaxf(mprev, pm[t]);
#pragma unroll 1
        for (int j = 0; j < 16; ++j) {
            const int s = (tid & 7) + 8 * j;
            float dot = 0.f;
#pragma unroll 16
            for (int d = 0; d < 64; ++d) dot = fmaf(Q[t * 65 + d], K[s * 65 + d], dot);
            SM[r * 129 + s] = (s <= t) ? dot * expf(bb[t] - bb[s] + ib[s] - mt) : 0.f;
        }
        __syncthreads();
        float acc[8], qc[8], den = 0.f, qn = 0.f;
#pragma unroll
        for (int j = 0; j < 8; ++j) { acc[j] = 0.f; qc[j] = 0.f; }
#pragma unroll 4
        for (int s = 0; s < 128; ++s) {
            const float w = SM[r * 129 + s]; den += w;
#pragma unroll
            for (int j = 0; j < 8; ++j) acc[j] = fmaf(w, V[s * 64 + d0 + j], acc[j]);
        }
#pragma unroll 4
        for (int k = 0; k < 64; ++k) {
            const float qv = Q[t * 65 + k]; qn = fmaf(qv, nv[k], qn);
#pragma unroll
            for (int j = 0; j < 8; ++j) qc[j] = fmaf(qv, C[k * 64 + d0 + j], qc[j]);
        }
        const float winter = expf(bb[t] + mprev - mt);
        den += winter * qn;
        const float denom = fmaxf(fabsf(den), expf(-mt));
        float hv[8], sum = 0.f;
#pragma unroll
        for (int j = 0; j < 8; ++j) { hv[j] = (acc[j] + winter * qc[j]) / denom; sum += hv[j]; }
        sum += __shfl_xor(sum, 1); sum += __shfl_xor(sum, 2); sum += __shfl_xor(sum, 4);
        const float mean = sum * (1.0f / 64.0f);
        float sq = 0.f;
#pragma unroll
        for (int j = 0; j < 8; ++j) { const float dd = hv[j] - mean; sq += dd * dd; }
        sq += __shfl_xor(sq, 1); sq += __shfl_xor(sq, 2); sq += __shfl_xor(sq, 4);
        const float rstd = 1.0f / sqrtf(sq * (1.0f / 64.0f) + LN_EPS);
        float y[8];
#pragma unroll
        for (int j = 0; j < 8; ++j) {
            const int d = d0 + j;
            const float g = p.mls_g[li * 256 + h * 64 + d];
            const float mo = bf2f(Z[(size_t)(t0 + t) * ZW + C_MO + h * 64 + d]);
            y[j] = (hv[j] - mean) * rstd * g * sigmoidf_(mo);
        }
        { uint4 w; w.x = pk2(y[0], y[1]); w.y = pk2(y[2], y[3]); w.z = pk2(y[4], y[5]); w.w = pk2(y[6], y[7]);
          *(uint4*)(MIX + (size_t)(t0 + t) * DM + 768 + h * 64 + d0) = w; }
        __syncthreads();
    }
}

template <int NB>
__device__ __forceinline__ void ln_rows(const bf16* U, bf16* XBo, signed char* XQ, float* XS, int r0, int rstep, const float* g, const float* bta, int lane) {
    float4 v[NB][4]; float s[NB];
#pragma unroll
    for (int u = 0; u < NB; ++u) { const int r = (r0 + u * rstep < NT) ? r0 + u * rstep : r0; const bf16* row = U + (size_t)r * DM; s[u] = 0.f;
#pragma unroll
        for (int j = 0; j < 4; ++j) { const uint2 ub = *(const uint2*)(row + 256 * j + 4 * lane); v[u][j] = make_float4(__uint_as_float(ub.x << 16), __uint_as_float(ub.x & 0xffff0000u), __uint_as_float(ub.y << 16), __uint_as_float(ub.y & 0xffff0000u)); } }
    float4 gg[4], bv[4];
#pragma unroll
    for (int j = 0; j < 4; ++j) { gg[j] = *(const float4*)(g + 256 * j + 4 * lane); bv[j] = *(const float4*)(bta + 256 * j + 4 * lane); }
#pragma unroll
    for (int u = 0; u < NB; ++u)
#pragma unroll
        for (int j = 0; j < 4; ++j) s[u] += (v[u][j].x + v[u][j].y) + (v[u][j].z + v[u][j].w);
#pragma unroll
    for (int o = 1; o < 64; o <<= 1)
#pragma unroll
        for (int u = 0; u < NB; ++u) s[u] += __shfl_xor(s[u], o);
    float s2[NB];
#pragma unroll
    for (int u = 0; u < NB; ++u) { const float mean = s[u] * (1.0f / DM); s2[u] = 0.f;
#pragma unroll
        for (int j = 0; j < 4; ++j) { v[u][j].x -= mean; v[u][j].y -= mean; v[u][j].z -= mean; v[u][j].w -= mean; s2[u] += (v[u][j].x * v[u][j].x + v[u][j].y * v[u][j].y) + (v[u][j].z * v[u][j].z + v[u][j].w * v[u][j].w); } }
#pragma unroll
    for (int o = 1; o < 64; o <<= 1)
#pragma unroll
        for (int u = 0; u < NB; ++u) s2[u] += __shfl_xor(s2[u], o);
    float am[NB];
#pragma unroll
    for (int u = 0; u < NB; ++u) { const float rstd = 1.0f / sqrtf(s2[u] * (1.0f / DM) + LN_EPS); const int r = r0 + u * rstep; am[u] = 0.f;
#pragma unroll
        for (int j = 0; j < 4; ++j) {
            const float4 o = make_float4(v[u][j].x * rstd * gg[j].x + bv[j].x, v[u][j].y * rstd * gg[j].y + bv[j].y, v[u][j].z * rstd * gg[j].z + bv[j].z, v[u][j].w * rstd * gg[j].w + bv[j].w);
            if (r < NT) *(uint2*)(XBo + (size_t)r * DM + 256 * j + 4 * lane) = make_uint2(pk2(o.x, o.y), pk2(o.z, o.w));
            v[u][j] = o; am[u] = fmaxf(am[u], fmaxf(fmaxf(fabsf(o.x), fabsf(o.y)), fmaxf(fabsf(o.z), fabsf(o.w))));
        } }
#pragma unroll
    for (int o = 1; o < 64; o <<= 1)
#pragma unroll
        for (int u = 0; u < NB; ++u) am[u] = fmaxf(am[u], __shfl_xor(am[u], o));
#pragma unroll
    for (int u = 0; u < NB; ++u) {
        const int r = r0 + u * rstep;
        if (r < NT) {
            const float inv = am[u] > 0.f ? 127.0f / am[u] : 0.f; signed char* qrow = XQ + (size_t)r * DM;
#pragma unroll
            for (int j = 0; j < 4; ++j) {
                const unsigned q0 = (unsigned)__float2int_rn(v[u][j].x * inv) & 0xffu, q1 = (unsigned)__float2int_rn(v[u][j].y * inv) & 0xffu, q2 = (unsigned)__float2int_rn(v[u][j].z * inv) & 0xffu, q3 = (unsigned)__float2int_rn(v[u][j].w * inv) & 0xffu;
                *(unsigned*)(qrow + 256 * j + 4 * lane) = q0 | (q1 << 8) | (q2 << 16) | (q3 << 24);
            }
            if (lane == 0) XS[r] = am[u] * (1.0f / 127.0f);
        }
    }
}

__device__ __forceinline__ void topk_item(const Params& p, int li, int item, float* lds) {
    const int tid = threadIdx.x, lane = tid & 63, wave = tid >> 6;
    const int tile = item >> 3, h = item & 7, tok0 = tile * 64;
    const bf16* QRY = (const bf16*)(p.ws + WS_QRY);
    int* RI = (int*)(p.ws + WS_RI); float* RG = (float*)(p.ws + WS_RG);
    float* Kk = lds; float* Qt = Kk + 128 * 129; float* SC = Qt + 64 * 129; float* TKV = SC + 64 * 128; int* TKI = (int*)(TKV + 2048);
#pragma unroll 1
    for (int pp = 0; pp < 2; ++pp) {
        const float* kb = p.keys + ((size_t)((li * 8 + h) * 2 + pp)) * 128 * 128;
        for (int idx = tid; idx < 128 * 128; idx += NTHR) { const int n = idx >> 7, c = idx & 127; Kk[n * 129 + c] = kb[idx]; }
        for (int idx = tid; idx < 64 * 128; idx += NTHR) { const int tok = idx >> 7, c = idx & 127; Qt[tok * 129 + c] = bf2f(QRY[(size_t)(tok0 + tok) * 2048 + h * 256 + pp * 128 + c]); }
        __syncthreads();
        {
            const int tok = tid >> 3;
#pragma unroll 1
            for (int j = 0; j < 16; ++j) {
                const int n = (tid & 7) + 8 * j;
                float dot = 0.f;
#pragma unroll 16
                for (int c = 0; c < 128; ++c) dot = fmaf(Qt[tok * 129 + c], Kk[n * 129 + c], dot);
                SC[tok * 128 + n] = dot;
            }
        }
        __syncthreads();
#pragma unroll 1
        for (int q = 0; q < 8; ++q) {
            const int tok = wave * 8 + q;
            float v0 = SC[tok * 128 + lane], v1 = SC[tok * 128 + 64 + lane];
#pragma unroll 1
            for (int k = 0; k < 16; ++k) {
                const float wm = wave_max(fmaxf(v0, v1));
                const unsigned long long b0 = __ballot(v0 == wm);
                int idx;
                if (b0) { const int sl = __ffsll((long long)b0) - 1; idx = sl; if (lane == sl) v0 = -INFINITY; }
                else { const unsigned long long b1 = __ballot(v1 == wm); const int sl = __ffsll((long long)b1) - 1; idx = 64 + sl; if (lane == sl) v1 = -INFINITY; }
                if (lane == 0) { TKV[(tok * 2 + pp) * 16 + k] = wm; TKI[(tok * 2 + pp) * 16 + k] = idx; }
            }
        }
        __syncthreads();
    }
#pragma unroll 1
    for (int q = 0; q < 8; ++q) {
        const int tok = wave * 8 + q;
        const float s1 = TKV[(tok * 2) * 16 + (lane >> 2)];
        float cnd[4];
#pragma unroll
        for (int j = 0; j < 4; ++j) cnd[j] = s1 + TKV[(tok * 2 + 1) * 16 + (lane & 3) * 4 + j];
        float myval = 0.f; int myflat = 0;
#pragma unroll 1
        for (int k = 0; k < 16; ++k) {
            const float wm = wave_max(fmaxf(fmaxf(cnd[0], cnd[1]), fmaxf(cnd[2], cnd[3])));
            const bool has = (cnd[0] == wm) | (cnd[1] == wm) | (cnd[2] == wm) | (cnd[3] == wm);
            const unsigned long long bl = __ballot(has);
            const int sl = __ffsll((long long)bl) - 1;
            int fl = 0;
            if (lane == sl) {
                int j = (cnd[0] == wm) ? 0 : ((cnd[1] == wm) ? 1 : ((cnd[2] == wm) ? 2 : 3));
                fl = lane * 4 + j;
                if (j == 0) cnd[0] = -INFINITY; else if (j == 1) cnd[1] = -INFINITY; else if (j == 2) cnd[2] = -INFINITY; else cnd[3] = -INFINITY;
            }
            fl = __shfl(fl, sl);
            if (lane == k) { myval = wm; myflat = fl; }
        }
        const float m0 = __shfl(myval, 0);
        const float e = (lane < 16) ? expf(myval - m0) : 0.f;
        const float ssum = wave_sum(e);
        if (lane < 16) {
            const int a = myflat >> 4, bq = myflat & 15;
            const int eidx = TKI[(tok * 2) * 16 + a] * 128 + TKI[(tok * 2 + 1) * 16 + bq];
            RI[(size_t)(tok0 + tok) * 128 + h * 16 + lane] = eidx;
            RG[(size_t)(tok0 + tok) * 128 + h * 16 + lane] = e / ssum;
        }
    }
    __syncthreads();
}

__device__ __forceinline__ float key_embed(float v, unsigned idx, unsigned keepmask) { return __uint_as_float((__float_as_uint(v) & keepmask) | idx); }

template <int N>
__device__ __forceinline__ void bitonic_desc(float (&a)[N]) {
#pragma unroll
    for (int k = 2; k <= N; k <<= 1)
#pragma unroll
        for (int j = k >> 1; j > 0; j >>= 1)
#pragma unroll
            for (int i = 0; i < N; ++i) {
                const int l = i ^ j;
                if (l > i) { const float hi = fmaxf(a[i], a[l]), lo = fminf(a[i], a[l]); if ((i & k) == 0) { a[i] = hi; a[l] = lo; } else { a[i] = lo; a[l] = hi; } }
            }
}
__device__ __forceinline__ void merge_top16(float (&a)[16], const float (&b)[16]) {
#pragma unroll
    for (int i = 0; i < 16; ++i) a[i] = fmaxf(a[i], b[15 - i]);
#pragma unroll
    for (int j = 8; j > 0; j >>= 1)
#pragma unroll
        for (int i = 0; i < 16; ++i) { const int l = i ^ j; if (l > i) { const float hi = fmaxf(a[i], a[l]), lo = fminf(a[i], a[l]); a[i] = hi; a[l] = lo; } }
}
__device__ __forceinline__ void topk_half(const bf16x8_t (&qf)[8], const LAS unsigned char* kl, int r32, int hh, float (&out)[16]) {
    f32x16 st[4];
#pragma unroll
    for (int tl = 0; tl < 4; ++tl) {
        f32x16 a16 = {0.f, 0.f, 0.f, 0.f, 0.f, 0.f, 0.f, 0.f, 0.f, 0.f, 0.f, 0.f, 0.f, 0.f, 0.f, 0.f};
        const int n = 32 * tl + r32;
#pragma unroll
        for (int ks = 0; ks < 8; ++ks) {
            const int c = 8 * hh + ks;
            const bf16x8_t kf = *(const LAS bf16x8_t*)(kl + n * 256 + ((c ^ (n & 15)) << 4));
            a16 = __builtin_amdgcn_mfma_f32_32x32x16_bf16(kf, qf[ks], a16, 0, 0, 0);
        }
        st[tl] = a16;
    }
#pragma unroll
    for (int tl = 0; tl < 4; ++tl)
#pragma unroll
        for (int rg = 0; rg < 16; ++rg) st[tl][rg] = key_embed(st[tl][rg], (unsigned)(32 * tl + (rg & 3) + 8 * (rg >> 2)) | ((unsigned)hh << 2), 0xffffff80u);
    float g0[16], g1[16], g2[16], g3[16];
#pragma unroll
    for (int rg = 0; rg < 16; ++rg) { g0[rg] = st[0][rg]; g1[rg] = st[1][rg]; g2[rg] = st[2][rg]; g3[rg] = st[3][rg]; }
    bitonic_desc<16>(g0); bitonic_desc<16>(g1); bitonic_desc<16>(g2); bitonic_desc<16>(g3);
    merge_top16(g0, g1); merge_top16(g2, g3); merge_top16(g0, g2);
#pragma unroll
    for (int i = 0; i < 16; ++i) g1[i] = __shfl_xor(g0[i], 32);
    merge_top16(g0, g1);
#pragma unroll
    for (int i = 0; i < 16; ++i) out[i] = g0[i];
}

__device__ __forceinline__ void topk_unit(const Params& p, int li, int item, LAS unsigned char* lds) {
    const int tid = threadIdx.x, lane = tid & 63, wave = __builtin_amdgcn_readfirstlane(tid >> 6);
    const int r32 = lane & 31, hh = lane >> 5;
    const int tile = item >> 3, h = item & 7;
    const int t = tile * 256 + 32 * wave + r32;
    const bf16* QRY = (const bf16*)(p.ws + WS_QRY);
    const bf16* KB = (const bf16*)(p.ws + WS_KEYS) + (size_t)((li * 8 + h) * 2) * 128 * 128;
    int* RI = (int*)(p.ws + WS_RI); float* RG = (float*)(p.ws + WS_RG);
    RGN_T0(10)
    bf16x8_t qfA[8], qfB[8];
#pragma unroll
    for (int ks = 0; ks < 8; ++ks) { qfA[ks] = *(const bf16x8_t*)(QRY + (size_t)t * 2048 + h * 256 + 64 * hh + 8 * ks); qfB[ks] = *(const bf16x8_t*)(QRY + (size_t)t * 2048 + h * 256 + 128 + 64 * hh + 8 * ks); }
#pragma unroll 4
    for (int idx = tid; idx < 2 * 128 * 16; idx += NTHR) {
        const int pp = idx >> 11, n = (idx >> 4) & 127, c = idx & 15;
        const u32x4 v = *(const u32x4*)(KB + (size_t)(pp * 128 + n) * 128 + c * 8);
        *(LAS u32x4*)(lds + pp * 32768 + n * 256 + ((c ^ (n & 15)) << 4)) = v;
    }
    __syncthreads();
    RGN_T1(10, lds)
    RGN_T0(11)
    float sk0[16], sk1[16];
    topk_half(qfA, lds, r32, hh, sk0);
    RGN_T1(11, lds)
    RGN_T0(12)
    topk_half(qfB, lds + 32768, r32, hh, sk1);
    RGN_T1(12, lds)
    RGN_T0(13)
    unsigned i1s[16], i2[16];
#pragma unroll
    for (int a = 0; a < 16; ++a) { i1s[a] = (__float_as_uint(sk0[a]) & 127u) << 7; i2[a] = __float_as_uint(sk1[a]) & 127u; }
    float cd[50];
    {
        constexpr int CA[50] = {0, 0, 0, 0, 0, 0, 0, 0, 0, 0, 0, 0, 0, 0, 0, 0, 1, 1, 1, 1, 1, 1, 1, 1, 2, 2, 2, 2, 2, 3, 3, 3, 3, 4, 4, 4, 5, 5, 6, 6, 7, 7, 8, 9, 10, 11, 12, 13, 14, 15};
        constexpr int CB[50] = {0, 1, 2, 3, 4, 5, 6, 7, 8, 9, 10, 11, 12, 13, 14, 15, 0, 1, 2, 3, 4, 5, 6, 7, 0, 1, 2, 3, 4, 0, 1, 2, 3, 0, 1, 2, 0, 1, 0, 1, 0, 1, 0, 0, 0, 0, 0, 0, 0, 0};
#pragma unroll
        for (int n = 0; n < 50; ++n) cd[n] = key_embed(sk0[CA[n]] + sk1[CB[n]], i1s[CA[n]] | i2[CB[n]], 0xffffc000u);
    }
    float sel[16], h1[16], h2[16], h3[16];
#pragma unroll
    for (int i = 0; i < 16; ++i) { sel[i] = cd[i]; h1[i] = cd[16 + i]; h2[i] = cd[32 + i]; h3[i] = -INFINITY; }
    h3[0] = fmaxf(cd[48], cd[49]); h3[1] = fminf(cd[48], cd[49]);
    bitonic_desc<16>(sel); bitonic_desc<16>(h1); bitonic_desc<16>(h2);
    merge_top16(sel, h1); merge_top16(h2, h3); merge_top16(sel, h2);
    float ev[16], es = 0.f;
    const float m0 = __uint_as_float((__float_as_uint(sel[0]) & 0xffffc000u) | 0x2000u);
#pragma unroll
    for (int k = 0; k < 16; ++k) { const float vk = __uint_as_float((__float_as_uint(sel[k]) & 0xffffc000u) | 0x2000u); ev[k] = __expf(vk - m0); es += ev[k]; }
    const float rs = 1.0f / es;
    int oi[8]; float og[8];
#pragma unroll
    for (int k = 0; k < 8; ++k) { float s_lo = sel[k], s_hi = sel[k + 8], g_lo = ev[k], g_hi = ev[k + 8]; asm volatile("" : "+v"(s_lo), "+v"(s_hi), "+v"(g_lo), "+v"(g_hi));
        const float sv = hh ? s_hi : s_lo; const float gv = hh ? g_hi : g_lo; oi[k] = (int)(__float_as_uint(sv) & 0x3fffu); og[k] = gv * rs; }
    int* rip = RI + (size_t)t * 128 + h * 16 + 8 * hh; float* rgp = RG + (size_t)t * 128 + h * 16 + 8 * hh;
    *(int4*)rip = make_int4(oi[0], oi[1], oi[2], oi[3]); *(int4*)(rip + 4) = make_int4(oi[4], oi[5], oi[6], oi[7]);
    *(float4*)rgp = make_float4(og[0], og[1], og[2], og[3]); *(float4*)(rgp + 4) = make_float4(og[4], og[5], og[6], og[7]);
    __syncthreads();
    RGN_T1(13, lds)
}

template <bool SIGNED>
__device__ __forceinline__ void quant_rows(const float* src, unsigned char* dst, float* scl, int lane, int gw, int NGW) {
    for (int r0 = gw; r0 < 16384; r0 += 2 * NGW) {
        float4 a[2][4]; float am[2];
#pragma unroll
        for (int u = 0; u < 2; ++u) { const int r = (r0 + u * NGW < 16384) ? r0 + u * NGW : r0; const float4* s4 = (const float4*)(src + (size_t)r * 1024 + 16 * lane);
#pragma unroll
            for (int j = 0; j < 4; ++j) a[u][j] = s4[j]; }
#pragma unroll
        for (int u = 0; u < 2; ++u) { float m = 0.f;
#pragma unroll
            for (int j = 0; j < 4; ++j) m = fmaxf(m, fmaxf(fmaxf(fabsf(a[u][j].x), fabsf(a[u][j].y)), fmaxf(fabsf(a[u][j].z), fabsf(a[u][j].w))));
            am[u] = m; }
#pragma unroll
        for (int o = 1; o < 64; o <<= 1) { am[0] = fmaxf(am[0], __shfl_xor(am[0], o)); am[1] = fmaxf(am[1], __shfl_xor(am[1], o)); }
#pragma unroll
        for (int u = 0; u < 2; ++u) {
            const int r = r0 + u * NGW;
            if (r < 16384) {
                const float inv = am[u] > 0.f ? 127.0f / am[u] : 0.f;
                unsigned w[4];
#pragma unroll
                for (int j = 0; j < 4; ++j) {
                    constexpr int OFS = SIGNED ? 0 : 128;
                    const unsigned q0 = (unsigned)(__float2int_rn(a[u][j].x * inv) + OFS) & 0xffu, q1 = (unsigned)(__float2int_rn(a[u][j].y * inv) + OFS) & 0xffu, q2 = (unsigned)(__float2int_rn(a[u][j].z * inv) + OFS) & 0xffu, q3 = (unsigned)(__float2int_rn(a[u][j].w * inv) + OFS) & 0xffu;
                    w[j] = q0 | (q1 << 8) | (q2 << 16) | (q3 << 24);
                }
                *(uint4*)(dst + (size_t)(lane >> 3) * (16384 * 128) + (size_t)r * 128 + 16 * (lane & 7)) = make_uint4(w[0], w[1], w[2], w[3]);
                if (lane == 0) scl[r] = am[u] * (1.0f / 127.0f);
            }
        }
    }
}

__device__ __forceinline__ void ub4(unsigned w, float* o) { o[0] = (float)(w & 0xffu); o[1] = (float)((w >> 8) & 0xffu); o[2] = (float)((w >> 16) & 0xffu); o[3] = (float)(w >> 24); }

__device__ __forceinline__ void peer_token(const Params& p, int li, int t, int lane) {
    float* stream = p.out;
    const bf16* E = (const bf16*)(p.ws + WS_E); bf16* XB = (bf16*)(p.ws + WS_XB);
    const int* RI = (const int*)(p.ws + WS_RI); const float* RG = (const float*)(p.ws + WS_RG);
    const unsigned char* UQ = (const unsigned char*)(p.ws + WS_UQ); const unsigned char* VQ = (const unsigned char*)(p.ws + WS_VQ);
    const float* US = (const float*)(p.ws + WS_US); const float* VS = (const float*)(p.ws + WS_VS);
    float* row = stream + (size_t)t * DM + 16 * lane;
    float x[16], acc[16];
#pragma unroll
    for (int j = 0; j < 4; ++j) { const float4 v = *(const float4*)(row + 4 * j); x[4 * j] = v.x; x[4 * j + 1] = v.y; x[4 * j + 2] = v.z; x[4 * j + 3] = v.w; }
    float sx = 0.f;
#pragma unroll
    for (int j = 0; j < 16; ++j) { sx += x[j]; acc[j] = 0.f; }
    const float sumx128 = 128.0f * wave_sum(sx);
    const int e0 = RI[(size_t)t * 128 + lane], e1 = RI[(size_t)t * 128 + 64 + lane];
    const float g0 = RG[(size_t)t * 128 + lane], g1 = RG[(size_t)t * 128 + 64 + lane];
    const float su0 = US[e0], su1 = US[e1], sv0 = VS[e0], sv1 = VS[e1];
    float csum = 0.f;
    const int mi = (lane >> 3) & 7;
#pragma unroll 1
    for (int bt = 0; bt < 16; ++bt) {
        const bool lo = bt < 8;
        const int esel = lo ? e0 : e1;
        uint4 uq[8], vq[8];
#pragma unroll
        for (int i = 0; i < 8; ++i) {
            const int e = __builtin_amdgcn_readlane(esel, (bt * 8 + i) & 63);
            uq[i] = *(const uint4*)(UQ + (size_t)e * 1024 + 16 * lane);
            vq[i] = *(const uint4*)(VQ + (size_t)e * 1024 + 16 * lane);
        }
        float d[8];
#pragma unroll
        for (int i = 0; i < 8; ++i) {
            float f[16]; ub4(uq[i].x, f); ub4(uq[i].y, f + 4); ub4(uq[i].z, f + 8); ub4(uq[i].w, f + 12);
            float s = 0.f;
#pragma unroll
            for (int j = 0; j < 16; ++j) s = fmaf(x[j], f[j], s);
            d[i] = s;
        }
#pragma unroll
        for (int i = 0; i < 4; ++i) { const bool up = (lane & 32) != 0; const float send = up ? d[i] : d[i + 4]; const float keep = up ? d[i + 4] : d[i]; d[i] = keep + __shfl_xor(send, 32); }
#pragma unroll
        for (int i = 0; i < 2; ++i) { const bool up = (lane & 16) != 0; const float send = up ? d[i] : d[i + 2]; const float keep = up ? d[i + 2] : d[i]; d[i] = keep + __shfl_xor(send, 16); }
        { const bool up = (lane & 8) != 0; const float send = up ? d[0] : d[1]; const float keep = up ? d[1] : d[0]; d[0] = keep + __shfl_xor(send, 8); }
        float dq = d[0]; dq += __shfl_xor(dq, 4); dq += __shfl_xor(dq, 2); dq += __shfl_xor(dq, 1);
        const int src = (bt * 8 + mi) & 63;
        const float su = __shfl(lo ? su0 : su1, src), sv = __shfl(lo ? sv0 : sv1, src), gg = __shfl(lo ? g0 : g1, src);
        const float dot = su * (dq - sumx128);
        const float cf = 0.5f * dot * (1.0f + erff(dot * 0.70710678118f)) * gg * sv;
#pragma unroll
        for (int i = 0; i < 8; ++i) {
            const float c = __int_as_float(__builtin_amdgcn_readlane(__float_as_int(cf), 8 * i));
            csum += c;
            float f[16]; ub4(vq[i].x, f); ub4(vq[i].y, f + 4); ub4(vq[i].z, f + 8); ub4(vq[i].w, f + 12);
#pragma unroll
            for (int j = 0; j < 16; ++j) acc[j] = fmaf(c, f[j], acc[j]);
        }
    }
    const float off = 128.0f * csum;
    float s = 0.f;
    {
        const uint4 ea = *(const uint4*)(E + (size_t)t * DM + 16 * lane), eb = *(const uint4*)(E + (size_t)t * DM + 16 * lane + 8);
        float ev[16]; unpack8(ea, ev); unpack8(eb, ev + 8);
#pragma unroll
        for (int j = 0; j < 16; ++j) { acc[j] = (acc[j] - off) + DN_ALPHA * x[j] + ev[j]; s += acc[j]; }
    }
    const float mean = wave_sum(s) * (1.0f / DM);
    float s2 = 0.f;
#pragma unroll
    for (int j = 0; j < 16; ++j) { acc[j] -= mean; s2 += acc[j] * acc[j]; }
    const float rstd = 1.0f / sqrtf(wave_sum(s2) * (1.0f / DM) + LN_EPS);
    const float* g2 = p.ln2_g + li * DM + 16 * lane; const float* b2 = p.ln2_b + li * DM + 16 * lane;
    float o[16];
#pragma unroll
    for (int j = 0; j < 4; ++j) {
        const float4 gg = *(const float4*)(g2 + 4 * j), bv = *(const float4*)(b2 + 4 * j);
        o[4 * j] = acc[4 * j] * rstd * gg.x + bv.x; o[4 * j + 1] = acc[4 * j + 1] * rstd * gg.y + bv.y; o[4 * j + 2] = acc[4 * j + 2] * rstd * gg.z + bv.z; o[4 * j + 3] = acc[4 * j + 3] * rstd * gg.w + bv.w;
        *(float4*)(row + 4 * j) = make_float4(o[4 * j], o[4 * j + 1], o[4 * j + 2], o[4 * j + 3]);
    }
    if (li == 0) {
        bf16* xb = XB + (size_t)t * DM + 16 * lane;
        *(uint4*)xb = make_uint4(pk2(o[0], o[1]), pk2(o[2], o[3]), pk2(o[4], o[5]), pk2(o[6], o[7]));
        *(uint4*)(xb + 8) = make_uint4(pk2(o[8], o[9]), pk2(o[10], o[11]), pk2(o[12], o[13]), pk2(o[14], o[15]));
    }
}

struct SlicePlan { int m, mi, wid, wstride; };
__device__ __forceinline__ SlicePlan slice_plan(const Params& p, unsigned rank, int wave) {
    unsigned* bar = (unsigned*)(p.ws + WS_CTL) + 1024;
    const unsigned x = xb_xcc_id();
    SlicePlan sp; sp.m = 0; sp.mi = 0; int nloc = 1;
#pragma unroll
    for (unsigned j = 0; j < 16; ++j) { const unsigned c = xb_ld(&bar[XB_XCNT(j)]); if (j == x) { sp.mi = sp.m; nloc = (int)c; } if (c > 0u) ++sp.m; }
    sp.wid = (int)rank * NWAVE + wave; sp.wstride = nloc * NWAVE;
    return sp;
}
#define PEER_TPW 16
__device__ __forceinline__ int peer_tok(int n, int wid, int wstride) { return ((n >> 4) * wstride + wid) * PEER_TPW + (n & 15); }
__device__ __forceinline__ void peer_u_slice(const Params& p, int xs, int wid, int wstride, int lane) {
    const int* RI = (const int*)(p.ws + WS_RI);
    const signed char* X1Q = (const signed char*)(p.ws + WS_X1Q); const signed char* UQ = (const signed char*)(p.ws + WS_UQ);
    int* PI = (int*)(p.ws + WS_PI) + (size_t)xs * NT * 128;
    const int g = lane >> 3, q = lane & 7, loff = 128 * xs + 16 * q;
    const signed char* UQs = UQ + (size_t)xs * (16384 * 128) + 16 * q;
    const int ngrp = (NT / PEER_TPW - wid + wstride - 1) / wstride, N = ngrp * PEER_TPW;
    if (N <= 0) return;
    int eA[16], eB[16]; int4 uA[16], uB[16]; int4 x0, x1, x2, x3;
#define PU_E(E, X, t) do { const int4* rp_ = (const int4*)(RI + (size_t)(t) * 128 + 16 * g); X = *(const int4*)(X1Q + (size_t)(t) * DM + loff); _Pragma("unroll") for (int b4 = 0; b4 < 4; ++b4) { const int4 r_ = rp_[b4]; E[4 * b4] = r_.x; E[4 * b4 + 1] = r_.y; E[4 * b4 + 2] = r_.z; E[4 * b4 + 3] = r_.w; } } while (0)
#define PU_U(U, E) do { _Pragma("unroll") for (int bt = 0; bt < 16; ++bt) U[bt] = *(const int4*)(UQs + (size_t)E[bt] * 128); } while (0)
#define PU_C(U, X, t) do { _Pragma("unroll") for (int b4 = 0; b4 < 4; ++b4) { int dd_[4]; _Pragma("unroll") for (int b1 = 0; b1 < 4; ++b1) { const int bt = 4 * b4 + b1; \
        int d = __builtin_amdgcn_sdot4(X.x, U[bt].x, 0, false); d = __builtin_amdgcn_sdot4(X.y, U[bt].y, d, false); d = __builtin_amdgcn_sdot4(X.z, U[bt].z, d, false); d = __builtin_amdgcn_sdot4(X.w, U[bt].w, d, false); \
        d += __shfl_xor(d, 1); d += __shfl_xor(d, 2); d += __shfl_xor(d, 4); dd_[b1] = d; } \
        if (q == 0) *((int4*)(PI + (size_t)(t) * 128 + 16 * g) + b4) = make_int4(dd_[0], dd_[1], dd_[2], dd_[3]); } } while (0)
#define TK(n) peer_tok((n), wid, wstride)
#define PU_FENCE() asm volatile("" ::: "memory")
    PU_E(eA, x0, TK(0)); PU_E(eB, x1, TK(1)); PU_U(uA, eA); PU_E(eA, x2, TK(2));
#pragma unroll 1
    for (int i = 0; i < N; i += 4) {
        PU_U(uB, eB);                  if (i + 3 < N) PU_E(eB, x3, TK(i + 3)); PU_FENCE(); PU_C(uA, x0, TK(i));
        if (i + 2 < N) PU_U(uA, eA);   if (i + 4 < N) PU_E(eA, x0, TK(i + 4)); PU_FENCE(); PU_C(uB, x1, TK(i + 1));
        if (i + 3 < N) PU_U(uB, eB);   if (i + 5 < N) PU_E(eB, x1, TK(i + 5)); PU_FENCE(); PU_C(uA, x2, TK(i + 2));
        if (i + 4 < N) PU_U(uA, eA);   if (i + 6 < N) PU_E(eA, x2, TK(i + 6)); PU_FENCE(); PU_C(uB, x3, TK(i + 3));
    }
#undef PU_E
#undef PU_U
#undef PU_C
#undef PU_FENCE
}
__device__ __forceinline__ void peer_coef_tokens2(const Params& p, int t0, int t1, int lane) {
    const int* RI = (const int*)(p.ws + WS_RI); const float* RG = (const float*)(p.ws + WS_RG);
    const float* US = (const float*)(p.ws + WS_US); const float* VS = (const float*)(p.ws + WS_VS);
    const int* PI = (const int*)(p.ws + WS_PI);
    signed char* PC = (signed char*)(p.ws + WS_PC); float* PCS = (float*)(p.ws + WS_PCS);
    int e[2][2], acc[2][2]; float rg[2][2], sx[2];
#pragma unroll
    for (int u = 0; u < 2; ++u) { const int t = u ? t1 : t0; sx[u] = ((const float*)(p.ws + WS_X1S))[t];
#pragma unroll
        for (int hf = 0; hf < 2; ++hf) { const int k = lane + 64 * hf; e[u][hf] = RI[(size_t)t * 128 + k]; rg[u][hf] = RG[(size_t)t * 128 + k]; int a = 0;
#pragma unroll
            for (int x = 0; x < 8; ++x) a += PI[((size_t)x * NT + t) * 128 + k];
            acc[u][hf] = a; } }
    float su[2][2], sv[2][2];
#pragma unroll
    for (int u = 0; u < 2; ++u)
#pragma unroll
        for (int hf = 0; hf < 2; ++hf) { su[u][hf] = US[e[u][hf]]; sv[u][hf] = VS[e[u][hf]]; }
    float c[2][2], cm[2];
#pragma unroll
    for (int u = 0; u < 2; ++u) {
#pragma unroll
        for (int hf = 0; hf < 2; ++hf) { const float dot = su[u][hf] * sx[u] * (float)acc[u][hf]; c[u][hf] = 0.5f * dot * (1.0f + erff(dot * 0.70710678118f)) * rg[u][hf] * sv[u][hf]; }
        cm[u] = fmaxf(fabsf(c[u][0]), fabsf(c[u][1])); }
#pragma unroll
    for (int o = 1; o < 64; o <<= 1) { cm[0] = fmaxf(cm[0], __shfl_xor(cm[0], o)); cm[1] = fmaxf(cm[1], __shfl_xor(cm[1], o)); }
#pragma unroll
    for (int u = 0; u < 2; ++u) {
        if (u == 0 || t1 != t0) {
            const int t = u ? t1 : t0; const float inv = cm[u] > 0.f ? 127.0f / cm[u] : 0.f;
            PC[(size_t)t * 128 + lane] = (signed char)__float2int_rn(c[u][0] * inv);
            PC[(size_t)t * 128 + 64 + lane] = (signed char)__float2int_rn(c[u][1] * inv);
            if (lane == 0) PCS[t] = cm[u] * (1.0f / 127.0f);
        }
    }
}
__device__ __forceinline__ void peer_v_token(const uint4 (&vq)[16], const int4 cq, float cscale, bf16* yrow, int lane) {
    int acc[16];
#pragma unroll
    for (int j = 0; j < 16; ++j) acc[j] = 0;
    const int c4[4] = {cq.x, cq.y, cq.z, cq.w};
#pragma unroll
    for (int b4 = 0; b4 < 4; ++b4) {
#pragma unroll
        for (int dc = 0; dc < 4; ++dc) {
            const unsigned w0 = dc == 0 ? vq[4 * b4].x : dc == 1 ? vq[4 * b4].y : dc == 2 ? vq[4 * b4].z : vq[4 * b4].w;
            const unsigned w1 = dc == 0 ? vq[4 * b4 + 1].x : dc == 1 ? vq[4 * b4 + 1].y : dc == 2 ? vq[4 * b4 + 1].z : vq[4 * b4 + 1].w;
            const unsigned w2 = dc == 0 ? vq[4 * b4 + 2].x : dc == 1 ? vq[4 * b4 + 2].y : dc == 2 ? vq[4 * b4 + 2].z : vq[4 * b4 + 2].w;
            const unsigned w3 = dc == 0 ? vq[4 * b4 + 3].x : dc == 1 ? vq[4 * b4 + 3].y : dc == 2 ? vq[4 * b4 + 3].z : vq[4 * b4 + 3].w;
            const unsigned t0 = __builtin_amdgcn_perm(w1, w0, 0x05010400u), t1 = __builtin_amdgcn_perm(w1, w0, 0x07030602u);
            const unsigned t2 = __builtin_amdgcn_perm(w3, w2, 0x05010400u), t3 = __builtin_amdgcn_perm(w3, w2, 0x07030602u);
            const unsigned f0 = __builtin_amdgcn_perm(t2, t0, 0x05040100u), f1 = __builtin_amdgcn_perm(t2, t0, 0x07060302u);
            const unsigned f2 = __builtin_amdgcn_perm(t3, t1, 0x05040100u), f3 = __builtin_amdgcn_perm(t3, t1, 0x07060302u);
            acc[4 * dc + 0] = __builtin_amdgcn_sdot4((int)f0, c4[b4], acc[4 * dc + 0], false);
            acc[4 * dc + 1] = __builtin_amdgcn_sdot4((int)f1, c4[b4], acc[4 * dc + 1], false);
            acc[4 * dc + 2] = __builtin_amdgcn_sdot4((int)f2, c4[b4], acc[4 * dc + 2], false);
            acc[4 * dc + 3] = __builtin_amdgcn_sdot4((int)f3, c4[b4], acc[4 * dc + 3], false);
        }
    }
#pragma unroll
    for (int j = 0; j < 8; ++j) { const bool up = (lane & 32) != 0; const int send = up ? acc[j] : acc[j + 8]; const int keep = up ? acc[j + 8] : acc[j]; acc[j] = keep + __shfl_xor(send, 32); }
#pragma unroll
    for (int j = 0; j < 4; ++j) { const bool up = (lane & 16) != 0; const int send = up ? acc[j] : acc[j + 4]; const int keep = up ? acc[j + 4] : acc[j]; acc[j] = keep + __shfl_xor(send, 16); }
#pragma unroll
    for (int j = 0; j < 2; ++j) { const bool up = (lane & 8) != 0; const int send = up ? acc[j] : acc[j + 2]; const int keep = up ? acc[j + 2] : acc[j]; acc[j] = keep + __shfl_xor(send, 8); }
    const int j0 = 2 * ((lane >> 3) & 1) + 4 * ((lane >> 4) & 1) + 8 * ((lane >> 5) & 1);
    *(unsigned*)(yrow + j0) = pk2((float)acc[0] * cscale, (float)acc[1] * cscale);
}
__device__ __forceinline__ void peer_v_slice(const Params& p, int xs, int wid, int wstride, int lane) {
    const int* RI = (const int*)(p.ws + WS_RI);
    const unsigned char* VQ = (const unsigned char*)(p.ws + WS_VQ);
    const signed char* PC = (const signed char*)(p.ws + WS_PC); const float* PCS = (const float*)(p.ws + WS_PCS);
    bf16* Y = (bf16*)(p.ws + WS_Y);
    const int g = lane >> 3, q = lane & 7, loff = 128 * xs + 16 * q;
    const unsigned char* VQs = VQ + (size_t)xs * (16384 * 128) + 16 * q;
    const int ngrp = (NT / PEER_TPW - wid + wstride - 1) / wstride, N = ngrp * PEER_TPW;
    if (N <= 0) return;
    int eA[16], eB[16]; uint4 vA[16], vB[16]; int4 c0, c1, c2, c3; float o0, o1, o2, o3;
#define PV_E(E, C, O, t) do { const int4* rp_ = (const int4*)(RI + (size_t)(t) * 128 + 16 * g); C = *(const int4*)(PC + (size_t)(t) * 128 + 16 * g); O = PCS[(t)]; _Pragma("unroll") for (int b4 = 0; b4 < 4; ++b4) { const int4 r_ = rp_[b4]; E[4 * b4] = r_.x; E[4 * b4 + 1] = r_.y; E[4 * b4 + 2] = r_.z; E[4 * b4 + 3] = r_.w; } } while (0)
#define PV_U(V, E) do { _Pragma("unroll") for (int bt = 0; bt < 16; ++bt) V[bt] = *(const uint4*)(VQs + (size_t)E[bt] * 128); } while (0)
#define PV_C(V, C, O, t) peer_v_token(V, C, O, Y + (size_t)(t) * DM + loff, lane)
#define PV_FENCE() asm volatile("" ::: "memory")
    PV_E(eA, c0, o0, TK(0)); PV_E(eB, c1, o1, TK(1)); PV_U(vA, eA); PV_E(eA, c2, o2, TK(2));
#pragma unroll 1
    for (int i = 0; i < N; i += 4) {
        PV_U(vB, eB);                  if (i + 3 < N) PV_E(eB, c3, o3, TK(i + 3)); PV_FENCE(); PV_C(vA, c0, o0, TK(i));
        if (i + 2 < N) PV_U(vA, eA);   if (i + 4 < N) PV_E(eA, c0, o0, TK(i + 4)); PV_FENCE(); PV_C(vB, c1, o1, TK(i + 1));
        if (i + 3 < N) PV_U(vB, eB);   if (i + 5 < N) PV_E(eB, c1, o1, TK(i + 5)); PV_FENCE(); PV_C(vA, c2, o2, TK(i + 2));
        if (i + 4 < N) PV_U(vA, eA);   if (i + 6 < N) PV_E(eA, c2, o2, TK(i + 6)); PV_FENCE(); PV_C(vB, c3, o3, TK(i + 3));
    }
#undef PV_E
#undef PV_U
#undef PV_C
#undef PV_FENCE
#undef TK
}
__device__ __forceinline__ void up4(const uint2 w, float* o) { o[0] = __uint_as_float(w.x << 16); o[1] = __uint_as_float(w.x & 0xffff0000u); o[2] = __uint_as_float(w.y << 16); o[3] = __uint_as_float(w.y & 0xffff0000u); }
template <int NB>
__device__ __forceinline__ void peer_ln_tokens(const Params& p, int li, int t0, int tstep, int lane) {
    const bf16* E = (const bf16*)(p.ws + WS_E); bf16* XB = (bf16*)(p.ws + WS_XB); const bf16* Y = (const bf16*)(p.ws + WS_Y);
    uint2 xr[NB][4], yr[NB][4], er[NB][4];
#pragma unroll
    for (int u = 0; u < NB; ++u) { const int t = (t0 + u * tstep < NT) ? t0 + u * tstep : t0;
#pragma unroll
        for (int j = 0; j < 4; ++j) { const size_t o = (size_t)t * DM + 256 * j + 4 * lane; xr[u][j] = *(const uint2*)(XB + o); yr[u][j] = *(const uint2*)(Y + o); er[u][j] = *(const uint2*)(E + o); } }
    const float* g2 = p.ln2_g + li * DM; const float* b2 = p.ln2_b + li * DM;
    float4 gg[4], bv[4];
#pragma unroll
    for (int j = 0; j < 4; ++j) { gg[j] = *(const float4*)(g2 + 256 * j + 4 * lane); bv[j] = *(const float4*)(b2 + 256 * j + 4 * lane); }
    float4 v[NB][4]; float s[NB];
#pragma unroll
    for (int u = 0; u < NB; ++u) { s[u] = 0.f;
#pragma unroll
        for (int j = 0; j < 4; ++j) {
            float x[4], y[4], e[4]; up4(xr[u][j], x); up4(yr[u][j], y); up4(er[u][j], e);
            v[u][j].x = DN_ALPHA * x[0] + y[0] + e[0]; v[u][j].y = DN_ALPHA * x[1] + y[1] + e[1]; v[u][j].z = DN_ALPHA * x[2] + y[2] + e[2]; v[u][j].w = DN_ALPHA * x[3] + y[3] + e[3];
            s[u] += (v[u][j].x + v[u][j].y) + (v[u][j].z + v[u][j].w);
        } }
#pragma unroll
    for (int o = 1; o < 64; o <<= 1)
#pragma unroll
        for (int u = 0; u < NB; ++u) s[u] += __shfl_xor(s[u], o);
    float s2[NB];
#pragma unroll
    for (int u = 0; u < NB; ++u) { const float mean = s[u] * (1.0f / DM); s2[u] = 0.f;
#pragma unroll
        for (int j = 0; j < 4; ++j) { v[u][j].x -= mean; v[u][j].y -= mean; v[u][j].z -= mean; v[u][j].w -= mean; s2[u] += (v[u][j].x * v[u][j].x + v[u][j].y * v[u][j].y) + (v[u][j].z * v[u][j].z + v[u][j].w * v[u][j].w); } }
#pragma unroll
    for (int o = 1; o < 64; o <<= 1)
#pragma unroll
        for (int u = 0; u < NB; ++u) s2[u] += __shfl_xor(s2[u], o);
#pragma unroll
    for (int u = 0; u < NB; ++u) {
        const int t = t0 + u * tstep;
        if (t < NT) {
            const float rstd = 1.0f / sqrtf(s2[u] * (1.0f / DM) + LN_EPS);
#pragma unroll
            for (int j = 0; j < 4; ++j) {
                const float4 o = make_float4(v[u][j].x * rstd * gg[j].x + bv[j].x, v[u][j].y * rstd * gg[j].y + bv[j].y, v[u][j].z * rstd * gg[j].z + bv[j].z, v[u][j].w * rstd * gg[j].w + bv[j].w);
                if (li == 0) *(uint2*)(XB + (size_t)t * DM + 256 * j + 4 * lane) = make_uint2(pk2(o.x, o.y), pk2(o.z, o.w));
                else *(float4*)(p.out + (size_t)t * DM + 256 * j + 4 * lane) = o;
            }
        }
    }
}

constexpr int PH_PER_LAYER = 12, NPHASE = 1 + 2 * PH_PER_LAYER;

#ifndef PROBE_DUP
#define PROBE_DUP 0
#endif
#define PH_BEGIN(k) if (lo <= (k) && (k) < hi && ((k) == 0 || PHON(((k) - 1) % PH_PER_LAYER))) for (int rep_ = 0; rep_ < (((k) > 0 && ((PROBE_DUP >> (((k) - 1) % PH_PER_LAYER)) & 1)) ? 2 : 1); ++rep_) { unsigned long long probe_t0 = 0; if ((PROBE_T >> PH_BIT(k)) & 1) probe_t0 = __builtin_amdgcn_s_memrealtime();
#define PH_SYNC_DUP() do { if (rep_ == 0) { asm volatile("s_waitcnt vmcnt(0)" ::: "memory"); __syncthreads(); } } while (0)
#ifndef PROBE_T
#define PROBE_T 0
#endif
#define PH_BIT(k) ((k) == 0 ? 15 : (((k) - 1) % PH_PER_LAYER))
#define PH_END(k) if ((k) + 1 < hi) xcd_barrier(bar); if ((PROBE_T >> PH_BIT(k)) & 1) { const unsigned long long tn_ = __builtin_amdgcn_s_memrealtime(); probe_ticks += tn_ - probe_t0; } }

template <int LI>
__device__ __forceinline__ void run_layer(const Params& p, float* lds, const XcdBarrier& bar, int lo, int hi, unsigned long long& probe_ticks, unsigned rank) {
    constexpr int li = LI, base = 1 + LI * PH_PER_LAYER;
    const int tid = threadIdx.x, lane = tid & 63, wave = __builtin_amdgcn_readfirstlane(tid >> 6);
    const int G = gridDim.x;
    float* stream = p.out;
    LAS unsigned char* ldsb = (LAS unsigned char*)lds;
    PH_BEGIN(base + 0)
        EpiZ16 e{(bf16*)(p.ws + WS_Z), (float*)(p.ws + WS_GATES), (const float*)(p.ws + WS_ACOS), (const float*)(p.ws + WS_ASIN)};
        gemm16(ldsb, (const bf16*)(p.ws + WS_XB), (const bf16*)(p.ws + WS_WIN) + (size_t)li * NZP * DM, NZP, DM, e);
    PH_END(base + 0)
    PH_BEGIN(base + 1)
        for (int it = blockIdx.x; it < 1024 + 1536; it += G) {
            if (it < 512) ret_state_u(p, 2 * it + (wave >> 2), ldsb + (wave >> 2) * UNIT_LDS, wave & 3, tid & 255, lane);
            else if (it < 1024) mls_state_u(p, li, 2 * (it - 512) + (wave >> 2), ldsb + (wave >> 2) * UNIT_LDS, wave & 3, tid & 255, lane);
            else attn_unit(p, it - 1024, ldsb);
        }
    PH_END(base + 1)
    PH_BEGIN(base + 2)
        p3_scans(p);
        attn_merge(p);
    PH_END(base + 2)
    PH_BEGIN(base + 3)
        for (int it = blockIdx.x; it < 1024; it += G) {
            if (it < 512) ret_out_u(p, li, 2 * it + (wave >> 2), ldsb + (wave >> 2) * UNIT_LDS, wave & 3, tid & 255, lane);
            else mls_out_u(p, li, 2 * (it - 512) + (wave >> 2), ldsb + (wave >> 2) * UNIT_LDS, wave & 3, tid & 255, lane);
        }
    PH_END(base + 3)
    PH_BEGIN(base + 4)
        EpiRes16 e{(const bf16*)(p.ws + WS_XB), (bf16*)(p.ws + WS_U16)};
        gemm16(ldsb, (const bf16*)(p.ws + WS_MIX), (const bf16*)(p.ws + WS_WOUT) + (size_t)li * DM * DM, DM, DM, e);
    PH_END(base + 4)
    PH_BEGIN(base + 5)
        for (int r = blockIdx.x * NWAVE + wave; r < NT; r += 4 * G * NWAVE) ln_rows<4>((const bf16*)(p.ws + WS_U16), (bf16*)(p.ws + WS_XB), (signed char*)(p.ws + WS_X1Q), (float*)(p.ws + WS_X1S), r, G * NWAVE, p.ln1_g + li * DM, p.ln1_b + li * DM, lane);
        quant_rows<true>(p.pu + (size_t)li * 16384 * 1024, (unsigned char*)(p.ws + WS_UQ), (float*)(p.ws + WS_US), lane, blockIdx.x * NWAVE + wave, G * NWAVE);
        quant_rows<true>(p.pv + (size_t)li * 16384 * 1024, (unsigned char*)(p.ws + WS_VQ), (float*)(p.ws + WS_VS), lane, blockIdx.x * NWAVE + wave, G * NWAVE);
        EpiBf16Store e{(bf16*)(p.ws + WS_E), DM};
        gemm16(ldsb, (const bf16*)(p.ws + WS_PB) + (size_t)li * NT * 256, (const bf16*)(p.ws + WS_WP) + (size_t)li * DM * 256, DM, 256, e);
    PH_END(base + 5)
    PH_BEGIN(base + 6)
        EpiBf16Store eq{(bf16*)(p.ws + WS_QRY), 2048};
        gemm16(ldsb, (const bf16*)(p.ws + WS_XB), (const bf16*)(p.ws + WS_WQG) + (size_t)li * 3072 * DM, 2048, DM, eq);
        EpiGate16 eg{(bf16*)(p.ws + WS_E), p.bg + li * DM};
        gemm16(ldsb, (const bf16*)(p.ws + WS_XB), (const bf16*)(p.ws + WS_WQG) + (size_t)li * 3072 * DM + (size_t)2048 * DM, DM, DM, eg);
    PH_END(base + 6)
    PH_BEGIN(base + 7)
        for (int it = blockIdx.x; it < (NT / 256) * 8; it += G) topk_unit(p, li, it, ldsb);
    PH_END(base + 7)
    PH_BEGIN(base + 8)
        const SlicePlan sp = slice_plan(p, rank, wave);
        for (int xs = 0; xs < 8; ++xs) if ((xs % sp.m) == sp.mi) peer_u_slice(p, xs, sp.wid, sp.wstride, lane);
    PH_END(base + 8)
    PH_BEGIN(base + 9)
        for (int t = blockIdx.x * NWAVE + wave; t < NT; t += 2 * G * NWAVE) peer_coef_tokens2(p, t, (t + G * NWAVE < NT) ? t + G * NWAVE : t, lane);
    PH_END(base + 9)
    PH_BEGIN(base + 10)
        const SlicePlan sp = slice_plan(p, rank, wave);
        for (int xs = 0; xs < 8; ++xs) if ((xs % sp.m) == sp.mi) peer_v_slice(p, xs, sp.wid, sp.wstride, lane);
    PH_END(base + 10)
    PH_BEGIN(base + 11)
        for (int t = blockIdx.x * NWAVE + wave; t < NT; t += 4 * G * NWAVE) peer_ln_tokens<4>(p, li, t, G * NWAVE, lane);
    PH_END(base + 11)
}

__global__ void __launch_bounds__(NTHR, 2) mk_fwd(Params p) {
    extern __shared__ __attribute__((aligned(16))) unsigned char lds_raw[];
    float* lds = (float*)lds_raw;
    const int tid = threadIdx.x;
    volatile LAS unsigned* MISC = (volatile LAS unsigned*)((LAS unsigned char*)lds_raw + LDS_CTL_OFF);
    if (tid < 64) MISC[tid] = 0u;
    __syncthreads();
    const int lo = p.ph_lo, hi = p.ph_hi;
    XcdBarrier bar; bar.bar = (unsigned*)(p.ws + WS_CTL) + 1024; bar.x = 0; bar.st = nullptr;
    if (hi - lo > 1) bar = xcd_barrier_post((unsigned*)(p.ws + WS_CTL) + 1024, MISC + 8);
    __syncthreads();
    const unsigned rank = MISC[10];
    unsigned long long probe_ticks = 0;
    PH_BEGIN(0)
        p0_tables(p);
        p0_weights(p, lds);
    PH_END(0)
    run_layer<0>(p, lds, bar, lo, hi, probe_ticks, rank);
    run_layer<1>(p, lds, bar, lo, hi, probe_ticks, rank);
    if (PROBE_R) { __syncthreads(); probe_ticks += ((volatile LAS unsigned*)((LAS unsigned char*)lds_raw + 159 * 1024 + 128))[0]; }
    if (PROBE_T || PROBE_R) { const unsigned long long te_ = __builtin_amdgcn_s_memrealtime(); while (__builtin_amdgcn_s_memrealtime() - te_ < probe_ticks) __builtin_amdgcn_s_sleep(8); }
}

extern "C" void kernel_launch(void* const* d_in, const int* in_sizes, int n_in, void* d_out, int out_size, void* d_ws, size_t ws_size, hipStream_t stream) {
    static int grid = 0;
    if (grid == 0) {
        if (n_in != 19 || in_sizes[0] != NT * DM || out_size != NT * DM || ws_size < WS_END) { fprintf(stderr, "kernel_launch: unexpected shapes (n_in %d in0 %d out %d ws %zu)\n", n_in, n_in > 0 ? in_sizes[0] : -1, out_size, ws_size); grid = -1; return; }
        int dev = 0, cus = 0;
        if (hipGetDevice(&dev) != hipSuccess || hipDeviceGetAttribute(&cus, hipDeviceAttributeMultiprocessorCount, dev) != hipSuccess) { grid = -1; return; }
        if (hipFuncSetAttribute((const void*)mk_fwd, hipFuncAttributeMaxDynamicSharedMemorySize, LDS_BYTES) != hipSuccess) { fprintf(stderr, "kernel_launch: hipFuncSetAttribute failed\n"); grid = -1; return; }
        int per_cu = 0;
        if (hipOccupancyMaxActiveBlocksPerMultiprocessor(&per_cu, (const void*)mk_fwd, NTHR, LDS_BYTES) != hipSuccess || per_cu < 1) fprintf(stderr, "kernel_launch: occupancy query says %d\n", per_cu);
        (void)hipGetLastError();
        grid = cus;
    }
    if (grid < 0) return;
    if (hipMemsetAsync((char*)d_ws + WS_CTL, 0, CTL_ZERO_BYTES, stream) != hipSuccess) return;
    Params a{};
    a.x = (const float*)d_in[0]; a.p = (const float*)d_in[1]; a.w_in = (const float*)d_in[2]; a.conv_w = (const float*)d_in[3]; a.b_if = (const float*)d_in[4];
    a.ret_g = (const float*)d_in[5]; a.mls_g = (const float*)d_in[6]; a.w_out = (const float*)d_in[7]; a.ln1_g = (const float*)d_in[8]; a.ln1_b = (const float*)d_in[9];
    a.wq = (const float*)d_in[10]; a.keys = (const float*)d_in[11]; a.pu = (const float*)d_in[12]; a.pv = (const float*)d_in[13]; a.wg = (const float*)d_in[14];
    a.bg = (const float*)d_in[15]; a.wp = (const float*)d_in[16]; a.ln2_g = (const float*)d_in[17]; a.ln2_b = (const float*)d_in[18];
    a.out = (float*)d_out; a.ws = (unsigned char*)d_ws;
#if MK_SPLIT
    for (int ph = 0; ph < NPHASE; ++ph) { a.ph_lo = ph; a.ph_hi = ph + 1; hipLaunchKernelGGL(mk_fwd, dim3(grid), dim3(NTHR), LDS_BYTES, stream, a); }
#else
    a.ph_lo = 0; a.ph_hi = NPHASE;
    hipLaunchKernelGGL(mk_fwd, dim3(grid), dim3(NTHR), LDS_BYTES, stream, a);
#endif
}
```

```cpp
#include <hip/hip_runtime.h>
#include <cstdio>
#include <cstdint>
#include <cmath>

#ifndef MK_SPLIT
#define MK_SPLIT 0
#endif

#ifndef ONLY
#define ONLY -1
#endif
#ifndef PMASK
#define PMASK 0xfff
#endif
#define PHON(k) ((ONLY < 0 || ONLY == (k)) && ((PMASK >> (k)) & 1))
#define LAS __attribute__((address_space(3)))
typedef unsigned short bf16;
#ifndef PROBE_R
#define PROBE_R 0
#endif
#define RGN_T0(id) unsigned long long rgn_t0_##id = 0; if (PROBE_R == (id) && threadIdx.x == 0) rgn_t0_##id = __builtin_amdgcn_s_memrealtime();
#define RGN_T1(id, ldsbase) if (PROBE_R == (id) && threadIdx.x == 0) { volatile LAS unsigned* w_ = (volatile LAS unsigned*)((LAS unsigned char*)(ldsbase) + 159 * 1024 + 128); w_[0] = w_[0] + (unsigned)(__builtin_amdgcn_s_memrealtime() - rgn_t0_##id); }

#define XB_TMO      128
#define XB_XCNT(j)  (256  + 64 * (j))
#define XB_XSUB(j)  (1280 + 64 * (j))
#define XB_XGEN(j)  (2304 + 64 * (j))
#define XB_TOP      3328
#define XB_TOPGEN   3392
#define XCD_BAR_WORDS 3456
#define XB_SPIN_CAP (1u << 22)

__device__ __forceinline__ unsigned xb_ld(unsigned* p)              { return __hip_atomic_load(p, __ATOMIC_RELAXED, __HIP_MEMORY_SCOPE_AGENT); }
__device__ __forceinline__ unsigned xb_add(unsigned* p, unsigned v) { return __hip_atomic_fetch_add(p, v, __ATOMIC_RELAXED, __HIP_MEMORY_SCOPE_AGENT); }
__device__ __forceinline__ unsigned xb_xcc_id() { return (unsigned)__builtin_amdgcn_s_getreg((3 << 11) | 20) & 0xFu; }
#define XB_SPIN(cond, bar) do { unsigned _sp = 0; while (cond) { __builtin_amdgcn_s_sleep(1); \
    if ((++_sp & 255u) == 0u) { if (xb_ld(&(bar)[XB_TMO])) break; if (_sp > XB_SPIN_CAP) { atomicAdd(&(bar)[XB_TMO], 1u); break; } } } } while (0)

struct XcdBarrier { unsigned* bar; unsigned x; volatile LAS unsigned* st; };

__device__ __forceinline__ XcdBarrier xcd_barrier_post(unsigned* bar, volatile LAS unsigned* st) {
    XcdBarrier b; b.bar = bar; b.x = xb_xcc_id(); b.st = st;
    if (threadIdx.x == 0) st[2] = xb_add(&bar[XB_XCNT(b.x)], 1u);
    return b;
}
__device__ __forceinline__ void xcd_barrier_complete(unsigned* bar, unsigned x, unsigned& nloc, unsigned& nx) {
    const unsigned G = gridDim.x * gridDim.y * gridDim.z;
    unsigned sum, cnt, mine, sp = 0u;
    for (;;) {
        sum = 0u; cnt = 0u; mine = 0u;
#pragma unroll
        for (unsigned j = 0; j < 16; ++j) { const unsigned c = xb_ld(&bar[XB_XCNT(j)]); sum += c; cnt += (c > 0u) ? 1u : 0u; mine = (j == x) ? c : mine; }
        if (sum == G) break;
        __builtin_amdgcn_s_sleep(1);
        if ((++sp & 255u) == 0u) { if (xb_ld(&bar[XB_TMO])) break; if (sp > XB_SPIN_CAP) { atomicAdd(&bar[XB_TMO], 1u); break; } }
    }
    nloc = mine > 0u ? mine : 1u; nx = cnt > 0u ? cnt : 1u;
}
__device__ __forceinline__ void xcd_barrier(const XcdBarrier& b) {
    asm volatile("s_waitcnt vmcnt(0)" ::: "memory");
    __syncthreads();
    if (threadIdx.x == 0) {
        unsigned* bar = b.bar;
        __builtin_amdgcn_s_waitcnt(0);
        unsigned nloc = b.st[0], nx = b.st[1];
        if (nloc == 0u) { xcd_barrier_complete(bar, b.x, nloc, nx); b.st[0] = nloc; b.st[1] = nx; }
        const unsigned old = xb_add(&bar[XB_XSUB(b.x)], 1u);
        const unsigned gen = old / nloc;
        if (old + 1u == (gen + 1u) * nloc) {
            __builtin_amdgcn_fence(__ATOMIC_RELEASE, "agent");
            asm volatile("s_waitcnt vmcnt(0)" ::: "memory");
            const unsigned og = xb_add(&bar[XB_TOP], 1u);
            const unsigned tg = og / nx;
            if (og + 1u == (tg + 1u) * nx) xb_add(&bar[XB_TOPGEN], 1u);
            else XB_SPIN(xb_ld(&bar[XB_TOPGEN]) == tg, bar);
            __builtin_amdgcn_fence(__ATOMIC_ACQUIRE, "agent");
            xb_add(&bar[XB_XGEN(b.x)], 1u);
            asm volatile("s_waitcnt vmcnt(0)" ::: "memory");
        } else {
            XB_SPIN(xb_ld(&bar[XB_XGEN(b.x)]) == gen, bar);
            __builtin_amdgcn_fence(__ATOMIC_ACQUIRE, "agent");
            asm volatile("s_waitcnt vmcnt(0)" ::: "memory");
        }
    }
    __syncthreads();
}

namespace pg8 {
#define PG8_LAS __attribute__((address_space(3)))
typedef unsigned short bf16_t;
typedef short bf16x8 __attribute__((ext_vector_type(8)));
typedef float f32x4 __attribute__((ext_vector_type(4)));
typedef unsigned u32x4 __attribute__((ext_vector_type(4)));
constexpr int BM = 256, BK = 64, HALF = 128, HTB = HALF * BK * 2  , STAGE_BYTES = 8 * HTB, NXCD = 8, WGM = 8;

__host__ __device__ __forceinline__ int lds_byte(int r, int c) { const int st = (r >> 4) * 2 + (c >> 5), rr = r & 15, cc = c & 31, ob = rr * 64 + cc * 2; return st * 1024 + (ob ^ (((ob >> 9) & 1) << 5)); }
__host__ __device__ __forceinline__ void stage_rc(int b, int& R, int& C) { const int st = b / 1024, sb = b % 1024, swz = sb ^ (((sb >> 9) & 1) << 5); R = (st >> 1) * 16 + swz / 64; C = (st & 1) * 32 + (swz % 64) / 2; }
__host__ __device__ __forceinline__ int perm32(int rho) { const int n = rho >> 4, i = rho & 15; return 8 * (i >> 2) + 4 * n + (i & 3); }

struct Unit { int pm, pn; };
struct Gemm { const bf16_t* A; const bf16_t* Bt; int M, N, K; };

struct StaticOrder {
    int nM, nN, nwg, G, c;
    __host__ __device__ void init(int M, int N, int G_, int c_) { nM = M / BM; nN = N / BM; nwg = nM * nN; G = G_; c = c_; }
    __host__ __device__ bool next(int i, Unit& u) const {
        const long L = (long)i * G + c; if (L >= nwg) return false;
        int wgid = (int)L; { const int q = nwg / NXCD, r = nwg % NXCD, xcd = wgid % NXCD, off = wgid / NXCD; wgid = (xcd < r ? xcd * (q + 1) : r * (q + 1) + (xcd - r) * q) + off; }
        const int nig = WGM * nN, gid = wgid / nig, fm = gid * WGM, gsz = (nM - fm) < WGM ? (nM - fm) : WGM;
        u.pm = fm + ((wgid % nig) % gsz); u.pn = (wgid % nig) / gsz; return true;
    }
    __device__ __forceinline__ void a_ready(const Unit&) const {}
    __device__ __forceinline__ void done(const Unit&) const {}
};

__device__ __forceinline__ unsigned cvt_pk_bf16(float lo, float hi) { unsigned r; asm volatile("v_cvt_pk_bf16_f32 %0, %1, %2" : "=v"(r) : "v"(lo), "v"(hi)); return r; }
template <class Epi, class Sched, bool ALIGN_EPI = false, bool SP2 = false>
__device__ __forceinline__ void gemm_phase(PG8_LAS unsigned char* lds, const Gemm g, const Sched& S, const Epi& E) {
    const int tid = threadIdx.x, wid = __builtin_amdgcn_readfirstlane(tid >> 6), lane = tid & 63, wr = wid >> 2, wc = wid & 3, fr = lane & 15, fq = lane >> 4;
    const int K = g.K, nt = K / BK;
    unsigned voffA[2], voffB[2];
#pragma unroll
    for (int i = 0; i < 2; ++i) { int R, C; stage_rc(tid * 16 + i * 8192, R, C); const int Rb = Epi::PERM ? ((R & ~31) + perm32(R & 31)) : R;
        voffA[i] = (unsigned)(R * K + C) * 2u; voffB[i] = (unsigned)(Rb * K + C) * 2u; }
    const size_t kstep = (size_t)(BK * 2);
    const size_t hstep = (size_t)HALF * K * 2;
    const size_t tstep = 2 * hstep;
    const unsigned ldsw = (unsigned)wid * 1024u;
    const int aoff = lds_byte(wr * 64 + fr, fq * 8), boff = lds_byte(wc * 32 + fr, fq * 8);
#define PG8_SA(b, h) (((b) * 2 + (h)) * HTB)
#define PG8_SB(b, h) ((4 + (b) * 2 + (h)) * HTB)
#define PG8_STAGE(bufoff, gbase, voff) do { _Pragma("unroll") for (int _i = 0; _i < 2; ++_i) \
        __builtin_amdgcn_global_load_lds((const unsigned*)((const char*)(gbase) + (voff)[_i]), (PG8_LAS unsigned*)(lds + (bufoff) + ldsw + _i * 8192), 16, 0, 0); } while (0)
#define PG8_LDA(dst, b, h) do { _Pragma("unroll") for (int m = 0; m < 4; ++m) _Pragma("unroll") for (int k = 0; k < 2; ++k) dst[m][k] = *(const PG8_LAS bf16x8*)(lds + PG8_SA(b, h) + aoff + m * 2048 + k * 1024); } while (0)
#define PG8_LDB(dst, b, h) do { _Pragma("unroll") for (int n = 0; n < 2; ++n) _Pragma("unroll") for (int k = 0; k < 2; ++k) dst[n][k] = *(const PG8_LAS bf16x8*)(lds + PG8_SB(b, h) + boff + n * 2048 + k * 1024); } while (0)
#define PG8_MMA(ai, bj, At, Bt) do { __builtin_amdgcn_s_setprio(1); _Pragma("unroll") for (int m = 0; m < 4; ++m) _Pragma("unroll") for (int n = 0; n < 2; ++n) _Pragma("unroll") for (int k = 0; k < 2; ++k) \
        acc[ai][bj][m][n] = __builtin_amdgcn_mfma_f32_16x16x32_bf16(Bt[n][k], At[m][k], acc[ai][bj][m][n], 0, 0, 0); __builtin_amdgcn_s_setprio(0); } while (0)
#define PG8_WAIT_V(n) asm volatile("s_waitcnt vmcnt(" #n ")" ::: "memory")
#define PG8_WAIT_L(n) asm volatile("s_waitcnt lgkmcnt(" #n ")" ::: "memory")
#define PG8_BAR __builtin_amdgcn_s_barrier()
#define PG8_SCHED __builtin_amdgcn_sched_barrier(0)
    Unit cur, nxt; int ui = 0;
    if (!S.next(0, cur)) return;
    f32x4 acc[2][2][4][2];
#pragma unroll
    for (int a = 0; a < 2; ++a)
#pragma unroll
        for (int b = 0; b < 2; ++b)
#pragma unroll
            for (int m = 0; m < 4; ++m)
#pragma unroll
                for (int n = 0; n < 2; ++n) acc[a][b][m][n] = (f32x4){0.f, 0.f, 0.f, 0.f};
    bf16x8 At[4][2], B0[2][2], B1[2][2];
    const char* cA = (const char*)g.A + (size_t)cur.pm * tstep; const char* cB = (const char*)g.Bt + (size_t)cur.pn * tstep;
    S.a_ready(cur);
    if constexpr (SP2) {
        PG8_STAGE(PG8_SB(0, 0), cB, voffB); PG8_STAGE(PG8_SB(0, 1), cB + hstep, voffB); PG8_STAGE(PG8_SA(0, 0), cA, voffA); PG8_STAGE(PG8_SA(0, 1), cA + hstep, voffA);
        if (wr == 1) PG8_BAR;
        PG8_WAIT_V(2); PG8_BAR;
        PG8_STAGE(PG8_SB(1, 0), cB + kstep, voffB); PG8_STAGE(PG8_SA(1, 0), cA + kstep, voffA); PG8_STAGE(PG8_SB(1, 1), cB + hstep + kstep, voffB);
        PG8_WAIT_V(6); PG8_BAR;
    } else {
        PG8_STAGE(PG8_SB(0, 0), cB, voffB); PG8_STAGE(PG8_SA(0, 0), cA, voffA); PG8_STAGE(PG8_SB(0, 1), cB + hstep, voffB); PG8_STAGE(PG8_SA(0, 1), cA + hstep, voffA);
        if (wr == 1) PG8_BAR;
        PG8_WAIT_V(4); PG8_BAR;
        PG8_STAGE(PG8_SB(1, 0), cB + kstep, voffB); PG8_STAGE(PG8_SA(1, 0), cA + kstep, voffA); PG8_STAGE(PG8_SB(1, 1), cB + hstep + kstep, voffB);
        PG8_WAIT_V(6); PG8_BAR;
    }
    for (;;) {
        const bool has_next = S.next(ui + 1, nxt);
        const char* nA = has_next ? (const char*)g.A + (size_t)nxt.pm * tstep : cA; const char* nB = has_next ? (const char*)g.Bt + (size_t)nxt.pn * tstep : cB;
        for (int t = 0; t < nt; t += 2) {
            const bool last = (t == nt - 2);
            const char* a1 = cA + (size_t)(t + 1) * kstep;
            const char* a2 = last ? nA : cA + (size_t)(t + 2) * kstep; const char* b2 = last ? nB : cB + (size_t)(t + 2) * kstep;
            const char* a3 = a2 + kstep; const char* b3 = b2 + kstep;
            if (last && has_next) S.a_ready(nxt);
            if constexpr (SP2) {
            PG8_LDB(B0, 0, 0); PG8_LDB(B1, 0, 1); PG8_SCHED; PG8_LDA(At, 0, 0); PG8_STAGE(PG8_SA(1, 1), a1 + hstep, voffA);
            PG8_WAIT_V(8); PG8_WAIT_L(0); PG8_BAR; PG8_MMA(0, 0, At, B0); PG8_MMA(0, 1, At, B1); PG8_BAR; PG8_SCHED;
            PG8_LDA(At, 0, 1); PG8_STAGE(PG8_SB(0, 0), b2, voffB); PG8_STAGE(PG8_SB(0, 1), b2 + hstep, voffB); PG8_STAGE(PG8_SA(0, 0), a2, voffA);
            PG8_WAIT_V(8); PG8_WAIT_L(0); PG8_BAR; PG8_MMA(1, 0, At, B0); PG8_MMA(1, 1, At, B1); PG8_BAR; PG8_SCHED;
            PG8_LDB(B0, 1, 0); PG8_LDB(B1, 1, 1); PG8_SCHED; PG8_LDA(At, 1, 0); PG8_STAGE(PG8_SA(0, 1), a2 + hstep, voffA);
            PG8_WAIT_V(8); PG8_WAIT_L(0); PG8_BAR; PG8_MMA(0, 0, At, B0); PG8_MMA(0, 1, At, B1); PG8_BAR; PG8_SCHED;
            PG8_LDA(At, 1, 1); PG8_STAGE(PG8_SB(1, 0), b3, voffB); PG8_STAGE(PG8_SB(1, 1), b3 + hstep, voffB); PG8_STAGE(PG8_SA(1, 0), a3, voffA);
            PG8_WAIT_V(8); PG8_WAIT_L(0); PG8_BAR; PG8_MMA(1, 0, At, B0); PG8_MMA(1, 1, At, B1); PG8_BAR; PG8_SCHED;
            } else {
            PG8_LDB(B0, 0, 0); PG8_SCHED; PG8_LDA(At, 0, 0); PG8_STAGE(PG8_SA(1, 1), a1 + hstep, voffA);
            PG8_WAIT_L(8); PG8_BAR; PG8_WAIT_L(0); PG8_MMA(0, 0, At, B0); PG8_BAR; PG8_SCHED;
            PG8_LDB(B1, 0, 1); PG8_STAGE(PG8_SB(0, 0), b2, voffB);
            PG8_BAR; PG8_WAIT_L(0); PG8_MMA(0, 1, At, B1); PG8_BAR;
            PG8_LDA(At, 0, 1); PG8_STAGE(PG8_SA(0, 0), a2, voffA);
            PG8_BAR; PG8_WAIT_L(0); PG8_MMA(1, 0, At, B0); PG8_BAR; PG8_SCHED;
            PG8_STAGE(PG8_SB(0, 1), b2 + hstep, voffB);
            PG8_WAIT_V(6); PG8_BAR; PG8_MMA(1, 1, At, B1); PG8_BAR;
            PG8_LDB(B0, 1, 0); PG8_SCHED; PG8_LDA(At, 1, 0); PG8_STAGE(PG8_SA(0, 1), a2 + hstep, voffA);
            PG8_WAIT_L(8); PG8_BAR; PG8_WAIT_L(0); PG8_MMA(0, 0, At, B0); PG8_BAR; PG8_SCHED;
            PG8_LDB(B1, 1, 1); PG8_STAGE(PG8_SB(1, 0), b3, voffB);
            PG8_BAR; PG8_WAIT_L(0); PG8_MMA(0, 1, At, B1); PG8_BAR;
            PG8_LDA(At, 1, 1); PG8_STAGE(PG8_SA(1, 0), a3, voffA);
            PG8_BAR; PG8_WAIT_L(0); PG8_MMA(1, 0, At, B0); PG8_BAR; PG8_SCHED;
            PG8_STAGE(PG8_SB(1, 1), b3 + hstep, voffB);
            PG8_WAIT_V(6); PG8_BAR; PG8_MMA(1, 1, At, B1); PG8_BAR;
            }
        }
        if constexpr (ALIGN_EPI) { if (wr == 0) PG8_BAR; }
        if constexpr (!Epi::AFTER_DRAIN) { E(acc, cur, wr, wc, fr, fq); S.done(cur); }
        if (!has_next) break;
#pragma unroll
        for (int a = 0; a < 2; ++a)
#pragma unroll
            for (int b = 0; b < 2; ++b)
#pragma unroll
                for (int m = 0; m < 4; ++m)
#pragma unroll
                    for (int n = 0; n < 2; ++n) acc[a][b][m][n] = (f32x4){0.f, 0.f, 0.f, 0.f};
        cur = nxt; cA = nA; cB = nB; ++ui;
        if constexpr (ALIGN_EPI) { if (wr == 1) PG8_BAR; }
    }
    PG8_WAIT_V(0);
    if constexpr (!ALIGN_EPI) { if (wr == 0) PG8_BAR; }
    PG8_BAR;
    if constexpr (Epi::AFTER_DRAIN) { E.fused(acc, cur, wr, wc, fr, fq, lds, wid, lane); S.done(cur); }
#undef PG8_SA
#undef PG8_SB
#undef PG8_STAGE
#undef PG8_LDA
#undef PG8_LDB
#undef PG8_MMA
#undef PG8_WAIT_V
#undef PG8_WAIT_L
#undef PG8_BAR
#undef PG8_SCHED
}
}

constexpr int NB = 4, SEQ = 8192, NT = NB * SEQ, DM = 1024;
constexpr int ZW = 3328, NZ = 3336;
constexpr int C_RQ = 0, C_RK = 256, C_RV = 512, C_RG = 1024, C_AQ = 1536, C_AK = 1792, C_AV = 2048, C_MQ = 2304, C_MK = 2560, C_MV = 2816, C_MO = 3072;
constexpr float DN_ALPHA = 1.41421356237f;
constexpr float LN_EPS = 1e-5f;
constexpr int NTHR = 512, NWAVE = 8;
constexpr int LDS_BYTES = 160 * 1024;
constexpr int LDS_CTL_OFF = 159 * 1024;

constexpr size_t MiB = 1u << 20;
constexpr size_t WS_CTL = 0, CTL_ZERO_BYTES = 64 * 1024;
constexpr size_t WS_RCOS = 1 * MiB, WS_RSIN = 2 * MiB, WS_ACOS = 3 * MiB, WS_ASIN = 3 * MiB + 512 * 1024;
constexpr size_t WS_RST = 4 * MiB;
constexpr size_t WS_MC = 36 * MiB;
constexpr size_t WS_MN = 52 * MiB;
constexpr size_t WS_MA = 52 * MiB + 512 * 1024, WS_MML = WS_MA + 4096, WS_MMP = WS_MML + 4096;
constexpr size_t WS_GATES = 54 * MiB;
constexpr int NZP = 3584;
constexpr size_t WS_WIN = 56 * MiB;
constexpr size_t WS_WOUT = 70 * MiB;
constexpr size_t WS_WQG = 74 * MiB;
constexpr size_t WS_WP = 86 * MiB;
constexpr size_t WS_KEYS = 87 * MiB;
constexpr size_t WS_PB = 88 * MiB;
constexpr size_t WS_XB = 120 * MiB;
constexpr size_t WS_AO = 456 * MiB;
constexpr size_t WS_ALSE = 504 * MiB;
constexpr size_t WS_Z = 184 * MiB;
constexpr size_t WS_MIX = 392 * MiB;
constexpr size_t WS_U16 = 184 * MiB;
constexpr size_t WS_QRY = 184 * MiB;
constexpr size_t WS_E = 312 * MiB;
constexpr size_t WS_UQ = 376 * MiB, WS_VQ = 392 * MiB;
constexpr size_t WS_US = 408 * MiB, WS_VS = 408 * MiB + 65536;
constexpr size_t WS_X1Q = 4 * MiB;
constexpr size_t WS_X1S = 53 * MiB;
constexpr size_t WS_PC = 36 * MiB;
constexpr size_t WS_PCS = 53 * MiB + 256 * 1024;
constexpr size_t WS_PI = 184 * MiB;
constexpr size_t WS_Y = 184 * MiB;
constexpr int CW_PQ = 8192;
constexpr size_t WS_RI = 456 * MiB, WS_RG = 472 * MiB;
constexpr size_t WS_END = 506 * MiB;

struct Params {
    const float *x, *p, *w_in, *conv_w, *b_if, *ret_g, *mls_g, *w_out, *ln1_g, *ln1_b, *wq, *keys, *pu, *pv, *wg, *bg, *wp, *ln2_g, *ln2_b;
    float* out; unsigned char* ws; int ph_lo, ph_hi;
};

__device__ __forceinline__ float bf2f(bf16 h) { return __uint_as_float(((unsigned)h) << 16); }
__device__ __forceinline__ unsigned f2bf(float f) { unsigned u = __float_as_uint(f); return (u + 0x7fffu + ((u >> 16) & 1u)) >> 16; }
typedef float f32x2_t __attribute__((ext_vector_type(2))); typedef __bf16 bf16x2_t __attribute__((ext_vector_type(2)));
__device__ __forceinline__ unsigned cvtpk(float lo, float hi) { f32x2_t v = {lo, hi}; bf16x2_t b = __builtin_convertvector(v, bf16x2_t); return __builtin_bit_cast(unsigned, b); }
__device__ __forceinline__ unsigned pk2(float lo, float hi) { return cvtpk(lo, hi); }
__device__ __forceinline__ float wave_sum(float v) {
#pragma unroll
    for (int o = 1; o < 64; o <<= 1) v += __shfl_xor(v, o);
    return v;
}
__device__ __forceinline__ float wave_max(float v) {
#pragma unroll
    for (int o = 1; o < 64; o <<= 1) v = fmaxf(v, __shfl_xor(v, o));
    return v;
}
__device__ __forceinline__ float sigmoidf_(float x) { return __builtin_amdgcn_rcpf(1.f + __expf(-x)); }
__device__ __forceinline__ float siluf_(float x) { return x * __builtin_amdgcn_rcpf(1.f + __expf(-x)); }
__device__ __forceinline__ void unpack8(const uint4 v, float* o) {
    o[0] = __uint_as_float(v.x << 16); o[1] = __uint_as_float(v.x & 0xffff0000u);
    o[2] = __uint_as_float(v.y << 16); o[3] = __uint_as_float(v.y & 0xffff0000u);
    o[4] = __uint_as_float(v.z << 16); o[5] = __uint_as_float(v.z & 0xffff0000u);
    o[6] = __uint_as_float(v.w << 16); o[7] = __uint_as_float(v.w & 0xffff0000u);
}


typedef float f32x4 __attribute__((ext_vector_type(4)));
typedef unsigned u32x4 __attribute__((ext_vector_type(4)));
__device__ __forceinline__ void unpack8v(const u32x4 v, float* o) {
    o[0] = __uint_as_float(v.x << 16); o[1] = __uint_as_float(v.x & 0xffff0000u); o[2] = __uint_as_float(v.y << 16); o[3] = __uint_as_float(v.y & 0xffff0000u);
    o[4] = __uint_as_float(v.z << 16); o[5] = __uint_as_float(v.z & 0xffff0000u); o[6] = __uint_as_float(v.w << 16); o[7] = __uint_as_float(v.w & 0xffff0000u);
}
struct EpiZ16 {
    static constexpr bool PERM = true, AFTER_DRAIN = false;
    bf16* Z; float* gates; const float* acos_; const float* asin_;
    __device__ __forceinline__ void operator()(const f32x4 (&acc)[2][2][4][2], const pg8::Unit& u, int wr, int wc, int fr, int fq) const {
        const int row0 = u.pm * 256 + wr * 64 + fr;
        if (u.pn < 13) {
            const int col0 = u.pn * 256 + wc * 32 + 8 * fq;
            const bool rot = (u.pn == 6 || u.pn == 7) && ((wc & 1) == 0);
            const float qs = (u.pn == 6) ? 0.125f : 1.0f;
#pragma unroll
            for (int ai = 0; ai < 2; ++ai)
#pragma unroll
                for (int m = 0; m < 4; ++m) { const int row = row0 + ai * 128 + m * 16; bf16* rowp = Z + (size_t)row * ZW + col0;
#pragma unroll
                    for (int bj = 0; bj < 2; ++bj) { f32x4 v0 = acc[ai][bj][m][0], v1 = acc[ai][bj][m][1];
                        if (rot) {
                            f32x4 p0, p1;
#pragma unroll
                            for (int j = 0; j < 4; ++j) { p0[j] = __shfl_xor(v0[j], 16); p1[j] = __shfl_xor(v1[j], 16); }
                            if (fq < 2) {
                                const int pos = row & (SEQ - 1);
                                const f32x4 c0 = *(const f32x4*)(acos_ + pos * 8), c1 = *(const f32x4*)(acos_ + pos * 8 + 4), s0 = *(const f32x4*)(asin_ + pos * 8), s1 = *(const f32x4*)(asin_ + pos * 8 + 4);
                                const float sg = (fq == 0) ? -1.0f : 1.0f;
                                v0 = v0 * c0 + p0 * s0 * sg; v1 = v1 * c1 + p1 * s1 * sg;
                            }
                        }
                        v0 = v0 * qs; v1 = v1 * qs;
                        u32x4 w; w.x = pk2(v0[0], v0[1]); w.y = pk2(v0[2], v0[3]); w.z = pk2(v1[0], v1[1]); w.w = pk2(v1[2], v1[3]);
                        *(u32x4*)(rowp + bj * 128) = w; } }
        } else if (wc == 0 && fq == 0) {
#pragma unroll
            for (int ai = 0; ai < 2; ++ai)
#pragma unroll
                for (int m = 0; m < 4; ++m) { float* g = gates + (size_t)(row0 + ai * 128 + m * 16) * 8; *(f32x4*)g = acc[ai][0][m][0]; *(f32x4*)(g + 4) = acc[ai][0][m][1]; }
        }
    }
};
struct EpiBf16Store {
    static constexpr bool PERM = true, AFTER_DRAIN = false;
    bf16* O; int ldc;
    __device__ __forceinline__ void operator()(const f32x4 (&acc)[2][2][4][2], const pg8::Unit& u, int wr, int wc, int fr, int fq) const {
        const int row0 = u.pm * 256 + wr * 64 + fr, col0 = u.pn * 256 + wc * 32 + 8 * fq;
#pragma unroll
        for (int ai = 0; ai < 2; ++ai)
#pragma unroll
            for (int m = 0; m < 4; ++m) { bf16* rowp = O + (size_t)(row0 + ai * 128 + m * 16) * ldc + col0;
#pragma unroll
                for (int bj = 0; bj < 2; ++bj) { const f32x4 v0 = acc[ai][bj][m][0], v1 = acc[ai][bj][m][1];
                    u32x4 w; w.x = pk2(v0[0], v0[1]); w.y = pk2(v0[2], v0[3]); w.z = pk2(v1[0], v1[1]); w.w = pk2(v1[2], v1[3]);
                    *(u32x4*)(rowp + bj * 128) = w; } }
    }
};
struct EpiGate16 {
    static constexpr bool PERM = true, AFTER_DRAIN = false;
    bf16* E; const float* bg;
    __device__ __forceinline__ void operator()(const f32x4 (&acc)[2][2][4][2], const pg8::Unit& u, int wr, int wc, int fr, int fq) const {
        const int row0 = u.pm * 256 + wr * 64 + fr, col0 = u.pn * 256 + wc * 32 + 8 * fq;
#pragma unroll
        for (int bj = 0; bj < 2; ++bj) {
            const f32x4 b0 = *(const f32x4*)(bg + col0 + bj * 128), b1 = *(const f32x4*)(bg + col0 + bj * 128 + 4);
#pragma unroll
            for (int ai = 0; ai < 2; ++ai)
#pragma unroll
                for (int m = 0; m < 4; ++m) { bf16* ep = E + (size_t)(row0 + ai * 128 + m * 16) * DM + col0 + bj * 128;
                    float pp[8]; unpack8v(*(const u32x4*)ep, pp);
                    const f32x4 v0 = acc[ai][bj][m][0] + b0, v1 = acc[ai][bj][m][1] + b1;
                    u32x4 w; w.x = pk2(pp[0] * sigmoidf_(v0[0]), pp[1] * sigmoidf_(v0[1])); w.y = pk2(pp[2] * sigmoidf_(v0[2]), pp[3] * sigmoidf_(v0[3]));
                    w.z = pk2(pp[4] * sigmoidf_(v1[0]), pp[5] * sigmoidf_(v1[1])); w.w = pk2(pp[6] * sigmoidf_(v1[2]), pp[7] * sigmoidf_(v1[3]));
                    *(u32x4*)ep = w; }
        }
    }
};
struct EpiRes16 {
    static constexpr bool PERM = true, AFTER_DRAIN = false;
    const bf16* xinb; bf16* out;
    __device__ __forceinline__ void operator()(const f32x4 (&acc)[2][2][4][2], const pg8::Unit& u, int wr, int wc, int fr, int fq) const {
        const int row0 = u.pm * 256 + wr * 64 + fr, col0 = u.pn * 256 + wc * 32 + 8 * fq;
#pragma unroll
        for (int ai = 0; ai < 2; ++ai)
#pragma unroll
            for (int m = 0; m < 4; ++m) { const size_t ro = (size_t)(row0 + ai * 128 + m * 16) * DM + col0;
#pragma unroll
                for (int bj = 0; bj < 2; ++bj) { float xv[8]; unpack8v(*(const u32x4*)(xinb + ro + bj * 128), xv);
                    const f32x4 v0 = acc[ai][bj][m][0], v1 = acc[ai][bj][m][1];
                    u32x4 w; w.x = pk2(DN_ALPHA * xv[0] + v0[0], DN_ALPHA * xv[1] + v0[1]); w.y = pk2(DN_ALPHA * xv[2] + v0[2], DN_ALPHA * xv[3] + v0[3]);
                    w.z = pk2(DN_ALPHA * xv[4] + v1[0], DN_ALPHA * xv[5] + v1[1]); w.w = pk2(DN_ALPHA * xv[6] + v1[2], DN_ALPHA * xv[7] + v1[3]);
                    *(u32x4*)(out + ro + bj * 128) = w; } }
    }
};
template <class Epi>
__device__ __forceinline__ void gemm16(LAS unsigned char* lds, const bf16* A, const bf16* Bt, int N, int K, const Epi& e) {
    pg8::Gemm g{A, Bt, NT, N, K}; pg8::StaticOrder S; S.init(NT, N, (int)gridDim.x, (int)blockIdx.x);
    pg8::gemm_phase<Epi, pg8::StaticOrder, true, true>(lds, g, S, e);
}

__device__ __forceinline__ void tr_item(const float* W, int K, int N, bf16* WT, float* scr, int item, int nblk, int lane) {
    const int kb = item / nblk, nb = item - kb * nblk, k0 = 64 * kb, n0 = 64 * nb;
    const int col4 = (lane & 15) * 4; const bool ok = (n0 + col4) < N;
#pragma unroll 1
    for (int hf = 0; hf < 2; ++hf) {
        float4 v[8];
#pragma unroll
        for (int i = 0; i < 8; ++i) { const int row = (lane >> 4) + 4 * (i + 8 * hf); v[i] = ok ? *(const float4*)(W + (size_t)(k0 + row) * N + n0 + col4) : make_float4(0.f, 0.f, 0.f, 0.f); }
#pragma unroll
        for (int i = 0; i < 8; ++i) { const int row = (lane >> 4) + 4 * (i + 8 * hf); float* d = scr + row * 65 + col4; d[0] = v[i].x; d[1] = v[i].y; d[2] = v[i].z; d[3] = v[i].w; }
    }
    asm volatile("s_waitcnt lgkmcnt(0)" ::: "memory");
    const int c = lane & 7;
#pragma unroll
    for (int j = 0; j < 8; ++j) { const int nn = (lane >> 3) + 8 * j; const float* sp = scr + (8 * c) * 65 + nn;
        uint4 o; o.x = pk2(sp[0 * 65], sp[1 * 65]); o.y = pk2(sp[2 * 65], sp[3 * 65]); o.z = pk2(sp[4 * 65], sp[5 * 65]); o.w = pk2(sp[6 * 65], sp[7 * 65]);
        *(uint4*)(WT + (size_t)(n0 + nn) * K + k0 + 8 * c) = o; }
    asm volatile("s_waitcnt lgkmcnt(0)" ::: "memory");
}
__device__ __forceinline__ void cvt_f32_bf16(const float* src, bf16* dst, size_t n8) {
    const size_t gt = (size_t)blockIdx.x * NTHR + threadIdx.x, GT = (size_t)gridDim.x * NTHR;
    for (size_t i0 = gt; i0 < n8; i0 += 4 * GT) {
        float4 a[4], b[4];
#pragma unroll
        for (int u = 0; u < 4; ++u) { const size_t i = i0 + u * GT; if (i < n8) { a[u] = *(const float4*)(src + i * 8); b[u] = *(const float4*)(src + i * 8 + 4); } }
#pragma unroll
        for (int u = 0; u < 4; ++u) { const size_t i = i0 + u * GT; if (i < n8) { uint4 o; o.x = pk2(a[u].x, a[u].y); o.y = pk2(a[u].z, a[u].w); o.z = pk2(b[u].x, b[u].y); o.w = pk2(b[u].z, b[u].w); *(uint4*)(dst + i * 8) = o; } }
    }
}
__device__ __forceinline__ void p0_weights(const Params& p, float* lds) {
    const int lane = threadIdx.x & 63, wave = __builtin_amdgcn_readfirstlane((int)threadIdx.x >> 6);
    float* scr = lds + wave * (64 * 65);
    const int gw = blockIdx.x * NWAVE + wave, NGW = gridDim.x * NWAVE;
    constexpr int I_IN = 16 * (NZP / 64), I_OUT = 16 * 16, I_Q = 16 * 32, I_G = 16 * 16, I_P = 4 * 16, I_L = I_IN + I_OUT + I_Q + I_G + I_P;
    for (int it = gw; it < 2 * I_L; it += NGW) {
        const int li = it / I_L; int r = it - li * I_L;
        if (r < I_IN) { tr_item(p.w_in + (size_t)li * DM * NZ, DM, NZ, (bf16*)(p.ws + WS_WIN) + (size_t)li * NZP * DM, scr, r, NZP / 64, lane); continue; } r -= I_IN;
        if (r < I_OUT) { tr_item(p.w_out + (size_t)li * DM * DM, DM, DM, (bf16*)(p.ws + WS_WOUT) + (size_t)li * DM * DM, scr, r, 16, lane); continue; } r -= I_OUT;
        if (r < I_Q) { tr_item(p.wq + (size_t)li * DM * 2048, DM, 2048, (bf16*)(p.ws + WS_WQG) + (size_t)li * 3072 * DM, scr, r, 32, lane); continue; } r -= I_Q;
        if (r < I_G) { tr_item(p.wg + (size_t)li * DM * DM, DM, DM, (bf16*)(p.ws + WS_WQG) + (size_t)li * 3072 * DM + (size_t)2048 * DM, scr, r, 16, lane); continue; } r -= I_G;
        tr_item(p.wp + (size_t)li * 256 * DM, 256, DM, (bf16*)(p.ws + WS_WP) + (size_t)li * DM * 256, scr, r, 16, lane);
    }
    cvt_f32_bf16(p.x, (bf16*)(p.ws + WS_XB), (size_t)NT * DM / 8);
    cvt_f32_bf16(p.p, (bf16*)(p.ws + WS_PB), (size_t)2 * NT * 256 / 8);
    cvt_f32_bf16(p.keys, (bf16*)(p.ws + WS_KEYS), (size_t)2 * 8 * 2 * 128 * 128 / 8);
}

__device__ __forceinline__ void p0_tables(const Params& p) {
    float* rcos = (float*)(p.ws + WS_RCOS); float* rsin = (float*)(p.ws + WS_RSIN); float* acos_ = (float*)(p.ws + WS_ACOS); float* asin_ = (float*)(p.ws + WS_ASIN);
    const int gt = blockIdx.x * NTHR + threadIdx.x, GT = gridDim.x * NTHR;
    for (int i = gt; i < SEQ * 32; i += GT) { const int pos = i >> 5, k = i & 31; const float inv = powf(10000.0f, -(float)k / 32.0f); const float ang = (float)pos * inv; rcos[i] = cosf(ang); rsin[i] = sinf(ang); }
    for (int i = gt; i < SEQ * 8; i += GT) { const int pos = i >> 3, k = i & 7; const float inv = powf(500000.0f, -(float)k / 8.0f); const float ang = (float)pos * inv; acos_[i] = cosf(ang); asin_[i] = sinf(ang); }
}

__device__ __forceinline__ float ret_lg(int h) { return logf(1.0f - exp2f(-5.0f - (float)h)); }


__device__ __forceinline__ float logsigmoidf_(float f) { return fminf(f, 0.f) - log1pf(expf(-fabsf(f))); }


typedef short bf16x8_t __attribute__((ext_vector_type(8)));
typedef short s16x4_t __attribute__((ext_vector_type(4)));
typedef float f32x16 __attribute__((ext_vector_type(16)));
__device__ __forceinline__ s16x4_t lds_tr(const LAS unsigned char* p) { return __builtin_bit_cast(s16x4_t, __builtin_amdgcn_ds_read_tr16_b64_v4i16((LAS s16x4_t*)p)); }

__device__ __forceinline__ void attn_unit(const Params& p, int unit, LAS unsigned char* lds) {
    RGN_T0(9)
    const int tid = threadIdx.x, lane = tid & 63, wave = __builtin_amdgcn_readfirstlane(tid >> 6);
    const int r32 = lane & 31, hh = lane >> 5;
    const bf16* Z = (const bf16*)(p.ws + WS_Z);
    const int bh = unit / 96, uu = unit - bh * 96, r = uu >> 5, v = uu & 31;
    const int dl = 1 << (2 * r), nb = 32 >> (2 * r);
    const int x = v / nb, blk = v - x * nb, q0 = blk * 256;
    const int b = bh >> 2, h = bh & 3;
    bf16* AO = (bf16*)(p.ws + WS_AO) + (size_t)r * NT * 256; float* ALSE = (float*)(p.ws + WS_ALSE) + (size_t)r * NT * 4;
    LAS unsigned char* Ks = lds; LAS unsigned char* Vs = lds + 384 * 128;
#pragma unroll 3
    for (int idx = tid; idx < 384 * 8; idx += NTHR) {
        const int i = idx >> 3, c = idx & 7, jk = q0 - 128 + i;
        const int jc = jk < 0 ? 0 : jk;
        const bf16* zr = Z + (size_t)(b * SEQ + jc * dl + x) * ZW + h * 64 + c * 8;
        u32x4 kv = *(const u32x4*)(zr + C_AK), vv = *(const u32x4*)(zr + C_AV);
        if (jk < 0) { kv = (u32x4){0u, 0u, 0u, 0u}; vv = (u32x4){0u, 0u, 0u, 0u}; }
        const int off = i * 128 + ((c ^ (i & 7)) << 4);
        *(LAS u32x4*)(Ks + off) = kv; *(LAS u32x4*)(Vs + off) = vv;
    }
    const int jq = q0 + 32 * wave + r32;
    const int tokq = b * SEQ + jq * dl + x;
    bf16x8_t qf[4];
#pragma unroll
    for (int ks = 0; ks < 4; ++ks) qf[ks] = *(const bf16x8_t*)(Z + (size_t)tokq * ZW + C_AQ + h * 64 + 16 * ks + 8 * hh);
    __syncthreads();
    f32x16 st[5];
#pragma unroll
    for (int tl = 0; tl < 5; ++tl) {
        f32x16 a16 = {0.f, 0.f, 0.f, 0.f, 0.f, 0.f, 0.f, 0.f, 0.f, 0.f, 0.f, 0.f, 0.f, 0.f, 0.f, 0.f};
        const int i = 32 * wave + 32 * tl + r32;
#pragma unroll
        for (int ks = 0; ks < 4; ++ks) {
            const int c = 2 * ks + hh;
            const bf16x8_t kf = *(const LAS bf16x8_t*)(Ks + i * 128 + ((c ^ (i & 7)) << 4));
            a16 = __builtin_amdgcn_mfma_f32_32x32x16_bf16(kf, qf[ks], a16, 0, 0, 0);
        }
        st[tl] = a16;
    }
    const int kb = q0 + 32 * wave - 128;
    float m = -INFINITY;
#pragma unroll
    for (int tl = 0; tl < 5; ++tl)
#pragma unroll
        for (int rg = 0; rg < 16; ++rg) {
            const int c = 32 * tl + (rg & 3) + 8 * (rg >> 2) + 4 * hh;
            const bool valid = (c >= r32) && (c <= r32 + 128) && (kb + c >= 0);
            const float sv = valid ? st[tl][rg] : -INFINITY;
            st[tl][rg] = sv; m = fmaxf(m, sv);
        }
    m = fmaxf(m, __shfl_xor(m, 32));
    float den = 0.f;
#pragma unroll
    for (int tl = 0; tl < 5; ++tl)
#pragma unroll
        for (int rg = 0; rg < 16; ++rg) { const float pe = __expf(st[tl][rg] - m); st[tl][rg] = pe; den += pe; }
    den += __shfl_xor(den, 32);
    f32x16 o[2];
#pragma unroll
    for (int dt = 0; dt < 2; ++dt) o[dt] = (f32x16){0.f, 0.f, 0.f, 0.f, 0.f, 0.f, 0.f, 0.f, 0.f, 0.f, 0.f, 0.f, 0.f, 0.f, 0.f, 0.f};
    const int tq = (lane & 15) >> 2, tp = lane & 3, tg = (lane >> 4) & 1;
#pragma unroll
    for (int tl = 0; tl < 5; ++tl)
#pragma unroll
        for (int s2 = 0; s2 < 2; ++s2) {
            u32x4 pw; pw.x = cvtpk(st[tl][8 * s2 + 0], st[tl][8 * s2 + 1]); pw.y = cvtpk(st[tl][8 * s2 + 2], st[tl][8 * s2 + 3]); pw.z = cvtpk(st[tl][8 * s2 + 4], st[tl][8 * s2 + 5]); pw.w = cvtpk(st[tl][8 * s2 + 6], st[tl][8 * s2 + 7]);
            const bf16x8_t pb = __builtin_bit_cast(bf16x8_t, pw);
            const int i0 = 32 * wave + 32 * tl + 16 * s2 + 4 * hh + tq;
#pragma unroll
            for (int dt = 0; dt < 2; ++dt) {
                const int c = 4 * dt + 2 * tg + (tp >> 1);
                const int i1 = i0 + 8;
                const s16x4_t lo = lds_tr(Vs + i0 * 128 + ((c ^ (i0 & 7)) << 4) + 8 * (tp & 1));
                const s16x4_t hi = lds_tr(Vs + i1 * 128 + ((c ^ (i1 & 7)) << 4) + 8 * (tp & 1));
                const bf16x8_t vf = (bf16x8_t){lo[0], lo[1], lo[2], lo[3], hi[0], hi[1], hi[2], hi[3]};
                o[dt] = __builtin_amdgcn_mfma_f32_32x32x16_bf16(vf, pb, o[dt], 0, 0, 0);
            }
        }
    const float rden = 1.0f / den;
    bf16* orow = AO + (size_t)tokq * 256 + h * 64;
#pragma unroll
    for (int dt = 0; dt < 2; ++dt)
#pragma unroll
        for (int g4 = 0; g4 < 4; ++g4) {
            const int d = 32 * dt + 8 * g4 + 4 * hh;
            *(uint2*)(orow + d) = make_uint2(cvtpk(o[dt][4 * g4] * rden, o[dt][4 * g4 + 1] * rden), cvtpk(o[dt][4 * g4 + 2] * rden, o[dt][4 * g4 + 3] * rden));
        }
    if (hh == 0) ALSE[(size_t)tokq * 4 + h] = m + __logf(den);
    __syncthreads();
    RGN_T1(9, lds)
}

__device__ __forceinline__ void attn_merge(const Params& p) {
    const bf16* AO = (const bf16*)(p.ws + WS_AO); const float* ALSE = (const float*)(p.ws + WS_ALSE);
    bf16* MIX = (bf16*)(p.ws + WS_MIX);
    const int gt = blockIdx.x * NTHR + threadIdx.x, GT = gridDim.x * NTHR;
    for (int e0 = gt; e0 < NT * 32; e0 += 2 * GT) {
        float l[2][3]; uint4 a[2][3];
#pragma unroll
        for (int u = 0; u < 2; ++u) { const int e = (e0 + u * GT < NT * 32) ? e0 + u * GT : e0; const int t = e >> 5, c8 = e & 31, h = c8 >> 3;
#pragma unroll
            for (int r = 0; r < 3; ++r) { l[u][r] = ALSE[(size_t)r * NT * 4 + (size_t)t * 4 + h]; a[u][r] = *(const uint4*)(AO + (size_t)r * NT * 256 + (size_t)t * 256 + c8 * 8); } }
#pragma unroll
        for (int u = 0; u < 2; ++u) {
            const int e = e0 + u * GT;
            if (e < NT * 32) {
                const int t = e >> 5, c8 = e & 31;
                const float M = fmaxf(fmaxf(l[u][0], l[u][1]), l[u][2]);
                float w0 = __expf(l[u][0] - M), w1 = __expf(l[u][1] - M), w2 = __expf(l[u][2] - M);
                const float rs = 1.0f / (w0 + w1 + w2); w0 *= rs; w1 *= rs; w2 *= rs;
                float a0[8], a1[8], a2[8]; unpack8(a[u][0], a0); unpack8(a[u][1], a1); unpack8(a[u][2], a2);
                float y[8];
#pragma unroll
                for (int j = 0; j < 8; ++j) y[j] = w0 * a0[j] + w1 * a1[j] + w2 * a2[j];
                *(uint4*)(MIX + (size_t)t * DM + 512 + c8 * 8) = make_uint4(pk2(y[0], y[1]), pk2(y[2], y[3]), pk2(y[4], y[5]), pk2(y[6], y[7]));
            }
        }
    }
}

constexpr int UNIT_LDS = 79360;
__device__ __forceinline__ int swz16(int row, int chunk) { return (chunk ^ (row & 7)) << 4; }
template <bool ACCPERM>
__device__ __forceinline__ bf16x8_t frag_tr(const LAS unsigned char* img, int RB, int kbase, int cbase, int lane) {
    const int tq = (lane & 15) >> 2, tp = lane & 3, tg = (lane >> 4) & 1, hh = lane >> 5;
    const int r0 = kbase + (ACCPERM ? 4 : 8) * hh + tq, r1 = r0 + (ACCPERM ? 8 : 4);
    const int colb = (cbase + 16 * tg + 4 * tp) * 2, ch = colb >> 4, sub = colb & 15;
    const s16x4_t lo = lds_tr(img + r0 * RB + swz16(r0, ch) + sub);
    const s16x4_t hi = lds_tr(img + r1 * RB + swz16(r1, ch) + sub);
    return (bf16x8_t){lo[0], lo[1], lo[2], lo[3], hi[0], hi[1], hi[2], hi[3]};
}
__device__ __forceinline__ bf16x8_t frag_row(const LAS unsigned char* img, int RB, int row, int chunk) { return *(const LAS bf16x8_t*)(img + row * RB + swz16(row, chunk)); }
__device__ __forceinline__ u32x4 pack8(const float* v) { u32x4 w; w.x = pk2(v[0], v[1]); w.y = pk2(v[2], v[3]); w.z = pk2(v[4], v[5]); w.w = pk2(v[6], v[7]); return w; }
#define F16Z ((f32x16){0.f, 0.f, 0.f, 0.f, 0.f, 0.f, 0.f, 0.f, 0.f, 0.f, 0.f, 0.f, 0.f, 0.f, 0.f, 0.f})
__device__ __forceinline__ int acc_row(int rg, int hh) { return (rg & 3) + 8 * (rg >> 2) + 4 * hh; }

template <bool ZETA>
__device__ __forceinline__ void stage_ret_k(const Params& p, LAS unsigned char* Ks, int t0, int s0, int h, float lg, int tidU) {
    const bf16* Z = (const bf16*)(p.ws + WS_Z);
    const float* rcos = (const float*)(p.ws + WS_RCOS); const float* rsin = (const float*)(p.ws + WS_RSIN);
#pragma unroll
    for (int task = tidU; task < 512; task += 256) {
        const int row = task >> 2, pc = task & 3;
        const bf16* zr = Z + (size_t)(t0 + row) * ZW + C_RK + h * 64;
        float a[8], bq[8], o1[8], o2[8];
        unpack8v(*(const u32x4*)(zr + 8 * pc), a); unpack8v(*(const u32x4*)(zr + 32 + 8 * pc), bq);
        const f32x4 c0 = *(const f32x4*)(rcos + (s0 + row) * 32 + 8 * pc), c1 = *(const f32x4*)(rcos + (s0 + row) * 32 + 8 * pc + 4);
        const f32x4 n0 = *(const f32x4*)(rsin + (s0 + row) * 32 + 8 * pc), n1 = *(const f32x4*)(rsin + (s0 + row) * 32 + 8 * pc + 4);
        const float sc = ZETA ? 0.125f * __expf(lg * (float)(127 - row)) : 0.125f;
#pragma unroll
        for (int j = 0; j < 8; ++j) { const float cs = j < 4 ? c0[j & 3] : c1[j & 3], sn = j < 4 ? n0[j & 3] : n1[j & 3]; o1[j] = (a[j] * cs - bq[j] * sn) * sc; o2[j] = (bq[j] * cs + a[j] * sn) * sc; }
        *(LAS u32x4*)(Ks + row * 128 + swz16(row, pc)) = pack8(o1); *(LAS u32x4*)(Ks + row * 128 + swz16(row, pc + 4)) = pack8(o2);
    }
}
__device__ __forceinline__ void stage_copy(const bf16* src0, int ld, LAS unsigned char* img, int RB, int nrows, int nchunks, int tidU) {
#pragma unroll 4
    for (int task = tidU; task < nrows * nchunks; task += 256) {
        const int row = task / nchunks, c = task - row * nchunks;
        *(LAS u32x4*)(img + row * RB + swz16(row, c)) = *(const u32x4*)(src0 + (size_t)row * ld + 8 * c);
    }
}

__device__ __forceinline__ void ret_state_u(const Params& p, int unit, LAS unsigned char* ldsU, int wl, int tidU, int lane) {
    RGN_T0(7)
    const int c = unit & 63, bh = unit >> 6, h = bh & 3, b = bh >> 2, t0 = b * SEQ + c * 128, s0 = c * 128;
    const bf16* Z = (const bf16*)(p.ws + WS_Z); float* RST = (float*)(p.ws + WS_RST);
    LAS unsigned char* Ks = ldsU; LAS unsigned char* Vs = ldsU + 16384;
    stage_ret_k<true>(p, Ks, t0, s0, h, ret_lg(h), tidU);
    stage_copy(Z + (size_t)t0 * ZW + C_RV + h * 128, ZW, Vs, 256, 128, 16, tidU);
    __syncthreads();
    f32x16 a0 = F16Z, a1 = F16Z;
#pragma unroll 2
    for (int ks = 0; ks < 8; ++ks) {
        const bf16x8_t A = frag_tr<false>(Vs, 256, 16 * ks, 32 * wl, lane);
        const bf16x8_t B0 = frag_tr<false>(Ks, 128, 16 * ks, 0, lane), B1 = frag_tr<false>(Ks, 128, 16 * ks, 32, lane);
        a0 = __builtin_amdgcn_mfma_f32_32x32x16_bf16(A, B0, a0, 0, 0, 0); a1 = __builtin_amdgcn_mfma_f32_32x32x16_bf16(A, B1, a1, 0, 0, 0);
    }
    float* dst = RST + (size_t)unit * 8192; const int r32 = lane & 31, hh = lane >> 5;
#pragma unroll
    for (int rg = 0; rg < 16; ++rg) { const int dv = 32 * wl + acc_row(rg, hh); dst[dv * 64 + r32] = a0[rg]; dst[dv * 64 + 32 + r32] = a1[rg]; }
    __syncthreads();
    RGN_T1(7, ldsU)
}

__device__ __forceinline__ void mls_gates(const Params& p, int li, int t0, int h, int lane, float& b0, float& b1, float& g0, float& g1) {
    const float* gates = (const float*)(p.ws + WS_GATES);
    const float bi = p.b_if[li * 8 + h], bf = p.b_if[li * 8 + 4 + h];
    const int t = t0 + 2 * lane;
    const float i0 = gates[(size_t)t * 8 + h] + bi, i1 = gates[(size_t)(t + 1) * 8 + h] + bi;
    const float f0 = logsigmoidf_(gates[(size_t)t * 8 + 4 + h] + bf), f1 = logsigmoidf_(gates[(size_t)(t + 1) * 8 + 4 + h] + bf);
    const float tot = f0 + f1; float v = tot;
#pragma unroll
    for (int o = 1; o < 64; o <<= 1) { const float u = __shfl_up(v, o); if (lane >= o) v += u; }
    const float ex = v - tot;
    b0 = ex + f0; b1 = ex + tot; g0 = i0 - b0; g1 = i1 - b1;
}
__device__ __forceinline__ void conv8(const bf16* zq, const float* cw, int nprev, float scale, float* o) {
    float acc[8];
#pragma unroll
    for (int e = 0; e < 8; ++e) acc[e] = 0.f;
    u32x4 xr[4]; f32x4 w0[4], w1[4];
#pragma unroll
    for (int j = 0; j < 4; ++j) {
        const int back = (3 - j <= nprev) ? (3 - j) : 0;
        xr[j] = *(const u32x4*)(zq - (size_t)back * ZW);
        w0[j] = *(const f32x4*)(cw + j * 512); w1[j] = *(const f32x4*)(cw + j * 512 + 4);
    }
#pragma unroll
    for (int j = 0; j < 4; ++j) {
        const float ok = (3 - j <= nprev) ? 1.0f : 0.0f;
        float xv[8]; unpack8v(xr[j], xv);
#pragma unroll
        for (int e = 0; e < 8; ++e) acc[e] = fmaf((e < 4 ? w0[j][e & 3] : w1[j][e & 3]) * ok, xv[e], acc[e]);
    }
#pragma unroll
    for (int e = 0; e < 8; ++e) o[e] = siluf_(acc[e]) * scale;
}
__device__ __forceinline__ void stage_vext(const bf16* src0, LAS unsigned char* Vs, int tidU) {
#pragma unroll 3
    for (int task = tidU; task < 128 * 12; task += 256) {
        const int row = task / 12, c = task - row * 12;
        u32x4 v = *(const u32x4*)(src0 + (size_t)row * ZW + 8 * (c & 7));
        if (c >= 8) { v = (u32x4){0u, 0u, 0u, 0u}; if (c == 8) v.x = 0x3F80u; }
        *(LAS u32x4*)(Vs + row * 256 + swz16(row, c)) = v;
    }
}

__device__ __forceinline__ void mls_state_u(const Params& p, int li, int unit, LAS unsigned char* ldsU, int wl, int tidU, int lane) {
    RGN_T0(8)
    const int c = unit & 63, bh = unit >> 6, h = bh & 3, b = bh >> 2, t0 = b * SEQ + c * 128;
    const bf16* Z = (const bf16*)(p.ws + WS_Z);
    float* MC = (float*)(p.ws + WS_MC); float* MN = (float*)(p.ws + WS_MN); float* MA = (float*)(p.ws + WS_MA); float* MML = (float*)(p.ws + WS_MML);
    LAS unsigned char* Ks = ldsU; LAS unsigned char* Vs = ldsU + 16384; LAS float* wk = (LAS float*)(ldsU + 49152);
    if (wl == 0) {
        float b0, b1, g0, g1; mls_gates(p, li, t0, h, lane, b0, b1, g0, g1);
        const float gmax = wave_max(fmaxf(g0, g1));
        const float a = __shfl(b1, 63);
        wk[2 * lane] = __expf(g0 - gmax); wk[2 * lane + 1] = __expf(g1 - gmax);
        if (lane == 0) { MA[unit] = a; MML[unit] = a + gmax; }
    }
    stage_vext(Z + (size_t)t0 * ZW + C_MV + h * 64, Vs, tidU);
    __syncthreads();
    bf16* QKC = (bf16*)p.out;
#pragma unroll 2
    for (int task = tidU; task < 2048; task += 256) {
        const int isq = task >> 10, row = (task >> 3) & 127, cc = task & 7;
        float o[8]; conv8(Z + (size_t)(t0 + row) * ZW + (isq ? C_MQ : C_MK) + h * 64 + 8 * cc, p.conv_w + (size_t)li * 2048 + (isq ? 0 : 256) + h * 64 + 8 * cc, c * 128 + row, isq ? 1.0f : 0.125f, o);
        *(u32x4*)(QKC + (size_t)(t0 + row) * 512 + (isq ? 0 : 256) + h * 64 + 8 * cc) = pack8(o);
        if (!isq) { const float w = wk[row];
#pragma unroll
            for (int e = 0; e < 8; ++e) o[e] *= w;
            *(LAS u32x4*)(Ks + row * 128 + swz16(row, cc)) = pack8(o); }
    }
    __syncthreads();
    if (wl < 3) {
        f32x16 a0 = F16Z, a1 = F16Z;
#pragma unroll 2
        for (int ks = 0; ks < 8; ++ks) {
            const bf16x8_t A = frag_tr<false>(Vs, 256, 16 * ks, 32 * wl, lane);
            const bf16x8_t B0 = frag_tr<false>(Ks, 128, 16 * ks, 0, lane), B1 = frag_tr<false>(Ks, 128, 16 * ks, 32, lane);
            a0 = __builtin_amdgcn_mfma_f32_32x32x16_bf16(A, B0, a0, 0, 0, 0); a1 = __builtin_amdgcn_mfma_f32_32x32x16_bf16(A, B1, a1, 0, 0, 0);
        }
        const int r32 = lane & 31, hh = lane >> 5;
        if (wl < 2) {
            float* dst = MC + (size_t)unit * 4096;
#pragma unroll
            for (int rg = 0; rg < 16; ++rg) { const int v = 32 * wl + acc_row(rg, hh); dst[v * 64 + r32] = a0[rg]; dst[v * 64 + 32 + r32] = a1[rg]; }
        } else if (hh == 0) { MN[(size_t)unit * 64 + r32] = a0[0]; MN[(size_t)unit * 64 + 32 + r32] = a1[0]; }
    }
    __syncthreads();
    RGN_T1(8, ldsU)
}

__device__ __forceinline__ void epi_stage_put(LAS unsigned char* reg, int r32, int col, float a, float b, float c, float d) {
    typedef unsigned u32x2_ __attribute__((ext_vector_type(2)));
    *(LAS u32x2_*)(reg + r32 * 128 + swz16(r32, col >> 3) + ((col & 4) << 1)) = (u32x2_){pk2(a, b), pk2(c, d)};
}
__device__ __forceinline__ void ret_out_u(const Params& p, int li, int unit, LAS unsigned char* ldsU, int wl, int tidU, int lane) {
    const int c = unit & 63, bh = unit >> 6, h = bh & 3, b = bh >> 2, t0 = b * SEQ + c * 128, s0 = c * 128;
    const int r32 = lane & 31, hh = lane >> 5;
    const bf16* Z = (const bf16*)(p.ws + WS_Z); const float* RST = (const float*)(p.ws + WS_RST); bf16* MIX = (bf16*)(p.ws + WS_MIX);
    const float* rcos = (const float*)(p.ws + WS_RCOS); const float* rsin = (const float*)(p.ws + WS_RSIN);
    LAS unsigned char* Ks = ldsU; LAS unsigned char* Vs = ldsU + 16384; LAS unsigned char* Rs = ldsU + 49152;
    const float lg = ret_lg(h);
    RGN_T0(1)
    stage_ret_k<false>(p, Ks, t0, s0, h, lg, tidU);
    stage_copy(Z + (size_t)t0 * ZW + C_RV + h * 128, ZW, Vs, 256, 128, 16, tidU);
#pragma unroll
    for (int task = tidU; task < 1024; task += 256) {
        const int row = task >> 3, cc = task & 7;
        const float* src = RST + (size_t)unit * 8192 + row * 64 + 8 * cc;
        const f32x4 x0 = *(const f32x4*)src, x1 = *(const f32x4*)(src + 4);
        const float v[8] = {x0[0], x0[1], x0[2], x0[3], x1[0], x1[1], x1[2], x1[3]};
        *(LAS u32x4*)(Rs + row * 128 + swz16(row, cc)) = pack8(v);
    }
    const int t = 32 * wl + r32, tok = t0 + t, pos = s0 + t;
    bf16x8_t qf[4];
    {
        float f[4][8];
#pragma unroll
        for (int ks = 0; ks < 4; ++ks) unpack8v(*(const u32x4*)(Z + (size_t)tok * ZW + C_RQ + h * 64 + 16 * ks + 8 * hh), f[ks]);
#pragma unroll
        for (int ks = 0; ks < 2; ++ks) {
            const float* cp = rcos + pos * 32 + 16 * ks + 8 * hh; const float* sp = rsin + pos * 32 + 16 * ks + 8 * hh;
            const f32x4 c0 = *(const f32x4*)cp, c1 = *(const f32x4*)(cp + 4), n0 = *(const f32x4*)sp, n1 = *(const f32x4*)(sp + 4);
#pragma unroll
            for (int j = 0; j < 8; ++j) { const float cs = j < 4 ? c0[j & 3] : c1[j & 3], sn = j < 4 ? n0[j & 3] : n1[j & 3]; const float x1 = f[ks][j], x2 = f[ks + 2][j]; f[ks][j] = x1 * cs - x2 * sn; f[ks + 2][j] = x2 * cs + x1 * sn; }
        }
#pragma unroll
        for (int ks = 0; ks < 4; ++ks) qf[ks] = __builtin_bit_cast(bf16x8_t, pack8(f[ks]));
    }
    __syncthreads();
    RGN_T1(1, ldsU)
    RGN_T0(2)
    f32x16 o[4];
#pragma unroll
    for (int dt = 0; dt < 4; ++dt) {
        f32x16 a = F16Z;
#pragma unroll
        for (int ks = 0; ks < 4; ++ks) a = __builtin_amdgcn_mfma_f32_32x32x16_bf16(frag_row(Rs, 128, 32 * dt + r32, 2 * ks + hh), qf[ks], a, 0, 0, 0);
        o[dt] = a;
    }
    const float xi = __expf(lg * (float)(t + 1));
#pragma unroll
    for (int dt = 0; dt < 4; ++dt)
#pragma unroll
        for (int rg = 0; rg < 16; ++rg) o[dt][rg] *= xi;
#pragma unroll 1
    for (int tl = 0; tl <= wl; ++tl) {
        {
            f32x16 st = F16Z;
#pragma unroll
            for (int ks = 0; ks < 4; ++ks) st = __builtin_amdgcn_mfma_f32_32x32x16_bf16(frag_row(Ks, 128, 32 * tl + r32, 2 * ks + hh), qf[ks], st, 0, 0, 0);
#pragma unroll
            for (int rg = 0; rg < 16; ++rg) { const int s = 32 * tl + acc_row(rg, hh); st[rg] = (s <= t) ? st[rg] * __expf(lg * (float)(t - s)) : 0.f; }
#pragma unroll
            for (int s2 = 0; s2 < 2; ++s2) {
                u32x4 pw; pw.x = cvtpk(st[8 * s2 + 0], st[8 * s2 + 1]); pw.y = cvtpk(st[8 * s2 + 2], st[8 * s2 + 3]); pw.z = cvtpk(st[8 * s2 + 4], st[8 * s2 + 5]); pw.w = cvtpk(st[8 * s2 + 6], st[8 * s2 + 7]);
                const bf16x8_t pb = __builtin_bit_cast(bf16x8_t, pw);
#pragma unroll
                for (int dt = 0; dt < 4; ++dt) o[dt] = __builtin_amdgcn_mfma_f32_32x32x16_bf16(frag_tr<true>(Vs, 256, 32 * tl + 16 * s2, 32 * dt, lane), pb, o[dt], 0, 0, 0);
            }
        }
    }
    RGN_T1(2, ldsU)
    RGN_T0(3)
    float sum = 0.f, sq = 0.f;
#pragma unroll
    for (int dt = 0; dt < 4; ++dt)
#pragma unroll
        for (int rg = 0; rg < 16; ++rg) { sum += o[dt][rg]; sq += o[dt][rg] * o[dt][rg]; }
    sum += __shfl_xor(sum, 32); sq += __shfl_xor(sq, 32);
    const float mean = sum * (1.0f / 128.0f);
    const float rstd = 1.0f / sqrtf(fmaxf(sq * (1.0f / 128.0f) - mean * mean, 0.f) + LN_EPS);
    __syncthreads();
#pragma unroll
    for (int dt = 0; dt < 4; ++dt)
#pragma unroll
        for (int g4 = 0; g4 < 4; ++g4) {
            const int dv = 32 * dt + 8 * g4 + 4 * hh;
            const f32x4 gg = *(const f32x4*)(p.ret_g + li * 512 + h * 128 + dv);
            epi_stage_put(((dt < 2) ? Ks : Rs) + 4096 * wl, r32, dv & 63, (o[dt][4 * g4 + 0] - mean) * rstd * gg[0], (o[dt][4 * g4 + 1] - mean) * rstd * gg[1], (o[dt][4 * g4 + 2] - mean) * rstd * gg[2], (o[dt][4 * g4 + 3] - mean) * rstd * gg[3]);
        }
    asm volatile("s_waitcnt lgkmcnt(0)" ::: "memory");
#pragma unroll
    for (int j = 0; j < 8; ++j) {
        const int idx = (lane + 64 * j) & 255, half = j >> 2, row = idx >> 3, cc = idx & 7;
        const LAS unsigned char* reg = (half ? Rs : Ks) + 4096 * wl;
        float yv[8], gv[8]; unpack8v(*(const LAS u32x4*)(reg + row * 128 + swz16(row, cc)), yv);
        const size_t tk = (size_t)(t0 + 32 * wl + row);
        unpack8v(*(const u32x4*)(Z + tk * ZW + C_RG + h * 128 + 64 * half + 8 * cc), gv);
#pragma unroll
        for (int e = 0; e < 8; ++e) yv[e] *= siluf_(gv[e]);
        *(u32x4*)(MIX + tk * DM + h * 128 + 64 * half + 8 * cc) = pack8(yv);
    }
    __syncthreads();
    RGN_T1(3, ldsU)
}

__device__ __forceinline__ void mls_out_u(const Params& p, int li, int unit, LAS unsigned char* ldsU, int wl, int tidU, int lane) {
    const int c = unit & 63, bh = unit >> 6, h = bh & 3, b = bh >> 2, t0 = b * SEQ + c * 128;
    const int r32 = lane & 31, hh = lane >> 5;
    const bf16* Z = (const bf16*)(p.ws + WS_Z); bf16* MIX = (bf16*)(p.ws + WS_MIX);
    const float* MC = (const float*)(p.ws + WS_MC); const float* MN = (const float*)(p.ws + WS_MN); const float* MMP = (const float*)(p.ws + WS_MMP);
    LAS unsigned char* Ks = ldsU; LAS unsigned char* Qs = ldsU + 16384; LAS unsigned char* Vs = ldsU + 32768; LAS unsigned char* Cs = ldsU + 65536;
    LAS float* bb = (LAS float*)(ldsU + 77824); LAS float* gg = bb + 128; LAS float* pm = gg + 128;
    RGN_T0(4)
    if (wl == 0) {
        float b0, b1, g0, g1; mls_gates(p, li, t0, h, lane, b0, b1, g0, g1);
        const float p1 = fmaxf(g0, g1); float v = p1;
#pragma unroll
        for (int o = 1; o < 64; o <<= 1) { const float u = __shfl_up(v, o); if (lane >= o) v = fmaxf(v, u); }
        const float prev = __shfl_up(v, 1);
        const float ex = (lane == 0) ? -INFINITY : prev;
        bb[2 * lane] = b0; bb[2 * lane + 1] = b1; gg[2 * lane] = g0; gg[2 * lane + 1] = g1;
        pm[2 * lane] = fmaxf(ex, g0); pm[2 * lane + 1] = fmaxf(ex, p1);
    }
    stage_vext(Z + (size_t)t0 * ZW + C_MV + h * 64, Vs, tidU);
    stage_copy((const bf16*)p.out + (size_t)t0 * 512 + 256 + h * 64, 512, Ks, 128, 128, 8, tidU);
    stage_copy((const bf16*)p.out + (size_t)t0 * 512 + h * 64, 512, Qs, 128, 128, 8, tidU);
#pragma unroll
    for (int task = tidU; task < 96 * 8; task += 256) {
        const int row = task >> 3, cc = task & 7;
        const float* src = (row < 64) ? (MC + (size_t)unit * 4096 + row * 64 + 8 * cc) : (MN + (size_t)unit * 64 + 8 * cc);
        const f32x4 x0 = *(const f32x4*)src, x1 = *(const f32x4*)(src + 4);
        const float ok = (row <= 64) ? 1.0f : 0.0f;
        const float v[8] = {x0[0] * ok, x0[1] * ok, x0[2] * ok, x0[3] * ok, x1[0] * ok, x1[1] * ok, x1[2] * ok, x1[3] * ok};
        *(LAS u32x4*)(Cs + row * 128 + swz16(row, cc)) = pack8(v);
    }
    const float mprev = MMP[unit];
    __syncthreads();
    RGN_T1(4, ldsU)
    RGN_T0(5)
    const int t = 32 * wl + r32, tok = t0 + t;
    const float Mt = fmaxf(mprev, pm[t]), bt = bb[t];
    const float winter = __expf(mprev - Mt);
    bf16x8_t qf[4];
#pragma unroll
    for (int ks = 0; ks < 4; ++ks) qf[ks] = frag_row(Qs, 128, t, 2 * ks + hh);
    f32x16 o[3];
#pragma unroll
    for (int dt = 0; dt < 3; ++dt) {
        f32x16 a = F16Z;
#pragma unroll
        for (int ks = 0; ks < 4; ++ks) a = __builtin_amdgcn_mfma_f32_32x32x16_bf16(frag_row(Cs, 128, 32 * dt + r32, 2 * ks + hh), qf[ks], a, 0, 0, 0);
#pragma unroll
        for (int rg = 0; rg < 16; ++rg) a[rg] *= winter;
        o[dt] = a;
    }
#pragma unroll 1
    for (int tl = 0; tl <= wl; ++tl) {
        {
            f32x16 st = F16Z;
#pragma unroll
            for (int ks = 0; ks < 4; ++ks) st = __builtin_amdgcn_mfma_f32_32x32x16_bf16(frag_row(Ks, 128, 32 * tl + r32, 2 * ks + hh), qf[ks], st, 0, 0, 0);
#pragma unroll
            for (int g4 = 0; g4 < 4; ++g4) {
                const int sb = 32 * tl + 8 * g4 + 4 * hh;
                const f32x4 gv = *(const LAS f32x4*)(gg + sb);
#pragma unroll
                for (int j = 0; j < 4; ++j) st[4 * g4 + j] = (sb + j <= t) ? st[4 * g4 + j] * __expf(gv[j] - Mt) : 0.f;
            }
#pragma unroll
            for (int s2 = 0; s2 < 2; ++s2) {
                u32x4 pw; pw.x = cvtpk(st[8 * s2 + 0], st[8 * s2 + 1]); pw.y = cvtpk(st[8 * s2 + 2], st[8 * s2 + 3]); pw.z = cvtpk(st[8 * s2 + 4], st[8 * s2 + 5]); pw.w = cvtpk(st[8 * s2 + 6], st[8 * s2 + 7]);
                const bf16x8_t pb = __builtin_bit_cast(bf16x8_t, pw);
#pragma unroll
                for (int dt = 0; dt < 3; ++dt) o[dt] = __builtin_amdgcn_mfma_f32_32x32x16_bf16(frag_tr<true>(Vs, 256, 32 * tl + 16 * s2, 32 * dt, lane), pb, o[dt], 0, 0, 0);
            }
        }
    }
    RGN_T1(5, ldsU)
    RGN_T0(6)
    const float den = __shfl(o[2][0], r32);
    const float rden = 1.0f / fmaxf(fabsf(den), __expf(-(bt + Mt)));
    float sum = 0.f, sq = 0.f;
#pragma unroll
    for (int dt = 0; dt < 2; ++dt)
#pragma unroll
        for (int rg = 0; rg < 16; ++rg) { o[dt][rg] *= rden; sum += o[dt][rg]; sq += o[dt][rg] * o[dt][rg]; }
    sum += __shfl_xor(sum, 32); sq += __shfl_xor(sq, 32);
    const float mean = sum * (1.0f / 64.0f);
    const float rstd = 1.0f / sqrtf(fmaxf(sq * (1.0f / 64.0f) - mean * mean, 0.f) + LN_EPS);
    __syncthreads();
#pragma unroll
    for (int dt = 0; dt < 2; ++dt)
#pragma unroll
        for (int g4 = 0; g4 < 4; ++g4) {
            const int d = 32 * dt + 8 * g4 + 4 * hh;
            const f32x4 gn = *(const f32x4*)(p.mls_g + li * 256 + h * 64 + d);
            epi_stage_put(Ks + 4096 * wl, r32, d, (o[dt][4 * g4 + 0] - mean) * rstd * gn[0], (o[dt][4 * g4 + 1] - mean) * rstd * gn[1], (o[dt][4 * g4 + 2] - mean) * rstd * gn[2], (o[dt][4 * g4 + 3] - mean) * rstd * gn[3]);
        }
    asm volatile("s_waitcnt lgkmcnt(0)" ::: "memory");
#pragma unroll
    for (int j = 0; j < 4; ++j) {
        const int idx = lane + 64 * j, row = idx >> 3, cc = idx & 7;
        float yv[8], gv[8]; unpack8v(*(const LAS u32x4*)(Ks + 4096 * wl + row * 128 + swz16(row, cc)), yv);
        const size_t tk = (size_t)(t0 + 32 * wl + row);
        unpack8v(*(const u32x4*)(Z + tk * ZW + C_MO + h * 64 + 8 * cc), gv);
#pragma unroll
        for (int e = 0; e < 8; ++e) yv[e] *= sigmoidf_(gv[e]);
        *(u32x4*)(MIX + tk * DM + 768 + h * 64 + 8 * cc) = pack8(yv);
    }
    __syncthreads();
    RGN_T1(6, ldsU)
}

__device__ __forceinline__ void p3_scans(const Params& p) {
    float* RST = (float*)(p.ws + WS_RST);
    float* MC = (float*)(p.ws + WS_MC); float* MN = (float*)(p.ws + WS_MN); const float* MA = (const float*)(p.ws + WS_MA); const float* MML = (const float*)(p.ws + WS_MML); float* MMP = (float*)(p.ws + WS_MMP);
    const int gt = blockIdx.x * NTHR + threadIdx.x, GT = gridDim.x * NTHR;
    for (int e = gt; e < 16 * 8192; e += GT) {
        const int bh = e >> 13, el = e & 8191, h = bh & 3;
        const float gL = expf(ret_lg(h) * 128.0f);
        float R = 0.f;
        float* ptr = RST + (size_t)bh * 64 * 8192 + el;
#pragma unroll 1
        for (int cb = 0; cb < 64; cb += 16) {
            float sv[16];
#pragma unroll
            for (int j = 0; j < 16; ++j) sv[j] = ptr[(size_t)(cb + j) * 8192];
#pragma unroll
            for (int j = 0; j < 16; ++j) { ptr[(size_t)(cb + j) * 8192] = R; R = fmaf(gL, R, sv[j]); }
        }
    }
    for (int e = gt; e < 16 * 4160; e += GT) {
        const int bh = e / 4160, el = e - bh * 4160;
        float* ptr; size_t stride;
        if (el < 4096) { ptr = MC + (size_t)bh * 64 * 4096 + el; stride = 4096; } else { ptr = MN + (size_t)bh * 64 * 64 + (el - 4096); stride = 64; }
        float m = 0.f, C = 0.f;
#pragma unroll 1
        for (int cb = 0; cb < 64; cb += 16) {
            float sv[16], av[16], mlv[16];
#pragma unroll
            for (int j = 0; j < 16; ++j) { sv[j] = ptr[(size_t)(cb + j) * stride]; av[j] = MA[bh * 64 + cb + j]; mlv[j] = MML[bh * 64 + cb + j]; }
#pragma unroll
            for (int j = 0; j < 16; ++j) {
                const float mn = fmaxf(av[j] + m, mlv[j]);
                const float f1 = __expf(av[j] + m - mn), f2 = __expf(mlv[j] - mn);
                ptr[(size_t)(cb + j) * stride] = C; C = f1 * C + f2 * sv[j];
                if (el == 0) MMP[bh * 64 + cb + j] = m;
                m = mn;
            }
        }
    }
}


template <int NB>
__device__ __forceinline__ void ln_rows(const bf16* U, bf16* XBo, signed char* XQ, float* XS, int r0, int rstep, const float* g, const float* bta, int lane) {
    float4 v[NB][4]; float s[NB];
#pragma unroll
    for (int u = 0; u < NB; ++u) { const int r = (r0 + u * rstep < NT) ? r0 + u * rstep : r0; const bf16* row = U + (size_t)r * DM; s[u] = 0.f;
#pragma unroll
        for (int j = 0; j < 4; ++j) { const uint2 ub = *(const uint2*)(row + 256 * j + 4 * lane); v[u][j] = make_float4(__uint_as_float(ub.x << 16), __uint_as_float(ub.x & 0xffff0000u), __uint_as_float(ub.y << 16), __uint_as_float(ub.y & 0xffff0000u)); } }
    float4 gg[4], bv[4];
#pragma unroll
    for (int j = 0; j < 4; ++j) { gg[j] = *(const float4*)(g + 256 * j + 4 * lane); bv[j] = *(const float4*)(bta + 256 * j + 4 * lane); }
#pragma unroll
    for (int u = 0; u < NB; ++u)
#pragma unroll
        for (int j = 0; j < 4; ++j) s[u] += (v[u][j].x + v[u][j].y) + (v[u][j].z + v[u][j].w);
#pragma unroll
    for (int o = 1; o < 64; o <<= 1)
#pragma unroll
        for (int u = 0; u < NB; ++u) s[u] += __shfl_xor(s[u], o);
    float s2[NB];
#pragma unroll
    for (int u = 0; u < NB; ++u) { const float mean = s[u] * (1.0f / DM); s2[u] = 0.f;
#pragma unroll
        for (int j = 0; j < 4; ++j) { v[u][j].x -= mean; v[u][j].y -= mean; v[u][j].z -= mean; v[u][j].w -= mean; s2[u] += (v[u][j].x * v[u][j].x + v[u][j].y * v[u][j].y) + (v[u][j].z * v[u][j].z + v[u][j].w * v[u][j].w); } }
#pragma unroll
    for (int o = 1; o < 64; o <<= 1)
#pragma unroll
        for (int u = 0; u < NB; ++u) s2[u] += __shfl_xor(s2[u], o);
    float am[NB];
#pragma unroll
    for (int u = 0; u < NB; ++u) { const float rstd = 1.0f / sqrtf(s2[u] * (1.0f / DM) + LN_EPS); const int r = r0 + u * rstep; am[u] = 0.f;
#pragma unroll
        for (int j = 0; j < 4; ++j) {
            const float4 o = make_float4(v[u][j].x * rstd * gg[j].x + bv[j].x, v[u][j].y * rstd * gg[j].y + bv[j].y, v[u][j].z * rstd * gg[j].z + bv[j].z, v[u][j].w * rstd * gg[j].w + bv[j].w);
            if (r < NT) *(uint2*)(XBo + (size_t)r * DM + 256 * j + 4 * lane) = make_uint2(pk2(o.x, o.y), pk2(o.z, o.w));
            v[u][j] = o; am[u] = fmaxf(am[u], fmaxf(fmaxf(fabsf(o.x), fabsf(o.y)), fmaxf(fabsf(o.z), fabsf(o.w))));
        } }
#pragma unroll
    for (int o = 1; o < 64; o <<= 1)
#pragma unroll
        for (int u = 0; u < NB; ++u) am[u] = fmaxf(am[u], __shfl_xor(am[u], o));
#pragma unroll
    for (int u = 0; u < NB; ++u) {
        const int r = r0 + u * rstep;
        if (r < NT) {
            const float inv = am[u] > 0.f ? 127.0f / am[u] : 0.f; signed char* qrow = XQ + (size_t)r * DM;
#pragma unroll
            for (int j = 0; j < 4; ++j) {
                const unsigned q0 = (unsigned)__float2int_rn(v[u][j].x * inv) & 0xffu, q1 = (unsigned)__float2int_rn(v[u][j].y * inv) & 0xffu, q2 = (unsigned)__float2int_rn(v[u][j].z * inv) & 0xffu, q3 = (unsigned)__float2int_rn(v[u][j].w * inv) & 0xffu;
                *(unsigned*)(qrow + 256 * j + 4 * lane) = q0 | (q1 << 8) | (q2 << 16) | (q3 << 24);
            }
            if (lane == 0) XS[r] = am[u] * (1.0f / 127.0f);
        }
    }
}


__device__ __forceinline__ float key_embed(float v, unsigned idx, unsigned keepmask) { return __uint_as_float((__float_as_uint(v) & keepmask) | idx); }

template <int N>
__device__ __forceinline__ void bitonic_desc(float (&a)[N]) {
#pragma unroll
    for (int k = 2; k <= N; k <<= 1)
#pragma unroll
        for (int j = k >> 1; j > 0; j >>= 1)
#pragma unroll
            for (int i = 0; i < N; ++i) {
                const int l = i ^ j;
                if (l > i) { const float hi = fmaxf(a[i], a[l]), lo = fminf(a[i], a[l]); if ((i & k) == 0) { a[i] = hi; a[l] = lo; } else { a[i] = lo; a[l] = hi; } }
            }
}
__device__ __forceinline__ void merge_top16(float (&a)[16], const float (&b)[16]) {
#pragma unroll
    for (int i = 0; i < 16; ++i) a[i] = fmaxf(a[i], b[15 - i]);
#pragma unroll
    for (int j = 8; j > 0; j >>= 1)
#pragma unroll
        for (int i = 0; i < 16; ++i) { const int l = i ^ j; if (l > i) { const float hi = fmaxf(a[i], a[l]), lo = fminf(a[i], a[l]); a[i] = hi; a[l] = lo; } }
}
__device__ __forceinline__ void topk_half(const bf16x8_t (&qf)[8], const LAS unsigned char* kl, int r32, int hh, float (&out)[16]) {
    f32x16 st[4];
#pragma unroll
    for (int tl = 0; tl < 4; ++tl) {
        f32x16 a16 = {0.f, 0.f, 0.f, 0.f, 0.f, 0.f, 0.f, 0.f, 0.f, 0.f, 0.f, 0.f, 0.f, 0.f, 0.f, 0.f};
        const int n = 32 * tl + r32;
#pragma unroll
        for (int ks = 0; ks < 8; ++ks) {
            const int c = 8 * hh + ks;
            const bf16x8_t kf = *(const LAS bf16x8_t*)(kl + n * 256 + ((c ^ (n & 15)) << 4));
            a16 = __builtin_amdgcn_mfma_f32_32x32x16_bf16(kf, qf[ks], a16, 0, 0, 0);
        }
        st[tl] = a16;
    }
#pragma unroll
    for (int tl = 0; tl < 4; ++tl)
#pragma unroll
        for (int rg = 0; rg < 16; ++rg) st[tl][rg] = key_embed(st[tl][rg], (unsigned)(32 * tl + (rg & 3) + 8 * (rg >> 2)) | ((unsigned)hh << 2), 0xffffff80u);
    float g0[16], g1[16], g2[16], g3[16];
#pragma unroll
    for (int rg = 0; rg < 16; ++rg) { g0[rg] = st[0][rg]; g1[rg] = st[1][rg]; g2[rg] = st[2][rg]; g3[rg] = st[3][rg]; }
    bitonic_desc<16>(g0); bitonic_desc<16>(g1); bitonic_desc<16>(g2); bitonic_desc<16>(g3);
    merge_top16(g0, g1); merge_top16(g2, g3); merge_top16(g0, g2);
#pragma unroll
    for (int i = 0; i < 16; ++i) g1[i] = __shfl_xor(g0[i], 32);
    merge_top16(g0, g1);
#pragma unroll
    for (int i = 0; i < 16; ++i) out[i] = g0[i];
}

__device__ __forceinline__ void topk_unit(const Params& p, int li, int item, LAS unsigned char* lds) {
    const int tid = threadIdx.x, lane = tid & 63, wave = __builtin_amdgcn_readfirstlane(tid >> 6);
    const int r32 = lane & 31, hh = lane >> 5;
    const int tile = item >> 3, h = item & 7;
    const int t = tile * 256 + 32 * wave + r32;
    const bf16* QRY = (const bf16*)(p.ws + WS_QRY);
    const bf16* KB = (const bf16*)(p.ws + WS_KEYS) + (size_t)((li * 8 + h) * 2) * 128 * 128;
    int* RI = (int*)(p.ws + WS_RI); float* RG = (float*)(p.ws + WS_RG);
    RGN_T0(10)
    bf16x8_t qfA[8], qfB[8];
#pragma unroll
    for (int ks = 0; ks < 8; ++ks) { qfA[ks] = *(const bf16x8_t*)(QRY + (size_t)t * 2048 + h * 256 + 64 * hh + 8 * ks); qfB[ks] = *(const bf16x8_t*)(QRY + (size_t)t * 2048 + h * 256 + 128 + 64 * hh + 8 * ks); }
#pragma unroll 4
    for (int idx = tid; idx < 2 * 128 * 16; idx += NTHR) {
        const int pp = idx >> 11, n = (idx >> 4) & 127, c = idx & 15;
        const u32x4 v = *(const u32x4*)(KB + (size_t)(pp * 128 + n) * 128 + c * 8);
        *(LAS u32x4*)(lds + pp * 32768 + n * 256 + ((c ^ (n & 15)) << 4)) = v;
    }
    __syncthreads();
    RGN_T1(10, lds)
    RGN_T0(11)
    float sk0[16], sk1[16];
    topk_half(qfA, lds, r32, hh, sk0);
    RGN_T1(11, lds)
    RGN_T0(12)
    topk_half(qfB, lds + 32768, r32, hh, sk1);
    RGN_T1(12, lds)
    RGN_T0(13)
    unsigned i1s[16], i2[16];
#pragma unroll
    for (int a = 0; a < 16; ++a) { i1s[a] = (__float_as_uint(sk0[a]) & 127u) << 7; i2[a] = __float_as_uint(sk1[a]) & 127u; }
    float cd[50];
    {
        constexpr int CA[50] = {0, 0, 0, 0, 0, 0, 0, 0, 0, 0, 0, 0, 0, 0, 0, 0, 1, 1, 1, 1, 1, 1, 1, 1, 2, 2, 2, 2, 2, 3, 3, 3, 3, 4, 4, 4, 5, 5, 6, 6, 7, 7, 8, 9, 10, 11, 12, 13, 14, 15};
        constexpr int CB[50] = {0, 1, 2, 3, 4, 5, 6, 7, 8, 9, 10, 11, 12, 13, 14, 15, 0, 1, 2, 3, 4, 5, 6, 7, 0, 1, 2, 3, 4, 0, 1, 2, 3, 0, 1, 2, 0, 1, 0, 1, 0, 1, 0, 0, 0, 0, 0, 0, 0, 0};
#pragma unroll
        for (int n = 0; n < 50; ++n) cd[n] = key_embed(sk0[CA[n]] + sk1[CB[n]], i1s[CA[n]] | i2[CB[n]], 0xffffc000u);
    }
    float sel[16], h1[16], h2[16], h3[16];
#pragma unroll
    for (int i = 0; i < 16; ++i) { sel[i] = cd[i]; h1[i] = cd[16 + i]; h2[i] = cd[32 + i]; h3[i] = -INFINITY; }
    h3[0] = fmaxf(cd[48], cd[49]); h3[1] = fminf(cd[48], cd[49]);
    bitonic_desc<16>(sel); bitonic_desc<16>(h1); bitonic_desc<16>(h2);
    merge_top16(sel, h1); merge_top16(h2, h3); merge_top16(sel, h2);
    float ev[16], es = 0.f;
    const float m0 = __uint_as_float((__float_as_uint(sel[0]) & 0xffffc000u) | 0x2000u);
#pragma unroll
    for (int k = 0; k < 16; ++k) { const float vk = __uint_as_float((__float_as_uint(sel[k]) & 0xffffc000u) | 0x2000u); ev[k] = __expf(vk - m0); es += ev[k]; }
    const float rs = 1.0f / es;
    int oi[8]; float og[8];
#pragma unroll
    for (int k = 0; k < 8; ++k) { float s_lo = sel[k], s_hi = sel[k + 8], g_lo = ev[k], g_hi = ev[k + 8]; asm volatile("" : "+v"(s_lo), "+v"(s_hi), "+v"(g_lo), "+v"(g_hi));
        const float sv = hh ? s_hi : s_lo; const float gv = hh ? g_hi : g_lo; oi[k] = (int)(__float_as_uint(sv) & 0x3fffu); og[k] = gv * rs; }
    int* rip = RI + (size_t)t * 128 + h * 16 + 8 * hh; float* rgp = RG + (size_t)t * 128 + h * 16 + 8 * hh;
    *(int4*)rip = make_int4(oi[0], oi[1], oi[2], oi[3]); *(int4*)(rip + 4) = make_int4(oi[4], oi[5], oi[6], oi[7]);
    *(float4*)rgp = make_float4(og[0], og[1], og[2], og[3]); *(float4*)(rgp + 4) = make_float4(og[4], og[5], og[6], og[7]);
    __syncthreads();
    RGN_T1(13, lds)
}

template <bool SIGNED>
__device__ __forceinline__ void quant_rows(const float* src, unsigned char* dst, float* scl, int lane, int gw, int NGW) {
    for (int r0 = gw; r0 < 16384; r0 += 2 * NGW) {
        float4 a[2][4]; float am[2];
#pragma unroll
        for (int u = 0; u < 2; ++u) { const int r = (r0 + u * NGW < 16384) ? r0 + u * NGW : r0; const float4* s4 = (const float4*)(src + (size_t)r * 1024 + 16 * lane);
#pragma unroll
            for (int j = 0; j < 4; ++j) a[u][j] = s4[j]; }
#pragma unroll
        for (int u = 0; u < 2; ++u) { float m = 0.f;
#pragma unroll
            for (int j = 0; j < 4; ++j) m = fmaxf(m, fmaxf(fmaxf(fabsf(a[u][j].x), fabsf(a[u][j].y)), fmaxf(fabsf(a[u][j].z), fabsf(a[u][j].w))));
            am[u] = m; }
#pragma unroll
        for (int o = 1; o < 64; o <<= 1) { am[0] = fmaxf(am[0], __shfl_xor(am[0], o)); am[1] = fmaxf(am[1], __shfl_xor(am[1], o)); }
#pragma unroll
        for (int u = 0; u < 2; ++u) {
            const int r = r0 + u * NGW;
            if (r < 16384) {
                const float inv = am[u] > 0.f ? 127.0f / am[u] : 0.f;
                unsigned w[4];
#pragma unroll
                for (int j = 0; j < 4; ++j) {
                    constexpr int OFS = SIGNED ? 0 : 128;
                    const unsigned q0 = (unsigned)(__float2int_rn(a[u][j].x * inv) + OFS) & 0xffu, q1 = (unsigned)(__float2int_rn(a[u][j].y * inv) + OFS) & 0xffu, q2 = (unsigned)(__float2int_rn(a[u][j].z * inv) + OFS) & 0xffu, q3 = (unsigned)(__float2int_rn(a[u][j].w * inv) + OFS) & 0xffu;
                    w[j] = q0 | (q1 << 8) | (q2 << 16) | (q3 << 24);
                }
                *(uint4*)(dst + (size_t)(lane >> 3) * (16384 * 128) + (size_t)r * 128 + 16 * (lane & 7)) = make_uint4(w[0], w[1], w[2], w[3]);
                if (lane == 0) scl[r] = am[u] * (1.0f / 127.0f);
            }
        }
    }
}

__device__ __forceinline__ void ub4(unsigned w, float* o) { o[0] = (float)(w & 0xffu); o[1] = (float)((w >> 8) & 0xffu); o[2] = (float)((w >> 16) & 0xffu); o[3] = (float)(w >> 24); }


struct SlicePlan { int m, mi, wid, wstride; };
__device__ __forceinline__ SlicePlan slice_plan(const Params& p, unsigned rank, int wave) {
    unsigned* bar = (unsigned*)(p.ws + WS_CTL) + 1024;
    const unsigned x = xb_xcc_id();
    SlicePlan sp; sp.m = 0; sp.mi = 0; int nloc = 1;
#pragma unroll
    for (unsigned j = 0; j < 16; ++j) { const unsigned c = xb_ld(&bar[XB_XCNT(j)]); if (j == x) { sp.mi = sp.m; nloc = (int)c; } if (c > 0u) ++sp.m; }
    sp.wid = (int)rank * NWAVE + wave; sp.wstride = nloc * NWAVE;
    return sp;
}
#define PEER_TPW 16
__device__ __forceinline__ int peer_tok(int n, int wid, int wstride) { return ((n >> 4) * wstride + wid) * PEER_TPW + (n & 15); }
__device__ __forceinline__ void peer_u_slice(const Params& p, int xs, int wid, int wstride, int lane) {
    const int* RI = (const int*)(p.ws + WS_RI);
    const signed char* X1Q = (const signed char*)(p.ws + WS_X1Q); const signed char* UQ = (const signed char*)(p.ws + WS_UQ);
    int* PI = (int*)(p.ws + WS_PI) + (size_t)xs * NT * 128;
    const int g = lane >> 3, q = lane & 7, loff = 128 * xs + 16 * q;
    const signed char* UQs = UQ + (size_t)xs * (16384 * 128) + 16 * q;
    const int ngrp = (NT / PEER_TPW - wid + wstride - 1) / wstride, N = ngrp * PEER_TPW;
    if (N <= 0) return;
    int eA[16], eB[16]; int4 uA[16], uB[16]; int4 x0, x1, x2, x3;
#define PU_E(E, X, t) do { const int4* rp_ = (const int4*)(RI + (size_t)(t) * 128 + 16 * g); X = *(const int4*)(X1Q + (size_t)(t) * DM + loff); _Pragma("unroll") for (int b4 = 0; b4 < 4; ++b4) { const int4 r_ = rp_[b4]; E[4 * b4] = r_.x; E[4 * b4 + 1] = r_.y; E[4 * b4 + 2] = r_.z; E[4 * b4 + 3] = r_.w; } } while (0)
#define PU_U(U, E) do { _Pragma("unroll") for (int bt = 0; bt < 16; ++bt) U[bt] = *(const int4*)(UQs + (size_t)E[bt] * 128); } while (0)
#define PU_C(U, X, t) do { _Pragma("unroll") for (int b4 = 0; b4 < 4; ++b4) { int dd_[4]; _Pragma("unroll") for (int b1 = 0; b1 < 4; ++b1) { const int bt = 4 * b4 + b1; \
        int d = __builtin_amdgcn_sdot4(X.x, U[bt].x, 0, false); d = __builtin_amdgcn_sdot4(X.y, U[bt].y, d, false); d = __builtin_amdgcn_sdot4(X.z, U[bt].z, d, false); d = __builtin_amdgcn_sdot4(X.w, U[bt].w, d, false); \
        d += __shfl_xor(d, 1); d += __shfl_xor(d, 2); d += __shfl_xor(d, 4); dd_[b1] = d; } \
        if (q == 0) *((int4*)(PI + (size_t)(t) * 128 + 16 * g) + b4) = make_int4(dd_[0], dd_[1], dd_[2], dd_[3]); } } while (0)
#define TK(n) peer_tok((n), wid, wstride)
#define PU_FENCE() asm volatile("" ::: "memory")
    PU_E(eA, x0, TK(0)); PU_E(eB, x1, TK(1)); PU_U(uA, eA); PU_E(eA, x2, TK(2));
#pragma unroll 1
    for (int i = 0; i < N; i += 4) {
        PU_U(uB, eB);                  if (i + 3 < N) PU_E(eB, x3, TK(i + 3)); PU_FENCE(); PU_C(uA, x0, TK(i));
        if (i + 2 < N) PU_U(uA, eA);   if (i + 4 < N) PU_E(eA, x0, TK(i + 4)); PU_FENCE(); PU_C(uB, x1, TK(i + 1));
        if (i + 3 < N) PU_U(uB, eB);   if (i + 5 < N) PU_E(eB, x1, TK(i + 5)); PU_FENCE(); PU_C(uA, x2, TK(i + 2));
        if (i + 4 < N) PU_U(uA, eA);   if (i + 6 < N) PU_E(eA, x2, TK(i + 6)); PU_FENCE(); PU_C(uB, x3, TK(i + 3));
    }
#undef PU_E
#undef PU_U
#undef PU_C
#undef PU_FENCE
}
__device__ __forceinline__ void peer_coef_tokens2(const Params& p, int t0, int t1, int lane) {
    const int* RI = (const int*)(p.ws + WS_RI); const float* RG = (const float*)(p.ws + WS_RG);
    const float* US = (const float*)(p.ws + WS_US); const float* VS = (const float*)(p.ws + WS_VS);
    const int* PI = (const int*)(p.ws + WS_PI);
    signed char* PC = (signed char*)(p.ws + WS_PC); float* PCS = (float*)(p.ws + WS_PCS);
    int e[2][2], acc[2][2]; float rg[2][2], sx[2];
#pragma unroll
    for (int u = 0; u < 2; ++u) { const int t = u ? t1 : t0; sx[u] = ((const float*)(p.ws + WS_X1S))[t];
#pragma unroll
        for (int hf = 0; hf < 2; ++hf) { const int k = lane + 64 * hf; e[u][hf] = RI[(size_t)t * 128 + k]; rg[u][hf] = RG[(size_t)t * 128 + k]; int a = 0;
#pragma unroll
            for (int x = 0; x < 8; ++x) a += PI[((size_t)x * NT + t) * 128 + k];
            acc[u][hf] = a; } }
    float su[2][2], sv[2][2];
#pragma unroll
    for (int u = 0; u < 2; ++u)
#pragma unroll
        for (int hf = 0; hf < 2; ++hf) { su[u][hf] = US[e[u][hf]]; sv[u][hf] = VS[e[u][hf]]; }
    float c[2][2], cm[2];
#pragma unroll
    for (int u = 0; u < 2; ++u) {
#pragma unroll
        for (int hf = 0; hf < 2; ++hf) { const float dot = su[u][hf] * sx[u] * (float)acc[u][hf]; c[u][hf] = 0.5f * dot * (1.0f + erff(dot * 0.70710678118f)) * rg[u][hf] * sv[u][hf]; }
        cm[u] = fmaxf(fabsf(c[u][0]), fabsf(c[u][1])); }
#pragma unroll
    for (int o = 1; o < 64; o <<= 1) { cm[0] = fmaxf(cm[0], __shfl_xor(cm[0], o)); cm[1] = fmaxf(cm[1], __shfl_xor(cm[1], o)); }
#pragma unroll
    for (int u = 0; u < 2; ++u) {
        if (u == 0 || t1 != t0) {
            const int t = u ? t1 : t0; const float inv = cm[u] > 0.f ? 127.0f / cm[u] : 0.f;
            PC[(size_t)t * 128 + lane] = (signed char)__float2int_rn(c[u][0] * inv);
            PC[(size_t)t * 128 + 64 + lane] = (signed char)__float2int_rn(c[u][1] * inv);
            if (lane == 0) PCS[t] = cm[u] * (1.0f / 127.0f);
        }
    }
}
__device__ __forceinline__ void peer_v_token(const uint4 (&vq)[16], const int4 cq, float cscale, bf16* yrow, int lane) {
    int acc[16];
#pragma unroll
    for (int j = 0; j < 16; ++j) acc[j] = 0;
    const int c4[4] = {cq.x, cq.y, cq.z, cq.w};
#pragma unroll
    for (int b4 = 0; b4 < 4; ++b4) {
#pragma unroll
        for (int dc = 0; dc < 4; ++dc) {
            const unsigned w0 = dc == 0 ? vq[4 * b4].x : dc == 1 ? vq[4 * b4].y : dc == 2 ? vq[4 * b4].z : vq[4 * b4].w;
            const unsigned w1 = dc == 0 ? vq[4 * b4 + 1].x : dc == 1 ? vq[4 * b4 + 1].y : dc == 2 ? vq[4 * b4 + 1].z : vq[4 * b4 + 1].w;
            const unsigned w2 = dc == 0 ? vq[4 * b4 + 2].x : dc == 1 ? vq[4 * b4 + 2].y : dc == 2 ? vq[4 * b4 + 2].z : vq[4 * b4 + 2].w;
            const unsigned w3 = dc == 0 ? vq[4 * b4 + 3].x : dc == 1 ? vq[4 * b4 + 3].y : dc == 2 ? vq[4 * b4 + 3].z : vq[4 * b4 + 3].w;
            const unsigned t0 = __builtin_amdgcn_perm(w1, w0, 0x05010400u), t1 = __builtin_amdgcn_perm(w1, w0, 0x07030602u);
            const unsigned t2 = __builtin_amdgcn_perm(w3, w2, 0x05010400u), t3 = __builtin_amdgcn_perm(w3, w2, 0x07030602u);
            const unsigned f0 = __builtin_amdgcn_perm(t2, t0, 0x05040100u), f1 = __builtin_amdgcn_perm(t2, t0, 0x07060302u);
            const unsigned f2 = __builtin_amdgcn_perm(t3, t1, 0x05040100u), f3 = __builtin_amdgcn_perm(t3, t1, 0x07060302u);
            acc[4 * dc + 0] = __builtin_amdgcn_sdot4((int)f0, c4[b4], acc[4 * dc + 0], false);
            acc[4 * dc + 1] = __builtin_amdgcn_sdot4((int)f1, c4[b4], acc[4 * dc + 1], false);
            acc[4 * dc + 2] = __builtin_amdgcn_sdot4((int)f2, c4[b4], acc[4 * dc + 2], false);
            acc[4 * dc + 3] = __builtin_amdgcn_sdot4((int)f3, c4[b4], acc[4 * dc + 3], false);
        }
    }
#pragma unroll
    for (int j = 0; j < 8; ++j) { const bool up = (lane & 32) != 0; const int send = up ? acc[j] : acc[j + 8]; const int keep = up ? acc[j + 8] : acc[j]; acc[j] = keep + __shfl_xor(send, 32); }
#pragma unroll
    for (int j = 0; j < 4; ++j) { const bool up = (lane & 16) != 0; const int send = up ? acc[j] : acc[j + 4]; const int keep = up ? acc[j + 4] : acc[j]; acc[j] = keep + __shfl_xor(send, 16); }
#pragma unroll
    for (int j = 0; j < 2; ++j) { const bool up = (lane & 8) != 0; const int send = up ? acc[j] : acc[j + 2]; const int keep = up ? acc[j + 2] : acc[j]; acc[j] = keep + __shfl_xor(send, 8); }
    const int j0 = 2 * ((lane >> 3) & 1) + 4 * ((lane >> 4) & 1) + 8 * ((lane >> 5) & 1);
    *(unsigned*)(yrow + j0) = pk2((float)acc[0] * cscale, (float)acc[1] * cscale);
}
__device__ __forceinline__ void peer_v_slice(const Params& p, int xs, int wid, int wstride, int lane) {
    const int* RI = (const int*)(p.ws + WS_RI);
    const unsigned char* VQ = (const unsigned char*)(p.ws + WS_VQ);
    const signed char* PC = (const signed char*)(p.ws + WS_PC); const float* PCS = (const float*)(p.ws + WS_PCS);
    bf16* Y = (bf16*)(p.ws + WS_Y);
    const int g = lane >> 3, q = lane & 7, loff = 128 * xs + 16 * q;
    const unsigned char* VQs = VQ + (size_t)xs * (16384 * 128) + 16 * q;
    const int ngrp = (NT / PEER_TPW - wid + wstride - 1) / wstride, N = ngrp * PEER_TPW;
    if (N <= 0) return;
    int eA[16], eB[16]; uint4 vA[16], vB[16]; int4 c0, c1, c2, c3; float o0, o1, o2, o3;
#define PV_E(E, C, O, t) do { const int4* rp_ = (const int4*)(RI + (size_t)(t) * 128 + 16 * g); C = *(const int4*)(PC + (size_t)(t) * 128 + 16 * g); O = PCS[(t)]; _Pragma("unroll") for (int b4 = 0; b4 < 4; ++b4) { const int4 r_ = rp_[b4]; E[4 * b4] = r_.x; E[4 * b4 + 1] = r_.y; E[4 * b4 + 2] = r_.z; E[4 * b4 + 3] = r_.w; } } while (0)
#define PV_U(V, E) do { _Pragma("unroll") for (int bt = 0; bt < 16; ++bt) V[bt] = *(const uint4*)(VQs + (size_t)E[bt] * 128); } while (0)
#define PV_C(V, C, O, t) peer_v_token(V, C, O, Y + (size_t)(t) * DM + loff, lane)
#define PV_FENCE() asm volatile("" ::: "memory")
    PV_E(eA, c0, o0, TK(0)); PV_E(eB, c1, o1, TK(1)); PV_U(vA, eA); PV_E(eA, c2, o2, TK(2));
#pragma unroll 1
    for (int i = 0; i < N; i += 4) {
        PV_U(vB, eB);                  if (i + 3 < N) PV_E(eB, c3, o3, TK(i + 3)); PV_FENCE(); PV_C(vA, c0, o0, TK(i));
        if (i + 2 < N) PV_U(vA, eA);   if (i + 4 < N) PV_E(eA, c0, o0, TK(i + 4)); PV_FENCE(); PV_C(vB, c1, o1, TK(i + 1));
        if (i + 3 < N) PV_U(vB, eB);   if (i + 5 < N) PV_E(eB, c1, o1, TK(i + 5)); PV_FENCE(); PV_C(vA, c2, o2, TK(i + 2));
        if (i + 4 < N) PV_U(vA, eA);   if (i + 6 < N) PV_E(eA, c2, o2, TK(i + 6)); PV_FENCE(); PV_C(vB, c3, o3, TK(i + 3));
    }
#undef PV_E
#undef PV_U
#undef PV_C
#undef PV_FENCE
#undef TK
}
__device__ __forceinline__ void up4(const uint2 w, float* o) { o[0] = __uint_as_float(w.x << 16); o[1] = __uint_as_float(w.x & 0xffff0000u); o[2] = __uint_as_float(w.y << 16); o[3] = __uint_as_float(w.y & 0xffff0000u); }
template <int NB>
__device__ __forceinline__ void peer_ln_tokens(const Params& p, int li, int t0, int tstep, int lane) {
    const bf16* E = (const bf16*)(p.ws + WS_E); bf16* XB = (bf16*)(p.ws + WS_XB); const bf16* Y = (const bf16*)(p.ws + WS_Y);
    uint2 xr[NB][4], yr[NB][4], er[NB][4];
#pragma unroll
    for (int u = 0; u < NB; ++u) { const int t = (t0 + u * tstep < NT) ? t0 + u * tstep : t0;
#pragma unroll
        for (int j = 0; j < 4; ++j) { const size_t o = (size_t)t * DM + 256 * j + 4 * lane; xr[u][j] = *(const uint2*)(XB + o); yr[u][j] = *(const uint2*)(Y + o); er[u][j] = *(const uint2*)(E + o); } }
    const float* g2 = p.ln2_g + li * DM; const float* b2 = p.ln2_b + li * DM;
    float4 gg[4], bv[4];
#pragma unroll
    for (int j = 0; j < 4; ++j) { gg[j] = *(const float4*)(g2 + 256 * j + 4 * lane); bv[j] = *(const float4*)(b2 + 256 * j + 4 * lane); }
    float4 v[NB][4]; float s[NB];
#pragma unroll
    for (int u = 0; u < NB; ++u) { s[u] = 0.f;
#pragma unroll
        for (int j = 0; j < 4; ++j) {
            float x[4], y[4], e[4]; up4(xr[u][j], x); up4(yr[u][j], y); up4(er[u][j], e);
            v[u][j].x = DN_ALPHA * x[0] + y[0] + e[0]; v[u][j].y = DN_ALPHA * x[1] + y[1] + e[1]; v[u][j].z = DN_ALPHA * x[2] + y[2] + e[2]; v[u][j].w = DN_ALPHA * x[3] + y[3] + e[3];
            s[u] += (v[u][j].x + v[u][j].y) + (v[u][j].z + v[u][j].w);
        } }
#pragma unroll
    for (int o = 1; o < 64; o <<= 1)
#pragma unroll
        for (int u = 0; u < NB; ++u) s[u] += __shfl_xor(s[u], o);
    float s2[NB];
#pragma unroll
    for (int u = 0; u < NB; ++u) { const float mean = s[u] * (1.0f / DM); s2[u] = 0.f;
#pragma unroll
        for (int j = 0; j < 4; ++j) { v[u][j].x -= mean; v[u][j].y -= mean; v[u][j].z -= mean; v[u][j].w -= mean; s2[u] += (v[u][j].x * v[u][j].x + v[u][j].y * v[u][j].y) + (v[u][j].z * v[u][j].z + v[u][j].w * v[u][j].w); } }
#pragma unroll
    for (int o = 1; o < 64; o <<= 1)
#pragma unroll
        for (int u = 0; u < NB; ++u) s2[u] += __shfl_xor(s2[u], o);
#pragma unroll
    for (int u = 0; u < NB; ++u) {
        const int t = t0 + u * tstep;
        if (t < NT) {
            const float rstd = 1.0f / sqrtf(s2[u] * (1.0f / DM) + LN_EPS);
#pragma unroll
            for (int j = 0; j < 4; ++j) {
                const float4 o = make_float4(v[u][j].x * rstd * gg[j].x + bv[j].x, v[u][j].y * rstd * gg[j].y + bv[j].y, v[u][j].z * rstd * gg[j].z + bv[j].z, v[u][j].w * rstd * gg[j].w + bv[j].w);
                if (li == 0) *(uint2*)(XB + (size_t)t * DM + 256 * j + 4 * lane) = make_uint2(pk2(o.x, o.y), pk2(o.z, o.w));
                else *(float4*)(p.out + (size_t)t * DM + 256 * j + 4 * lane) = o;
            }
        }
    }
}

constexpr int PH_PER_LAYER = 12, NPHASE = 1 + 2 * PH_PER_LAYER;

#ifndef PROBE_DUP
#define PROBE_DUP 0
#endif
#define PH_BEGIN(k) if (lo <= (k) && (k) < hi && ((k) == 0 || PHON(((k) - 1) % PH_PER_LAYER))) for (int rep_ = 0; rep_ < (((k) > 0 && ((PROBE_DUP >> (((k) - 1) % PH_PER_LAYER)) & 1)) ? 2 : 1); ++rep_) { unsigned long long probe_t0 = 0; if ((PROBE_T >> PH_BIT(k)) & 1) probe_t0 = __builtin_amdgcn_s_memrealtime();
#define PH_SYNC_DUP() do { if (rep_ == 0) { asm volatile("s_waitcnt vmcnt(0)" ::: "memory"); __syncthreads(); } } while (0)
#ifndef PROBE_T
#define PROBE_T 0
#endif
#define PH_BIT(k) ((k) == 0 ? 15 : (((k) - 1) % PH_PER_LAYER))
#define PH_END(k) if ((k) + 1 < hi) xcd_barrier(bar); if ((PROBE_T >> PH_BIT(k)) & 1) { const unsigned long long tn_ = __builtin_amdgcn_s_memrealtime(); probe_ticks += tn_ - probe_t0; } }

template <int LI>
__device__ __forceinline__ void run_layer(const Params& p, float* lds, const XcdBarrier& bar, int lo, int hi, unsigned long long& probe_ticks, unsigned rank) {
    constexpr int li = LI, base = 1 + LI * PH_PER_LAYER;
    const int tid = threadIdx.x, lane = tid & 63, wave = __builtin_amdgcn_readfirstlane(tid >> 6);
    const int G = gridDim.x;
    float* stream = p.out;
    LAS unsigned char* ldsb = (LAS unsigned char*)lds;
    PH_BEGIN(base + 0)
        EpiZ16 e{(bf16*)(p.ws + WS_Z), (float*)(p.ws + WS_GATES), (const float*)(p.ws + WS_ACOS), (const float*)(p.ws + WS_ASIN)};
        gemm16(ldsb, (const bf16*)(p.ws + WS_XB), (const bf16*)(p.ws + WS_WIN) + (size_t)li * NZP * DM, NZP, DM, e);
    PH_END(base + 0)
    PH_BEGIN(base + 1)
        for (int it = blockIdx.x; it < 1024 + 1536; it += G) {
            if (it < 512) ret_state_u(p, 2 * it + (wave >> 2), ldsb + (wave >> 2) * UNIT_LDS, wave & 3, tid & 255, lane);
            else if (it < 1024) mls_state_u(p, li, 2 * (it - 512) + (wave >> 2), ldsb + (wave >> 2) * UNIT_LDS, wave & 3, tid & 255, lane);
            else attn_unit(p, it - 1024, ldsb);
        }
    PH_END(base + 1)
    PH_BEGIN(base + 2)
        p3_scans(p);
        attn_merge(p);
    PH_END(base + 2)
    PH_BEGIN(base + 3)
        for (int it = blockIdx.x; it < 1024; it += G) {
            if (it < 512) ret_out_u(p, li, 2 * it + (wave >> 2), ldsb + (wave >> 2) * UNIT_LDS, wave & 3, tid & 255, lane);
            else mls_out_u(p, li, 2 * (it - 512) + (wave >> 2), ldsb + (wave >> 2) * UNIT_LDS, wave & 3, tid & 255, lane);
        }
    PH_END(base + 3)
    PH_BEGIN(base + 4)
        EpiRes16 e{(const bf16*)(p.ws + WS_XB), (bf16*)(p.ws + WS_U16)};
        gemm16(ldsb, (const bf16*)(p.ws + WS_MIX), (const bf16*)(p.ws + WS_WOUT) + (size_t)li * DM * DM, DM, DM, e);
    PH_END(base + 4)
    PH_BEGIN(base + 5)
        for (int r = blockIdx.x * NWAVE + wave; r < NT; r += 4 * G * NWAVE) ln_rows<4>((const bf16*)(p.ws + WS_U16), (bf16*)(p.ws + WS_XB), (signed char*)(p.ws + WS_X1Q), (float*)(p.ws + WS_X1S), r, G * NWAVE, p.ln1_g + li * DM, p.ln1_b + li * DM, lane);
        quant_rows<true>(p.pu + (size_t)li * 16384 * 1024, (unsigned char*)(p.ws + WS_UQ), (float*)(p.ws + WS_US), lane, blockIdx.x * NWAVE + wave, G * NWAVE);
        quant_rows<true>(p.pv + (size_t)li * 16384 * 1024, (unsigned char*)(p.ws + WS_VQ), (float*)(p.ws + WS_VS), lane, blockIdx.x * NWAVE + wave, G * NWAVE);
        EpiBf16Store e{(bf16*)(p.ws + WS_E), DM};
        gemm16(ldsb, (const bf16*)(p.ws + WS_PB) + (size_t)li * NT * 256, (const bf16*)(p.ws + WS_WP) + (size_t)li * DM * 256, DM, 256, e);
    PH_END(base + 5)
    PH_BEGIN(base + 6)
        EpiBf16Store eq{(bf16*)(p.ws + WS_QRY), 2048};
        gemm16(ldsb, (const bf16*)(p.ws + WS_XB), (const bf16*)(p.ws + WS_WQG) + (size_t)li * 3072 * DM, 2048, DM, eq);
        EpiGate16 eg{(bf16*)(p.ws + WS_E), p.bg + li * DM};
        gemm16(ldsb, (const bf16*)(p.ws + WS_XB), (const bf16*)(p.ws + WS_WQG) + (size_t)li * 3072 * DM + (size_t)2048 * DM, DM, DM, eg);
    PH_END(base + 6)
    PH_BEGIN(base + 7)
        for (int it = blockIdx.x; it < (NT / 256) * 8; it += G) topk_unit(p, li, it, ldsb);
    PH_END(base + 7)
    PH_BEGIN(base + 8)
        const SlicePlan sp = slice_plan(p, rank, wave);
        for (int xs = 0; xs < 8; ++xs) if ((xs % sp.m) == sp.mi) peer_u_slice(p, xs, sp.wid, sp.wstride, lane);
    PH_END(base + 8)
    PH_BEGIN(base + 9)
        for (int t = blockIdx.x * NWAVE + wave; t < NT; t += 2 * G * NWAVE) peer_coef_tokens2(p, t, (t + G * NWAVE < NT) ? t + G * NWAVE : t, lane);
    PH_END(base + 9)
    PH_BEGIN(base + 10)
        const SlicePlan sp = slice_plan(p, rank, wave);
        for (int xs = 0; xs < 8; ++xs) if ((xs % sp.m) == sp.mi) peer_v_slice(p, xs, sp.wid, sp.wstride, lane);
    PH_END(base + 10)
    PH_BEGIN(base + 11)
        for (int t = blockIdx.x * NWAVE + wave; t < NT; t += 4 * G * NWAVE) peer_ln_tokens<4>(p, li, t, G * NWAVE, lane);
    PH_END(base + 11)
}

__global__ void __launch_bounds__(NTHR, 2) mk_fwd(Params p) {
    extern __shared__ __attribute__((aligned(16))) unsigned char lds_raw[];
    float* lds = (float*)lds_raw;
    const int tid = threadIdx.x;
    volatile LAS unsigned* MISC = (volatile LAS unsigned*)((LAS unsigned char*)lds_raw + LDS_CTL_OFF);
    if (tid < 64) MISC[tid] = 0u;
    __syncthreads();
    const int lo = p.ph_lo, hi = p.ph_hi;
    XcdBarrier bar; bar.bar = (unsigned*)(p.ws + WS_CTL) + 1024; bar.x = 0; bar.st = nullptr;
    if (hi - lo > 1) bar = xcd_barrier_post((unsigned*)(p.ws + WS_CTL) + 1024, MISC + 8);
    __syncthreads();
    const unsigned rank = MISC[10];
    unsigned long long probe_ticks = 0;
    PH_BEGIN(0)
        p0_tables(p);
        p0_weights(p, lds);
    PH_END(0)
    run_layer<0>(p, lds, bar, lo, hi, probe_ticks, rank);
    run_layer<1>(p, lds, bar, lo, hi, probe_ticks, rank);
    if (PROBE_R) { __syncthreads(); probe_ticks += ((volatile LAS unsigned*)((LAS unsigned char*)lds_raw + 159 * 1024 + 128))[0]; }
    if (PROBE_T || PROBE_R) { const unsigned long long te_ = __builtin_amdgcn_s_memrealtime(); while (__builtin_amdgcn_s_memrealtime() - te_ < probe_ticks) __builtin_amdgcn_s_sleep(8); }
}

extern "C" void kernel_launch(void* const* d_in, const int* in_sizes, int n_in, void* d_out, int out_size, void* d_ws, size_t ws_size, hipStream_t stream) {
    static int grid = 0;
    if (grid == 0) {
        if (n_in != 19 || in_sizes[0] != NT * DM || out_size != NT * DM || ws_size < WS_END) { fprintf(stderr, "kernel_launch: unexpected shapes (n_in %d in0 %d out %d ws %zu)\n", n_in, n_in > 0 ? in_sizes[0] : -1, out_size, ws_size); grid = -1; return; }
        int dev = 0, cus = 0;
        if (hipGetDevice(&dev) != hipSuccess || hipDeviceGetAttribute(&cus, hipDeviceAttributeMultiprocessorCount, dev) != hipSuccess) { grid = -1; return; }
        if (hipFuncSetAttribute((const void*)mk_fwd, hipFuncAttributeMaxDynamicSharedMemorySize, LDS_BYTES) != hipSuccess) { fprintf(stderr, "kernel_launch: hipFuncSetAttribute failed\n"); grid = -1; return; }
        int per_cu = 0;
        if (hipOccupancyMaxActiveBlocksPerMultiprocessor(&per_cu, (const void*)mk_fwd, NTHR, LDS_BYTES) != hipSuccess || per_cu < 1) fprintf(stderr, "kernel_launch: occupancy query says %d\n", per_cu);
        (void)hipGetLastError();
        grid = cus;
    }
    if (grid < 0) return;
    if (hipMemsetAsync((char*)d_ws + WS_CTL, 0, CTL_ZERO_BYTES, stream) != hipSuccess) return;
    Params a{};
    a.x = (const float*)d_in[0]; a.p = (const float*)d_in[1]; a.w_in = (const float*)d_in[2]; a.conv_w = (const float*)d_in[3]; a.b_if = (const float*)d_in[4];
    a.ret_g = (const float*)d_in[5]; a.mls_g = (const float*)d_in[6]; a.w_out = (const float*)d_in[7]; a.ln1_g = (const float*)d_in[8]; a.ln1_b = (const float*)d_in[9];
    a.wq = (const float*)d_in[10]; a.keys = (const float*)d_in[11]; a.pu = (const float*)d_in[12]; a.pv = (const float*)d_in[13]; a.wg = (const float*)d_in[14];
    a.bg = (const float*)d_in[15]; a.wp = (const float*)d_in[16]; a.ln2_g = (const float*)d_in[17]; a.ln2_b = (const float*)d_in[18];
    a.out = (float*)d_out; a.ws = (unsigned char*)d_ws;
#if MK_SPLIT
    for (int ph = 0; ph < NPHASE; ++ph) { a.ph_lo = ph; a.ph_hi = ph + 1; hipLaunchKernelGGL(mk_fwd, dim3(grid), dim3(NTHR), LDS_BYTES, stream, a); }
#else
    a.ph_lo = 0; a.ph_hi = NPHASE;
    hipLaunchKernelGGL(mk_fwd, dim3(grid), dim3(NTHR), LDS_BYTES, stream, a);
#endif
}
```

```cpp
#include <hip/hip_runtime.h>
#include <cstdio>
#include <cstdint>
#include <cmath>

#ifndef MK_SPLIT
#define MK_SPLIT 0
#endif

#ifndef ONLY
#define ONLY -1
#endif
#ifndef PMASK
#define PMASK 0xfff
#endif
#define PHON(k) ((ONLY < 0 || ONLY == (k)) && ((PMASK >> (k)) & 1))
#define LAS __attribute__((address_space(3)))
typedef unsigned short bf16;
#ifndef PROBE_R
#define PROBE_R 0
#endif
#define RGN_T0(id) unsigned long long rgn_t0_##id = 0; if (PROBE_R == (id) && threadIdx.x == 0) rgn_t0_##id = __builtin_amdgcn_s_memrealtime();
#define RGN_T1(id, ldsbase) if (PROBE_R == (id) && threadIdx.x == 0) { volatile LAS unsigned* w_ = (volatile LAS unsigned*)((LAS unsigned char*)(ldsbase) + 159 * 1024 + 128); w_[0] = w_[0] + (unsigned)(__builtin_amdgcn_s_memrealtime() - rgn_t0_##id); }

#define XB_TMO      128
#define XB_XCNT(j)  (256  + 64 * (j))
#define XB_XSUB(j)  (1280 + 64 * (j))
#define XB_XGEN(j)  (2304 + 64 * (j))
#define XB_TOP      3328
#define XB_TOPGEN   3392
#define XCD_BAR_WORDS 3456
#define XB_SPIN_CAP (1u << 22)

__device__ __forceinline__ unsigned xb_ld(unsigned* p)              { return __hip_atomic_load(p, __ATOMIC_RELAXED, __HIP_MEMORY_SCOPE_AGENT); }
__device__ __forceinline__ unsigned xb_add(unsigned* p, unsigned v) { return __hip_atomic_fetch_add(p, v, __ATOMIC_RELAXED, __HIP_MEMORY_SCOPE_AGENT); }
__device__ __forceinline__ unsigned xb_xcc_id() { return (unsigned)__builtin_amdgcn_s_getreg((3 << 11) | 20) & 0xFu; }
#define XB_SPIN(cond, bar) do { unsigned _sp = 0; while (cond) { __builtin_amdgcn_s_sleep(1); \
    if ((++_sp & 255u) == 0u) { if (xb_ld(&(bar)[XB_TMO])) break; if (_sp > XB_SPIN_CAP) { atomicAdd(&(bar)[XB_TMO], 1u); break; } } } } while (0)

struct XcdBarrier { unsigned* bar; unsigned x; volatile LAS unsigned* st; };

__device__ __forceinline__ XcdBarrier xcd_barrier_post(unsigned* bar, volatile LAS unsigned* st) {
    XcdBarrier b; b.bar = bar; b.x = xb_xcc_id(); b.st = st;
    if (threadIdx.x == 0) st[2] = xb_add(&bar[XB_XCNT(b.x)], 1u);
    return b;
}
__device__ __forceinline__ void xcd_barrier_complete(unsigned* bar, unsigned x, unsigned& nloc, unsigned& nx) {
    const unsigned G = gridDim.x * gridDim.y * gridDim.z;
    unsigned sum, cnt, mine, sp = 0u;
    for (;;) {
        sum = 0u; cnt = 0u; mine = 0u;
#pragma unroll
        for (unsigned j = 0; j < 16; ++j) { const unsigned c = xb_ld(&bar[XB_XCNT(j)]); sum += c; cnt += (c > 0u) ? 1u : 0u; mine = (j == x) ? c : mine; }
        if (sum == G) break;
        __builtin_amdgcn_s_sleep(1);
        if ((++sp & 255u) == 0u) { if (xb_ld(&bar[XB_TMO])) break; if (sp > XB_SPIN_CAP) { atomicAdd(&bar[XB_TMO], 1u); break; } }
    }
    nloc = mine > 0u ? mine : 1u; nx = cnt > 0u ? cnt : 1u;
}
__device__ __forceinline__ void xcd_barrier(const XcdBarrier& b) {
    asm volatile("s_waitcnt vmcnt(0)" ::: "memory");
    __syncthreads();
    if (threadIdx.x == 0) {
        unsigned* bar = b.bar;
        __builtin_amdgcn_s_waitcnt(0);
        unsigned nloc = b.st[0], nx = b.st[1];
        if (nloc == 0u) { xcd_barrier_complete(bar, b.x, nloc, nx); b.st[0] = nloc; b.st[1] = nx; }
        const unsigned old = xb_add(&bar[XB_XSUB(b.x)], 1u);
        const unsigned gen = old / nloc;
        if (old + 1u == (gen + 1u) * nloc) {
            __builtin_amdgcn_fence(__ATOMIC_RELEASE, "agent");
            asm volatile("s_waitcnt vmcnt(0)" ::: "memory");
            const unsigned og = xb_add(&bar[XB_TOP], 1u);
            const unsigned tg = og / nx;
            if (og + 1u == (tg + 1u) * nx) xb_add(&bar[XB_TOPGEN], 1u);
            else XB_SPIN(xb_ld(&bar[XB_TOPGEN]) == tg, bar);
            __builtin_amdgcn_fence(__ATOMIC_ACQUIRE, "agent");
            xb_add(&bar[XB_XGEN(b.x)], 1u);
            asm volatile("s_waitcnt vmcnt(0)" ::: "memory");
        } else {
            XB_SPIN(xb_ld(&bar[XB_XGEN(b.x)]) == gen, bar);
            __builtin_amdgcn_fence(__ATOMIC_ACQUIRE, "agent");
            asm volatile("s_waitcnt vmcnt(0)" ::: "memory");
        }
    }
    __syncthreads();
}

namespace pg8 {
#define PG8_LAS __attribute__((address_space(3)))
typedef unsigned short bf16_t;
typedef short bf16x8 __attribute__((ext_vector_type(8)));
typedef float f32x4 __attribute__((ext_vector_type(4)));
typedef unsigned u32x4 __attribute__((ext_vector_type(4)));
constexpr int BM = 256, BK = 64, HALF = 128, HTB = HALF * BK * 2  , STAGE_BYTES = 8 * HTB, NXCD = 8, WGM = 8;

__host__ __device__ __forceinline__ int lds_byte(int r, int c) { const int st = (r >> 4) * 2 + (c >> 5), rr = r & 15, cc = c & 31, ob = rr * 64 + cc * 2; return st * 1024 + (ob ^ (((ob >> 9) & 1) << 5)); }
__host__ __device__ __forceinline__ void stage_rc(int b, int& R, int& C) { const int st = b / 1024, sb = b % 1024, swz = sb ^ (((sb >> 9) & 1) << 5); R = (st >> 1) * 16 + swz / 64; C = (st & 1) * 32 + (swz % 64) / 2; }
__host__ __device__ __forceinline__ int perm32(int rho) { const int n = rho >> 4, i = rho & 15; return 8 * (i >> 2) + 4 * n + (i & 3); }

struct Unit { int pm, pn; };
struct Gemm { const bf16_t* A; const bf16_t* Bt; int M, N, K; };

struct StaticOrder {
    int nM, nN, nwg, G, c;
    __host__ __device__ void init(int M, int N, int G_, int c_) { nM = M / BM; nN = N / BM; nwg = nM * nN; G = G_; c = c_; }
    __host__ __device__ bool next(int i, Unit& u) const {
        const long L = (long)i * G + c; if (L >= nwg) return false;
        int wgid = (int)L; { const int q = nwg / NXCD, r = nwg % NXCD, xcd = wgid % NXCD, off = wgid / NXCD; wgid = (xcd < r ? xcd * (q + 1) : r * (q + 1) + (xcd - r) * q) + off; }
        const int nig = WGM * nN, gid = wgid / nig, fm = gid * WGM, gsz = (nM - fm) < WGM ? (nM - fm) : WGM;
        u.pm = fm + ((wgid % nig) % gsz); u.pn = (wgid % nig) / gsz; return true;
    }
    __device__ __forceinline__ void a_ready(const Unit&) const {}
    __device__ __forceinline__ void done(const Unit&) const {}
};

__device__ __forceinline__ unsigned cvt_pk_bf16(float lo, float hi) { unsigned r; asm volatile("v_cvt_pk_bf16_f32 %0, %1, %2" : "=v"(r) : "v"(lo), "v"(hi)); return r; }
template <class Epi, class Sched, bool ALIGN_EPI = false, bool SP2 = false>
__device__ __forceinline__ void gemm_phase(PG8_LAS unsigned char* lds, const Gemm g, const Sched& S, const Epi& E) {
    const int tid = threadIdx.x, wid = __builtin_amdgcn_readfirstlane(tid >> 6), lane = tid & 63, wr = wid >> 2, wc = wid & 3, fr = lane & 15, fq = lane >> 4;
    const int K = g.K, nt = K / BK;
    unsigned voffA[2], voffB[2];
#pragma unroll
    for (int i = 0; i < 2; ++i) { int R, C; stage_rc(tid * 16 + i * 8192, R, C); const int Rb = Epi::PERM ? ((R & ~31) + perm32(R & 31)) : R;
        voffA[i] = (unsigned)(R * K + C) * 2u; voffB[i] = (unsigned)(Rb * K + C) * 2u; }
    const size_t kstep = (size_t)(BK * 2);
    const size_t hstep = (size_t)HALF * K * 2;
    const size_t tstep = 2 * hstep;
    const unsigned ldsw = (unsigned)wid * 1024u;
    const int aoff = lds_byte(wr * 64 + fr, fq * 8), boff = lds_byte(wc * 32 + fr, fq * 8);
#define PG8_SA(b, h) (((b) * 2 + (h)) * HTB)
#define PG8_SB(b, h) ((4 + (b) * 2 + (h)) * HTB)
#define PG8_STAGE(bufoff, gbase, voff) do { _Pragma("unroll") for (int _i = 0; _i < 2; ++_i) \
        __builtin_amdgcn_global_load_lds((const unsigned*)((const char*)(gbase) + (voff)[_i]), (PG8_LAS unsigned*)(lds + (bufoff) + ldsw + _i * 8192), 16, 0, 0); } while (0)
#define PG8_LDA(dst, b, h) do { _Pragma("unroll") for (int m = 0; m < 4; ++m) _Pragma("unroll") for (int k = 0; k < 2; ++k) dst[m][k] = *(const PG8_LAS bf16x8*)(lds + PG8_SA(b, h) + aoff + m * 2048 + k * 1024); } while (0)
#define PG8_LDB(dst, b, h) do { _Pragma("unroll") for (int n = 0; n < 2; ++n) _Pragma("unroll") for (int k = 0; k < 2; ++k) dst[n][k] = *(const PG8_LAS bf16x8*)(lds + PG8_SB(b, h) + boff + n * 2048 + k * 1024); } while (0)
#define PG8_MMA(ai, bj, At, Bt) do { __builtin_amdgcn_s_setprio(1); _Pragma("unroll") for (int m = 0; m < 4; ++m) _Pragma("unroll") for (int n = 0; n < 2; ++n) _Pragma("unroll") for (int k = 0; k < 2; ++k) \
        acc[ai][bj][m][n] = __builtin_amdgcn_mfma_f32_16x16x32_bf16(Bt[n][k], At[m][k], acc[ai][bj][m][n], 0, 0, 0); __builtin_amdgcn_s_setprio(0); } while (0)
#define PG8_WAIT_V(n) asm volatile("s_waitcnt vmcnt(" #n ")" ::: "memory")
#define PG8_WAIT_L(n) asm volatile("s_waitcnt lgkmcnt(" #n ")" ::: "memory")
#define PG8_BAR __builtin_amdgcn_s_barrier()
#define PG8_SCHED __builtin_amdgcn_sched_barrier(0)
    Unit cur, nxt; int ui = 0;
    if (!S.next(0, cur)) return;
    f32x4 acc[2][2][4][2];
#pragma unroll
    for (int a = 0; a < 2; ++a)
#pragma unroll
        for (int b = 0; b < 2; ++b)
#pragma unroll
            for (int m = 0; m < 4; ++m)
#pragma unroll
                for (int n = 0; n < 2; ++n) acc[a][b][m][n] = (f32x4){0.f, 0.f, 0.f, 0.f};
    bf16x8 At[4][2], B0[2][2], B1[2][2];
    const char* cA = (const char*)g.A + (size_t)cur.pm * tstep; const char* cB = (const char*)g.Bt + (size_t)cur.pn * tstep;
    S.a_ready(cur);
    if constexpr (SP2) {
        PG8_STAGE(PG8_SB(0, 0), cB, voffB); PG8_STAGE(PG8_SB(0, 1), cB + hstep, voffB); PG8_STAGE(PG8_SA(0, 0), cA, voffA); PG8_STAGE(PG8_SA(0, 1), cA + hstep, voffA);
        if (wr == 1) PG8_BAR;
        PG8_WAIT_V(2); PG8_BAR;
        PG8_STAGE(PG8_SB(1, 0), cB + kstep, voffB); PG8_STAGE(PG8_SA(1, 0), cA + kstep, voffA); PG8_STAGE(PG8_SB(1, 1), cB + hstep + kstep, voffB);
        PG8_WAIT_V(6); PG8_BAR;
    } else {
        PG8_STAGE(PG8_SB(0, 0), cB, voffB); PG8_STAGE(PG8_SA(0, 0), cA, voffA); PG8_STAGE(PG8_SB(0, 1), cB + hstep, voffB); PG8_STAGE(PG8_SA(0, 1), cA + hstep, voffA);
        if (wr == 1) PG8_BAR;
        PG8_WAIT_V(4); PG8_BAR;
        PG8_STAGE(PG8_SB(1, 0), cB + kstep, voffB); PG8_STAGE(PG8_SA(1, 0), cA + kstep, voffA); PG8_STAGE(PG8_SB(1, 1), cB + hstep + kstep, voffB);
        PG8_WAIT_V(6); PG8_BAR;
    }
    for (;;) {
        const bool has_next = S.next(ui + 1, nxt);
        const char* nA = has_next ? (const char*)g.A + (size_t)nxt.pm * tstep : cA; const char* nB = has_next ? (const char*)g.Bt + (size_t)nxt.pn * tstep : cB;
        for (int t = 0; t < nt; t += 2) {
            const bool last = (t == nt - 2);
            const char* a1 = cA + (size_t)(t + 1) * kstep;
            const char* a2 = last ? nA : cA + (size_t)(t + 2) * kstep; const char* b2 = last ? nB : cB + (size_t)(t + 2) * kstep;
            const char* a3 = a2 + kstep; const char* b3 = b2 + kstep;
            if (last && has_next) S.a_ready(nxt);
            if constexpr (SP2) {
            PG8_LDB(B0, 0, 0); PG8_LDB(B1, 0, 1); PG8_SCHED; PG8_LDA(At, 0, 0); PG8_STAGE(PG8_SA(1, 1), a1 + hstep, voffA);
            PG8_WAIT_V(8); PG8_WAIT_L(0); PG8_BAR; PG8_MMA(0, 0, At, B0); PG8_MMA(0, 1, At, B1); PG8_BAR; PG8_SCHED;
            PG8_LDA(At, 0, 1); PG8_STAGE(PG8_SB(0, 0), b2, voffB); PG8_STAGE(PG8_SB(0, 1), b2 + hstep, voffB); PG8_STAGE(PG8_SA(0, 0), a2, voffA);
            PG8_WAIT_V(8); PG8_WAIT_L(0); PG8_BAR; PG8_MMA(1, 0, At, B0); PG8_MMA(1, 1, At, B1); PG8_BAR; PG8_SCHED;
            PG8_LDB(B0, 1, 0); PG8_LDB(B1, 1, 1); PG8_SCHED; PG8_LDA(At, 1, 0); PG8_STAGE(PG8_SA(0, 1), a2 + hstep, voffA);
            PG8_WAIT_V(8); PG8_WAIT_L(0); PG8_BAR; PG8_MMA(0, 0, At, B0); PG8_MMA(0, 1, At, B1); PG8_BAR; PG8_SCHED;
            PG8_LDA(At, 1, 1); PG8_STAGE(PG8_SB(1, 0), b3, voffB); PG8_STAGE(PG8_SB(1, 1), b3 + hstep, voffB); PG8_STAGE(PG8_SA(1, 0), a3, voffA);
            PG8_WAIT_V(8); PG8_WAIT_L(0); PG8_BAR; PG8_MMA(1, 0, At, B0); PG8_MMA(1, 1, At, B1); PG8_BAR; PG8_SCHED;
            } else {
            PG8_LDB(B0, 0, 0); PG8_SCHED; PG8_LDA(At, 0, 0); PG8_STAGE(PG8_SA(1, 1), a1 + hstep, voffA);
            PG8_WAIT_L(8); PG8_BAR; PG8_WAIT_L(0); PG8_MMA(0, 0, At, B0); PG8_BAR; PG8_SCHED;
            PG8_LDB(B1, 0, 1); PG8_STAGE(PG8_SB(0, 0), b2, voffB);
            PG8_BAR; PG8_WAIT_L(0); PG8_MMA(0, 1, At, B1); PG8_BAR;
            PG8_LDA(At, 0, 1); PG8_STAGE(PG8_SA(0, 0), a2, voffA);
            PG8_BAR; PG8_WAIT_L(0); PG8_MMA(1, 0, At, B0); PG8_BAR; PG8_SCHED;
            PG8_STAGE(PG8_SB(0, 1), b2 + hstep, voffB);
            PG8_WAIT_V(6); PG8_BAR; PG8_MMA(1, 1, At, B1); PG8_BAR;
            PG8_LDB(B0, 1, 0); PG8_SCHED; PG8_LDA(At, 1, 0); PG8_STAGE(PG8_SA(0, 1), a2 + hstep, voffA);
            PG8_WAIT_L(8); PG8_BAR; PG8_WAIT_L(0); PG8_MMA(0, 0, At, B0); PG8_BAR; PG8_SCHED;
            PG8_LDB(B1, 1, 1); PG8_STAGE(PG8_SB(1, 0), b3, voffB);
            PG8_BAR; PG8_WAIT_L(0); PG8_MMA(0, 1, At, B1); PG8_BAR;
            PG8_LDA(At, 1, 1); PG8_STAGE(PG8_SA(1, 0), a3, voffA);
            PG8_BAR; PG8_WAIT_L(0); PG8_MMA(1, 0, At, B0); PG8_BAR; PG8_SCHED;
            PG8_STAGE(PG8_SB(1, 1), b3 + hstep, voffB);
            PG8_WAIT_V(6); PG8_BAR; PG8_MMA(1, 1, At, B1); PG8_BAR;
            }
        }
        if constexpr (ALIGN_EPI) { if (wr == 0) PG8_BAR; }
        if constexpr (!Epi::AFTER_DRAIN) { E(acc, cur, wr, wc, fr, fq); S.done(cur); }
        if (!has_next) break;
#pragma unroll
        for (int a = 0; a < 2; ++a)
#pragma unroll
            for (int b = 0; b < 2; ++b)
#pragma unroll
                for (int m = 0; m < 4; ++m)
#pragma unroll
                    for (int n = 0; n < 2; ++n) acc[a][b][m][n] = (f32x4){0.f, 0.f, 0.f, 0.f};
        cur = nxt; cA = nA; cB = nB; ++ui;
        if constexpr (ALIGN_EPI) { if (wr == 1) PG8_BAR; }
    }
    PG8_WAIT_V(0);
    if constexpr (!ALIGN_EPI) { if (wr == 0) PG8_BAR; }
    PG8_BAR;
    if constexpr (Epi::AFTER_DRAIN) { E.fused(acc, cur, wr, wc, fr, fq, lds, wid, lane); S.done(cur); }
#undef PG8_SA
#undef PG8_SB
#undef PG8_STAGE
#undef PG8_LDA
#undef PG8_LDB
#undef PG8_MMA
#undef PG8_WAIT_V
#undef PG8_WAIT_L
#undef PG8_BAR
#undef PG8_SCHED
}
}

constexpr int NB = 4, SEQ = 8192, NT = NB * SEQ, DM = 1024;
constexpr int ZW = 3328, NZ = 3336;
constexpr int C_RQ = 0, C_RK = 256, C_RV = 512, C_RG = 1024, C_AQ = 1536, C_AK = 1792, C_AV = 2048, C_MQ = 2304, C_MK = 2560, C_MV = 2816, C_MO = 3072;
constexpr float DN_ALPHA = 1.41421356237f;
constexpr float LN_EPS = 1e-5f;
constexpr int NTHR = 512, NWAVE = 8;
constexpr int LDS_BYTES = 160 * 1024;
constexpr int LDS_CTL_OFF = 159 * 1024;

constexpr size_t MiB = 1u << 20;
constexpr size_t WS_CTL = 0, CTL_ZERO_BYTES = 64 * 1024;
constexpr size_t WS_RCOS = 1 * MiB, WS_RSIN = 2 * MiB, WS_ACOS = 3 * MiB, WS_ASIN = 3 * MiB + 512 * 1024;
constexpr size_t WS_RST = 4 * MiB;
constexpr size_t WS_MC = 36 * MiB;
constexpr size_t WS_MN = 52 * MiB;
constexpr size_t WS_MA = 52 * MiB + 512 * 1024, WS_MML = WS_MA + 4096, WS_MMP = WS_MML + 4096;
constexpr size_t WS_GATES = 54 * MiB;
constexpr int NZP = 3584;
constexpr size_t WS_WIN = 56 * MiB;
constexpr size_t WS_WOUT = 70 * MiB;
constexpr size_t WS_WQG = 74 * MiB;
constexpr size_t WS_WP = 86 * MiB;
constexpr size_t WS_KEYS = 87 * MiB;
constexpr size_t WS_PB = 88 * MiB;
constexpr size_t WS_XB = 120 * MiB;
constexpr size_t WS_AO = 456 * MiB;
constexpr size_t WS_ALSE = 504 * MiB;
constexpr size_t WS_Z = 184 * MiB;
constexpr size_t WS_MIX = 392 * MiB;
constexpr size_t WS_U16 = 184 * MiB;
constexpr size_t WS_QRY = 184 * MiB;
constexpr size_t WS_E = 312 * MiB;
constexpr size_t WS_UQ = 376 * MiB, WS_VQ = 392 * MiB;
constexpr size_t WS_US = 408 * MiB, WS_VS = 408 * MiB + 65536;
constexpr size_t WS_X1Q = 4 * MiB;
constexpr size_t WS_X1S = 53 * MiB;
constexpr size_t WS_PC = 36 * MiB;
constexpr size_t WS_PCS = 53 * MiB + 256 * 1024;
constexpr size_t WS_PI = 184 * MiB;
constexpr size_t WS_Y = 184 * MiB;
constexpr int CW_PQ = 8192;
constexpr size_t WS_RI = 456 * MiB, WS_RG = 472 * MiB;
constexpr size_t WS_END = 506 * MiB;

struct Params {
    const float *x, *p, *w_in, *conv_w, *b_if, *ret_g, *mls_g, *w_out, *ln1_g, *ln1_b, *wq, *keys, *pu, *pv, *wg, *bg, *wp, *ln2_g, *ln2_b;
    float* out; unsigned char* ws; int ph_lo, ph_hi;
};

__device__ __forceinline__ float bf2f(bf16 h) { return __uint_as_float(((unsigned)h) << 16); }
__device__ __forceinline__ unsigned f2bf(float f) { unsigned u = __float_as_uint(f); return (u + 0x7fffu + ((u >> 16) & 1u)) >> 16; }
typedef float f32x2_t __attribute__((ext_vector_type(2))); typedef __bf16 bf16x2_t __attribute__((ext_vector_type(2)));
__device__ __forceinline__ unsigned cvtpk(float lo, float hi) { f32x2_t v = {lo, hi}; bf16x2_t b = __builtin_convertvector(v, bf16x2_t); return __builtin_bit_cast(unsigned, b); }
__device__ __forceinline__ unsigned pk2(float lo, float hi) { return cvtpk(lo, hi); }
__device__ __forceinline__ float wave_sum(float v) {
#pragma unroll
    for (int o = 1; o < 64; o <<= 1) v += __shfl_xor(v, o);
    return v;
}
__device__ __forceinline__ float wave_max(float v) {
#pragma unroll
    for (int o = 1; o < 64; o <<= 1) v = fmaxf(v, __shfl_xor(v, o));
    return v;
}
__device__ __forceinline__ float sigmoidf_(float x) { return __builtin_amdgcn_rcpf(1.f + __expf(-x)); }
__device__ __forceinline__ float siluf_(float x) { return x * __builtin_amdgcn_rcpf(1.f + __expf(-x)); }
__device__ __forceinline__ void unpack8(const uint4 v, float* o) {
    o[0] = __uint_as_float(v.x << 16); o[1] = __uint_as_float(v.x & 0xffff0000u);
    o[2] = __uint_as_float(v.y << 16); o[3] = __uint_as_float(v.y & 0xffff0000u);
    o[4] = __uint_as_float(v.z << 16); o[5] = __uint_as_float(v.z & 0xffff0000u);
    o[6] = __uint_as_float(v.w << 16); o[7] = __uint_as_float(v.w & 0xffff0000u);
}


typedef float f32x4 __attribute__((ext_vector_type(4)));
typedef unsigned u32x4 __attribute__((ext_vector_type(4)));
__device__ __forceinline__ void unpack8v(const u32x4 v, float* o) {
    o[0] = __uint_as_float(v.x << 16); o[1] = __uint_as_float(v.x & 0xffff0000u); o[2] = __uint_as_float(v.y << 16); o[3] = __uint_as_float(v.y & 0xffff0000u);
    o[4] = __uint_as_float(v.z << 16); o[5] = __uint_as_float(v.z & 0xffff0000u); o[6] = __uint_as_float(v.w << 16); o[7] = __uint_as_float(v.w & 0xffff0000u);
}
struct EpiZ16 {
    static constexpr bool PERM = true, AFTER_DRAIN = false;
    bf16* Z; float* gates; const float* acos_; const float* asin_;
    __device__ __forceinline__ void operator()(const f32x4 (&acc)[2][2][4][2], const pg8::Unit& u, int wr, int wc, int fr, int fq) const {
        const int row0 = u.pm * 256 + wr * 64 + fr;
        if (u.pn < 13) {
            const int col0 = u.pn * 256 + wc * 32 + 8 * fq;
            const bool rot = (u.pn == 6 || u.pn == 7) && ((wc & 1) == 0);
            const float qs = (u.pn == 6) ? 0.125f : 1.0f;
#pragma unroll
            for (int ai = 0; ai < 2; ++ai)
#pragma unroll
                for (int m = 0; m < 4; ++m) { const int row = row0 + ai * 128 + m * 16; bf16* rowp = Z + (size_t)row * ZW + col0;
#pragma unroll
                    for (int bj = 0; bj < 2; ++bj) { f32x4 v0 = acc[ai][bj][m][0], v1 = acc[ai][bj][m][1];
                        if (rot) {
                            f32x4 p0, p1;
#pragma unroll
                            for (int j = 0; j < 4; ++j) { p0[j] = __shfl_xor(v0[j], 16); p1[j] = __shfl_xor(v1[j], 16); }
                            if (fq < 2) {
                                const int pos = row & (SEQ - 1);
                                const f32x4 c0 = *(const f32x4*)(acos_ + pos * 8), c1 = *(const f32x4*)(acos_ + pos * 8 + 4), s0 = *(const f32x4*)(asin_ + pos * 8), s1 = *(const f32x4*)(asin_ + pos * 8 + 4);
                                const float sg = (fq == 0) ? -1.0f : 1.0f;
                                v0 = v0 * c0 + p0 * s0 * sg; v1 = v1 * c1 + p1 * s1 * sg;
                            }
                        }
                        v0 = v0 * qs; v1 = v1 * qs;
                        u32x4 w; w.x = pk2(v0[0], v0[1]); w.y = pk2(v0[2], v0[3]); w.z = pk2(v1[0], v1[1]); w.w = pk2(v1[2], v1[3]);
                        *(u32x4*)(rowp + bj * 128) = w; } }
        } else if (wc == 0 && fq == 0) {
#pragma unroll
            for (int ai = 0; ai < 2; ++ai)
#pragma unroll
                for (int m = 0; m < 4; ++m) { float* g = gates + (size_t)(row0 + ai * 128 + m * 16) * 8; *(f32x4*)g = acc[ai][0][m][0]; *(f32x4*)(g + 4) = acc[ai][0][m][1]; }
        }
    }
};
struct EpiBf16Store {
    static constexpr bool PERM = true, AFTER_DRAIN = false;
    bf16* O; int ldc;
    __device__ __forceinline__ void operator()(const f32x4 (&acc)[2][2][4][2], const pg8::Unit& u, int wr, int wc, int fr, int fq) const {
        const int row0 = u.pm * 256 + wr * 64 + fr, col0 = u.pn * 256 + wc * 32 + 8 * fq;
#pragma unroll
        for (int ai = 0; ai < 2; ++ai)
#pragma unroll
            for (int m = 0; m < 4; ++m) { bf16* rowp = O + (size_t)(row0 + ai * 128 + m * 16) * ldc + col0;
#pragma unroll
                for (int bj = 0; bj < 2; ++bj) { const f32x4 v0 = acc[ai][bj][m][0], v1 = acc[ai][bj][m][1];
                    u32x4 w; w.x = pk2(v0[0], v0[1]); w.y = pk2(v0[2], v0[3]); w.z = pk2(v1[0], v1[1]); w.w = pk2(v1[2], v1[3]);
                    *(u32x4*)(rowp + bj * 128) = w; } }
    }
};
struct EpiGate16 {
    static constexpr bool PERM = true, AFTER_DRAIN = false;
    bf16* E; const float* bg;
    __device__ __forceinline__ void operator()(const f32x4 (&acc)[2][2][4][2], const pg8::Unit& u, int wr, int wc, int fr, int fq) const {
        const int row0 = u.pm * 256 + wr * 64 + fr, col0 = u.pn * 256 + wc * 32 + 8 * fq;
#pragma unroll
        for (int bj = 0; bj < 2; ++bj) {
            const f32x4 b0 = *(const f32x4*)(bg + col0 + bj * 128), b1 = *(const f32x4*)(bg + col0 + bj * 128 + 4);
#pragma unroll
            for (int ai = 0; ai < 2; ++ai)
#pragma unroll
                for (int m = 0; m < 4; ++m) { bf16* ep = E + (size_t)(row0 + ai * 128 + m * 16) * DM + col0 + bj * 128;
                    float pp[8]; unpack8v(*(const u32x4*)ep, pp);
                    const f32x4 v0 = acc[ai][bj][m][0] + b0, v1 = acc[ai][bj][m][1] + b1;
                    u32x4 w; w.x = pk2(pp[0] * sigmoidf_(v0[0]), pp[1] * sigmoidf_(v0[1])); w.y = pk2(pp[2] * sigmoidf_(v0[2]), pp[3] * sigmoidf_(v0[3]));
                    w.z = pk2(pp[4] * sigmoidf_(v1[0]), pp[5] * sigmoidf_(v1[1])); w.w = pk2(pp[6] * sigmoidf_(v1[2]), pp[7] * sigmoidf_(v1[3]));
                    *(u32x4*)ep = w; }
        }
    }
};
struct EpiRes16 {
    static constexpr bool PERM = true, AFTER_DRAIN = false;
    const bf16* xinb; bf16* out;
    __device__ __forceinline__ void operator()(const f32x4 (&acc)[2][2][4][2], const pg8::Unit& u, int wr, int wc, int fr, int fq) const {
        const int row0 = u.pm * 256 + wr * 64 + fr, col0 = u.pn * 256 + wc * 32 + 8 * fq;
#pragma unroll
        for (int ai = 0; ai < 2; ++ai)
#pragma unroll
            for (int m = 0; m < 4; ++m) { const size_t ro = (size_t)(row0 + ai * 128 + m * 16) * DM + col0;
#pragma unroll
                for (int bj = 0; bj < 2; ++bj) { float xv[8]; unpack8v(*(const u32x4*)(xinb + ro + bj * 128), xv);
                    const f32x4 v0 = acc[ai][bj][m][0], v1 = acc[ai][bj][m][1];
                    u32x4 w; w.x = pk2(DN_ALPHA * xv[0] + v0[0], DN_ALPHA * xv[1] + v0[1]); w.y = pk2(DN_ALPHA * xv[2] + v0[2], DN_ALPHA * xv[3] + v0[3]);
                    w.z = pk2(DN_ALPHA * xv[4] + v1[0], DN_ALPHA * xv[5] + v1[1]); w.w = pk2(DN_ALPHA * xv[6] + v1[2], DN_ALPHA * xv[7] + v1[3]);
                    *(u32x4*)(out + ro + bj * 128) = w; } }
    }
};
template <class Epi>
__device__ __forceinline__ void gemm16(LAS unsigned char* lds, const bf16* A, const bf16* Bt, int N, int K, const Epi& e) {
    pg8::Gemm g{A, Bt, NT, N, K}; pg8::StaticOrder S; S.init(NT, N, (int)gridDim.x, (int)blockIdx.x);
    pg8::gemm_phase<Epi, pg8::StaticOrder, true, true>(lds, g, S, e);
}

__device__ __forceinline__ void tr_item(const float* W, int K, int N, bf16* WT, float* scr, int item, int nblk, int lane) {
    const int kb = item / nblk, nb = item - kb * nblk, k0 = 64 * kb, n0 = 64 * nb;
    const int col4 = (lane & 15) * 4; const bool ok = (n0 + col4) < N;
#pragma unroll 1
    for (int hf = 0; hf < 2; ++hf) {
        float4 v[8];
#pragma unroll
        for (int i = 0; i < 8; ++i) { const int row = (lane >> 4) + 4 * (i + 8 * hf); v[i] = ok ? *(const float4*)(W + (size_t)(k0 + row) * N + n0 + col4) : make_float4(0.f, 0.f, 0.f, 0.f); }
#pragma unroll
        for (int i = 0; i < 8; ++i) { const int row = (lane >> 4) + 4 * (i + 8 * hf); float* d = scr + row * 65 + col4; d[0] = v[i].x; d[1] = v[i].y; d[2] = v[i].z; d[3] = v[i].w; }
    }
    asm volatile("s_waitcnt lgkmcnt(0)" ::: "memory");
    const int c = lane & 7;
#pragma unroll
    for (int j = 0; j < 8; ++j) { const int nn = (lane >> 3) + 8 * j; const float* sp = scr + (8 * c) * 65 + nn;
        uint4 o; o.x = pk2(sp[0 * 65], sp[1 * 65]); o.y = pk2(sp[2 * 65], sp[3 * 65]); o.z = pk2(sp[4 * 65], sp[5 * 65]); o.w = pk2(sp[6 * 65], sp[7 * 65]);
        *(uint4*)(WT + (size_t)(n0 + nn) * K + k0 + 8 * c) = o; }
    asm volatile("s_waitcnt lgkmcnt(0)" ::: "memory");
}
__device__ __forceinline__ void cvt_f32_bf16(const float* src, bf16* dst, size_t n8) {
    const size_t gt = (size_t)blockIdx.x * NTHR + threadIdx.x, GT = (size_t)gridDim.x * NTHR;
    for (size_t i0 = gt; i0 < n8; i0 += 4 * GT) {
        float4 a[4], b[4];
#pragma unroll
        for (int u = 0; u < 4; ++u) { const size_t i = i0 + u * GT; if (i < n8) { a[u] = *(const float4*)(src + i * 8); b[u] = *(const float4*)(src + i * 8 + 4); } }
#pragma unroll
        for (int u = 0; u < 4; ++u) { const size_t i = i0 + u * GT; if (i < n8) { uint4 o; o.x = pk2(a[u].x, a[u].y); o.y = pk2(a[u].z, a[u].w); o.z = pk2(b[u].x, b[u].y); o.w = pk2(b[u].z, b[u].w); *(uint4*)(dst + i * 8) = o; } }
    }
}
__device__ __forceinline__ void p0_weights(const Params& p, float* lds) {
    const int lane = threadIdx.x & 63, wave = __builtin_amdgcn_readfirstlane((int)threadIdx.x >> 6);
    float* scr = lds + wave * (64 * 65);
    const int gw = blockIdx.x * NWAVE + wave, NGW = gridDim.x * NWAVE;
    constexpr int I_IN = 16 * (NZP / 64), I_OUT = 16 * 16, I_Q = 16 * 32, I_G = 16 * 16, I_P = 4 * 16, I_L = I_IN + I_OUT + I_Q + I_G + I_P;
    for (int it = gw; it < 2 * I_L; it += NGW) {
        const int li = it / I_L; int r = it - li * I_L;
        if (r < I_IN) { tr_item(p.w_in + (size_t)li * DM * NZ, DM, NZ, (bf16*)(p.ws + WS_WIN) + (size_t)li * NZP * DM, scr, r, NZP / 64, lane); continue; } r -= I_IN;
        if (r < I_OUT) { tr_item(p.w_out + (size_t)li * DM * DM, DM, DM, (bf16*)(p.ws + WS_WOUT) + (size_t)li * DM * DM, scr, r, 16, lane); continue; } r -= I_OUT;
        if (r < I_Q) { tr_item(p.wq + (size_t)li * DM * 2048, DM, 2048, (bf16*)(p.ws + WS_WQG) + (size_t)li * 3072 * DM, scr, r, 32, lane); continue; } r -= I_Q;
        if (r < I_G) { tr_item(p.wg + (size_t)li * DM * DM, DM, DM, (bf16*)(p.ws + WS_WQG) + (size_t)li * 3072 * DM + (size_t)2048 * DM, scr, r, 16, lane); continue; } r -= I_G;
        tr_item(p.wp + (size_t)li * 256 * DM, 256, DM, (bf16*)(p.ws + WS_WP) + (size_t)li * DM * 256, scr, r, 16, lane);
    }
    cvt_f32_bf16(p.x, (bf16*)(p.ws + WS_XB), (size_t)NT * DM / 8);
    cvt_f32_bf16(p.p, (bf16*)(p.ws + WS_PB), (size_t)2 * NT * 256 / 8);
    cvt_f32_bf16(p.keys, (bf16*)(p.ws + WS_KEYS), (size_t)2 * 8 * 2 * 128 * 128 / 8);
}

__device__ __forceinline__ void p0_tables(const Params& p) {
    float* rcos = (float*)(p.ws + WS_RCOS); float* rsin = (float*)(p.ws + WS_RSIN); float* acos_ = (float*)(p.ws + WS_ACOS); float* asin_ = (float*)(p.ws + WS_ASIN);
    const int gt = blockIdx.x * NTHR + threadIdx.x, GT = gridDim.x * NTHR;
    for (int i = gt; i < SEQ * 32; i += GT) { const int pos = i >> 5, k = i & 31; const float inv = powf(10000.0f, -(float)k / 32.0f); const float ang = (float)pos * inv; rcos[i] = cosf(ang); rsin[i] = sinf(ang); }
    for (int i = gt; i < SEQ * 8; i += GT) { const int pos = i >> 3, k = i & 7; const float inv = powf(500000.0f, -(float)k / 8.0f); const float ang = (float)pos * inv; acos_[i] = cosf(ang); asin_[i] = sinf(ang); }
}

__device__ __forceinline__ float ret_lg(int h) { return logf(1.0f - exp2f(-5.0f - (float)h)); }


__device__ __forceinline__ float logsigmoidf_(float f) { return fminf(f, 0.f) - log1pf(expf(-fabsf(f))); }


typedef short bf16x8_t __attribute__((ext_vector_type(8)));
typedef short s16x4_t __attribute__((ext_vector_type(4)));
typedef float f32x16 __attribute__((ext_vector_type(16)));
__device__ __forceinline__ s16x4_t lds_tr(const LAS unsigned char* p) { return __builtin_bit_cast(s16x4_t, __builtin_amdgcn_ds_read_tr16_b64_v4i16((LAS s16x4_t*)p)); }

__device__ __forceinline__ void attn_unit(const Params& p, int unit, LAS unsigned char* lds) {
    RGN_T0(9)
    const int tid = threadIdx.x, lane = tid & 63, wave = __builtin_amdgcn_readfirstlane(tid >> 6);
    const int r32 = lane & 31, hh = lane >> 5;
    const bf16* Z = (const bf16*)(p.ws + WS_Z);
    const int bh = unit / 96, uu = unit - bh * 96, r = uu >> 5, v = uu & 31;
    const int dl = 1 << (2 * r), nb = 32 >> (2 * r);
    const int x = v / nb, blk = v - x * nb, q0 = blk * 256;
    const int b = bh >> 2, h = bh & 3;
    bf16* AO = (bf16*)(p.ws + WS_AO) + (size_t)r * NT * 256; float* ALSE = (float*)(p.ws + WS_ALSE) + (size_t)r * NT * 4;
    LAS unsigned char* Ks = lds; LAS unsigned char* Vs = lds + 384 * 128;
#pragma unroll 3
    for (int idx = tid; idx < 384 * 8; idx += NTHR) {
        const int i = idx >> 3, c = idx & 7, jk = q0 - 128 + i;
        const int jc = jk < 0 ? 0 : jk;
        const bf16* zr = Z + (size_t)(b * SEQ + jc * dl + x) * ZW + h * 64 + c * 8;
        u32x4 kv = *(const u32x4*)(zr + C_AK), vv = *(const u32x4*)(zr + C_AV);
        if (jk < 0) { kv = (u32x4){0u, 0u, 0u, 0u}; vv = (u32x4){0u, 0u, 0u, 0u}; }
        const int off = i * 128 + ((c ^ (i & 7)) << 4);
        *(LAS u32x4*)(Ks + off) = kv; *(LAS u32x4*)(Vs + off) = vv;
    }
    const int jq = q0 + 32 * wave + r32;
    const int tokq = b * SEQ + jq * dl + x;
    bf16x8_t qf[4];
#pragma unroll
    for (int ks = 0; ks < 4; ++ks) qf[ks] = *(const bf16x8_t*)(Z + (size_t)tokq * ZW + C_AQ + h * 64 + 16 * ks + 8 * hh);
    __syncthreads();
    f32x16 st[5];
#pragma unroll
    for (int tl = 0; tl < 5; ++tl) {
        f32x16 a16 = {0.f, 0.f, 0.f, 0.f, 0.f, 0.f, 0.f, 0.f, 0.f, 0.f, 0.f, 0.f, 0.f, 0.f, 0.f, 0.f};
        const int i = 32 * wave + 32 * tl + r32;
#pragma unroll
        for (int ks = 0; ks < 4; ++ks) {
            const int c = 2 * ks + hh;
            const bf16x8_t kf = *(const LAS bf16x8_t*)(Ks + i * 128 + ((c ^ (i & 7)) << 4));
            a16 = __builtin_amdgcn_mfma_f32_32x32x16_bf16(kf, qf[ks], a16, 0, 0, 0);
        }
        st[tl] = a16;
    }
    const int kb = q0 + 32 * wave - 128;
    float m = -INFINITY;
#pragma unroll
    for (int tl = 0; tl < 5; ++tl)
#pragma unroll
        for (int rg = 0; rg < 16; ++rg) {
            const int c = 32 * tl + (rg & 3) + 8 * (rg >> 2) + 4 * hh;
            const bool valid = (c >= r32) && (c <= r32 + 128) && (kb + c >= 0);
            const float sv = valid ? st[tl][rg] : -INFINITY;
            st[tl][rg] = sv; m = fmaxf(m, sv);
        }
    m = fmaxf(m, __shfl_xor(m, 32));
    float den = 0.f;
#pragma unroll
    for (int tl = 0; tl < 5; ++tl)
#pragma unroll
        for (int rg = 0; rg < 16; ++rg) { const float pe = __expf(st[tl][rg] - m); st[tl][rg] = pe; den += pe; }
    den += __shfl_xor(den, 32);
    f32x16 o[2];
#pragma unroll
    for (int dt = 0; dt < 2; ++dt) o[dt] = (f32x16){0.f, 0.f, 0.f, 0.f, 0.f, 0.f, 0.f, 0.f, 0.f, 0.f, 0.f, 0.f, 0.f, 0.f, 0.f, 0.f};
    const int tq = (lane & 15) >> 2, tp = lane & 3, tg = (lane >> 4) & 1;
#pragma unroll
    for (int tl = 0; tl < 5; ++tl)
#pragma unroll
        for (int s2 = 0; s2 < 2; ++s2) {
            u32x4 pw; pw.x = cvtpk(st[tl][8 * s2 + 0], st[tl][8 * s2 + 1]); pw.y = cvtpk(st[tl][8 * s2 + 2], st[tl][8 * s2 + 3]); pw.z = cvtpk(st[tl][8 * s2 + 4], st[tl][8 * s2 + 5]); pw.w = cvtpk(st[tl][8 * s2 + 6], st[tl][8 * s2 + 7]);
            const bf16x8_t pb = __builtin_bit_cast(bf16x8_t, pw);
            const int i0 = 32 * wave + 32 * tl + 16 * s2 + 4 * hh + tq;
#pragma unroll
            for (int dt = 0; dt < 2; ++dt) {
                const int c = 4 * dt + 2 * tg + (tp >> 1);
                const int i1 = i0 + 8;
                const s16x4_t lo = lds_tr(Vs + i0 * 128 + ((c ^ (i0 & 7)) << 4) + 8 * (tp & 1));
                const s16x4_t hi = lds_tr(Vs + i1 * 128 + ((c ^ (i1 & 7)) << 4) + 8 * (tp & 1));
                const bf16x8_t vf = (bf16x8_t){lo[0], lo[1], lo[2], lo[3], hi[0], hi[1], hi[2], hi[3]};
                o[dt] = __builtin_amdgcn_mfma_f32_32x32x16_bf16(vf, pb, o[dt], 0, 0, 0);
            }
        }
    const float rden = 1.0f / den;
    bf16* orow = AO + (size_t)tokq * 256 + h * 64;
#pragma unroll
    for (int dt = 0; dt < 2; ++dt)
#pragma unroll
        for (int g4 = 0; g4 < 4; ++g4) {
            const int d = 32 * dt + 8 * g4 + 4 * hh;
            *(uint2*)(orow + d) = make_uint2(cvtpk(o[dt][4 * g4] * rden, o[dt][4 * g4 + 1] * rden), cvtpk(o[dt][4 * g4 + 2] * rden, o[dt][4 * g4 + 3] * rden));
        }
    if (hh == 0) ALSE[(size_t)tokq * 4 + h] = m + __logf(den);
    __syncthreads();
    RGN_T1(9, lds)
}

__device__ __forceinline__ void attn_merge(const Params& p) {
    const bf16* AO = (const bf16*)(p.ws + WS_AO); const float* ALSE = (const float*)(p.ws + WS_ALSE);
    bf16* MIX = (bf16*)(p.ws + WS_MIX);
    const int gt = blockIdx.x * NTHR + threadIdx.x, GT = gridDim.x * NTHR;
    for (int e0 = gt; e0 < NT * 32; e0 += 2 * GT) {
        float l[2][3]; uint4 a[2][3];
#pragma unroll
        for (int u = 0; u < 2; ++u) { const int e = (e0 + u * GT < NT * 32) ? e0 + u * GT : e0; const int t = e >> 5, c8 = e & 31, h = c8 >> 3;
#pragma unroll
            for (int r = 0; r < 3; ++r) { l[u][r] = ALSE[(size_t)r * NT * 4 + (size_t)t * 4 + h]; a[u][r] = *(const uint4*)(AO + (size_t)r * NT * 256 + (size_t)t * 256 + c8 * 8); } }
#pragma unroll
        for (int u = 0; u < 2; ++u) {
            const int e = e0 + u * GT;
            if (e < NT * 32) {
                const int t = e >> 5, c8 = e & 31;
                const float M = fmaxf(fmaxf(l[u][0], l[u][1]), l[u][2]);
                float w0 = __expf(l[u][0] - M), w1 = __expf(l[u][1] - M), w2 = __expf(l[u][2] - M);
                const float rs = 1.0f / (w0 + w1 + w2); w0 *= rs; w1 *= rs; w2 *= rs;
                float a0[8], a1[8], a2[8]; unpack8(a[u][0], a0); unpack8(a[u][1], a1); unpack8(a[u][2], a2);
                float y[8];
#pragma unroll
                for (int j = 0; j < 8; ++j) y[j] = w0 * a0[j] + w1 * a1[j] + w2 * a2[j];
                *(uint4*)(MIX + (size_t)t * DM + 512 + c8 * 8) = make_uint4(pk2(y[0], y[1]), pk2(y[2], y[3]), pk2(y[4], y[5]), pk2(y[6], y[7]));
            }
        }
    }
}

constexpr int UNIT_LDS = 79360;
__device__ __forceinline__ int swz16(int row, int chunk) { return (chunk ^ (row & 7)) << 4; }
template <bool ACCPERM>
__device__ __forceinline__ bf16x8_t frag_tr(const LAS unsigned char* img, int RB, int kbase, int cbase, int lane) {
    const int tq = (lane & 15) >> 2, tp = lane & 3, tg = (lane >> 4) & 1, hh = lane >> 5;
    const int r0 = kbase + (ACCPERM ? 4 : 8) * hh + tq, r1 = r0 + (ACCPERM ? 8 : 4);
    const int colb = (cbase + 16 * tg + 4 * tp) * 2, ch = colb >> 4, sub = colb & 15;
    const s16x4_t lo = lds_tr(img + r0 * RB + swz16(r0, ch) + sub);
    const s16x4_t hi = lds_tr(img + r1 * RB + swz16(r1, ch) + sub);
    return (bf16x8_t){lo[0], lo[1], lo[2], lo[3], hi[0], hi[1], hi[2], hi[3]};
}
__device__ __forceinline__ bf16x8_t frag_row(const LAS unsigned char* img, int RB, int row, int chunk) { return *(const LAS bf16x8_t*)(img + row * RB + swz16(row, chunk)); }
__device__ __forceinline__ u32x4 pack8(const float* v) { u32x4 w; w.x = pk2(v[0], v[1]); w.y = pk2(v[2], v[3]); w.z = pk2(v[4], v[5]); w.w = pk2(v[6], v[7]); return w; }
#define F16Z ((f32x16){0.f, 0.f, 0.f, 0.f, 0.f, 0.f, 0.f, 0.f, 0.f, 0.f, 0.f, 0.f, 0.f, 0.f, 0.f, 0.f})
__device__ __forceinline__ int acc_row(int rg, int hh) { return (rg & 3) + 8 * (rg >> 2) + 4 * hh; }

template <bool ZETA>
__device__ __forceinline__ void stage_ret_k(const Params& p, LAS unsigned char* Ks, int t0, int s0, int h, float lg, int tidU) {
    const bf16* Z = (const bf16*)(p.ws + WS_Z);
    const float* rcos = (const float*)(p.ws + WS_RCOS); const float* rsin = (const float*)(p.ws + WS_RSIN);
#pragma unroll
    for (int task = tidU; task < 512; task += 256) {
        const int row = task >> 2, pc = task & 3;
        const bf16* zr = Z + (size_t)(t0 + row) * ZW + C_RK + h * 64;
        float a[8], bq[8], o1[8], o2[8];
        unpack8v(*(const u32x4*)(zr + 8 * pc), a); unpack8v(*(const u32x4*)(zr + 32 + 8 * pc), bq);
        const f32x4 c0 = *(const f32x4*)(rcos + (s0 + row) * 32 + 8 * pc), c1 = *(const f32x4*)(rcos + (s0 + row) * 32 + 8 * pc + 4);
        const f32x4 n0 = *(const f32x4*)(rsin + (s0 + row) * 32 + 8 * pc), n1 = *(const f32x4*)(rsin + (s0 + row) * 32 + 8 * pc + 4);
        const float sc = ZETA ? 0.125f * __expf(lg * (float)(127 - row)) : 0.125f;
#pragma unroll
        for (int j = 0; j < 8; ++j) { const float cs = j < 4 ? c0[j & 3] : c1[j & 3], sn = j < 4 ? n0[j & 3] : n1[j & 3]; o1[j] = (a[j] * cs - bq[j] * sn) * sc; o2[j] = (bq[j] * cs + a[j] * sn) * sc; }
        *(LAS u32x4*)(Ks + row * 128 + swz16(row, pc)) = pack8(o1); *(LAS u32x4*)(Ks + row * 128 + swz16(row, pc + 4)) = pack8(o2);
    }
}
__device__ __forceinline__ void stage_copy(const bf16* src0, int ld, LAS unsigned char* img, int RB, int nrows, int nchunks, int tidU) {
#pragma unroll 4
    for (int task = tidU; task < nrows * nchunks; task += 256) {
        const int row = task / nchunks, c = task - row * nchunks;
        *(LAS u32x4*)(img + row * RB + swz16(row, c)) = *(const u32x4*)(src0 + (size_t)row * ld + 8 * c);
    }
}

__device__ __forceinline__ void ret_state_u(const Params& p, int unit, LAS unsigned char* ldsU, int wl, int tidU, int lane) {
    RGN_T0(7)
    const int c = unit & 63, bh = unit >> 6, h = bh & 3, b = bh >> 2, t0 = b * SEQ + c * 128, s0 = c * 128;
    const bf16* Z = (const bf16*)(p.ws + WS_Z); float* RST = (float*)(p.ws + WS_RST);
    LAS unsigned char* Ks = ldsU; LAS unsigned char* Vs = ldsU + 16384;
    stage_ret_k<true>(p, Ks, t0, s0, h, ret_lg(h), tidU);
    stage_copy(Z + (size_t)t0 * ZW + C_RV + h * 128, ZW, Vs, 256, 128, 16, tidU);
    __syncthreads();
    f32x16 a0 = F16Z, a1 = F16Z;
#pragma unroll 2
    for (int ks = 0; ks < 8; ++ks) {
        const bf16x8_t A = frag_tr<false>(Vs, 256, 16 * ks, 32 * wl, lane);
        const bf16x8_t B0 = frag_tr<false>(Ks, 128, 16 * ks, 0, lane), B1 = frag_tr<false>(Ks, 128, 16 * ks, 32, lane);
        a0 = __builtin_amdgcn_mfma_f32_32x32x16_bf16(A, B0, a0, 0, 0, 0); a1 = __builtin_amdgcn_mfma_f32_32x32x16_bf16(A, B1, a1, 0, 0, 0);
    }
    float* dst = RST + (size_t)unit * 8192; const int r32 = lane & 31, hh = lane >> 5;
#pragma unroll
    for (int rg = 0; rg < 16; ++rg) { const int dv = 32 * wl + acc_row(rg, hh); dst[dv * 64 + r32] = a0[rg]; dst[dv * 64 + 32 + r32] = a1[rg]; }
    __syncthreads();
    RGN_T1(7, ldsU)
}

__device__ __forceinline__ void mls_gates(const Params& p, int li, int t0, int h, int lane, float& b0, float& b1, float& g0, float& g1) {
    const float* gates = (const float*)(p.ws + WS_GATES);
    const float bi = p.b_if[li * 8 + h], bf = p.b_if[li * 8 + 4 + h];
    const int t = t0 + 2 * lane;
    const float i0 = gates[(size_t)t * 8 + h] + bi, i1 = gates[(size_t)(t + 1) * 8 + h] + bi;
    const float f0 = logsigmoidf_(gates[(size_t)t * 8 + 4 + h] + bf), f1 = logsigmoidf_(gates[(size_t)(t + 1) * 8 + 4 + h] + bf);
    const float tot = f0 + f1; float v = tot;
#pragma unroll
    for (int o = 1; o < 64; o <<= 1) { const float u = __shfl_up(v, o); if (lane >= o) v += u; }
    const float ex = v - tot;
    b0 = ex + f0; b1 = ex + tot; g0 = i0 - b0; g1 = i1 - b1;
}
__device__ __forceinline__ void conv8(const bf16* zq, const float* cw, int nprev, float scale, float* o) {
    float acc[8];
#pragma unroll
    for (int e = 0; e < 8; ++e) acc[e] = 0.f;
    u32x4 xr[4]; f32x4 w0[4], w1[4];
#pragma unroll
    for (int j = 0; j < 4; ++j) {
        const int back = (3 - j <= nprev) ? (3 - j) : 0;
        xr[j] = *(const u32x4*)(zq - (size_t)back * ZW);
        w0[j] = *(const f32x4*)(cw + j * 512); w1[j] = *(const f32x4*)(cw + j * 512 + 4);
    }
#pragma unroll
    for (int j = 0; j < 4; ++j) {
        const float ok = (3 - j <= nprev) ? 1.0f : 0.0f;
        float xv[8]; unpack8v(xr[j], xv);
#pragma unroll
        for (int e = 0; e < 8; ++e) acc[e] = fmaf((e < 4 ? w0[j][e & 3] : w1[j][e & 3]) * ok, xv[e], acc[e]);
    }
#pragma unroll
    for (int e = 0; e < 8; ++e) o[e] = siluf_(acc[e]) * scale;
}
__device__ __forceinline__ void stage_vext(const bf16* src0, LAS unsigned char* Vs, int tidU) {
#pragma unroll 3
    for (int task = tidU; task < 128 * 12; task += 256) {
        const int row = task / 12, c = task - row * 12;
        u32x4 v = *(const u32x4*)(src0 + (size_t)row * ZW + 8 * (c & 7));
        if (c >= 8) { v = (u32x4){0u, 0u, 0u, 0u}; if (c == 8) v.x = 0x3F80u; }
        *(LAS u32x4*)(Vs + row * 256 + swz16(row, c)) = v;
    }
}

__device__ __forceinline__ void mls_state_u(const Params& p, int li, int unit, LAS unsigned char* ldsU, int wl, int tidU, int lane) {
    RGN_T0(8)
    const int c = unit & 63, bh = unit >> 6, h = bh & 3, b = bh >> 2, t0 = b * SEQ + c * 128;
    const bf16* Z = (const bf16*)(p.ws + WS_Z);
    float* MC = (float*)(p.ws + WS_MC); float* MN = (float*)(p.ws + WS_MN); float* MA = (float*)(p.ws + WS_MA); float* MML = (float*)(p.ws + WS_MML);
    LAS unsigned char* Ks = ldsU; LAS unsigned char* Vs = ldsU + 16384; LAS float* wk = (LAS float*)(ldsU + 49152);
    if (wl == 0) {
        float b0, b1, g0, g1; mls_gates(p, li, t0, h, lane, b0, b1, g0, g1);
        const float gmax = wave_max(fmaxf(g0, g1));
        const float a = __shfl(b1, 63);
        wk[2 * lane] = __expf(g0 - gmax); wk[2 * lane + 1] = __expf(g1 - gmax);
        if (lane == 0) { MA[unit] = a; MML[unit] = a + gmax; }
    }
    stage_vext(Z + (size_t)t0 * ZW + C_MV + h * 64, Vs, tidU);
    __syncthreads();
    bf16* QKC = (bf16*)p.out;
#pragma unroll 2
    for (int task = tidU; task < 2048; task += 256) {
        const int isq = task >> 10, row = (task >> 3) & 127, cc = task & 7;
        float o[8]; conv8(Z + (size_t)(t0 + row) * ZW + (isq ? C_MQ : C_MK) + h * 64 + 8 * cc, p.conv_w + (size_t)li * 2048 + (isq ? 0 : 256) + h * 64 + 8 * cc, c * 128 + row, isq ? 1.0f : 0.125f, o);
        *(u32x4*)(QKC + (size_t)(t0 + row) * 512 + (isq ? 0 : 256) + h * 64 + 8 * cc) = pack8(o);
        if (!isq) { const float w = wk[row];
#pragma unroll
            for (int e = 0; e < 8; ++e) o[e] *= w;
            *(LAS u32x4*)(Ks + row * 128 + swz16(row, cc)) = pack8(o); }
    }
    __syncthreads();
    if (wl < 3) {
        f32x16 a0 = F16Z, a1 = F16Z;
#pragma unroll 2
        for (int ks = 0; ks < 8; ++ks) {
            const bf16x8_t A = frag_tr<false>(Vs, 256, 16 * ks, 32 * wl, lane);
            const bf16x8_t B0 = frag_tr<false>(Ks, 128, 16 * ks, 0, lane), B1 = frag_tr<false>(Ks, 128, 16 * ks, 32, lane);
            a0 = __builtin_amdgcn_mfma_f32_32x32x16_bf16(A, B0, a0, 0, 0, 0); a1 = __builtin_amdgcn_mfma_f32_32x32x16_bf16(A, B1, a1, 0, 0, 0);
        }
        const int r32 = lane & 31, hh = lane >> 5;
        if (wl < 2) {
            float* dst = MC + (size_t)unit * 4096;
#pragma unroll
            for (int rg = 0; rg < 16; ++rg) { const int v = 32 * wl + acc_row(rg, hh); dst[v * 64 + r32] = a0[rg]; dst[v * 64 + 32 + r32] = a1[rg]; }
        } else if (hh == 0) { MN[(size_t)unit * 64 + r32] = a0[0]; MN[(size_t)unit * 64 + 32 + r32] = a1[0]; }
    }
    __syncthreads();
    RGN_T1(8, ldsU)
}

__device__ __forceinline__ void epi_stage_put(LAS unsigned char* reg, int r32, int col, float a, float b, float c, float d) {
    typedef unsigned u32x2_ __attribute__((ext_vector_type(2)));
    *(LAS u32x2_*)(reg + r32 * 128 + swz16(r32, col >> 3) + ((col & 4) << 1)) = (u32x2_){pk2(a, b), pk2(c, d)};
}
__device__ __forceinline__ void ret_out_u(const Params& p, int li, int unit, LAS unsigned char* ldsU, int wl, int tidU, int lane) {
    const int c = unit & 63, bh = unit >> 6, h = bh & 3, b = bh >> 2, t0 = b * SEQ + c * 128, s0 = c * 128;
    const int r32 = lane & 31, hh = lane >> 5;
    const bf16* Z = (const bf16*)(p.ws + WS_Z); const float* RST = (const float*)(p.ws + WS_RST); bf16* MIX = (bf16*)(p.ws + WS_MIX);
    const float* rcos = (const float*)(p.ws + WS_RCOS); const float* rsin = (const float*)(p.ws + WS_RSIN);
    LAS unsigned char* Ks = ldsU; LAS unsigned char* Vs = ldsU + 16384; LAS unsigned char* Rs = ldsU + 49152;
    const float lg = ret_lg(h);
    RGN_T0(1)
    stage_ret_k<false>(p, Ks, t0, s0, h, lg, tidU);
    stage_copy(Z + (size_t)t0 * ZW + C_RV + h * 128, ZW, Vs, 256, 128, 16, tidU);
#pragma unroll
    for (int task = tidU; task < 1024; task += 256) {
        const int row = task >> 3, cc = task & 7;
        const float* src = RST + (size_t)unit * 8192 + row * 64 + 8 * cc;
        const f32x4 x0 = *(const f32x4*)src, x1 = *(const f32x4*)(src + 4);
        const float v[8] = {x0[0], x0[1], x0[2], x0[3], x1[0], x1[1], x1[2], x1[3]};
        *(LAS u32x4*)(Rs + row * 128 + swz16(row, cc)) = pack8(v);
    }
    const int t = 32 * wl + r32, tok = t0 + t, pos = s0 + t;
    bf16x8_t qf[4];
    {
        float f[4][8];
#pragma unroll
        for (int ks = 0; ks < 4; ++ks) unpack8v(*(const u32x4*)(Z + (size_t)tok * ZW + C_RQ + h * 64 + 16 * ks + 8 * hh), f[ks]);
#pragma unroll
        for (int ks = 0; ks < 2; ++ks) {
            const float* cp = rcos + pos * 32 + 16 * ks + 8 * hh; const float* sp = rsin + pos * 32 + 16 * ks + 8 * hh;
            const f32x4 c0 = *(const f32x4*)cp, c1 = *(const f32x4*)(cp + 4), n0 = *(const f32x4*)sp, n1 = *(const f32x4*)(sp + 4);
#pragma unroll
            for (int j = 0; j < 8; ++j) { const float cs = j < 4 ? c0[j & 3] : c1[j & 3], sn = j < 4 ? n0[j & 3] : n1[j & 3]; const float x1 = f[ks][j], x2 = f[ks + 2][j]; f[ks][j] = x1 * cs - x2 * sn; f[ks + 2][j] = x2 * cs + x1 * sn; }
        }
#pragma unroll
        for (int ks = 0; ks < 4; ++ks) qf[ks] = __builtin_bit_cast(bf16x8_t, pack8(f[ks]));
    }
    __syncthreads();
    RGN_T1(1, ldsU)
    RGN_T0(2)
    f32x16 o[4];
#pragma unroll
    for (int dt = 0; dt < 4; ++dt) {
        f32x16 a = F16Z;
#pragma unroll
        for (int ks = 0; ks < 4; ++ks) a = __builtin_amdgcn_mfma_f32_32x32x16_bf16(frag_row(Rs, 128, 32 * dt + r32, 2 * ks + hh), qf[ks], a, 0, 0, 0);
        o[dt] = a;
    }
    const float xi = __expf(lg * (float)(t + 1));
#pragma unroll
    for (int dt = 0; dt < 4; ++dt)
#pragma unroll
        for (int rg = 0; rg < 16; ++rg) o[dt][rg] *= xi;
#pragma unroll 1
    for (int tl = 0; tl <= wl; ++tl) {
        {
            f32x16 st = F16Z;
#pragma unroll
            for (int ks = 0; ks < 4; ++ks) st = __builtin_amdgcn_mfma_f32_32x32x16_bf16(frag_row(Ks, 128, 32 * tl + r32, 2 * ks + hh), qf[ks], st, 0, 0, 0);
#pragma unroll
            for (int rg = 0; rg < 16; ++rg) { const int s = 32 * tl + acc_row(rg, hh); st[rg] = (s <= t) ? st[rg] * __expf(lg * (float)(t - s)) : 0.f; }
#pragma unroll
            for (int s2 = 0; s2 < 2; ++s2) {
                u32x4 pw; pw.x = cvtpk(st[8 * s2 + 0], st[8 * s2 + 1]); pw.y = cvtpk(st[8 * s2 + 2], st[8 * s2 + 3]); pw.z = cvtpk(st[8 * s2 + 4], st[8 * s2 + 5]); pw.w = cvtpk(st[8 * s2 + 6], st[8 * s2 + 7]);
                const bf16x8_t pb = __builtin_bit_cast(bf16x8_t, pw);
#pragma unroll
                for (int dt = 0; dt < 4; ++dt) o[dt] = __builtin_amdgcn_mfma_f32_32x32x16_bf16(frag_tr<true>(Vs, 256, 32 * tl + 16 * s2, 32 * dt, lane), pb, o[dt], 0, 0, 0);
            }
        }
    }
    RGN_T1(2, ldsU)
    RGN_T0(3)
    float sum = 0.f, sq = 0.f;
#pragma unroll
    for (int dt = 0; dt < 4; ++dt)
#pragma unroll
        for (int rg = 0; rg < 16; ++rg) { sum += o[dt][rg]; sq += o[dt][rg] * o[dt][rg]; }
    sum += __shfl_xor(sum, 32); sq += __shfl_xor(sq, 32);
    const float mean = sum * (1.0f / 128.0f);
    const float rstd = 1.0f / sqrtf(fmaxf(sq * (1.0f / 128.0f) - mean * mean, 0.f) + LN_EPS);
    __syncthreads();
#pragma unroll
    for (int dt = 0; dt < 4; ++dt)
#pragma unroll
        for (int g4 = 0; g4 < 4; ++g4) {
            const int dv = 32 * dt + 8 * g4 + 4 * hh;
            const f32x4 gg = *(const f32x4*)(p.ret_g + li * 512 + h * 128 + dv);
            epi_stage_put(((dt < 2) ? Ks : Rs) + 4096 * wl, r32, dv & 63, (o[dt][4 * g4 + 0] - mean) * rstd * gg[0], (o[dt][4 * g4 + 1] - mean) * rstd * gg[1], (o[dt][4 * g4 + 2] - mean) * rstd * gg[2], (o[dt][4 * g4 + 3] - mean) * rstd * gg[3]);
        }
    asm volatile("s_waitcnt lgkmcnt(0)" ::: "memory");
#pragma unroll
    for (int j = 0; j < 8; ++j) {
        const int idx = (lane + 64 * j) & 255, half = j >> 2, row = idx >> 3, cc = idx & 7;
        const LAS unsigned char* reg = (half ? Rs : Ks) + 4096 * wl;
        float yv[8], gv[8]; unpack8v(*(const LAS u32x4*)(reg + row * 128 + swz16(row, cc)), yv);
        const size_t tk = (size_t)(t0 + 32 * wl + row);
        unpack8v(*(const u32x4*)(Z + tk * ZW + C_RG + h * 128 + 64 * half + 8 * cc), gv);
#pragma unroll
        for (int e = 0; e < 8; ++e) yv[e] *= siluf_(gv[e]);
        *(u32x4*)(MIX + tk * DM + h * 128 + 64 * half + 8 * cc) = pack8(yv);
    }
    __syncthreads();
    RGN_T1(3, ldsU)
}

__device__ __forceinline__ void mls_out_u(const Params& p, int li, int unit, LAS unsigned char* ldsU, int wl, int tidU, int lane) {
    const int c = unit & 63, bh = unit >> 6, h = bh & 3, b = bh >> 2, t0 = b * SEQ + c * 128;
    const int r32 = lane & 31, hh = lane >> 5;
    const bf16* Z = (const bf16*)(p.ws + WS_Z); bf16* MIX = (bf16*)(p.ws + WS_MIX);
    const float* MC = (const float*)(p.ws + WS_MC); const float* MN = (const float*)(p.ws + WS_MN); const float* MMP = (const float*)(p.ws + WS_MMP);
    LAS unsigned char* Ks = ldsU; LAS unsigned char* Qs = ldsU + 16384; LAS unsigned char* Vs = ldsU + 32768; LAS unsigned char* Cs = ldsU + 65536;
    LAS float* bb = (LAS float*)(ldsU + 77824); LAS float* gg = bb + 128; LAS float* pm = gg + 128;
    RGN_T0(4)
    if (wl == 0) {
        float b0, b1, g0, g1; mls_gates(p, li, t0, h, lane, b0, b1, g0, g1);
        const float p1 = fmaxf(g0, g1); float v = p1;
#pragma unroll
        for (int o = 1; o < 64; o <<= 1) { const float u = __shfl_up(v, o); if (lane >= o) v = fmaxf(v, u); }
        const float prev = __shfl_up(v, 1);
        const float ex = (lane == 0) ? -INFINITY : prev;
        bb[2 * lane] = b0; bb[2 * lane + 1] = b1; gg[2 * lane] = g0; gg[2 * lane + 1] = g1;
        pm[2 * lane] = fmaxf(ex, g0); pm[2 * lane + 1] = fmaxf(ex, p1);
    }
    stage_vext(Z + (size_t)t0 * ZW + C_MV + h * 64, Vs, tidU);
    stage_copy((const bf16*)p.out + (size_t)t0 * 512 + 256 + h * 64, 512, Ks, 128, 128, 8, tidU);
    stage_copy((const bf16*)p.out + (size_t)t0 * 512 + h * 64, 512, Qs, 128, 128, 8, tidU);
#pragma unroll
    for (int task = tidU; task < 96 * 8; task += 256) {
        const int row = task >> 3, cc = task & 7;
        const float* src = (row < 64) ? (MC + (size_t)unit * 4096 + row * 64 + 8 * cc) : (MN + (size_t)unit * 64 + 8 * cc);
        const f32x4 x0 = *(const f32x4*)src, x1 = *(const f32x4*)(src + 4);
        const float ok = (row <= 64) ? 1.0f : 0.0f;
        const float v[8] = {x0[0] * ok, x0[1] * ok, x0[2] * ok, x0[3] * ok, x1[0] * ok, x1[1] * ok, x1[2] * ok, x1[3] * ok};
        *(LAS u32x4*)(Cs + row * 128 + swz16(row, cc)) = pack8(v);
    }
    const float mprev = MMP[unit];
    __syncthreads();
    RGN_T1(4, ldsU)
    RGN_T0(5)
    const int t = 32 * wl + r32, tok = t0 + t;
    const float Mt = fmaxf(mprev, pm[t]), bt = bb[t];
    const float winter = __expf(mprev - Mt);
    bf16x8_t qf[4];
#pragma unroll
    for (int ks = 0; ks < 4; ++ks) qf[ks] = frag_row(Qs, 128, t, 2 * ks + hh);
    f32x16 o[3];
#pragma unroll
    for (int dt = 0; dt < 3; ++dt) {
        f32x16 a = F16Z;
#pragma unroll
        for (int ks = 0; ks < 4; ++ks) a = __builtin_amdgcn_mfma_f32_32x32x16_bf16(frag_row(Cs, 128, 32 * dt + r32, 2 * ks + hh), qf[ks], a, 0, 0, 0);
#pragma unroll
        for (int rg = 0; rg < 16; ++rg) a[rg] *= winter;
        o[dt] = a;
    }
#pragma unroll 1
    for (int tl = 0; tl <= wl; ++tl) {
        {
            f32x16 st = F16Z;
#pragma unroll
            for (int ks = 0; ks < 4; ++ks) st = __builtin_amdgcn_mfma_f32_32x32x16_bf16(frag_row(Ks, 128, 32 * tl + r32, 2 * ks + hh), qf[ks], st, 0, 0, 0);
#pragma unroll
            for (int g4 = 0; g4 < 4; ++g4) {
                const int sb = 32 * tl + 8 * g4 + 4 * hh;
                const f32x4 gv = *(const LAS f32x4*)(gg + sb);
#pragma unroll
                for (int j = 0; j < 4; ++j) st[4 * g4 + j] = (sb + j <= t) ? st[4 * g4 + j] * __expf(gv[j] - Mt) : 0.f;
            }
#pragma unroll
            for (int s2 = 0; s2 < 2; ++s2) {
                u32x4 pw; pw.x = cvtpk(st[8 * s2 + 0], st[8 * s2 + 1]); pw.y = cvtpk(st[8 * s2 + 2], st[8 * s2 + 3]); pw.z = cvtpk(st[8 * s2 + 4], st[8 * s2 + 5]); pw.w = cvtpk(st[8 * s2 + 6], st[8 * s2 + 7]);
                const bf16x8_t pb = __builtin_bit_cast(bf16x8_t, pw);
#pragma unroll
                for (int dt = 0; dt < 3; ++dt) o[dt] = __builtin_amdgcn_mfma_f32_32x32x16_bf16(frag_tr<true>(Vs, 256, 32 * tl + 16 * s2, 32 * dt, lane), pb, o[dt], 0, 0, 0);
            }
        }
    }
    RGN_T1(5, ldsU)
    RGN_T0(6)
    const float den = __shfl(o[2][0], r32);
    const float rden = 1.0f / fmaxf(fabsf(den), __expf(-(bt + Mt)));
    float sum = 0.f, sq = 0.f;
#pragma unroll
    for (int dt = 0; dt < 2; ++dt)
#pragma unroll
        for (int rg = 0; rg < 16; ++rg) { o[dt][rg] *= rden; sum += o[dt][rg]; sq += o[dt][rg] * o[dt][rg]; }
    sum += __shfl_xor(sum, 32); sq += __shfl_xor(sq, 32);
    const float mean = sum * (1.0f / 64.0f);
    const float rstd = 1.0f / sqrtf(fmaxf(sq * (1.0f / 64.0f) - mean * mean, 0.f) + LN_EPS);
    __syncthreads();
#pragma unroll
    for (int dt = 0; dt < 2; ++dt)
#pragma unroll
        for (int g4 = 0; g4 < 4; ++g4) {
            const int d = 32 * dt + 8 * g4 + 4 * hh;
            const f32x4 gn = *(const f32x4*)(p.mls_g + li * 256 + h * 64 + d);
            epi_stage_put(Ks + 4096 * wl, r32, d, (o[dt][4 * g4 + 0] - mean) * rstd * gn[0], (o[dt][4 * g4 + 1] - mean) * rstd * gn[1], (o[dt][4 * g4 + 2] - mean) * rstd * gn[2], (o[dt][4 * g4 + 3] - mean) * rstd * gn[3]);
        }
    asm volatile("s_waitcnt lgkmcnt(0)" ::: "memory");
#pragma unroll
    for (int j = 0; j < 4; ++j) {
        const int idx = lane + 64 * j, row = idx >> 3, cc = idx & 7;
        float yv[8], gv[8]; unpack8v(*(const LAS u32x4*)(Ks + 4096 * wl + row * 128 + swz16(row, cc)), yv);
        const size_t tk = (size_t)(t0 + 32 * wl + row);
        unpack8v(*(const u32x4*)(Z + tk * ZW + C_MO + h * 64 + 8 * cc), gv);
#pragma unroll
        for (int e = 0; e < 8; ++e) yv[e] *= sigmoidf_(gv[e]);
        *(u32x4*)(MIX + tk * DM + 768 + h * 64 + 8 * cc) = pack8(yv);
    }
    __syncthreads();
    RGN_T1(6, ldsU)
}

__device__ __forceinline__ void p3_scans(const Params& p) {
    float* RST = (float*)(p.ws + WS_RST);
    float* MC = (float*)(p.ws + WS_MC); float* MN = (float*)(p.ws + WS_MN); const float* MA = (const float*)(p.ws + WS_MA); const float* MML = (const float*)(p.ws + WS_MML); float* MMP = (float*)(p.ws + WS_MMP);
    const int gt = blockIdx.x * NTHR + threadIdx.x, GT = gridDim.x * NTHR;
    for (int e = gt; e < 16 * 8192; e += GT) {
        const int bh = e >> 13, el = e & 8191, h = bh & 3;
        const float gL = expf(ret_lg(h) * 128.0f);
        float R = 0.f;
        float* ptr = RST + (size_t)bh * 64 * 8192 + el;
#pragma unroll 1
        for (int cb = 0; cb < 64; cb += 16) {
            float sv[16];
#pragma unroll
            for (int j = 0; j < 16; ++j) sv[j] = ptr[(size_t)(cb + j) * 8192];
#pragma unroll
            for (int j = 0; j < 16; ++j) { ptr[(size_t)(cb + j) * 8192] = R; R = fmaf(gL, R, sv[j]); }
        }
    }
    for (int e = gt; e < 16 * 4160; e += GT) {
        const int bh = e / 4160, el = e - bh * 4160;
        float* ptr; size_t stride;
        if (el < 4096) { ptr = MC + (size_t)bh * 64 * 4096 + el; stride = 4096; } else { ptr = MN + (size_t)bh * 64 * 64 + (el - 4096); stride = 64; }
        float m = 0.f, C = 0.f;
#pragma unroll 1
        for (int cb = 0; cb < 64; cb += 16) {
            float sv[16], av[16], mlv[16];
#pragma unroll
            for (int j = 0; j < 16; ++j) { sv[j] = ptr[(size_t)(cb + j) * stride]; av[j] = MA[bh * 64 + cb + j]; mlv[j] = MML[bh * 64 + cb + j]; }
#pragma unroll
            for (int j = 0; j < 16; ++j) {
                const float mn = fmaxf(av[j] + m, mlv[j]);
                const float f1 = __expf(av[j] + m - mn), f2 = __expf(mlv[j] - mn);
                ptr[(size_t)(cb + j) * stride] = C; C = f1 * C + f2 * sv[j];
                if (el == 0) MMP[bh * 64 + cb + j] = m;
                m = mn;
            }
        }
    }
}


template <int NB>
__device__ __forceinline__ void ln_rows(const bf16* U, bf16* XBo, signed char* XQ, float* XS, int r0, int rstep, const float* g, const float* bta, int lane) {
    float v[NB][16]; float s[NB];
#pragma unroll
    for (int u = 0; u < NB; ++u) { const int r = (r0 + u * rstep < NT) ? r0 + u * rstep : r0; const bf16* row = U + (size_t)r * DM + 8 * lane; s[u] = 0.f;
        const uint4 w0 = *(const uint4*)row, w1 = *(const uint4*)(row + 512); unpack8(w0, v[u]); unpack8(w1, v[u] + 8); }
    float gg[16], bv[16];
#pragma unroll
    for (int j = 0; j < 2; ++j) { const float4 a0 = *(const float4*)(g + 512 * j + 8 * lane), a1 = *(const float4*)(g + 512 * j + 8 * lane + 4), c0 = *(const float4*)(bta + 512 * j + 8 * lane), c1 = *(const float4*)(bta + 512 * j + 8 * lane + 4);
        gg[8 * j] = a0.x; gg[8 * j + 1] = a0.y; gg[8 * j + 2] = a0.z; gg[8 * j + 3] = a0.w; gg[8 * j + 4] = a1.x; gg[8 * j + 5] = a1.y; gg[8 * j + 6] = a1.z; gg[8 * j + 7] = a1.w;
        bv[8 * j] = c0.x; bv[8 * j + 1] = c0.y; bv[8 * j + 2] = c0.z; bv[8 * j + 3] = c0.w; bv[8 * j + 4] = c1.x; bv[8 * j + 5] = c1.y; bv[8 * j + 6] = c1.z; bv[8 * j + 7] = c1.w; }
#pragma unroll
    for (int u = 0; u < NB; ++u)
#pragma unroll
        for (int e = 0; e < 16; ++e) s[u] += v[u][e];
#pragma unroll
    for (int o = 1; o < 64; o <<= 1)
#pragma unroll
        for (int u = 0; u < NB; ++u) s[u] += __shfl_xor(s[u], o);
    float s2[NB];
#pragma unroll
    for (int u = 0; u < NB; ++u) { const float mean = s[u] * (1.0f / DM); s2[u] = 0.f;
#pragma unroll
        for (int e = 0; e < 16; ++e) { v[u][e] -= mean; s2[u] += v[u][e] * v[u][e]; } }
#pragma unroll
    for (int o = 1; o < 64; o <<= 1)
#pragma unroll
        for (int u = 0; u < NB; ++u) s2[u] += __shfl_xor(s2[u], o);
    float am[NB];
#pragma unroll
    for (int u = 0; u < NB; ++u) { const float rstd = 1.0f / sqrtf(s2[u] * (1.0f / DM) + LN_EPS); const int r = r0 + u * rstep; am[u] = 0.f;
#pragma unroll
        for (int e = 0; e < 16; ++e) { v[u][e] = v[u][e] * rstd * gg[e] + bv[e]; am[u] = fmaxf(am[u], fabsf(v[u][e])); }
        if (r < NT) { bf16* orow = XBo + (size_t)r * DM + 8 * lane;
            *(uint4*)orow = make_uint4(pk2(v[u][0], v[u][1]), pk2(v[u][2], v[u][3]), pk2(v[u][4], v[u][5]), pk2(v[u][6], v[u][7]));
            *(uint4*)(orow + 512) = make_uint4(pk2(v[u][8], v[u][9]), pk2(v[u][10], v[u][11]), pk2(v[u][12], v[u][13]), pk2(v[u][14], v[u][15])); } }
#pragma unroll
    for (int o = 1; o < 64; o <<= 1)
#pragma unroll
        for (int u = 0; u < NB; ++u) am[u] = fmaxf(am[u], __shfl_xor(am[u], o));
#pragma unroll
    for (int u = 0; u < NB; ++u) {
        const int r = r0 + u * rstep;
        if (r < NT) {
            const float inv = am[u] > 0.f ? 127.0f / am[u] : 0.f; signed char* qrow = XQ + (size_t)r * DM + 8 * lane;
            unsigned w[4];
#pragma unroll
            for (int k = 0; k < 4; ++k) { const unsigned q0 = (unsigned)__float2int_rn(v[u][4 * k] * inv) & 0xffu, q1 = (unsigned)__float2int_rn(v[u][4 * k + 1] * inv) & 0xffu, q2 = (unsigned)__float2int_rn(v[u][4 * k + 2] * inv) & 0xffu, q3 = (unsigned)__float2int_rn(v[u][4 * k + 3] * inv) & 0xffu; w[k] = q0 | (q1 << 8) | (q2 << 16) | (q3 << 24); }
            *(uint2*)qrow = make_uint2(w[0], w[1]); *(uint2*)(qrow + 512) = make_uint2(w[2], w[3]);
            if (lane == 0) XS[r] = am[u] * (1.0f / 127.0f);
        }
    }
}


__device__ __forceinline__ float key_embed(float v, unsigned idx, unsigned keepmask) { return __uint_as_float((__float_as_uint(v) & keepmask) | idx); }

template <int N>
__device__ __forceinline__ void bitonic_desc(float (&a)[N]) {
#pragma unroll
    for (int k = 2; k <= N; k <<= 1)
#pragma unroll
        for (int j = k >> 1; j > 0; j >>= 1)
#pragma unroll
            for (int i = 0; i < N; ++i) {
                const int l = i ^ j;
                if (l > i) { const float hi = fmaxf(a[i], a[l]), lo = fminf(a[i], a[l]); if ((i & k) == 0) { a[i] = hi; a[l] = lo; } else { a[i] = lo; a[l] = hi; } }
            }
}
__device__ __forceinline__ void merge_top16(float (&a)[16], const float (&b)[16]) {
#pragma unroll
    for (int i = 0; i < 16; ++i) a[i] = fmaxf(a[i], b[15 - i]);
#pragma unroll
    for (int j = 8; j > 0; j >>= 1)
#pragma unroll
        for (int i = 0; i < 16; ++i) { const int l = i ^ j; if (l > i) { const float hi = fmaxf(a[i], a[l]), lo = fminf(a[i], a[l]); a[i] = hi; a[l] = lo; } }
}
__device__ __forceinline__ void topk_half(const bf16x8_t (&qf)[8], const LAS unsigned char* kl, int r32, int hh, float (&out)[16]) {
    f32x16 st[4];
#pragma unroll
    for (int tl = 0; tl < 4; ++tl) {
        f32x16 a16 = {0.f, 0.f, 0.f, 0.f, 0.f, 0.f, 0.f, 0.f, 0.f, 0.f, 0.f, 0.f, 0.f, 0.f, 0.f, 0.f};
        const int n = 32 * tl + r32;
#pragma unroll
        for (int ks = 0; ks < 8; ++ks) {
            const int c = 8 * hh + ks;
            const bf16x8_t kf = *(const LAS bf16x8_t*)(kl + n * 256 + ((c ^ (n & 15)) << 4));
            a16 = __builtin_amdgcn_mfma_f32_32x32x16_bf16(kf, qf[ks], a16, 0, 0, 0);
        }
        st[tl] = a16;
    }
#pragma unroll
    for (int tl = 0; tl < 4; ++tl)
#pragma unroll
        for (int rg = 0; rg < 16; ++rg) st[tl][rg] = key_embed(st[tl][rg], (unsigned)(32 * tl + (rg & 3) + 8 * (rg >> 2)) | ((unsigned)hh << 2), 0xffffff80u);
    float g0[16], g1[16], g2[16], g3[16];
#pragma unroll
    for (int rg = 0; rg < 16; ++rg) { g0[rg] = st[0][rg]; g1[rg] = st[1][rg]; g2[rg] = st[2][rg]; g3[rg] = st[3][rg]; }
    bitonic_desc<16>(g0); bitonic_desc<16>(g1); bitonic_desc<16>(g2); bitonic_desc<16>(g3);
    merge_top16(g0, g1); merge_top16(g2, g3); merge_top16(g0, g2);
#pragma unroll
    for (int i = 0; i < 16; ++i) g1[i] = __shfl_xor(g0[i], 32);
    merge_top16(g0, g1);
#pragma unroll
    for (int i = 0; i < 16; ++i) out[i] = g0[i];
}

__device__ __forceinline__ void topk_unit(const Params& p, int li, int item, LAS unsigned char* lds) {
    const int tid = threadIdx.x, lane = tid & 63, wave = __builtin_amdgcn_readfirstlane(tid >> 6);
    const int r32 = lane & 31, hh = lane >> 5;
    const int tile = item >> 3, h = item & 7;
    const int t = tile * 256 + 32 * wave + r32;
    const bf16* QRY = (const bf16*)(p.ws + WS_QRY);
    const bf16* KB = (const bf16*)(p.ws + WS_KEYS) + (size_t)((li * 8 + h) * 2) * 128 * 128;
    int* RI = (int*)(p.ws + WS_RI); float* RG = (float*)(p.ws + WS_RG);
    RGN_T0(10)
    bf16x8_t qfA[8], qfB[8];
#pragma unroll
    for (int ks = 0; ks < 8; ++ks) { qfA[ks] = *(const bf16x8_t*)(QRY + (size_t)t * 2048 + h * 256 + 64 * hh + 8 * ks); qfB[ks] = *(const bf16x8_t*)(QRY + (size_t)t * 2048 + h * 256 + 128 + 64 * hh + 8 * ks); }
#pragma unroll 4
    for (int idx = tid; idx < 2 * 128 * 16; idx += NTHR) {
        const int pp = idx >> 11, n = (idx >> 4) & 127, c = idx & 15;
        const u32x4 v = *(const u32x4*)(KB + (size_t)(pp * 128 + n) * 128 + c * 8);
        *(LAS u32x4*)(lds + pp * 32768 + n * 256 + ((c ^ (n & 15)) << 4)) = v;
    }
    __syncthreads();
    RGN_T1(10, lds)
    RGN_T0(11)
    float sk0[16], sk1[16];
    topk_half(qfA, lds, r32, hh, sk0);
    RGN_T1(11, lds)
    RGN_T0(12)
    topk_half(qfB, lds + 32768, r32, hh, sk1);
    RGN_T1(12, lds)
    RGN_T0(13)
    unsigned i1s[16], i2[16];
#pragma unroll
    for (int a = 0; a < 16; ++a) { i1s[a] = (__float_as_uint(sk0[a]) & 127u) << 7; i2[a] = __float_as_uint(sk1[a]) & 127u; }
    float cd[50];
    {
        constexpr int CA[50] = {0, 0, 0, 0, 0, 0, 0, 0, 0, 0, 0, 0, 0, 0, 0, 0, 1, 1, 1, 1, 1, 1, 1, 1, 2, 2, 2, 2, 2, 3, 3, 3, 3, 4, 4, 4, 5, 5, 6, 6, 7, 7, 8, 9, 10, 11, 12, 13, 14, 15};
        constexpr int CB[50] = {0, 1, 2, 3, 4, 5, 6, 7, 8, 9, 10, 11, 12, 13, 14, 15, 0, 1, 2, 3, 4, 5, 6, 7, 0, 1, 2, 3, 4, 0, 1, 2, 3, 0, 1, 2, 0, 1, 0, 1, 0, 1, 0, 0, 0, 0, 0, 0, 0, 0};
#pragma unroll
        for (int n = 0; n < 50; ++n) cd[n] = key_embed(sk0[CA[n]] + sk1[CB[n]], i1s[CA[n]] | i2[CB[n]], 0xffffc000u);
    }
    float sel[16], h1[16], h2[16], h3[16];
#pragma unroll
    for (int i = 0; i < 16; ++i) { sel[i] = cd[i]; h1[i] = cd[16 + i]; h2[i] = cd[32 + i]; h3[i] = -INFINITY; }
    h3[0] = fmaxf(cd[48], cd[49]); h3[1] = fminf(cd[48], cd[49]);
    bitonic_desc<16>(sel); bitonic_desc<16>(h1); bitonic_desc<16>(h2);
    merge_top16(sel, h1); merge_top16(h2, h3); merge_top16(sel, h2);
    float ev[16], es = 0.f;
    const float m0 = __uint_as_float((__float_as_uint(sel[0]) & 0xffffc000u) | 0x2000u);
#pragma unroll
    for (int k = 0; k < 16; ++k) { const float vk = __uint_as_float((__float_as_uint(sel[k]) & 0xffffc000u) | 0x2000u); ev[k] = __expf(vk - m0); es += ev[k]; }
    const float rs = 1.0f / es;
    int oi[8]; float og[8];
#pragma unroll
    for (int k = 0; k < 8; ++k) { float s_lo = sel[k], s_hi = sel[k + 8], g_lo = ev[k], g_hi = ev[k + 8]; asm volatile("" : "+v"(s_lo), "+v"(s_hi), "+v"(g_lo), "+v"(g_hi));
        const float sv = hh ? s_hi : s_lo; const float gv = hh ? g_hi : g_lo; oi[k] = (int)(__float_as_uint(sv) & 0x3fffu); og[k] = gv * rs; }
    int* rip = RI + (size_t)t * 128 + h * 16 + 8 * hh; float* rgp = RG + (size_t)t * 128 + h * 16 + 8 * hh;
    *(int4*)rip = make_int4(oi[0], oi[1], oi[2], oi[3]); *(int4*)(rip + 4) = make_int4(oi[4], oi[5], oi[6], oi[7]);
    *(float4*)rgp = make_float4(og[0], og[1], og[2], og[3]); *(float4*)(rgp + 4) = make_float4(og[4], og[5], og[6], og[7]);
    __syncthreads();
    RGN_T1(13, lds)
}

template <bool SIGNED>
__device__ __forceinline__ void quant_rows(const float* src, unsigned char* dst, float* scl, int lane, int gw, int NGW) {
    for (int r0 = gw; r0 < 16384; r0 += 2 * NGW) {
        float4 a[2][4]; float am[2];
#pragma unroll
        for (int u = 0; u < 2; ++u) { const int r = (r0 + u * NGW < 16384) ? r0 + u * NGW : r0; const float4* s4 = (const float4*)(src + (size_t)r * 1024 + 16 * lane);
#pragma unroll
            for (int j = 0; j < 4; ++j) a[u][j] = s4[j]; }
#pragma unroll
        for (int u = 0; u < 2; ++u) { float m = 0.f;
#pragma unroll
            for (int j = 0; j < 4; ++j) m = fmaxf(m, fmaxf(fmaxf(fabsf(a[u][j].x), fabsf(a[u][j].y)), fmaxf(fabsf(a[u][j].z), fabsf(a[u][j].w))));
            am[u] = m; }
#pragma unroll
        for (int o = 1; o < 64; o <<= 1) { am[0] = fmaxf(am[0], __shfl_xor(am[0], o)); am[1] = fmaxf(am[1], __shfl_xor(am[1], o)); }
#pragma unroll
        for (int u = 0; u < 2; ++u) {
            const int r = r0 + u * NGW;
            if (r < 16384) {
                const float inv = am[u] > 0.f ? 127.0f / am[u] : 0.f;
                unsigned w[4];
#pragma unroll
                for (int j = 0; j < 4; ++j) {
                    constexpr int OFS = SIGNED ? 0 : 128;
                    const unsigned q0 = (unsigned)(__float2int_rn(a[u][j].x * inv) + OFS) & 0xffu, q1 = (unsigned)(__float2int_rn(a[u][j].y * inv) + OFS) & 0xffu, q2 = (unsigned)(__float2int_rn(a[u][j].z * inv) + OFS) & 0xffu, q3 = (unsigned)(__float2int_rn(a[u][j].w * inv) + OFS) & 0xffu;
                    w[j] = q0 | (q1 << 8) | (q2 << 16) | (q3 << 24);
                }
                *(uint4*)(dst + (size_t)(lane >> 3) * (16384 * 128) + (size_t)r * 128 + 16 * (lane & 7)) = make_uint4(w[0], w[1], w[2], w[3]);
                if (lane == 0) scl[r] = am[u] * (1.0f / 127.0f);
            }
        }
    }
}

__device__ __forceinline__ void ub4(unsigned w, float* o) { o[0] = (float)(w & 0xffu); o[1] = (float)((w >> 8) & 0xffu); o[2] = (float)((w >> 16) & 0xffu); o[3] = (float)(w >> 24); }


struct SlicePlan { int m, mi, wid, wstride; };
__device__ __forceinline__ SlicePlan slice_plan(const Params& p, unsigned rank, int wave) {
    unsigned* bar = (unsigned*)(p.ws + WS_CTL) + 1024;
    const unsigned x = xb_xcc_id();
    SlicePlan sp; sp.m = 0; sp.mi = 0; int nloc = 1;
#pragma unroll
    for (unsigned j = 0; j < 16; ++j) { const unsigned c = xb_ld(&bar[XB_XCNT(j)]); if (j == x) { sp.mi = sp.m; nloc = (int)c; } if (c > 0u) ++sp.m; }
    sp.wid = (int)rank * NWAVE + wave; sp.wstride = nloc * NWAVE;
    return sp;
}
#define PEER_TPW 16
__device__ __forceinline__ int peer_tok(int n, int wid, int wstride) { return ((n >> 4) * wstride + wid) * PEER_TPW + (n & 15); }
typedef int i32x4v __attribute__((ext_vector_type(4)));
__device__ __forceinline__ int sum8_dpp(int d) {
    d += __builtin_amdgcn_update_dpp(0, d, 0xB1, 0xF, 0xF, true);
    d += __builtin_amdgcn_update_dpp(0, d, 0x4E, 0xF, 0xF, true);
    d += __builtin_amdgcn_update_dpp(0, d, 0x141, 0xF, 0xF, true);
    return d;
}
__device__ __forceinline__ void peer_u_slice(const Params& p, int xs, int wid, int wstride, int lane, LAS unsigned char* ldsw) {
    const int* RI = (const int*)(p.ws + WS_RI);
    const signed char* X1Q = (const signed char*)(p.ws + WS_X1Q); const signed char* UQ = (const signed char*)(p.ws + WS_UQ);
    int* PI = (int*)(p.ws + WS_PI) + (size_t)xs * NT * 128;
    const int g = lane >> 3, q = lane & 7;
    const auto urs = __builtin_amdgcn_make_buffer_rsrc((void*)(UQ + (size_t)xs * (16384 * 128)), 0, 16384 * 128, 0x00020000);
    const unsigned lq = 16u * (unsigned)q;
    const int ngrp = (NT / PEER_TPW - wid + wstride - 1) / wstride, N = ngrp * PEER_TPW;
    if (N <= 0) return;
    int4 uA[16], uB[16];
#define TK(n) peer_tok((n), wid, wstride)
#define PU_U(U, n) do { const LAS i32x4v* rp_ = (const LAS i32x4v*)(ldsw + ((n) & 15) * 512 + 64 * g); _Pragma("unroll") for (int b4 = 0; b4 < 4; ++b4) { const i32x4v e_ = rp_[b4]; \
        { const u32x4 r_ = __builtin_amdgcn_raw_buffer_load_b128(urs, ((unsigned)e_.x << 7) + lq, 0, 0); U[4 * b4 + 0] = make_int4((int)r_.x, (int)r_.y, (int)r_.z, (int)r_.w); } \
        { const u32x4 r_ = __builtin_amdgcn_raw_buffer_load_b128(urs, ((unsigned)e_.y << 7) + lq, 0, 0); U[4 * b4 + 1] = make_int4((int)r_.x, (int)r_.y, (int)r_.z, (int)r_.w); } \
        { const u32x4 r_ = __builtin_amdgcn_raw_buffer_load_b128(urs, ((unsigned)e_.z << 7) + lq, 0, 0); U[4 * b4 + 2] = make_int4((int)r_.x, (int)r_.y, (int)r_.z, (int)r_.w); } \
        { const u32x4 r_ = __builtin_amdgcn_raw_buffer_load_b128(urs, ((unsigned)e_.w << 7) + lq, 0, 0); U[4 * b4 + 3] = make_int4((int)r_.x, (int)r_.y, (int)r_.z, (int)r_.w); } } } while (0)
#define PU_C(U, n) do { const i32x4v X = *(const LAS i32x4v*)(ldsw + 8192 + ((n) & 15) * 128 + 16 * q); int lo_ = 0, hi_ = 0; _Pragma("unroll") for (int bt = 0; bt < 16; ++bt) { \
        int d = __builtin_amdgcn_sdot4(X.x, U[bt].x, 0, false); d = __builtin_amdgcn_sdot4(X.y, U[bt].y, d, false); d = __builtin_amdgcn_sdot4(X.z, U[bt].z, d, false); d = __builtin_amdgcn_sdot4(X.w, U[bt].w, d, false); \
        d = sum8_dpp(d); if (bt & 1) hi_ = (q == (bt >> 1)) ? d : hi_; else lo_ = (q == (bt >> 1)) ? d : lo_; } \
        *(int2*)(PI + (size_t)TK(n) * 128 + 16 * g + 2 * q) = make_int2(lo_, hi_); } while (0)
#define PU_FENCE() asm volatile("" ::: "memory")
#pragma unroll
    for (int c = 0; c < 4; ++c) { const int* gs = RI + (size_t)TK(0) * 128 + c * 512 + lane * 4; const int4 r0 = *(const int4*)gs, r1 = *(const int4*)(gs + 256);
        *(LAS i32x4v*)(ldsw + c * 2048 + lane * 16) = (i32x4v){r0.x, r0.y, r0.z, r0.w}; *(LAS i32x4v*)(ldsw + c * 2048 + 1024 + lane * 16) = (i32x4v){r1.x, r1.y, r1.z, r1.w};
        if (lane < 32) { const int4 xr = *(const int4*)(X1Q + (size_t)(TK(0) + 4 * c + (lane >> 3)) * DM + 128 * xs + 16 * (lane & 7)); *(LAS i32x4v*)(ldsw + 8192 + c * 512 + lane * 16) = (i32x4v){xr.x, xr.y, xr.z, xr.w}; } }
    PU_FENCE();
    PU_U(uA, 0);
#pragma unroll 1
    for (int i = 0; i < N; i += 4) {
        const int kn = (i >> 4) + 1, ch = (i >> 2) & 3; const bool pf = kn < ngrp;
        int4 r0 = make_int4(0, 0, 0, 0), r1 = make_int4(0, 0, 0, 0), rx = make_int4(0, 0, 0, 0);
        if (pf) { const int tn = TK(16 * kn); const int* gs = RI + (size_t)tn * 128 + ch * 512 + lane * 4; r0 = *(const int4*)gs; r1 = *(const int4*)(gs + 256);
            if (lane < 32) rx = *(const int4*)(X1Q + (size_t)(tn + 4 * ch + (lane >> 3)) * DM + 128 * xs + 16 * (lane & 7)); }
        PU_U(uB, i + 1);                  PU_FENCE(); PU_C(uA, i);
        if (i + 2 < N) PU_U(uA, i + 2);   PU_FENCE(); PU_C(uB, i + 1);
        if (i + 3 < N) PU_U(uB, i + 3);   PU_FENCE(); PU_C(uA, i + 2);
        if (i + 4 < N) PU_U(uA, i + 4);   PU_FENCE(); PU_C(uB, i + 3);
        if (pf) { LAS unsigned char* d = ldsw + ch * 2048 + lane * 16; *(LAS i32x4v*)d = (i32x4v){r0.x, r0.y, r0.z, r0.w}; *(LAS i32x4v*)(d + 1024) = (i32x4v){r1.x, r1.y, r1.z, r1.w};
            if (lane < 32) *(LAS i32x4v*)(ldsw + 8192 + ch * 512 + lane * 16) = (i32x4v){rx.x, rx.y, rx.z, rx.w}; }
        PU_FENCE();
    }
#undef PU_U
#undef PU_C
#undef PU_FENCE
}
__device__ __forceinline__ void peer_coef_tokens4(const Params& p, int tA, int tstep, int lane) {
    const int* RI = (const int*)(p.ws + WS_RI); const float* RG = (const float*)(p.ws + WS_RG);
    const float* US = (const float*)(p.ws + WS_US); const float* VS = (const float*)(p.ws + WS_VS);
    const int* PI = (const int*)(p.ws + WS_PI);
    signed char* PC = (signed char*)(p.ws + WS_PC); float* PCS = (float*)(p.ws + WS_PCS);
    const int hw = lane >> 5, l32 = lane & 31;
    int4 e[2], acc[2]; float4 rg[2]; float sx[2]; int tt[2];
#pragma unroll
    for (int u = 0; u < 2; ++u) { const int tr = tA + (2 * u + hw) * tstep; const int t = tr < NT ? tr : tA; tt[u] = tr;
        sx[u] = ((const float*)(p.ws + WS_X1S))[t];
        e[u] = *(const int4*)(RI + (size_t)t * 128 + 4 * l32); rg[u] = *(const float4*)(RG + (size_t)t * 128 + 4 * l32);
        int4 a = make_int4(0, 0, 0, 0);
#pragma unroll
        for (int x = 0; x < 8; ++x) { const int4 pv = *(const int4*)(PI + ((size_t)x * NT + t) * 128 + 4 * l32); a.x += pv.x; a.y += pv.y; a.z += pv.z; a.w += pv.w; }
        acc[u] = a; }
    float su[2][4], sv[2][4];
#pragma unroll
    for (int u = 0; u < 2; ++u) { const int ee[4] = {e[u].x, e[u].y, e[u].z, e[u].w};
#pragma unroll
        for (int k = 0; k < 4; ++k) { su[u][k] = US[ee[k]]; sv[u][k] = VS[ee[k]]; } }
    float c[2][4], cm[2];
#pragma unroll
    for (int u = 0; u < 2; ++u) { const int aa[4] = {acc[u].x, acc[u].y, acc[u].z, acc[u].w}; const float gg[4] = {rg[u].x, rg[u].y, rg[u].z, rg[u].w}; cm[u] = 0.f;
#pragma unroll
        for (int k = 0; k < 4; ++k) { const float dot = su[u][k] * sx[u] * (float)aa[k]; c[u][k] = 0.5f * dot * (1.0f + erff(dot * 0.70710678118f)) * gg[k] * sv[u][k]; cm[u] = fmaxf(cm[u], fabsf(c[u][k])); } }
#pragma unroll
    for (int o = 1; o < 32; o <<= 1) { cm[0] = fmaxf(cm[0], __shfl_xor(cm[0], o)); cm[1] = fmaxf(cm[1], __shfl_xor(cm[1], o)); }
#pragma unroll
    for (int u = 0; u < 2; ++u) {
        const int t = tt[u];
        if (t < NT) {
            const float inv = cm[u] > 0.f ? 127.0f / cm[u] : 0.f;
            const unsigned q0 = (unsigned)__float2int_rn(c[u][0] * inv) & 0xffu, q1 = (unsigned)__float2int_rn(c[u][1] * inv) & 0xffu, q2 = (unsigned)__float2int_rn(c[u][2] * inv) & 0xffu, q3 = (unsigned)__float2int_rn(c[u][3] * inv) & 0xffu;
            *(unsigned*)(PC + (size_t)t * 128 + 4 * l32) = q0 | (q1 << 8) | (q2 << 16) | (q3 << 24);
            if (l32 == 0) PCS[t] = cm[u] * (1.0f / 127.0f);
        }
    }
}
__device__ __forceinline__ void peer_v_token(const uint4 (&vq)[16], const int4 cq, float cscale, bf16* yrow, int lane) {
    int acc[16];
#pragma unroll
    for (int j = 0; j < 16; ++j) acc[j] = 0;
    const int c4[4] = {cq.x, cq.y, cq.z, cq.w};
#pragma unroll
    for (int b4 = 0; b4 < 4; ++b4) {
#pragma unroll
        for (int dc = 0; dc < 4; ++dc) {
            const unsigned w0 = dc == 0 ? vq[4 * b4].x : dc == 1 ? vq[4 * b4].y : dc == 2 ? vq[4 * b4].z : vq[4 * b4].w;
            const unsigned w1 = dc == 0 ? vq[4 * b4 + 1].x : dc == 1 ? vq[4 * b4 + 1].y : dc == 2 ? vq[4 * b4 + 1].z : vq[4 * b4 + 1].w;
            const unsigned w2 = dc == 0 ? vq[4 * b4 + 2].x : dc == 1 ? vq[4 * b4 + 2].y : dc == 2 ? vq[4 * b4 + 2].z : vq[4 * b4 + 2].w;
            const unsigned w3 = dc == 0 ? vq[4 * b4 + 3].x : dc == 1 ? vq[4 * b4 + 3].y : dc == 2 ? vq[4 * b4 + 3].z : vq[4 * b4 + 3].w;
            const unsigned t0 = __builtin_amdgcn_perm(w1, w0, 0x05010400u), t1 = __builtin_amdgcn_perm(w1, w0, 0x07030602u);
            const unsigned t2 = __builtin_amdgcn_perm(w3, w2, 0x05010400u), t3 = __builtin_amdgcn_perm(w3, w2, 0x07030602u);
            const unsigned f0 = __builtin_amdgcn_perm(t2, t0, 0x05040100u), f1 = __builtin_amdgcn_perm(t2, t0, 0x07060302u);
            const unsigned f2 = __builtin_amdgcn_perm(t3, t1, 0x05040100u), f3 = __builtin_amdgcn_perm(t3, t1, 0x07060302u);
            acc[4 * dc + 0] = __builtin_amdgcn_sdot4((int)f0, c4[b4], acc[4 * dc + 0], false);
            acc[4 * dc + 1] = __builtin_amdgcn_sdot4((int)f1, c4[b4], acc[4 * dc + 1], false);
            acc[4 * dc + 2] = __builtin_amdgcn_sdot4((int)f2, c4[b4], acc[4 * dc + 2], false);
            acc[4 * dc + 3] = __builtin_amdgcn_sdot4((int)f3, c4[b4], acc[4 * dc + 3], false);
        }
    }
#pragma unroll
    for (int j = 0; j < 8; ++j) { const auto r = __builtin_amdgcn_permlane32_swap((unsigned)acc[j], (unsigned)acc[j + 8], false, false); acc[j] = (int)(r[0] + r[1]); }
#pragma unroll
    for (int j = 0; j < 4; ++j) { const auto r = __builtin_amdgcn_permlane16_swap((unsigned)acc[j], (unsigned)acc[j + 4], false, false); acc[j] = (int)(r[0] + r[1]); }
#pragma unroll
    for (int j = 0; j < 2; ++j) { const bool up = (lane & 8) != 0; const int send = up ? acc[j] : acc[j + 2]; const int keep = up ? acc[j + 2] : acc[j]; acc[j] = keep + __builtin_amdgcn_update_dpp(0, send, 0x128, 0xF, 0xF, true); }
    const int j0 = 2 * ((lane >> 3) & 1) + 4 * ((lane >> 4) & 1) + 8 * ((lane >> 5) & 1);
    *(unsigned*)(yrow + j0) = pk2((float)acc[0] * cscale, (float)acc[1] * cscale);
}
__device__ __forceinline__ void peer_v_slice(const Params& p, int xs, int wid, int wstride, int lane, LAS unsigned char* ldsw) {
    const int* RI = (const int*)(p.ws + WS_RI);
    const unsigned char* VQ = (const unsigned char*)(p.ws + WS_VQ);
    const signed char* PC = (const signed char*)(p.ws + WS_PC); const float* PCS = (const float*)(p.ws + WS_PCS);
    bf16* Y = (bf16*)(p.ws + WS_Y);
    const int g = lane >> 3, q = lane & 7, loff = 128 * xs + 16 * q;
    const auto vrs = __builtin_amdgcn_make_buffer_rsrc((void*)(VQ + (size_t)xs * (16384 * 128)), 0, 16384 * 128, 0x00020000);
    const unsigned lq = 16u * (unsigned)q;
    const int ngrp = (NT / PEER_TPW - wid + wstride - 1) / wstride, N = ngrp * PEER_TPW;
    if (N <= 0) return;
    uint4 vA[16], vB[16];
#define PV_U(V, n) do { const LAS i32x4v* rp_ = (const LAS i32x4v*)(ldsw + ((n) & 15) * 512 + 64 * g); _Pragma("unroll") for (int b4 = 0; b4 < 4; ++b4) { const i32x4v e_ = rp_[b4]; \
        { const u32x4 r_ = __builtin_amdgcn_raw_buffer_load_b128(vrs, ((unsigned)e_.x << 7) + lq, 0, 0); V[4 * b4 + 0] = make_uint4(r_.x, r_.y, r_.z, r_.w); } \
        { const u32x4 r_ = __builtin_amdgcn_raw_buffer_load_b128(vrs, ((unsigned)e_.y << 7) + lq, 0, 0); V[4 * b4 + 1] = make_uint4(r_.x, r_.y, r_.z, r_.w); } \
        { const u32x4 r_ = __builtin_amdgcn_raw_buffer_load_b128(vrs, ((unsigned)e_.z << 7) + lq, 0, 0); V[4 * b4 + 2] = make_uint4(r_.x, r_.y, r_.z, r_.w); } \
        { const u32x4 r_ = __builtin_amdgcn_raw_buffer_load_b128(vrs, ((unsigned)e_.w << 7) + lq, 0, 0); V[4 * b4 + 3] = make_uint4(r_.x, r_.y, r_.z, r_.w); } } } while (0)
#define PV_C(V, n) do { const i32x4v c_ = *(const LAS i32x4v*)(ldsw + 8192 + ((n) & 15) * 128 + 16 * g); const float o_ = *(const LAS float*)(ldsw + 10240 + ((n) & 15) * 4); \
        peer_v_token(V, make_int4(c_.x, c_.y, c_.z, c_.w), o_, Y + (size_t)TK(n) * DM + loff, lane); } while (0)
#define PV_FENCE() asm volatile("" ::: "memory")
#pragma unroll
    for (int c = 0; c < 4; ++c) { const int* gs = RI + (size_t)TK(0) * 128 + c * 512 + lane * 4; const int4 r0 = *(const int4*)gs, r1 = *(const int4*)(gs + 256);
        *(LAS i32x4v*)(ldsw + c * 2048 + lane * 16) = (i32x4v){r0.x, r0.y, r0.z, r0.w}; *(LAS i32x4v*)(ldsw + c * 2048 + 1024 + lane * 16) = (i32x4v){r1.x, r1.y, r1.z, r1.w};
        if (lane < 32) { const int4 cr = *(const int4*)(PC + (size_t)(TK(0) + 4 * c) * 128 + lane * 16); *(LAS i32x4v*)(ldsw + 8192 + c * 512 + lane * 16) = (i32x4v){cr.x, cr.y, cr.z, cr.w}; }
        if (lane < 4) *(LAS float*)(ldsw + 10240 + (4 * c + lane) * 4) = PCS[TK(0) + 4 * c + lane]; }
    PV_FENCE();
    PV_U(vA, 0);
#pragma unroll 1
    for (int i = 0; i < N; i += 4) {
        const int kn = (i >> 4) + 1, ch = (i >> 2) & 3; const bool pf = kn < ngrp;
        int4 r0 = make_int4(0, 0, 0, 0), r1 = make_int4(0, 0, 0, 0), rc = make_int4(0, 0, 0, 0); float rs = 0.f;
        if (pf) { const int tn = TK(16 * kn); const int* gs = RI + (size_t)tn * 128 + ch * 512 + lane * 4; r0 = *(const int4*)gs; r1 = *(const int4*)(gs + 256);
            if (lane < 32) rc = *(const int4*)(PC + (size_t)(tn + 4 * ch) * 128 + lane * 16);
            if (lane < 4) rs = PCS[tn + 4 * ch + lane]; }
        PV_U(vB, i + 1);                  PV_FENCE(); PV_C(vA, i);
        if (i + 2 < N) PV_U(vA, i + 2);   PV_FENCE(); PV_C(vB, i + 1);
        if (i + 3 < N) PV_U(vB, i + 3);   PV_FENCE(); PV_C(vA, i + 2);
        if (i + 4 < N) PV_U(vA, i + 4);   PV_FENCE(); PV_C(vB, i + 3);
        if (pf) { LAS unsigned char* d = ldsw + ch * 2048 + lane * 16; *(LAS i32x4v*)d = (i32x4v){r0.x, r0.y, r0.z, r0.w}; *(LAS i32x4v*)(d + 1024) = (i32x4v){r1.x, r1.y, r1.z, r1.w};
            if (lane < 32) *(LAS i32x4v*)(ldsw + 8192 + ch * 512 + lane * 16) = (i32x4v){rc.x, rc.y, rc.z, rc.w};
            if (lane < 4) *(LAS float*)(ldsw + 10240 + (4 * ch + lane) * 4) = rs; }
        PV_FENCE();
    }
#undef PV_U
#undef PV_C
#undef PV_FENCE
#undef TK
}
__device__ __forceinline__ void up4(const uint2 w, float* o) { o[0] = __uint_as_float(w.x << 16); o[1] = __uint_as_float(w.x & 0xffff0000u); o[2] = __uint_as_float(w.y << 16); o[3] = __uint_as_float(w.y & 0xffff0000u); }
template <int NB>
__device__ __forceinline__ void peer_ln_tokens(const Params& p, int li, int t0, int tstep, int lane) {
    const bf16* E = (const bf16*)(p.ws + WS_E); bf16* XB = (bf16*)(p.ws + WS_XB); const bf16* Y = (const bf16*)(p.ws + WS_Y);
    uint4 xr[NB][2], yr[NB][2], er[NB][2];
#pragma unroll
    for (int u = 0; u < NB; ++u) { const int t = (t0 + u * tstep < NT) ? t0 + u * tstep : t0;
#pragma unroll
        for (int j = 0; j < 2; ++j) { const size_t o = (size_t)t * DM + 512 * j + 8 * lane; xr[u][j] = *(const uint4*)(XB + o); yr[u][j] = *(const uint4*)(Y + o); er[u][j] = *(const uint4*)(E + o); } }
    const float* g2 = p.ln2_g + li * DM; const float* b2 = p.ln2_b + li * DM;
    float gg[16], bv[16];
#pragma unroll
    for (int j = 0; j < 2; ++j) { const float4 a0 = *(const float4*)(g2 + 512 * j + 8 * lane), a1 = *(const float4*)(g2 + 512 * j + 8 * lane + 4), c0 = *(const float4*)(b2 + 512 * j + 8 * lane), c1 = *(const float4*)(b2 + 512 * j + 8 * lane + 4);
        gg[8 * j] = a0.x; gg[8 * j + 1] = a0.y; gg[8 * j + 2] = a0.z; gg[8 * j + 3] = a0.w; gg[8 * j + 4] = a1.x; gg[8 * j + 5] = a1.y; gg[8 * j + 6] = a1.z; gg[8 * j + 7] = a1.w;
        bv[8 * j] = c0.x; bv[8 * j + 1] = c0.y; bv[8 * j + 2] = c0.z; bv[8 * j + 3] = c0.w; bv[8 * j + 4] = c1.x; bv[8 * j + 5] = c1.y; bv[8 * j + 6] = c1.z; bv[8 * j + 7] = c1.w; }
    float v[NB][16]; float s[NB];
#pragma unroll
    for (int u = 0; u < NB; ++u) { s[u] = 0.f;
#pragma unroll
        for (int j = 0; j < 2; ++j) { float x[8], y[8], e[8]; unpack8(xr[u][j], x); unpack8(yr[u][j], y); unpack8(er[u][j], e);
#pragma unroll
            for (int k = 0; k < 8; ++k) { v[u][8 * j + k] = DN_ALPHA * x[k] + y[k] + e[k]; s[u] += v[u][8 * j + k]; } } }
#pragma unroll
    for (int o = 1; o < 64; o <<= 1)
#pragma unroll
        for (int u = 0; u < NB; ++u) s[u] += __shfl_xor(s[u], o);
    float s2[NB];
#pragma unroll
    for (int u = 0; u < NB; ++u) { const float mean = s[u] * (1.0f / DM); s2[u] = 0.f;
#pragma unroll
        for (int e = 0; e < 16; ++e) { v[u][e] -= mean; s2[u] += v[u][e] * v[u][e]; } }
#pragma unroll
    for (int o = 1; o < 64; o <<= 1)
#pragma unroll
        for (int u = 0; u < NB; ++u) s2[u] += __shfl_xor(s2[u], o);
#pragma unroll
    for (int u = 0; u < NB; ++u) {
        const int t = t0 + u * tstep;
        if (t < NT) {
            const float rstd = 1.0f / sqrtf(s2[u] * (1.0f / DM) + LN_EPS);
            float o[16];
#pragma unroll
            for (int e = 0; e < 16; ++e) o[e] = v[u][e] * rstd * gg[e] + bv[e];
#pragma unroll
            for (int j = 0; j < 2; ++j) {
                if (li == 0) *(uint4*)(XB + (size_t)t * DM + 512 * j + 8 * lane) = make_uint4(pk2(o[8 * j], o[8 * j + 1]), pk2(o[8 * j + 2], o[8 * j + 3]), pk2(o[8 * j + 4], o[8 * j + 5]), pk2(o[8 * j + 6], o[8 * j + 7]));
                else { float* op = p.out + (size_t)t * DM + 512 * j + 8 * lane; *(float4*)op = make_float4(o[8 * j], o[8 * j + 1], o[8 * j + 2], o[8 * j + 3]); *(float4*)(op + 4) = make_float4(o[8 * j + 4], o[8 * j + 5], o[8 * j + 6], o[8 * j + 7]); }
            }
        }
    }
}

constexpr int PH_PER_LAYER = 12, NPHASE = 1 + 2 * PH_PER_LAYER;

#ifndef PROBE_DUP
#define PROBE_DUP 0
#endif
#define PH_BEGIN(k) if (lo <= (k) && (k) < hi && ((k) == 0 || PHON(((k) - 1) % PH_PER_LAYER))) for (int rep_ = 0; rep_ < (((k) > 0 && ((PROBE_DUP >> (((k) - 1) % PH_PER_LAYER)) & 1)) ? 2 : 1); ++rep_) { unsigned long long probe_t0 = 0; if ((PROBE_T >> PH_BIT(k)) & 1) probe_t0 = __builtin_amdgcn_s_memrealtime();
#define PH_SYNC_DUP() do { if (rep_ == 0) { asm volatile("s_waitcnt vmcnt(0)" ::: "memory"); __syncthreads(); } } while (0)
#ifndef PROBE_T
#define PROBE_T 0
#endif
#define PH_BIT(k) ((k) == 0 ? 15 : (((k) - 1) % PH_PER_LAYER))
#define PH_END(k) if ((k) + 1 < hi) xcd_barrier(bar); if ((PROBE_T >> PH_BIT(k)) & 1) { const unsigned long long tn_ = __builtin_amdgcn_s_memrealtime(); probe_ticks += tn_ - probe_t0; } }

template <int LI>
__device__ __forceinline__ void run_layer(const Params& p, float* lds, const XcdBarrier& bar, int lo, int hi, unsigned long long& probe_ticks, unsigned rank) {
    constexpr int li = LI, base = 1 + LI * PH_PER_LAYER;
    const int tid = threadIdx.x, lane = tid & 63, wave = __builtin_amdgcn_readfirstlane(tid >> 6);
    const int G = gridDim.x;
    float* stream = p.out;
    LAS unsigned char* ldsb = (LAS unsigned char*)lds;
    PH_BEGIN(base + 0)
        EpiZ16 e{(bf16*)(p.ws + WS_Z), (float*)(p.ws + WS_GATES), (const float*)(p.ws + WS_ACOS), (const float*)(p.ws + WS_ASIN)};
        gemm16(ldsb, (const bf16*)(p.ws + WS_XB), (const bf16*)(p.ws + WS_WIN) + (size_t)li * NZP * DM, NZP, DM, e);
    PH_END(base + 0)
    PH_BEGIN(base + 1)
        for (int it = blockIdx.x; it < 1024 + 1536; it += G) {
            if (it < 512) ret_state_u(p, 2 * it + (wave >> 2), ldsb + (wave >> 2) * UNIT_LDS, wave & 3, tid & 255, lane);
            else if (it < 1024) mls_state_u(p, li, 2 * (it - 512) + (wave >> 2), ldsb + (wave >> 2) * UNIT_LDS, wave & 3, tid & 255, lane);
            else attn_unit(p, it - 1024, ldsb);
        }
    PH_END(base + 1)
    PH_BEGIN(base + 2)
        p3_scans(p);
        attn_merge(p);
    PH_END(base + 2)
    PH_BEGIN(base + 3)
        for (int it = blockIdx.x; it < 1024; it += G) {
            if (it < 512) ret_out_u(p, li, 2 * it + (wave >> 2), ldsb + (wave >> 2) * UNIT_LDS, wave & 3, tid & 255, lane);
            else mls_out_u(p, li, 2 * (it - 512) + (wave >> 2), ldsb + (wave >> 2) * UNIT_LDS, wave & 3, tid & 255, lane);
        }
    PH_END(base + 3)
    PH_BEGIN(base + 4)
        EpiRes16 e{(const bf16*)(p.ws + WS_XB), (bf16*)(p.ws + WS_U16)};
        gemm16(ldsb, (const bf16*)(p.ws + WS_MIX), (const bf16*)(p.ws + WS_WOUT) + (size_t)li * DM * DM, DM, DM, e);
    PH_END(base + 4)
    PH_BEGIN(base + 5)
        for (int r = blockIdx.x * NWAVE + wave; r < NT; r += 4 * G * NWAVE) ln_rows<4>((const bf16*)(p.ws + WS_U16), (bf16*)(p.ws + WS_XB), (signed char*)(p.ws + WS_X1Q), (float*)(p.ws + WS_X1S), r, G * NWAVE, p.ln1_g + li * DM, p.ln1_b + li * DM, lane);
        quant_rows<true>(p.pu + (size_t)li * 16384 * 1024, (unsigned char*)(p.ws + WS_UQ), (float*)(p.ws + WS_US), lane, blockIdx.x * NWAVE + wave, G * NWAVE);
        quant_rows<true>(p.pv + (size_t)li * 16384 * 1024, (unsigned char*)(p.ws + WS_VQ), (float*)(p.ws + WS_VS), lane, blockIdx.x * NWAVE + wave, G * NWAVE);
        EpiBf16Store e{(bf16*)(p.ws + WS_E), DM};
        gemm16(ldsb, (const bf16*)(p.ws + WS_PB) + (size_t)li * NT * 256, (const bf16*)(p.ws + WS_WP) + (size_t)li * DM * 256, DM, 256, e);
    PH_END(base + 5)
    PH_BEGIN(base + 6)
        EpiBf16Store eq{(bf16*)(p.ws + WS_QRY), 2048};
        gemm16(ldsb, (const bf16*)(p.ws + WS_XB), (const bf16*)(p.ws + WS_WQG) + (size_t)li * 3072 * DM, 2048, DM, eq);
        EpiGate16 eg{(bf16*)(p.ws + WS_E), p.bg + li * DM};
        gemm16(ldsb, (const bf16*)(p.ws + WS_XB), (const bf16*)(p.ws + WS_WQG) + (size_t)li * 3072 * DM + (size_t)2048 * DM, DM, DM, eg);
    PH_END(base + 6)
    PH_BEGIN(base + 7)
        for (int it = blockIdx.x; it < (NT / 256) * 8; it += G) topk_unit(p, li, it, ldsb);
    PH_END(base + 7)
    PH_BEGIN(base + 8)
        const SlicePlan sp = slice_plan(p, rank, wave);
        for (int xs = 0; xs < 8; ++xs) if ((xs % sp.m) == sp.mi) peer_u_slice(p, xs, sp.wid, sp.wstride, lane, ldsb + wave * 12288);
    PH_END(base + 8)
    PH_BEGIN(base + 9)
        for (int t = blockIdx.x * NWAVE + wave; t < NT; t += 4 * G * NWAVE) peer_coef_tokens4(p, t, G * NWAVE, lane);
    PH_END(base + 9)
    PH_BEGIN(base + 10)
        const SlicePlan sp = slice_plan(p, rank, wave);
        for (int xs = 0; xs < 8; ++xs) if ((xs % sp.m) == sp.mi) peer_v_slice(p, xs, sp.wid, sp.wstride, lane, ldsb + wave * 12288);
    PH_END(base + 10)
    PH_BEGIN(base + 11)
        for (int t = blockIdx.x * NWAVE + wave; t < NT; t += 4 * G * NWAVE) peer_ln_tokens<4>(p, li, t, G * NWAVE, lane);
    PH_END(base + 11)
}

__global__ void __launch_bounds__(NTHR, 2) mk_fwd(Params p) {
    extern __shared__ __attribute__((aligned(16))) unsigned char lds_raw[];
    float* lds = (float*)lds_raw;
    const int tid = threadIdx.x;
    volatile LAS unsigned* MISC = (volatile LAS unsigned*)((LAS unsigned char*)lds_raw + LDS_CTL_OFF);
    if (tid < 64) MISC[tid] = 0u;
    __syncthreads();
    const int lo = p.ph_lo, hi = p.ph_hi;
    XcdBarrier bar; bar.bar = (unsigned*)(p.ws + WS_CTL) + 1024; bar.x = 0; bar.st = nullptr;
    if (hi - lo > 1) bar = xcd_barrier_post((unsigned*)(p.ws + WS_CTL) + 1024, MISC + 8);
    __syncthreads();
    const unsigned rank = MISC[10];
    unsigned long long probe_ticks = 0;
    PH_BEGIN(0)
        p0_tables(p);
        p0_weights(p, lds);
    PH_END(0)
    run_layer<0>(p, lds, bar, lo, hi, probe_ticks, rank);
    run_layer<1>(p, lds, bar, lo, hi, probe_ticks, rank);
    if (PROBE_R) { __syncthreads(); probe_ticks += ((volatile LAS unsigned*)((LAS unsigned char*)lds_raw + 159 * 1024 + 128))[0]; }
    if (PROBE_T || PROBE_R) { const unsigned long long te_ = __builtin_amdgcn_s_memrealtime(); while (__builtin_amdgcn_s_memrealtime() - te_ < probe_ticks) __builtin_amdgcn_s_sleep(8); }
}

extern "C" void kernel_launch(void* const* d_in, const int* in_sizes, int n_in, void* d_out, int out_size, void* d_ws, size_t ws_size, hipStream_t stream) {
    static int grid = 0;
    if (grid == 0) {
        if (n_in != 19 || in_sizes[0] != NT * DM || out_size != NT * DM || ws_size < WS_END) { fprintf(stderr, "kernel_launch: unexpected shapes (n_in %d in0 %d out %d ws %zu)\n", n_in, n_in > 0 ? in_sizes[0] : -1, out_size, ws_size); grid = -1; return; }
        int dev = 0, cus = 0;
        if (hipGetDevice(&dev) != hipSuccess || hipDeviceGetAttribute(&cus, hipDeviceAttributeMultiprocessorCount, dev) != hipSuccess) { grid = -1; return; }
        if (hipFuncSetAttribute((const void*)mk_fwd, hipFuncAttributeMaxDynamicSharedMemorySize, LDS_BYTES) != hipSuccess) { fprintf(stderr, "kernel_launch: hipFuncSetAttribute failed\n"); grid = -1; return; }
        int per_cu = 0;
        if (hipOccupancyMaxActiveBlocksPerMultiprocessor(&per_cu, (const void*)mk_fwd, NTHR, LDS_BYTES) != hipSuccess || per_cu < 1) fprintf(stderr, "kernel_launch: occupancy query says %d\n", per_cu);
        (void)hipGetLastError();
        grid = cus;
    }
    if (grid < 0) return;
    if (hipMemsetAsync((char*)d_ws + WS_CTL, 0, CTL_ZERO_BYTES, stream) != hipSuccess) return;
    Params a{};
    a.x = (const float*)d_in[0]; a.p = (const float*)d_in[1]; a.w_in = (const float*)d_in[2]; a.conv_w = (const float*)d_in[3]; a.b_if = (const float*)d_in[4];
    a.ret_g = (const float*)d_in[5]; a.mls_g = (const float*)d_in[6]; a.w_out = (const float*)d_in[7]; a.ln1_g = (const float*)d_in[8]; a.ln1_b = (const float*)d_in[9];
    a.wq = (const float*)d_in[10]; a.keys = (const float*)d_in[11]; a.pu = (const float*)d_in[12]; a.pv = (const float*)d_in[13]; a.wg = (const float*)d_in[14];
    a.bg = (const float*)d_in[15]; a.wp = (const float*)d_in[16]; a.ln2_g = (const float*)d_in[17]; a.ln2_b = (const float*)d_in[18];
    a.out = (float*)d_out; a.ws = (unsigned char*)d_ws;
#if MK_SPLIT
    for (int ph = 0; ph < NPHASE; ++ph) { a.ph_lo = ph; a.ph_hi = ph + 1; hipLaunchKernelGGL(mk_fwd, dim3(grid), dim3(NTHR), LDS_BYTES, stream, a); }
#else
    a.ph_lo = 0; a.ph_hi = NPHASE;
    hipLaunchKernelGGL(mk_fwd, dim3(grid), dim3(NTHR), LDS_BYTES, stream, a);
#endif
}
```
